# Optimizing an MI355X kernel written in HIP

```python
import math
import jax
import jax.numpy as jnp
from jax import lax
import numpy as np


D_MODEL = 1024
BATCH = 1
SEQ = 16384
DEPTH = 2

GRID_W = 64
CTX_LEN = 256
HEADS_A = 4
HD_A = 64
VD_A = 2 * HD_A
WIDTH_A = HEADS_A * VD_A
HEADS_B = 4
KV_HEADS_B = 2
REP_B = HEADS_B // KV_HEADS_B
HD_B = 64
WIDTH_B = HEADS_B * HD_B
WINDOW = 128
BLOCK = 128
CONV_CH = 256
CONV_K = 31
MIX_WIDTH = WIDTH_A + WIDTH_B + CONV_CH
SEG_QA = HEADS_A * 2 * HD_A
SEG_KA = HEADS_A * 2 * HD_A
SEG_VA = HEADS_A * VD_A
SEG_QB = HEADS_B * HD_B
SEG_KB = KV_HEADS_B * HD_B
SEG_VB = KV_HEADS_B * HD_B
SEG_UC = 2 * CONV_CH
IN_WIDTH = SEG_QA + SEG_KA + SEG_VA + SEG_QB + SEG_KB + SEG_VB + SEG_UC
SPLIT_POINTS = (SEG_QA,
                SEG_QA + SEG_KA,
                SEG_QA + SEG_KA + SEG_VA,
                SEG_QA + SEG_KA + SEG_VA + SEG_QB,
                SEG_QA + SEG_KA + SEG_VA + SEG_QB + SEG_KB,
                SEG_QA + SEG_KA + SEG_VA + SEG_QB + SEG_KB + SEG_VB)
N_EXPERTS = 16
N_GROUPS = 4
EXPERTS_PER_GROUP = N_EXPERTS // N_GROUPS
TOP_K = 2
EXPERT_FF = 512
ROPE_BASE = 10000.0
EPS = 1e-6
NEG_INF = -1e30

kernel_name = 'hybrid_diffusion_parallel_heads_moe'


def rmsnorm(x, g):
    xf = x.astype(jnp.float32)
    y = xf * lax.rsqrt(jnp.mean(xf * xf, axis=-1, keepdims=True) + EPS)
    return (y * g.astype(jnp.float32)).astype(x.dtype)


def modulate(h, shift, scale):
    return h * (1 + scale) + shift


def axial_rope_tables(n_tok, head_dim):
    rows = n_tok // GRID_W
    row = jnp.repeat(jnp.arange(rows, dtype=jnp.float32), GRID_W)
    col = jnp.tile(jnp.arange(GRID_W, dtype=jnp.float32), rows)
    pos = jnp.stack([row, col], axis=-1)
    n_freq = head_dim // 4
    inv = ROPE_BASE ** (-jnp.arange(n_freq, dtype=jnp.float32) / n_freq)
    ang = pos[:, :, None] * inv[None, None, :]
    return jnp.cos(ang), jnp.sin(ang)


def apply_axial_rope(x, cos, sin):
    shp = x.shape
    nf = shp[-1] // 4
    xr = x.reshape(shp[:-1] + (2, 2, nf))
    x1 = xr[..., 0, :]
    x2 = xr[..., 1, :]
    bshape = (1, shp[1]) + (1,) * (x.ndim - 3) + (2, nf)
    c = cos.reshape(bshape).astype(x.dtype)
    s = sin.reshape(bshape).astype(x.dtype)
    out = jnp.stack([x1 * c - x2 * s, x2 * c + x1 * s], axis=-2)
    return out.reshape(shp)


def diff_softmax_attend(q, k, v, lam):
    s = jnp.einsum('bqhmd,bkhmd->bhmqk', q, k).astype(jnp.float32) * (HD_A ** -0.5)
    p = jax.nn.softmax(s, axis=-1)
    a = p[:, :, 0] - lam * p[:, :, 1]
    return jnp.einsum('bhqk,bkhe->bqhe', a.astype(v.dtype), v)


def diff_attention_latent(q, k_all, v_all, lam):
    B, S = q.shape[:2]
    nb = S // BLOCK
    qb = jnp.moveaxis(q.reshape((B, nb, BLOCK) + q.shape[2:]), 1, 0)
    ob = lax.map(lambda qi: diff_softmax_attend(qi, k_all, v_all, lam), qb)
    return jnp.moveaxis(ob, 0, 1).reshape(B, S, HEADS_A, VD_A)


def diff_head_norm(o, g, lambda_init):
    of = o.astype(jnp.float32)
    y = of * lax.rsqrt(jnp.mean(of * of, axis=-1, keepdims=True) + EPS) * g.astype(jnp.float32)
    y = y * (1.0 - lambda_init)
    return y.reshape(o.shape[:2] + (WIDTH_A,)).astype(o.dtype)


def sink_softmax(scores, sink):
    full = jnp.concatenate([scores, jnp.broadcast_to(sink, scores.shape[:-1] + (1,))], axis=-1)
    return jax.nn.softmax(full, axis=-1)[..., :-1]


def window_sink_gqa_latent(q, k, v, kc, vc, sink):
    B, S = q.shape[:2]
    C = kc.shape[1]
    nb = S // BLOCK
    scale = HD_B ** -0.5
    qb = q.reshape(B, nb, BLOCK, KV_HEADS_B, REP_B, HD_B)
    pad = ((0, 0), (BLOCK, BLOCK), (0, 0), (0, 0))
    kp = jnp.pad(k, pad).reshape(B, nb + 2, BLOCK, KV_HEADS_B, HD_B)
    vp = jnp.pad(v, pad).reshape(B, nb + 2, BLOCK, KV_HEADS_B, HD_B)
    kband = jnp.concatenate([kp[:, :-2], kp[:, 1:-1], kp[:, 2:]], axis=2)
    vband = jnp.concatenate([vp[:, :-2], vp[:, 1:-1], vp[:, 2:]], axis=2)
    s_loc = jnp.einsum('bnqgrd,bnkgd->bngrqk', qb, kband).astype(jnp.float32) * scale
    blk = jnp.arange(nb)[:, None]
    qpos = blk * BLOCK + jnp.arange(BLOCK)[None, :]
    kpos = (blk - 1) * BLOCK + jnp.arange(3 * BLOCK)[None, :]
    valid = (jnp.abs(qpos[:, :, None] - kpos[:, None, :]) <= WINDOW) & (kpos >= 0)[:, None, :] & (kpos < S)[:, None, :]
    s_loc = jnp.where(valid[None, :, None, None], s_loc, NEG_INF)
    s_ctx = jnp.einsum('bnqgrd,bkgd->bngrqk', qb, kc).astype(jnp.float32) * scale
    sk = sink.astype(jnp.float32).reshape(KV_HEADS_B, REP_B)[None, None, :, :, None, None]
    p = sink_softmax(jnp.concatenate([s_ctx, s_loc], axis=-1), sk)
    p_ctx = p[..., :C].astype(v.dtype)
    p_loc = p[..., C:].astype(v.dtype)
    o = jnp.einsum('bngrqk,bkgd->bnqgrd', p_ctx, vc) + jnp.einsum('bngrqk,bnkgd->bnqgrd', p_loc, vband)
    return o.reshape(B, S, WIDTH_B)


def sink_gqa_context(q, k, v, sink):
    B, C = q.shape[:2]
    qg = q.reshape(B, C, KV_HEADS_B, REP_B, HD_B)
    s = jnp.einsum('bqgrd,bkgd->bgrqk', qg, k).astype(jnp.float32) * (HD_B ** -0.5)
    sk = sink.astype(jnp.float32).reshape(KV_HEADS_B, REP_B)[None, :, :, None, None]
    p = sink_softmax(s, sk)
    o = jnp.einsum('bgrqk,bkgd->bqgrd', p.astype(v.dtype), v)
    return o.reshape(B, C, WIDTH_B)


def conv_module(u, w, b, ln_g, ln_b):
    a, g = jnp.split(u, 2, axis=-1)
    z = a * jax.nn.sigmoid(g)
    z = lax.conv_general_dilated(z, w[:, None, :], window_strides=(1,),
                                 padding=[(CONV_K // 2, CONV_K // 2)],
                                 dimension_numbers=('NWC', 'WIO', 'NWC'),
                                 feature_group_count=CONV_CH) + b
    zf = z.astype(jnp.float32)
    mu = jnp.mean(zf, axis=-1, keepdims=True)
    var = jnp.mean(jnp.square(zf - mu), axis=-1, keepdims=True)
    zn = (zf - mu) * lax.rsqrt(var + EPS) * ln_g.astype(jnp.float32) + ln_b.astype(jnp.float32)
    return jax.nn.silu(zn).astype(u.dtype)


def grouped_moe(h, router_w, router_bias, w1, w3, w2):
    n = h.shape[0]
    s = jax.nn.sigmoid((h @ router_w).astype(jnp.float32))
    biased = s + router_bias.astype(jnp.float32)
    grp = lax.top_k(biased.reshape(n, N_GROUPS, EXPERTS_PER_GROUP), TOP_K)[0].sum(-1)
    g_sel = jnp.argmax(grp, axis=-1)
    in_grp = (jnp.arange(N_EXPERTS) // EXPERTS_PER_GROUP)[None, :] == g_sel[:, None]
    _, idx = lax.top_k(jnp.where(in_grp, biased, -jnp.inf), TOP_K)
    sel = jnp.take_along_axis(s, idx, axis=-1)
    wts = sel / jnp.sum(sel, axis=-1, keepdims=True)
    combine = jnp.sum(jax.nn.one_hot(idx, N_EXPERTS, dtype=jnp.float32) * wts[..., None], axis=1).astype(h.dtype)
    out = jnp.zeros_like(h)
    for e in range(N_EXPERTS):
        he = (jax.nn.silu(h @ w1[e]) * (h @ w3[e])) @ w2[e]
        out = out + combine[:, e:e + 1] * he
    return out


def setup_inputs(seed: int = 0) -> dict:
    key = jax.random.key(seed)
    ks = jax.random.split(key, 24)
    D = D_MODEL

    def nrm(k, shape, s):
        return jax.random.normal(k, shape, jnp.float32) * s

    return {
        'x': nrm(ks[0], (BATCH, SEQ, D), 1.0),
        'c': nrm(ks[1], (BATCH, D), 1.0),
        'ctx': nrm(ks[2], (BATCH, CTX_LEN, D), 1.0),
        'c_ctx': nrm(ks[3], (D,), 1.0),
        'w_ada': nrm(ks[4], (DEPTH, D, 6 * D), 0.5 * D ** -0.5),
        'b_ada': nrm(ks[5], (DEPTH, 6 * D), 0.02),
        'g_mix': 1.0 + nrm(ks[6], (DEPTH, D), 0.05),
        'w_in': nrm(ks[7], (DEPTH, D, IN_WIDTH), D ** -0.5),
        'diff_lambda': nrm(ks[8], (DEPTH, 4, HD_A), 0.1),
        'diff_norm_g': 1.0 + nrm(ks[9], (DEPTH, VD_A), 0.05),
        'attn_sink': nrm(ks[10], (DEPTH, HEADS_B), 0.5),
        'conv_w': nrm(ks[11], (DEPTH, CONV_K, CONV_CH), CONV_K ** -0.5),
        'conv_b': nrm(ks[12], (DEPTH, CONV_CH), 0.02),
        'conv_ln_g': 1.0 + nrm(ks[13], (DEPTH, CONV_CH), 0.05),
        'conv_ln_b': nrm(ks[14], (DEPTH, CONV_CH), 0.02),
        'w_out': nrm(ks[15], (DEPTH, MIX_WIDTH, D), MIX_WIDTH ** -0.5),
        'g_ffn': 1.0 + nrm(ks[16], (DEPTH, D), 0.05),
        'router_w': nrm(ks[17], (D, N_EXPERTS), D ** -0.5),
        'router_bias': nrm(ks[18], (N_EXPERTS,), 0.01),
        'w1': nrm(ks[19], (DEPTH, N_EXPERTS, D, EXPERT_FF), D ** -0.5),
        'w3': nrm(ks[20], (DEPTH, N_EXPERTS, D, EXPERT_FF), D ** -0.5),
        'w2': nrm(ks[21], (DEPTH, N_EXPERTS, EXPERT_FF, D), EXPERT_FF ** -0.5),
        'g_final': 1.0 + nrm(ks[22], (D,), 0.05),
    }


def reference(x, c, ctx, c_ctx, w_ada, b_ada, g_mix, w_in, diff_lambda, diff_norm_g, attn_sink,
              conv_w, conv_b, conv_ln_g, conv_ln_b, w_out, g_ffn, router_w, router_bias, w1, w3, w2, g_final):
    B, S, D = x.shape
    C = ctx.shape[1]
    cos, sin = axial_rope_tables(S, HD_A)
    xc = ctx
    silu_c = jax.nn.silu(c)
    silu_cc = jax.nn.silu(c_ctx)
    for l in range(DEPTH):
        last = l == DEPTH - 1
        mod = (silu_c @ w_ada[l] + b_ada[l]).reshape(B, 6, D)
        modc = (silu_cc @ w_ada[l] + b_ada[l]).reshape(6, D)

        h = modulate(rmsnorm(x, g_mix[l]), mod[:, 0, None], mod[:, 1, None])
        hc = modulate(rmsnorm(xc, g_mix[l]), modc[0], modc[1])
        qa, ka, va, qb, kb, vb, uc = jnp.split(h @ w_in[l], SPLIT_POINTS, axis=-1)
        qa_c, ka_c, va_c, qb_c, kb_c, vb_c, uc_c = jnp.split(hc @ w_in[l], SPLIT_POINTS, axis=-1)

        qa = apply_axial_rope(qa.reshape(B, S, HEADS_A, 2, HD_A), cos, sin)
        ka = apply_axial_rope(ka.reshape(B, S, HEADS_A, 2, HD_A), cos, sin)
        va = va.reshape(B, S, HEADS_A, VD_A)
        ka_c = ka_c.reshape(B, C, HEADS_A, 2, HD_A)
        va_c = va_c.reshape(B, C, HEADS_A, VD_A)
        qb = apply_axial_rope(qb.reshape(B, S, HEADS_B, HD_B), cos, sin)
        kb = apply_axial_rope(kb.reshape(B, S, KV_HEADS_B, HD_B), cos, sin)
        vb = vb.reshape(B, S, KV_HEADS_B, HD_B)
        kb_c = kb_c.reshape(B, C, KV_HEADS_B, HD_B)
        vb_c = vb_c.reshape(B, C, KV_HEADS_B, HD_B)

        lambda_init = 0.8 - 0.6 * math.exp(-0.3 * l)
        dl = diff_lambda[l].astype(jnp.float32)
        lam = jnp.exp(jnp.sum(dl[0] * dl[1])) - jnp.exp(jnp.sum(dl[2] * dl[3])) + lambda_init

        k_all = jnp.concatenate([ka_c, ka], axis=1)
        v_all = jnp.concatenate([va_c, va], axis=1)
        o_a = diff_head_norm(diff_attention_latent(qa, k_all, v_all, lam), diff_norm_g[l], lambda_init)
        o_b = window_sink_gqa_latent(qb, kb, vb, kb_c, vb_c, attn_sink[l])
        o_c = conv_module(uc, conv_w[l], conv_b[l], conv_ln_g[l], conv_ln_b[l])
        x = x + mod[:, 2, None] * (jnp.concatenate([o_a, o_b, o_c], axis=-1) @ w_out[l])

        if not last:
            o_ac = diff_head_norm(diff_softmax_attend(qa_c.reshape(B, C, HEADS_A, 2, HD_A), ka_c, va_c, lam),
                                  diff_norm_g[l], lambda_init)
            o_bc = sink_gqa_context(qb_c.reshape(B, C, HEADS_B, HD_B), kb_c, vb_c, attn_sink[l])
            o_cc = conv_module(uc_c, conv_w[l], conv_b[l], conv_ln_g[l], conv_ln_b[l])
            xc = xc + modc[2] * (jnp.concatenate([o_ac, o_bc, o_cc], axis=-1) @ w_out[l])

        h2 = modulate(rmsnorm(x, g_ffn[l]), mod[:, 3, None], mod[:, 4, None])
        if last:
            tokens = h2.reshape(B * S, D)
        else:
            h2c = modulate(rmsnorm(xc, g_ffn[l]), modc[3], modc[4])
            tokens = jnp.concatenate([h2.reshape(B * S, D), h2c.reshape(B * C, D)], axis=0)
        y = grouped_moe(tokens, router_w, router_bias, w1[l], w3[l], w2[l])
        x = x + mod[:, 5, None] * y[:B * S].reshape(B, S, D)
        if not last:
            xc = xc + modc[5] * y[B * S:].reshape(B, C, D)
    return rmsnorm(x, g_final)
```

```cpp
#define MK_PER_PHASE 0
#include <hip/hip_runtime.h>
#include <cstdio>
#include <cstdint>

#define GAS __attribute__((address_space(1)))
#define LAS __attribute__((address_space(3)))
typedef unsigned short bf16_t;
typedef short bf16x8 __attribute__((ext_vector_type(8)));
typedef short s16x4 __attribute__((ext_vector_type(4)));
typedef float f32x2 __attribute__((ext_vector_type(2)));
typedef float f32x4 __attribute__((ext_vector_type(4)));
typedef float f32x16 __attribute__((ext_vector_type(16)));
typedef unsigned u32x2 __attribute__((ext_vector_type(2)));
typedef unsigned u32x4 __attribute__((ext_vector_type(4)));
typedef GAS unsigned gu32;

constexpr int SEQ = 16384, CTX = 256, NROW = SEQ + CTX, DM = 1024, INW = 2560, NEXP = 16, FFE = 512, DEPTH = 2;
constexpr int XS_ROWS = 37376;
constexpr float EPS = 1e-6f, LOG2E = 1.4426950408889634f, QSCALE = 0.125f * 1.4426950408889634f;
constexpr int NWAVES = 8, NTHREADS = 512;

constexpr size_t MiB = 1u << 20;
constexpr size_t WS_CTL = 0, CTL_ZERO_BYTES = 128 * 1024;
constexpr size_t WS_MOD = 1 * MiB;
constexpr size_t WS_ROPEC = WS_MOD + 128 * 1024, WS_ROPES = WS_MOD + 192 * 1024;
constexpr size_t WS_LAM = WS_MOD + 256 * 1024;
constexpr size_t WS_CNT = WS_MOD + 320 * 1024;
constexpr size_t WS_TSG = WS_MOD + 384 * 1024;
constexpr size_t WS_TOKE = 2 * MiB, WS_TOKW = 2 * MiB + 256 * 1024, WS_TOKP = 2 * MiB + 512 * 1024;
constexpr size_t WS_ROWTOK = 3 * MiB;
constexpr size_t WS_WIN = 4 * MiB;
constexpr size_t WS_WOUT = 14 * MiB;
constexpr size_t WS_W13 = 18 * MiB;
constexpr size_t WS_W2 = 82 * MiB;
constexpr size_t WS_XB = 114 * MiB;
constexpr size_t WS_HB = 179 * MiB;
constexpr size_t WS_RA = 212 * MiB;
constexpr size_t RA_QA = WS_RA, RA_KA = RA_QA + (size_t)NROW * 512 * 2, RA_VA = RA_KA + (size_t)NROW * 512 * 2;
constexpr size_t RA_QB = RA_VA + (size_t)NROW * 512 * 2, RA_KB = RA_QB + (size_t)NROW * 256 * 2, RA_VB = RA_KB + (size_t)NROW * 128 * 2;
constexpr size_t RA_Z = RA_VB + (size_t)NROW * 256 * 2, RA_END = RA_Z + (size_t)NROW * 256 * 2;
constexpr size_t WS_RB = 290 * MiB;
constexpr size_t WS_ROWTOK2 = 327 * MiB;
constexpr size_t WS_END = 330 * MiB;
static_assert(RA_END <= WS_RB && WS_RA + (size_t)XS_ROWS * 2048 <= WS_RB && WS_RB + (size_t)XS_ROWS * 1024 <= WS_END && WS_RB + (size_t)256 * 256 * 128 * 4 <= WS_END, "ws map");
static_assert(WS_XB + (size_t)NROW * DM * 4 <= WS_HB && WS_HB + (size_t)NROW * DM * 2 <= WS_RA && WS_W13 + (size_t)2 * 16 * 1024 * 1024 * 2 <= WS_W2 && WS_W2 + (size_t)2 * 16 * 1024 * 512 * 2 <= WS_XB, "ws map 2");
constexpr int ROWCAP = 16640;
constexpr int CW_TOT = 24576;
constexpr int CW_MOEF = 28672;
constexpr int CW_OPC = 30720;
constexpr int CW_CTXC = 31232;
constexpr int CW_BAR = 4096;

constexpr int RING_BYTES = 131072;
constexpr int MISC_OFF = RING_BYTES;
constexpr int LDS_BYTES = 147456;

#define LDS_WAIT() asm volatile("s_waitcnt lgkmcnt(0)" ::: "memory")
#define VM_WAIT() asm volatile("s_waitcnt vmcnt(0)" ::: "memory")
__device__ __forceinline__ unsigned f2bf(float f) { unsigned u = __builtin_bit_cast(unsigned, f); return (u + 0x7fffu + ((u >> 16) & 1u)) >> 16; }
__device__ __forceinline__ unsigned pk2(float lo, float hi) { return f2bf(lo) | (f2bf(hi) << 16); }
__device__ __forceinline__ float bf2f(unsigned short b) { return __builtin_bit_cast(float, (unsigned)b << 16); }
__device__ __forceinline__ unsigned cvt_pk_bf16(float lo, float hi) { unsigned r; asm volatile("v_cvt_pk_bf16_f32 %0, %1, %2" : "=v"(r) : "v"(lo), "v"(hi)); return r; }
__device__ __forceinline__ float wave_sum(float v) {
#pragma unroll
    for (int o = 1; o < 64; o <<= 1) v += __shfl_xor(v, o);
    return v;
}
__device__ __forceinline__ f32x4 ld4bf(const bf16_t* p) { const u32x2 w = *(const u32x2*)p; return (f32x4){__builtin_bit_cast(float, w.x << 16), __builtin_bit_cast(float, w.x & 0xffff0000u), __builtin_bit_cast(float, w.y << 16), __builtin_bit_cast(float, w.y & 0xffff0000u)}; }
__device__ __forceinline__ void st4bf(bf16_t* p, const f32x4 v) { u32x2 w; w.x = cvt_pk_bf16(v.x, v.y); w.y = cvt_pk_bf16(v.z, v.w); *(u32x2*)p = w; }
__device__ __forceinline__ float silu_f(float a) { return a * __builtin_amdgcn_rcpf(1.f + __builtin_amdgcn_exp2f(-a * LOG2E)); }
__device__ __forceinline__ float sigmoid_f(float a) { return __builtin_amdgcn_rcpf(1.f + __builtin_amdgcn_exp2f(-a * LOG2E)); }
extern __shared__ __attribute__((aligned(16))) unsigned char g_lds[];
__device__ __forceinline__ int otid() {
    const unsigned slot = (unsigned)__builtin_amdgcn_s_getreg((5 << 11) | 4) & 63u;
    const int wave = ((const volatile LAS int*)((LAS unsigned char*)g_lds + MISC_OFF + 256))[slot];
    int ln; asm volatile("v_mbcnt_lo_u32_b32 %0, -1, 0\n\tv_mbcnt_hi_u32_b32 %0, -1, %0" : "=v"(ln));
    int t = (wave << 6) | ln;
    asm volatile("" : "+v"(t)); return t; }
namespace pg8 {
#define PG8_LAS __attribute__((address_space(3)))
constexpr int BM = 256, BK = 64, HALF = 128, HTB = HALF * BK * 2  , STAGE_BYTES = 8 * HTB, NXCD = 8, WGM = 8;

__host__ __device__ __forceinline__ int lds_byte(int r, int c) { const int st = (r >> 4) * 2 + (c >> 5), rr = r & 15, cc = c & 31, ob = rr * 64 + cc * 2; return st * 1024 + (ob ^ (((ob >> 9) & 1) << 5)); }
__host__ __device__ __forceinline__ void stage_rc(int b, int& R, int& C) { const int st = b / 1024, sb = b % 1024, swz = sb ^ (((sb >> 9) & 1) << 5); R = (st >> 1) * 16 + swz / 64; C = (st & 1) * 32 + (swz % 64) / 2; }
__host__ __device__ __forceinline__ int perm32(int rho) { const int n = rho >> 4, i = rho & 15; return 8 * (i >> 2) + 4 * n + (i & 3); }

struct Unit { int pm, pn, aux; };
struct Gemm { const bf16_t* A; const bf16_t* Bt; int M, N, K; };

struct StaticOrder {
    int nM, nN, nwg, G, c;
    __host__ __device__ void init(int M, int N, int G_, int c_) { nM = M / BM; nN = N / BM; nwg = nM * nN; G = G_; c = c_; }
    __host__ __device__ bool next(int i, Unit& u) const {
        const long L = (long)i * G + c; if (L >= nwg) return false;
        int wgid = (int)L; { const int q = nwg / NXCD, r = nwg % NXCD, xcd = wgid % NXCD, off = wgid / NXCD; wgid = (xcd < r ? xcd * (q + 1) : r * (q + 1) + (xcd - r) * q) + off; }
        const int nig = WGM * nN, gid = wgid / nig, fm = gid * WGM, gsz = (nM - fm) < WGM ? (nM - fm) : WGM;
        u.pm = fm + ((wgid % nig) % gsz); u.pn = (wgid % nig) / gsz; return true;
    }
    __host__ __device__ __forceinline__ int nloc() const { return c < nwg ? (nwg - c + G - 1) / G : 0; }
    __device__ __forceinline__ void a_ready(const Unit&) const {}
    __device__ __forceinline__ void done(const Unit&) const {}
};
template <class Epi, class Sched, bool ALIGN_EPI = false, bool SP2 = false, bool GATHER = false>
__device__ __forceinline__ void gemm_phase(PG8_LAS unsigned char* lds, const Gemm g, const Sched& S, const Epi& E) {
    const int tid = otid(), wid = __builtin_amdgcn_readfirstlane(tid >> 6), lane = tid & 63, wr = wid >> 2, wc = wid & 3, fr = lane & 15, fq = lane >> 4;
    const int K = g.K, nt = K / BK;
    unsigned voffA[2], voffB[2]; int rowA[2]; unsigned colA[2];
#pragma unroll
    for (int i = 0; i < 2; ++i) { int R, C; stage_rc(tid * 16 + i * 8192, R, C); const int Rb = Epi::PERM ? ((R & ~31) + perm32(R & 31)) : R;
        voffA[i] = (unsigned)(R * K + C) * 2u; voffB[i] = (unsigned)(Rb * K + C) * 2u; rowA[i] = R; colA[i] = (unsigned)C * 2u; }
    unsigned gc[2][2], gn[2][2];
#define PG8_GOFFS(dst, u) do { _Pragma("unroll") for (int h_ = 0; h_ < 2; ++h_) _Pragma("unroll") for (int i_ = 0; i_ < 2; ++i_) dst[h_][i_] = S.row_off((u), h_ * HALF + rowA[i_]) + colA[i_]; } while (0)
    const size_t kstep = (size_t)(BK * 2);
    const size_t hstep = (size_t)HALF * K * 2;
    const size_t tstep = 2 * hstep;
    const unsigned ldsw = (unsigned)wid * 1024u;
    const int aoff = lds_byte(wr * 64 + fr, fq * 8), boff = lds_byte(wc * 32 + fr, fq * 8);
#define PG8_SA(b, h) (((b) * 2 + (h)) * HTB)
#define PG8_SB(b, h) ((4 + (b) * 2 + (h)) * HTB)
#define PG8_STAGE(bufoff, gbase, voff) do { _Pragma("unroll") for (int _i = 0; _i < 2; ++_i) \
        __builtin_amdgcn_global_load_lds((const unsigned*)((const char*)(gbase) + (voff)[_i]), (PG8_LAS unsigned*)(lds + (bufoff) + ldsw + _i * 8192), 16, 0, 0); } while (0)
#define PG8_STAGE_A(bufoff, gbase, h, NX) do { _Pragma("unroll") for (int _i = 0; _i < 2; ++_i) { \
        const char* p_; if constexpr (GATHER) p_ = (const char*)(gbase) + ((NX) ? gn[h][_i] : gc[h][_i]); else p_ = (const char*)(gbase) + (h) * hstep + voffA[_i]; \
        __builtin_amdgcn_global_load_lds((const unsigned*)p_, (PG8_LAS unsigned*)(lds + (bufoff) + ldsw + _i * 8192), 16, 0, 0); } } while (0)
#define PG8_LDA(dst, b, h) do { _Pragma("unroll") for (int m = 0; m < 4; ++m) _Pragma("unroll") for (int k = 0; k < 2; ++k) dst[m][k] = *(const PG8_LAS bf16x8*)(lds + PG8_SA(b, h) + aoff + m * 2048 + k * 1024); } while (0)
#define PG8_LDB(dst, b, h) do { _Pragma("unroll") for (int n = 0; n < 2; ++n) _Pragma("unroll") for (int k = 0; k < 2; ++k) dst[n][k] = *(const PG8_LAS bf16x8*)(lds + PG8_SB(b, h) + boff + n * 2048 + k * 1024); } while (0)
#define PG8_MMA(ai, bj, At, Bt) do { __builtin_amdgcn_s_setprio(1); _Pragma("unroll") for (int m = 0; m < 4; ++m) _Pragma("unroll") for (int n = 0; n < 2; ++n) _Pragma("unroll") for (int k = 0; k < 2; ++k) \
        acc[ai][bj][m][n] = __builtin_amdgcn_mfma_f32_16x16x32_bf16(Bt[n][k], At[m][k], acc[ai][bj][m][n], 0, 0, 0); __builtin_amdgcn_s_setprio(0); } while (0)
#define PG8_WAIT_V(n) asm volatile("s_waitcnt vmcnt(" #n ")" ::: "memory")
#define PG8_WAIT_L(n) asm volatile("s_waitcnt lgkmcnt(" #n ")" ::: "memory")
#define PG8_BAR __builtin_amdgcn_s_barrier()
#define PG8_SCHED __builtin_amdgcn_sched_barrier(0)
    Unit cur, nxt; int ui = 0;
    if (!S.next(0, cur)) return;
    f32x4 acc[2][2][4][2];
#pragma unroll
    for (int a = 0; a < 2; ++a)
#pragma unroll
        for (int b = 0; b < 2; ++b)
#pragma unroll
            for (int m = 0; m < 4; ++m)
#pragma unroll
                for (int n = 0; n < 2; ++n) acc[a][b][m][n] = (f32x4){0.f, 0.f, 0.f, 0.f};
    bf16x8 At[4][2], B0[2][2], B1[2][2];
    const char* cA = GATHER ? (const char*)g.A : (const char*)g.A + (size_t)cur.pm * tstep; const char* cB = (const char*)g.Bt + (size_t)cur.pn * tstep;
    if constexpr (GATHER) { PG8_GOFFS(gc, cur); }
    S.a_ready(cur);
    if constexpr (SP2) {
        PG8_STAGE(PG8_SB(0, 0), cB, voffB); PG8_STAGE(PG8_SB(0, 1), cB + hstep, voffB); PG8_STAGE_A(PG8_SA(0, 0), cA, 0, false); PG8_STAGE_A(PG8_SA(0, 1), cA, 1, false);
        if (wr == 1) PG8_BAR;
        PG8_WAIT_V(2); PG8_BAR;
        PG8_STAGE(PG8_SB(1, 0), cB + kstep, voffB); PG8_STAGE_A(PG8_SA(1, 0), cA + kstep, 0, false); PG8_STAGE(PG8_SB(1, 1), cB + hstep + kstep, voffB);
        PG8_WAIT_V(6); PG8_BAR;
    } else {
        PG8_STAGE(PG8_SB(0, 0), cB, voffB); PG8_STAGE_A(PG8_SA(0, 0), cA, 0, false); PG8_STAGE(PG8_SB(0, 1), cB + hstep, voffB); PG8_STAGE_A(PG8_SA(0, 1), cA, 1, false);
        if (wr == 1) PG8_BAR;
        PG8_WAIT_V(4); PG8_BAR;
        PG8_STAGE(PG8_SB(1, 0), cB + kstep, voffB); PG8_STAGE_A(PG8_SA(1, 0), cA + kstep, 0, false); PG8_STAGE(PG8_SB(1, 1), cB + hstep + kstep, voffB);
        PG8_WAIT_V(6); PG8_BAR;
    }
    for (;;) {
        const bool has_next = S.next(ui + 1, nxt);
        if constexpr (GATHER) { if (has_next) { PG8_GOFFS(gn, nxt); } else {
#pragma unroll
            for (int h_ = 0; h_ < 2; ++h_) { gn[h_][0] = gc[h_][0]; gn[h_][1] = gc[h_][1]; } } }
        const char* nA = GATHER ? (const char*)g.A : has_next ? (const char*)g.A + (size_t)nxt.pm * tstep : cA; const char* nB = has_next ? (const char*)g.Bt + (size_t)nxt.pn * tstep : cB;
        for (int t = 0; t < nt; t += 2) {
            const bool last = (t == nt - 2);
            const char* a1 = cA + (size_t)(t + 1) * kstep;
            const char* a2 = last ? nA : cA + (size_t)(t + 2) * kstep; const char* b2 = last ? nB : cB + (size_t)(t + 2) * kstep;
            const char* a3 = a2 + kstep; const char* b3 = b2 + kstep;
            if (last && has_next) S.a_ready(nxt);
            if constexpr (SP2) {
            PG8_LDB(B0, 0, 0); PG8_LDB(B1, 0, 1); PG8_SCHED; PG8_LDA(At, 0, 0); PG8_STAGE_A(PG8_SA(1, 1), a1, 1, false);
            PG8_WAIT_V(8); PG8_WAIT_L(0); PG8_BAR; PG8_MMA(0, 0, At, B0); PG8_MMA(0, 1, At, B1); PG8_BAR; PG8_SCHED;
            PG8_LDA(At, 0, 1); PG8_STAGE(PG8_SB(0, 0), b2, voffB); PG8_STAGE(PG8_SB(0, 1), b2 + hstep, voffB); PG8_STAGE_A(PG8_SA(0, 0), a2, 0, last);
            PG8_WAIT_V(8); PG8_WAIT_L(0); PG8_BAR; PG8_MMA(1, 0, At, B0); PG8_MMA(1, 1, At, B1); PG8_BAR; PG8_SCHED;
            PG8_LDB(B0, 1, 0); PG8_LDB(B1, 1, 1); PG8_SCHED; PG8_LDA(At, 1, 0); PG8_STAGE_A(PG8_SA(0, 1), a2, 1, last);
            PG8_WAIT_V(8); PG8_WAIT_L(0); PG8_BAR; PG8_MMA(0, 0, At, B0); PG8_MMA(0, 1, At, B1); PG8_BAR; PG8_SCHED;
            PG8_LDA(At, 1, 1); PG8_STAGE(PG8_SB(1, 0), b3, voffB); PG8_STAGE(PG8_SB(1, 1), b3 + hstep, voffB); PG8_STAGE_A(PG8_SA(1, 0), a3, 0, last);
            PG8_WAIT_V(8); PG8_WAIT_L(0); PG8_BAR; PG8_MMA(1, 0, At, B0); PG8_MMA(1, 1, At, B1); PG8_BAR; PG8_SCHED;
            } else {
            PG8_LDB(B0, 0, 0); PG8_SCHED; PG8_LDA(At, 0, 0); PG8_STAGE_A(PG8_SA(1, 1), a1, 1, false);
            PG8_WAIT_L(8); PG8_BAR; PG8_WAIT_L(0); PG8_MMA(0, 0, At, B0); PG8_BAR; PG8_SCHED;
            PG8_LDB(B1, 0, 1); PG8_STAGE(PG8_SB(0, 0), b2, voffB);
            PG8_BAR; PG8_WAIT_L(0); PG8_MMA(0, 1, At, B1); PG8_BAR;
            PG8_LDA(At, 0, 1); PG8_STAGE_A(PG8_SA(0, 0), a2, 0, last);
            PG8_BAR; PG8_WAIT_L(0); PG8_MMA(1, 0, At, B0); PG8_BAR; PG8_SCHED;
            PG8_STAGE(PG8_SB(0, 1), b2 + hstep, voffB);
            PG8_WAIT_V(6); PG8_BAR; PG8_MMA(1, 1, At, B1); PG8_BAR;
            PG8_LDB(B0, 1, 0); PG8_SCHED; PG8_LDA(At, 1, 0); PG8_STAGE_A(PG8_SA(0, 1), a2, 1, last);
            PG8_WAIT_L(8); PG8_BAR; PG8_WAIT_L(0); PG8_MMA(0, 0, At, B0); PG8_BAR; PG8_SCHED;
            PG8_LDB(B1, 1, 1); PG8_STAGE(PG8_SB(1, 0), b3, voffB);
            PG8_BAR; PG8_WAIT_L(0); PG8_MMA(0, 1, At, B1); PG8_BAR;
            PG8_LDA(At, 1, 1); PG8_STAGE_A(PG8_SA(1, 0), a3, 0, last);
            PG8_BAR; PG8_WAIT_L(0); PG8_MMA(1, 0, At, B0); PG8_BAR; PG8_SCHED;
            PG8_STAGE(PG8_SB(1, 1), b3 + hstep, voffB);
            PG8_WAIT_V(6); PG8_BAR; PG8_MMA(1, 1, At, B1); PG8_BAR;
            }
        }
        if constexpr (ALIGN_EPI) { if (wr == 0) PG8_BAR; }
        if constexpr (!Epi::AFTER_DRAIN) { E(acc, cur, wr, wc, fr, fq); S.done(cur); }
        if (!has_next) break;
#pragma unroll
        for (int a = 0; a < 2; ++a)
#pragma unroll
            for (int b = 0; b < 2; ++b)
#pragma unroll
                for (int m = 0; m < 4; ++m)
#pragma unroll
                    for (int n = 0; n < 2; ++n) acc[a][b][m][n] = (f32x4){0.f, 0.f, 0.f, 0.f};
        cur = nxt; cA = nA; cB = nB; ++ui;
        if constexpr (GATHER) {
#pragma unroll
            for (int h_ = 0; h_ < 2; ++h_) { gc[h_][0] = gn[h_][0]; gc[h_][1] = gn[h_][1]; } }
        if constexpr (ALIGN_EPI) { if (wr == 1) PG8_BAR; }
    }
    PG8_WAIT_V(0);
    if constexpr (!ALIGN_EPI) { if (wr == 0) PG8_BAR; }
    PG8_BAR;
    if constexpr (Epi::AFTER_DRAIN) { E.fused(acc, cur, wr, wc, fr, fq, lds, wid, lane); S.done(cur); }
#undef PG8_SA
#undef PG8_SB
#undef PG8_STAGE
#undef PG8_STAGE_A
#undef PG8_GOFFS
#undef PG8_LDA
#undef PG8_LDB
#undef PG8_MMA
#undef PG8_WAIT_V
#undef PG8_WAIT_L
#undef PG8_BAR
#undef PG8_SCHED
}
}

namespace att2 {
constexpr int KSLOT = 8192, VSLOT = 16384, LDS_K = 0, LDS_V = 3 * KSLOT, LDS_WS = LDS_V + 3 * VSLOT, LDS_BYTES = LDS_WS + NWAVES * 256;
constexpr float THR = 8.f;
typedef LAS const char* lds_cptr;
typedef short v4i16_t __attribute__((ext_vector_type(4)));
typedef __bf16 bf2_t __attribute__((ext_vector_type(2)));
#define SBAR() __builtin_amdgcn_sched_barrier(0)
#define PIN(x) asm volatile("" : "+v"(x))
__device__ __forceinline__ int crow(int r, int hi) { return (r & 3) + 8 * (r >> 2) + 4 * hi; }
__device__ __forceinline__ f32x16 zero16() { float z = 0.f; asm volatile("" : "+v"(z)); f32x16 v;
#pragma unroll
    for (int r = 0; r < 16; ++r) v[r] = z;
    return v; }
__device__ __forceinline__ void glds16(const void* gsrc, unsigned lds_dst) { unsigned keep;
    asm volatile("s_mov_b32 %0, m0\n\ts_mov_b32 m0, %2\n\ts_nop 0\n\tglobal_load_lds_dwordx4 %1, off\n\ts_mov_b32 m0, %0" : "=&s"(keep) : "v"(gsrc), "s"(lds_dst) : "memory"); }
__device__ __forceinline__ bf16x8 kfrag(lds_cptr p) { return *(const LAS bf16x8*)p; }
__device__ __forceinline__ s16x4 vtr(lds_cptr p) { return __builtin_bit_cast(s16x4, __builtin_amdgcn_ds_read_tr16_b64_v4i16((LAS v4i16_t*)p)); }
__device__ __forceinline__ unsigned cvtpk_s(float lo, float hi) { typedef float f2 __attribute__((ext_vector_type(2))); typedef __bf16 b2 __attribute__((ext_vector_type(2)));
    f2 v = {lo, hi}; b2 b = __builtin_convertvector(v, b2); return __builtin_bit_cast(unsigned, b); }
#define MX3(a, b, c) __builtin_fmaxf(__builtin_fmaxf((a), (b)), (c))
__device__ __forceinline__ float rowmax(const f32x16& p0, const f32x16& p1) {
    float a = MX3(p0[0], p0[1], p1[0]), b = MX3(p0[2], p0[3], p1[1]); a = MX3(a, p1[2], p1[3]);
#pragma unroll
    for (int r = 4; r < 16; r += 4) { a = MX3(a, p0[r], p0[r + 1]); b = MX3(b, p0[r + 2], p0[r + 3]); a = MX3(a, p1[r], p1[r + 1]); b = MX3(b, p1[r + 2], p1[r + 3]); }
    float m = __builtin_fmaxf(a, b); auto rr = __builtin_amdgcn_permlane32_swap(__float_as_uint(m), __float_as_uint(m), false, false);
    return __builtin_fmaxf(__uint_as_float(rr[0]), __uint_as_float(rr[1])); }
__device__ __forceinline__ void wmask(f32x16& p0, f32x16& p1, int dk, int hi) {
#pragma unroll
    for (int r = 0; r < 16; ++r) { const int d = dk + crow(r, hi);
        if (d > 128 || d < -128) p0[r] = -1e30f;
        if (d + 32 > 128 || d + 32 < -128) p1[r] = -1e30f; } }
#define MFMA32(a, b, c) __builtin_amdgcn_mfma_f32_32x32x16_bf16(a, b, c, 0, 0, 0)
#define WAIT_BAR(N) asm volatile("s_waitcnt vmcnt(" #N ") lgkmcnt(0)\n\ts_barrier" ::: "memory")

template <int MODE, int LDK, int LDV, bool SAFE>
__device__ __forceinline__ void attn_body(const bf16_t* Qw, const bf16_t* Kh, const bf16_t* Vh, const int nA, const int a0, const int b0, const int NT, const int qpos,
                                          char* lds, const int tid, f32x16 (&o)[4], float& m_out, float& l_out) {
    constexpr int ND = (MODE == 1) ? 2 : 4, NVP = ND / 2;
    const int lane = tid & 63, r32 = lane & 31, hi = lane >> 5; const int wid = __builtin_amdgcn_readfirstlane(tid >> 6);
    const unsigned lds0 = (unsigned)(uintptr_t)lds; float* wsf = (float*)(lds + LDS_WS) + wid * 64;
#define KROW(t) ((t) < nA ? a0 + 64 * (t) : b0 + 64 * ((t) - nA))
    const bf16_t* ksrc = Kh + (size_t)lane * LDK + wid * 8;
    const bf16_t* vsrc = Vh + (size_t)(16 * (wid & 3) + (lane >> 2)) * LDV + (wid >> 2) * 32 + (lane & 3) * 8;
    const unsigned kdst = lds0 + LDS_K + wid * 1024, vdst = lds0 + LDS_V + (wid >> 2) * 4096 + (wid & 3) * 1024;
#define DMA_K(t, slot) glds16(ksrc + (size_t)KROW(t) * LDK, (unsigned)__builtin_amdgcn_readfirstlane(kdst + (slot) * KSLOT))
#define DMA_V(t, slot) do { const bf16_t* vs_ = vsrc + (size_t)KROW(t) * LDV; glds16(vs_, (unsigned)__builtin_amdgcn_readfirstlane(vdst + (slot) * VSLOT)); \
        if constexpr (NVP == 2) glds16(vs_ + 64, (unsigned)__builtin_amdgcn_readfirstlane(vdst + (slot) * VSLOT + 8192)); } while (0)
    const lds_cptr shm3 = (lds_cptr)(LAS char*)lds;
    const lds_cptr kp0 = shm3 + LDS_K + hi * 1024 + r32 * 16;
    const lds_cptr vp0 = shm3 + LDS_V + ((lane >> 4) & 1) * 32 + (lane & 3) * 8 + (4 * hi + ((lane & 15) >> 2)) * 64;
    bf16x8 qr[4];
#pragma unroll
    for (int d0 = 0; d0 < 4; ++d0) qr[d0] = *reinterpret_cast<const bf16x8*>(Qw + d0 * 16 + hi * 8);
    __syncthreads();
    if (wid >= 4) __builtin_amdgcn_s_setprio(1);
    DMA_K(0, 0); DMA_K(1, 1); DMA_V(0, 0);
    float mhat = 0.f, l_reg = 0.f;
#pragma unroll
    for (int d = 0; d < 4; ++d) o[d] = zero16();
    f32x16 negm = zero16(); PIN(negm);
    bool resc = false;
    if constexpr (NVP == 2) { WAIT_BAR(3); } else { WAIT_BAR(2); }
    f32x16 pA0, pA1, pB0, pB1;
    DMA_K(2, 2); DMA_V(1, 1);
    { bf16x8 kf[8];
#pragma unroll
      for (int i = 0; i < 8; ++i) kf[i] = kfrag(kp0 + (i >> 1) * 2048 + (i & 1) * 512);
      pA0 = MFMA32(kf[0], qr[0], negm); pA1 = MFMA32(kf[1], qr[0], negm); pA0 = MFMA32(kf[2], qr[1], pA0); pA1 = MFMA32(kf[3], qr[1], pA1);
      pA0 = MFMA32(kf[4], qr[2], pA0); pA1 = MFMA32(kf[5], qr[2], pA1); pA0 = MFMA32(kf[6], qr[3], pA0); pA1 = MFMA32(kf[7], qr[3], pA1); }
    if constexpr (MODE == 1) { if (0 >= nA) wmask(pA0, pA1, KROW(0) - qpos, hi); }
    { const float rm = rowmax(pA0, pA1); mhat = rm;
#pragma unroll
      for (int r = 0; r < 16; ++r) { pA0[r] = __builtin_amdgcn_exp2f(pA0[r] - rm); pA1[r] = __builtin_amdgcn_exp2f(pA1[r] - rm); }
#pragma unroll
      for (int r = 0; r < 16; ++r) negm[r] = -mhat;
      PIN(negm);
      if constexpr (!SAFE) { float s0 = 0.f, s1 = 0.f;
#pragma unroll
        for (int r = 0; r < 16; ++r) { s0 += pA0[r]; s1 += pA1[r]; }
        l_reg = s0 + s1; } }
    if constexpr (NVP == 2) { WAIT_BAR(3); } else { WAIT_BAR(2); }
    int sl_prev = 0, sl_cur = 1, sl_next = 2;
#define ROT() do { const int s_ = sl_prev; sl_prev = sl_cur; sl_cur = sl_next; sl_next = s_; } while (0)
#define RESC() do { if (resc) { asm volatile("s_waitcnt lgkmcnt(0)" ::: "memory"); \
        _Pragma("unroll") for (int d_ = 0; d_ < ND; ++d_) _Pragma("unroll") for (int r = 0; r < 16; ++r) o[d_][r] *= wsf[crow(r, hi)]; } } while (0)
    u32x4 pw0, pw1, pw2, pw3; s16x4 vl[16], vh[16]; bf16x8 kf[8]; float dummy_ = 0.f;
#define PAF(k) __builtin_bit_cast(bf16x8, pw##k)
#define VFR(i) (bf16x8){vl[i][0], vl[i][1], vl[i][2], vl[i][3], vh[i][0], vh[i][1], vh[i][2], vh[i][3]}
#define VRD(q, ks) do { if constexpr ((q) < ND) { vl[(q) * 4 + (ks)] = vtr(vp_ + ((q) * 4096 + (ks) * 1024)); vh[(q) * 4 + (ks)] = vtr(vp_ + ((q) * 4096 + (ks) * 1024 + 512)); } } while (0)
#define KRD(i) do { kf[i] = kfrag(kp_ + ((i) >> 1) * 2048 + ((i) & 1) * 512); } while (0)
#define PKW(P, i) cvtpk_s(P[i], P[i + 1])
#ifndef PROBE_VALU
#define PROBE_VALU 0
#endif
#ifndef ROWSUM_DOT2
#define ROWSUM_DOT2 0
#endif
#define DOT2(w, acc) __builtin_amdgcn_fdot2_f32_bf16(__builtin_bit_cast(bf2_t, (unsigned)(w)), __builtin_bit_cast(bf2_t, 0x3f803f80u), acc, false)
#define GAPA(MF, a0_, a1_, a2_, a3_, W0, W1, PW, i0_) do { MF; if (SAFE && !ROWSUM_DOT2) { sacc += a0_; sacb += a1_; sacc += a2_; sacb += a3_; PIN(sacc); PIN(sacb); } W0; W1; PIN(PW); \
        if (ROWSUM_DOT2) { sacc = DOT2(PW[i0_], sacc); sacb = DOT2(PW[(i0_) + 1], sacb); PIN(sacc); PIN(sacb); } SBAR(); } while (0)
#define EX(v) __builtin_amdgcn_exp2f(v)
#define GAPB(q, ks, X, i) do { if constexpr ((q) < ND) { o[q] = MFMA32(PAF(ks), VFR((q) * 4 + (ks)), o[q]); } X[i] = EX(X[i]); X[(i) + 1] = EX(X[(i) + 1]); X[(i) + 2] = EX(X[(i) + 2]); X[(i) + 3] = EX(X[(i) + 3]); PIN(X); SBAR(); } while (0)
#define GAPG(q, ks, ...) do { if constexpr ((q) < ND) { o[q] = MFMA32(PAF(ks), VFR((q) * 4 + (ks)), o[q]); } __VA_ARGS__; SBAR(); } while (0)
#define STEP(C0, C1, P0, P1, t, GK, GV) do { SBAR(); \
    const lds_cptr vp_ = vp0 + sl_prev * VSLOT; const lds_cptr kp_ = kp0 + sl_cur * KSLOT; \
    KRD(0); KRD(1); KRD(2); SBAR(); float sacc = (ROWSUM_DOT2 || !SAFE) ? 0.f : P0[0], sacb = (ROWSUM_DOT2 || !SAFE) ? 0.f : P0[1]; \
    KRD(3); SBAR();            GAPA(C0 = MFMA32(kf[0], qr[0], negm), P0[2], P0[3], P0[4], P0[5],     pw0[0] = PKW(P0, 0),  pw0[1] = PKW(P0, 2),  pw0, 0); \
    KRD(4); SBAR();            GAPA(C1 = MFMA32(kf[1], qr[0], negm), P0[6], P0[7], P0[8], P0[9],     pw0[2] = PKW(P0, 4),  pw0[3] = PKW(P0, 6),  pw0, 2); \
    KRD(5); SBAR();            GAPA(C0 = MFMA32(kf[2], qr[1], C0),   P0[10], P0[11], P0[12], P0[13], pw1[0] = PKW(P0, 8),  pw1[1] = PKW(P0, 10), pw1, 0); \
    KRD(6); SBAR();            GAPA(C1 = MFMA32(kf[3], qr[1], C1),   P0[14], P0[15], P1[0], P1[1],   pw1[2] = PKW(P0, 12), pw1[3] = PKW(P0, 14), pw1, 2); \
    KRD(7); VRD(0, 0); SBAR(); GAPA(C0 = MFMA32(kf[4], qr[2], C0),   P1[2], P1[3], P1[4], P1[5],     pw2[0] = PKW(P1, 0),  pw2[1] = PKW(P1, 2),  pw2, 0); \
            VRD(1, 0); SBAR(); GAPA(C1 = MFMA32(kf[5], qr[2], C1),   P1[6], P1[7], P1[8], P1[9],     pw2[2] = PKW(P1, 4),  pw2[3] = PKW(P1, 6),  pw2, 2); \
            VRD(2, 0); SBAR(); GAPA(C0 = MFMA32(kf[6], qr[3], C0),   P1[10], P1[11], P1[12], P1[13], pw3[0] = PKW(P1, 8),  pw3[1] = PKW(P1, 10), pw3, 0); \
            VRD(3, 0); SBAR(); GAPA(C1 = MFMA32(kf[7], qr[3], C1),   P1[14], P1[15], 0.f, 0.f,       pw3[2] = PKW(P1, 12), pw3[3] = PKW(P1, 14), pw3, 2); \
    if constexpr (SAFE) l_reg += sacc + sacb; \
    if constexpr (MODE == 1) { if ((t) >= nA) wmask(C0, C1, KROW(t) - qpos, hi); } \
    SBAR(); \
      \
      \
    if constexpr (!SAFE) { \
      \
    VRD(0, 1); SBAR(); GAPG(0, 0, C0[0] = EX(C0[0]); C0[1] = EX(C0[1]); PIN(C0)); \
    VRD(1, 1); SBAR(); GAPG(1, 0, C0[2] = EX(C0[2]); C0[3] = EX(C0[3]); sacc += C0[0]; sacb += C0[1]; PIN(C0); PIN(sacc); PIN(sacb)); \
    VRD(2, 1); SBAR(); GAPG(2, 0, C0[4] = EX(C0[4]); C0[5] = EX(C0[5]); sacc += C0[2]; sacb += C0[3]; PIN(C0); PIN(sacc); PIN(sacb)); \
    VRD(3, 1); SBAR(); GAPG(3, 0, C0[6] = EX(C0[6]); C0[7] = EX(C0[7]); sacc += C0[4]; sacb += C0[5]; PIN(C0); PIN(sacc); PIN(sacb)); \
    VRD(0, 2); SBAR(); GAPG(0, 1, C0[8] = EX(C0[8]); C0[9] = EX(C0[9]); sacc += C0[6]; sacb += C0[7]; PIN(C0); PIN(sacc); PIN(sacb)); \
    VRD(1, 2); SBAR(); GAPG(1, 1, C0[10] = EX(C0[10]); C0[11] = EX(C0[11]); sacc += C0[8]; sacb += C0[9]; PIN(C0); PIN(sacc); PIN(sacb)); \
    VRD(2, 2); SBAR(); GAPG(2, 1, C0[12] = EX(C0[12]); C0[13] = EX(C0[13]); sacc += C0[10]; sacb += C0[11]; PIN(C0); PIN(sacc); PIN(sacb)); \
    VRD(3, 2); SBAR(); GAPG(3, 1, C0[14] = EX(C0[14]); C0[15] = EX(C0[15]); sacc += C0[12]; sacb += C0[13]; PIN(C0); PIN(sacc); PIN(sacb)); \
    VRD(0, 3); SBAR(); GAPG(0, 2, C1[0] = EX(C1[0]); C1[1] = EX(C1[1]); sacc += C0[14]; sacb += C0[15]; PIN(C1); PIN(sacc); PIN(sacb)); \
    VRD(1, 3); SBAR(); GAPG(1, 2, C1[2] = EX(C1[2]); C1[3] = EX(C1[3]); sacc += C1[0]; sacb += C1[1]; PIN(C1); PIN(sacc); PIN(sacb)); \
    VRD(2, 3); SBAR(); GAPG(2, 2, C1[4] = EX(C1[4]); C1[5] = EX(C1[5]); sacc += C1[2]; sacb += C1[3]; PIN(C1); PIN(sacc); PIN(sacb)); \
    VRD(3, 3); SBAR(); GAPG(3, 2, C1[6] = EX(C1[6]); C1[7] = EX(C1[7]); sacc += C1[4]; sacb += C1[5]; PIN(C1); PIN(sacc); PIN(sacb)); \
    if (GK) { DMA_K((t) + 2, sl_prev); } SBAR(); GAPG(0, 3, C1[8] = EX(C1[8]); C1[9] = EX(C1[9]); sacc += C1[6]; sacb += C1[7]; PIN(C1); PIN(sacc); PIN(sacb)); \
    if (GV) { DMA_V((t) + 1, sl_next); } SBAR(); GAPG(1, 3, C1[10] = EX(C1[10]); C1[11] = EX(C1[11]); sacc += C1[8]; sacb += C1[9]; PIN(C1); PIN(sacc); PIN(sacb)); \
    GAPG(2, 3, C1[12] = EX(C1[12]); C1[13] = EX(C1[13]); sacc += C1[10]; sacb += C1[11]; PIN(C1); PIN(sacc); PIN(sacb)); \
    GAPG(3, 3, C1[14] = EX(C1[14]); C1[15] = EX(C1[15]); sacc += C1[12]; sacb += C1[13]; PIN(C1); PIN(sacc); PIN(sacb)); \
    sacc += C1[14]; sacb += C1[15]; l_reg += sacc + sacb; \
    } else { \
    float mxa, mxb; \
    VRD(0, 1); SBAR(); GAPG(0, 0, mxa = MX3(C0[0], C0[1], C0[2]); mxb = MX3(C0[3], C0[4], C0[5]); mxa = MX3(mxa, C0[6], C0[7]); mxb = MX3(mxb, C0[8], C0[9]); PIN(mxa); PIN(mxb)); \
    VRD(1, 1); SBAR(); GAPG(1, 0, mxa = MX3(mxa, C0[10], C0[11]); mxb = MX3(mxb, C0[12], C0[13]); mxa = MX3(mxa, C0[14], C0[15]); mxb = MX3(mxb, C1[0], C1[1]); PIN(mxa); PIN(mxb)); \
    VRD(2, 1); SBAR(); GAPG(2, 0, mxa = MX3(mxa, C1[2], C1[3]); mxb = MX3(mxb, C1[4], C1[5]); mxa = MX3(mxa, C1[6], C1[7]); mxb = MX3(mxb, C1[8], C1[9]); PIN(mxa); PIN(mxb)); \
    VRD(3, 1); SBAR(); GAPG(3, 0, mxa = MX3(mxa, C1[10], C1[11]); mxb = MX3(mxb, C1[12], C1[13]); mxa = MX3(mxa, C1[14], C1[15]); PIN(mxa); PIN(mxb)); \
    { float rm = __builtin_fmaxf(mxa, mxb); { auto rr = __builtin_amdgcn_permlane32_swap(__float_as_uint(rm), __float_as_uint(rm), false, false); rm = __builtin_fmaxf(__uint_as_float(rr[0]), __uint_as_float(rr[1])); } \
      resc = false; \
      if (__builtin_expect(__any(rm > THR), 0)) { const float dl = __builtin_fmaxf(rm, 0.f); mhat += dl; \
          _Pragma("unroll") for (int r = 0; r < 16; ++r) { C0[r] -= dl; C1[r] -= dl; } \
          _Pragma("unroll") for (int r = 0; r < 16; ++r) negm[r] = -mhat; PIN(negm); \
          const float f = __builtin_amdgcn_exp2f(-dl); l_reg *= f; if (hi == 0) wsf[r32] = f; resc = true; } } \
    SBAR(); \
    VRD(0, 2); SBAR(); GAPG(0, 1, C0[0] = EX(C0[0]); C0[1] = EX(C0[1]); C0[2] = EX(C0[2]); PIN(C0)); \
    VRD(1, 2); SBAR(); GAPG(1, 1, C0[3] = EX(C0[3]); C0[4] = EX(C0[4]); C0[5] = EX(C0[5]); PIN(C0)); \
    VRD(2, 2); SBAR(); GAPG(2, 1, C0[6] = EX(C0[6]); C0[7] = EX(C0[7]); C0[8] = EX(C0[8]); PIN(C0)); \
    VRD(3, 2); SBAR(); GAPG(3, 1, C0[9] = EX(C0[9]); C0[10] = EX(C0[10]); C0[11] = EX(C0[11]); PIN(C0)); \
    VRD(0, 3); SBAR(); GAPG(0, 2, C0[12] = EX(C0[12]); C0[13] = EX(C0[13]); C0[14] = EX(C0[14]); PIN(C0)); \
    VRD(1, 3); SBAR(); GAPG(1, 2, C0[15] = EX(C0[15]); C1[0] = EX(C1[0]); C1[1] = EX(C1[1]); PIN(C0); PIN(C1)); \
    VRD(2, 3); SBAR(); GAPG(2, 2, C1[2] = EX(C1[2]); C1[3] = EX(C1[3]); C1[4] = EX(C1[4]); PIN(C1)); \
    VRD(3, 3); SBAR(); GAPG(3, 2, C1[5] = EX(C1[5]); C1[6] = EX(C1[6]); C1[7] = EX(C1[7]); PIN(C1)); \
    if (GK) { DMA_K((t) + 2, sl_prev); if (PROBE_DUPK) DMA_K((t) + 2, sl_prev); } SBAR(); GAPG(0, 3, C1[8] = EX(C1[8]); C1[9] = EX(C1[9]); PIN(C1)); \
    if (GV) { DMA_V((t) + 1, sl_next); if (PROBE_DUPV) DMA_V((t) + 1, sl_next); } SBAR(); GAPG(1, 3, C1[10] = EX(C1[10]); C1[11] = EX(C1[11]); PIN(C1)); \
    GAPG(2, 3, C1[12] = EX(C1[12]); C1[13] = EX(C1[13]); PIN(C1)); \
    GAPG(3, 3, C1[14] = EX(C1[14]); C1[15] = EX(C1[15]); PIN(C1)); \
    } \
    } while (0)
#ifndef PROBE_DUPK
#define PROBE_DUPK 0
#endif
#ifndef PROBE_DUPV
#define PROBE_DUPV 0
#endif
#define WAIT_N(n_) do { if ((n_) == 6) { WAIT_BAR(6); } else if ((n_) == 5) { WAIT_BAR(5); } else if ((n_) == 4) { WAIT_BAR(4); } else if ((n_) == 3) { WAIT_BAR(3); } else if ((n_) == 2) { WAIT_BAR(2); } else if ((n_) == 1) { WAIT_BAR(1); } else { WAIT_BAR(0); } } while (0)
#define ENDW(tt) do { const int nk_ = ((tt) + 2 < NT) ? 1 + PROBE_DUPK : 0, nv_ = ((tt) + 1 < NT) ? NVP * (1 + PROBE_DUPV) : 0; WAIT_N(nk_ + nv_); } while (0)
    int t = 1;
    for (; t + 3 < NT; t += 2) {
        STEP(pB0, pB1, pA0, pA1, t, true, true);     WAIT_N(1 + PROBE_DUPK + NVP * (1 + PROBE_DUPV)); RESC(); ROT();
        STEP(pA0, pA1, pB0, pB1, t + 1, true, true); WAIT_N(1 + PROBE_DUPK + NVP * (1 + PROBE_DUPV)); RESC(); ROT();
    }
    for (; t + 1 < NT; t += 2) {
        STEP(pB0, pB1, pA0, pA1, t, (t + 2 < NT), (t + 1 < NT));         ENDW(t);     RESC(); ROT();
        STEP(pA0, pA1, pB0, pB1, t + 1, (t + 3 < NT), (t + 2 < NT));     ENDW(t + 1); RESC(); ROT();
    }
    STEP(pB0, pB1, pA0, pA1, NT - 1, false, false); WAIT_BAR(0); RESC(); ROT();
    { if constexpr (SAFE) { float sacc = pB0[0] + pB0[1];
#pragma unroll
      for (int r = 2; r < 16; ++r) sacc += pB0[r];
#pragma unroll
      for (int r = 0; r < 16; ++r) sacc += pB1[r];
      l_reg += sacc; }
      pw0 = (u32x4){PKW(pB0, 0), PKW(pB0, 2), PKW(pB0, 4), PKW(pB0, 6)}; pw1 = (u32x4){PKW(pB0, 8), PKW(pB0, 10), PKW(pB0, 12), PKW(pB0, 14)};
      pw2 = (u32x4){PKW(pB1, 0), PKW(pB1, 2), PKW(pB1, 4), PKW(pB1, 6)}; pw3 = (u32x4){PKW(pB1, 8), PKW(pB1, 10), PKW(pB1, 12), PKW(pB1, 14)};
      const lds_cptr vp_ = vp0 + sl_prev * VSLOT;
#pragma unroll
      for (int q = 0; q < ND; ++q) {
          s16x4 l0 = vtr(vp_ + q * 4096), h0 = vtr(vp_ + q * 4096 + 512), l1 = vtr(vp_ + q * 4096 + 1024), h1 = vtr(vp_ + q * 4096 + 1024 + 512);
          s16x4 l2 = vtr(vp_ + q * 4096 + 2048), h2 = vtr(vp_ + q * 4096 + 2048 + 512), l3 = vtr(vp_ + q * 4096 + 3072), h3 = vtr(vp_ + q * 4096 + 3072 + 512);
#define PKV(L, H) (bf16x8){L[0], L[1], L[2], L[3], H[0], H[1], H[2], H[3]}
          o[q] = MFMA32(PAF(0), PKV(l0, h0), o[q]); o[q] = MFMA32(PAF(1), PKV(l1, h1), o[q]); o[q] = MFMA32(PAF(2), PKV(l2, h2), o[q]); o[q] = MFMA32(PAF(3), PKV(l3, h3), o[q]);
#undef PKV
      } }
    { auto rr = __builtin_amdgcn_permlane32_swap(__float_as_uint(l_reg), __float_as_uint(l_reg), false, false); l_reg = __uint_as_float(rr[0]) + __uint_as_float(rr[1]); }
    if (PROBE_VALU) asm volatile("" :: "v"(dummy_));
    __builtin_amdgcn_s_setprio(0);
    m_out = mhat; l_out = l_reg;
#undef KROW
#undef DMA_K
#undef DMA_V
#undef ROT
#undef RESC
#undef PAF
#undef VFR
#undef VRD
#undef KRD
#undef PKW
#undef GAPA
#undef DOT2
#undef GAPB
#undef GAPG
#undef EX
#undef STEP
#undef ENDW
#undef WAIT_N
}
#undef SBAR
#undef PIN
#undef MX3
#undef MFMA32
#undef WAIT_BAR
}

#define XB_TMO      128
#define XB_XCNT(j)  (256  + 64 * (j))
#define XB_XSUB(j)  (1280 + 64 * (j))
#define XB_XGEN(j)  (2304 + 64 * (j))
#define XB_TOP      3328
#define XB_TOPGEN   3392
#define XCD_BAR_WORDS 3456
#define XB_SPIN_CAP (1u << 18)

__device__ __forceinline__ unsigned xb_ld(unsigned* p)              { return __hip_atomic_load(p, __ATOMIC_RELAXED, __HIP_MEMORY_SCOPE_AGENT); }
__device__ __forceinline__ unsigned xb_add(unsigned* p, unsigned v) { return __hip_atomic_fetch_add(p, v, __ATOMIC_RELAXED, __HIP_MEMORY_SCOPE_AGENT); }
__device__ __forceinline__ unsigned xb_xcc_id() { return (unsigned)__builtin_amdgcn_s_getreg((3 << 11) | 20) & 0xFu; }
#define XB_SPIN(cond, bar) do { unsigned _sp = 0; while (cond) { __builtin_amdgcn_s_sleep(1); \
    if ((++_sp & 255u) == 0u) { if (xb_ld(&(bar)[XB_TMO])) break; if (_sp > XB_SPIN_CAP) { atomicAdd(&(bar)[XB_TMO], 1u); break; } } } } while (0)

struct XcdBarrier {
    unsigned* bar; unsigned x;
    volatile LAS unsigned* st;
};

__device__ __forceinline__ XcdBarrier xcd_barrier_post(unsigned* bar, volatile LAS unsigned* st) {
    XcdBarrier b; b.bar = bar; b.x = xb_xcc_id(); b.st = st;
    if (threadIdx.x == 0) (void)xb_add(&bar[XB_XCNT(b.x)], 1u);
    return b;
}
__device__ __forceinline__ void xcd_barrier_complete(unsigned* bar, unsigned x, unsigned& nloc, unsigned& nx) {
    const unsigned G = gridDim.x * gridDim.y * gridDim.z;
    unsigned sum, cnt, mine, sp = 0u;
    for (;;) {
        sum = 0u; cnt = 0u; mine = 0u;
#pragma unroll
        for (unsigned j = 0; j < 16; ++j) { const unsigned c = xb_ld(&bar[XB_XCNT(j)]); sum += c; cnt += (c > 0u) ? 1u : 0u; mine = (j == x) ? c : mine; }
        if (sum == G) break;
        __builtin_amdgcn_s_sleep(1);
        if ((++sp & 255u) == 0u) { if (xb_ld(&bar[XB_TMO])) break; if (sp > XB_SPIN_CAP) { atomicAdd(&bar[XB_TMO], 1u); break; } }
    }
    nloc = mine > 0u ? mine : 1u; nx = cnt > 0u ? cnt : 1u;
}

__device__ __forceinline__ void xcd_barrier(const XcdBarrier& b) {
    asm volatile("s_waitcnt vmcnt(0)" ::: "memory");
    __syncthreads();
    if (threadIdx.x == 0) {
        unsigned* bar = b.bar;
        __builtin_amdgcn_s_waitcnt(0);
        unsigned nloc = b.st[0], nx = b.st[1];
        if (nloc == 0u) { xcd_barrier_complete(bar, b.x, nloc, nx); b.st[0] = nloc; b.st[1] = nx; }
        const unsigned old = xb_add(&bar[XB_XSUB(b.x)], 1u);
        const unsigned gen = old / nloc;
        if (old + 1u == (gen + 1u) * nloc) {
            __builtin_amdgcn_fence(__ATOMIC_RELEASE, "agent");
            asm volatile("s_waitcnt vmcnt(0)" ::: "memory");
            const unsigned og = xb_add(&bar[XB_TOP], 1u);
            const unsigned tg = og / nx;
            if (og + 1u == (tg + 1u) * nx) xb_add(&bar[XB_TOPGEN], 1u);
            else XB_SPIN(xb_ld(&bar[XB_TOPGEN]) == tg, bar);
            __builtin_amdgcn_fence(__ATOMIC_ACQUIRE, "agent");
            xb_add(&bar[XB_XGEN(b.x)], 1u);
            asm volatile("s_waitcnt vmcnt(0)" ::: "memory");
        } else {
            XB_SPIN(xb_ld(&bar[XB_XGEN(b.x)]) == gen, bar);
            __builtin_amdgcn_fence(__ATOMIC_ACQUIRE, "agent");
            asm volatile("s_waitcnt vmcnt(0)" ::: "memory");
        }
    }
    __syncthreads();
}

struct Args { const float* in[23]; float* out; unsigned char* ws; int ph_lo, ph_hi; };
enum { I_X = 0, I_C, I_CTX, I_CCTX, I_WADA, I_BADA, I_GMIX, I_WIN, I_DLAM, I_DNG, I_SINK, I_CONVW, I_CONVB, I_LNG, I_LNB, I_WOUT, I_GFFN, I_RW, I_RB, I_W1, I_W3, I_W2, I_GFIN };
constexpr int N_PHASES = 18;
__device__ __constant__ const float LAMBDA_INIT[2] = {0.2f, 0.35550906759097f};

struct EpiInProj {
    static constexpr bool PERM = true, AFTER_DRAIN = false;
    unsigned char* ws; const float* ropeC; const float* ropeS;
    __device__ __forceinline__ void operator()(const f32x4 (&acc)[2][2][4][2], const pg8::Unit& u, int wr, int wc, int fr, int fq) const {
        const int pn = u.pn; const bool latent = u.pm < 64; const int rowb = u.pm * 256 + wr * 64 + fr;
        if (pn >= 8) {
            bf16_t* Z = (bf16_t*)(ws + RA_Z); const int ch0 = (pn - 8) * 128 + wc * 32 + 8 * fq;
#pragma unroll
            for (int ai = 0; ai < 2; ++ai)
#pragma unroll
                for (int m = 0; m < 4; ++m) { const int row = rowb + ai * 128 + m * 16;
                    const f32x4 a0 = acc[ai][0][m][0], a1 = acc[ai][0][m][1], g0 = acc[ai][1][m][0], g1 = acc[ai][1][m][1];
                    u32x4 w; w.x = cvt_pk_bf16(a0[0] * sigmoid_f(g0[0]), a0[1] * sigmoid_f(g0[1])); w.y = cvt_pk_bf16(a0[2] * sigmoid_f(g0[2]), a0[3] * sigmoid_f(g0[3]));
                    w.z = cvt_pk_bf16(a1[0] * sigmoid_f(g1[0]), a1[1] * sigmoid_f(g1[1])); w.w = cvt_pk_bf16(a1[2] * sigmoid_f(g1[2]), a1[3] * sigmoid_f(g1[3]));
                    *(u32x4*)(Z + (size_t)row * 256 + ch0) = w; }
            return;
        }
        const float sgn = (fq < 2) ? -1.f : 1.f;
        const bool anyrope = latent && (pn < 4 || pn >= 6);
#pragma unroll
        for (int ai = 0; ai < 2; ++ai)
#pragma unroll
            for (int m = 0; m < 4; ++m) { const int row = rowb + ai * 128 + m * 16;
                f32x4 c0, c1, s0, s1;
                if (anyrope) { const int pos = (wc & 1) ? (row & 63) : (row >> 6); const int fo = pos * 16 + 8 * (fq & 1);
                    c0 = *(const f32x4*)(ropeC + fo); c1 = *(const f32x4*)(ropeC + fo + 4); s0 = *(const f32x4*)(ropeS + fo) * sgn; s1 = *(const f32x4*)(ropeS + fo + 4) * sgn; }
#pragma unroll
                for (int bj = 0; bj < 2; ++bj) {
                    bf16_t* dst; int ld, dcol; bool rope; float sc = 1.f; bool isvb = false;
                    if (pn < 2)       { dst = (bf16_t*)(ws + RA_QA); ld = 512; dcol = pn * 256 + bj * 128 + wc * 32; rope = true; sc = QSCALE; }
                    else if (pn < 4)  { dst = (bf16_t*)(ws + RA_KA); ld = 512; dcol = (pn - 2) * 256 + bj * 128 + wc * 32; rope = true; }
                    else if (pn < 6)  { dst = (bf16_t*)(ws + RA_VA); ld = 512; dcol = (pn - 4) * 256 + bj * 128 + wc * 32; rope = false; }
                    else if (pn == 6) { dst = (bf16_t*)(ws + RA_QB); ld = 256; dcol = bj * 128 + wc * 32; rope = true; sc = QSCALE; }
                    else if (bj == 0) { dst = (bf16_t*)(ws + RA_KB); ld = 128; dcol = wc * 32; rope = true; }
                    else              { dst = (bf16_t*)(ws + RA_VB); ld = 256; dcol = (wc >> 1) * 128 + (wc & 1) * 32; rope = false; isvb = true; }
                    rope = rope && latent;
                    f32x4 x0 = acc[ai][bj][m][0], x1 = acc[ai][bj][m][1];
                    if (rope) { f32x4 p0, p1;
#pragma unroll
                        for (int j = 0; j < 4; ++j) { p0[j] = __shfl_xor(x0[j], 32); p1[j] = __shfl_xor(x1[j], 32); }
                        x0 = x0 * c0 + p0 * s0; x1 = x1 * c1 + p1 * s1; }
                    x0 = x0 * sc; x1 = x1 * sc;
                    bf16_t* p = dst + (size_t)row * ld + dcol + 8 * fq;
                    u32x4 w; w.x = cvt_pk_bf16(x0[0], x0[1]); w.y = cvt_pk_bf16(x0[2], x0[3]); w.z = cvt_pk_bf16(x1[0], x1[1]); w.w = cvt_pk_bf16(x1[2], x1[3]);
                    *(u32x4*)p = w;
                    if (isvb) { unsigned zz = 0u; asm volatile("" : "+v"(zz)); const u32x4 z = {zz, zz, zz, zz}; *(u32x4*)(p + 64) = z; } }
            }
    }
};
__device__ __forceinline__ void st16_wt(void* p, const u32x4 v) { asm volatile("global_store_dwordx4 %0, %1, off sc1\n\ts_nop 1" :: "v"(p), "v"(v) : "memory"); }
__device__ __forceinline__ void st4bf_wt(bf16_t* p, const f32x4 v) { u32x2 w; w.x = cvt_pk_bf16(v.x, v.y); w.y = cvt_pk_bf16(v.z, v.w); asm volatile("global_store_dwordx2 %0, %1, off sc1\n\ts_nop 0" :: "v"(p), "v"(w) : "memory"); }
struct OutOrder {
    pg8::StaticOrder in; gu32* cnt; gu32* ctxc;
    __device__ __forceinline__ bool next(int i, pg8::Unit& u) const {
        if (ctxc == nullptr) { if (i != 0) return false; return in.next(0, u); }
        const int c = blockIdx.x;
        if (c < 12) { if (i != 0) return false; u.pm = 61 + (c >> 2); u.pn = c & 3; u.aux = 0; return true; }
        if (i == 0) return in.next(0, u);
        if (i == 1 && c < 16) { u.pm = 64; u.pn = c - 12; u.aux = 0; return true; }
        return false; }
    __device__ __forceinline__ void a_ready(const pg8::Unit& u) const {
        if (ctxc != nullptr && u.pm >= 64) { for (unsigned s = 0; s < (1u << 20); ++s) { if ((unsigned)__builtin_amdgcn_readfirstlane((int)__hip_atomic_load(ctxc, __ATOMIC_RELAXED, __HIP_MEMORY_SCOPE_AGENT)) == 12u) break; __builtin_amdgcn_s_sleep(2); }
            __builtin_amdgcn_fence(__ATOMIC_ACQUIRE, "agent"); } }
    __device__ __forceinline__ void done(const pg8::Unit& u) const {
        asm volatile("s_waitcnt vmcnt(0)" ::: "memory");
        int ln; asm volatile("v_mbcnt_lo_u32_b32 %0, -1, 0\n\tv_mbcnt_hi_u32_b32 %0, -1, %0" : "=v"(ln));
        if (ln == 0) __hip_atomic_fetch_add(cnt + u.pm, 1u, __ATOMIC_RELAXED, __HIP_MEMORY_SCOPE_AGENT); }
};
struct EpiOutProj {
    static constexpr bool PERM = true, AFTER_DRAIN = false;
    const float* xin; const float* ctxin; bf16_t* XB; const float* gate_lat; const float* gate_ctx; int layer;
    __device__ __forceinline__ void operator()(const f32x4 (&acc)[2][2][4][2], const pg8::Unit& u, int wr, int wc, int fr, int fq) const {
        const bool isctx = u.pm >= 64; const float* gate = isctx ? gate_ctx : gate_lat; const int col8 = u.pn * 256 + wc * 32 + 8 * fq;
#pragma unroll
        for (int ai = 0; ai < 2; ++ai)
#pragma unroll
            for (int m = 0; m < 4; ++m) { const int row = u.pm * 256 + ai * 128 + wr * 64 + m * 16 + fr;
                const float* xo = isctx ? ctxin + (size_t)(row - SEQ) * DM : xin + (size_t)row * DM;
                bf16_t* xn = XB + (size_t)row * DM;
#pragma unroll
                for (int bj = 0; bj < 2; ++bj) { const int col = col8 + bj * 128;
                    f32x4 x0, x1;
                    if (layer == 0) { x0 = *(const f32x4*)(xo + col); x1 = *(const f32x4*)(xo + col + 4); }
                    else { const u32x4 w = *(const u32x4*)(xn + col);
                        x0 = (f32x4){__builtin_bit_cast(float, w.x << 16), __builtin_bit_cast(float, w.x & 0xffff0000u), __builtin_bit_cast(float, w.y << 16), __builtin_bit_cast(float, w.y & 0xffff0000u)};
                        x1 = (f32x4){__builtin_bit_cast(float, w.z << 16), __builtin_bit_cast(float, w.z & 0xffff0000u), __builtin_bit_cast(float, w.w << 16), __builtin_bit_cast(float, w.w & 0xffff0000u)}; }
                    const f32x4 g0 = *(const f32x4*)(gate + col), g1 = *(const f32x4*)(gate + col + 4);
                    const f32x4 y0 = x0 + g0 * acc[ai][bj][m][0], y1 = x1 + g1 * acc[ai][bj][m][1];
                    u32x4 o; o.x = cvt_pk_bf16(y0.x, y0.y); o.y = cvt_pk_bf16(y0.z, y0.w); o.z = cvt_pk_bf16(y1.x, y1.y); o.w = cvt_pk_bf16(y1.z, y1.w);
                    st16_wt(xn + col, o); } }
    }
};
struct EpiMoe1 {
    static constexpr bool PERM = true, AFTER_DRAIN = false;
    bf16_t* HS;
    __device__ __forceinline__ void operator()(const f32x4 (&acc)[2][2][4][2], const pg8::Unit& u, int wr, int wc, int fr, int fq) const {
        const int col8 = (u.pn & 3) * 128 + wc * 32 + 8 * fq;
#pragma unroll
        for (int ai = 0; ai < 2; ++ai)
#pragma unroll
            for (int m = 0; m < 4; ++m) { const int row = u.pm * 256 + ai * 128 + wr * 64 + m * 16 + fr;
                const f32x4 a0 = acc[ai][0][m][0], a1 = acc[ai][0][m][1], b0 = acc[ai][1][m][0], b1 = acc[ai][1][m][1];
                u32x4 w; w.x = cvt_pk_bf16(silu_f(a0[0]) * b0[0], silu_f(a0[1]) * b0[1]); w.y = cvt_pk_bf16(silu_f(a0[2]) * b0[2], silu_f(a0[3]) * b0[3]);
                w.z = cvt_pk_bf16(silu_f(a1[0]) * b1[0], silu_f(a1[1]) * b1[1]); w.w = cvt_pk_bf16(silu_f(a1[2]) * b1[2], silu_f(a1[3]) * b1[3]);
                st16_wt(HS + (size_t)row * FFE + col8, w); }
    }
};
struct EpiMoe2 {
    static constexpr bool PERM = true, AFTER_DRAIN = false;
    bf16_t* YS;
    __device__ __forceinline__ void operator()(const f32x4 (&acc)[2][2][4][2], const pg8::Unit& u, int wr, int wc, int fr, int fq) const {
        const int col8 = (u.pn & 3) * 256 + wc * 32 + 8 * fq;
#pragma unroll
        for (int ai = 0; ai < 2; ++ai)
#pragma unroll
            for (int m = 0; m < 4; ++m) { const int row = u.pm * 256 + ai * 128 + wr * 64 + m * 16 + fr;
#pragma unroll
                for (int bj = 0; bj < 2; ++bj) { const f32x4 v0 = acc[ai][bj][m][0], v1 = acc[ai][bj][m][1];
                    u32x4 w; w.x = cvt_pk_bf16(v0[0], v0[1]); w.y = cvt_pk_bf16(v0[2], v0[3]); w.z = cvt_pk_bf16(v1[0], v1[1]); w.w = cvt_pk_bf16(v1[2], v1[3]);
                    *(u32x4*)(YS + (size_t)row * DM + col8 + bj * 128) = w; } }
    }
};
struct MoeOrder {
    int G, vcu, nunits; int ts[16]; const int* rowtok;
    __device__ __forceinline__ unsigned row_off(const pg8::Unit& u, int r) const { return (unsigned)min((unsigned)rowtok[u.aux + r], (unsigned)(NROW - 1)) * (unsigned)(DM * 2); }
    __device__ __forceinline__ bool next(int i, pg8::Unit& u) const {
        const int L = i * G + vcu; if (L >= nunits) return false;
        const int rt = L >> 2, ct = L & 3; int e = 0, tb = ts[0];
#pragma unroll
        for (int k = 1; k < 16; ++k) { const bool ge = rt >= ts[k]; e += ge ? 1 : 0; tb = ge ? ts[k] : tb; }
        u.pm = rt; u.pn = e * 4 + ct; u.aux = e * ROWCAP + (rt - tb) * 256; return true;
    }
    __device__ __forceinline__ int nloc() const { return vcu < nunits ? (nunits - vcu + G - 1) / G : 0; }
    __device__ __forceinline__ void a_ready(const pg8::Unit&) const {}
    __device__ __forceinline__ void done(const pg8::Unit&) const {}
};

struct MoeOrder2 {
    int vcu, nunits, part; int ts[16];
    __device__ __forceinline__ bool next(int i, pg8::Unit& u) const {
        const int U = nunits, q = U >> 8, r = U & 255; int L;
        if (part == 0) { if (vcu < r || i >= q) return false; L = i * 256 + vcu; }
        else { int b = vcu + i * 256; if (b >= (q + 1) * r) return false; int k = 0; while (b >= r) { b -= r; ++k; } L = k * 256 + b; }
        const int rt = L >> 2, ct = L & 3; int e = 0;
#pragma unroll
        for (int k = 1; k < 16; ++k) e += (rt >= ts[k]) ? 1 : 0;
        u.pm = rt; u.pn = e * 4 + ct; u.aux = 0; return true; }
    __device__ __forceinline__ void a_ready(const pg8::Unit&) const {}
    __device__ __forceinline__ void done(const pg8::Unit&) const {}
};
__device__ __forceinline__ void moe_wait(gu32* flag, int base, int n) {
    const int tid = otid();
    if (tid < 64) { for (unsigned s = 0; s < (1u << 20); ++s) { bool ok = true;
            for (int j = tid; j < n; j += 64) ok = ok && (__hip_atomic_load(flag + base + j, __ATOMIC_RELAXED, __HIP_MEMORY_SCOPE_AGENT) == 1u);
            if (__all(ok)) break; __builtin_amdgcn_s_sleep(2); }
        __builtin_amdgcn_fence(__ATOMIC_ACQUIRE, "agent"); asm volatile("s_waitcnt vmcnt(0)" ::: "memory"); }
    __syncthreads();
}

__device__ __forceinline__ void tr_item(const float* W, int ldw, int k0, int n0, bf16_t* WT, int K, int nd0, LAS float* scr, int lane) {
    f32x4 v[8];
#pragma unroll
    for (int i = 0; i < 8; ++i) v[i] = *(const f32x4*)(W + (size_t)(k0 + 8 * i + (lane >> 3)) * ldw + n0 + (lane & 7) * 4);
#pragma unroll
    for (int i = 0; i < 8; ++i) { LAS float* d = scr + (8 * i + (lane >> 3)) * 33 + (lane & 7) * 4; d[0] = v[i].x; d[1] = v[i].y; d[2] = v[i].z; d[3] = v[i].w; }
    LDS_WAIT(); asm volatile("" ::: "memory");
    const int c = lane & 7;
#pragma unroll
    for (int j = 0; j < 4; ++j) { const int n = (lane >> 3) + 8 * j; const LAS float* s = scr + (8 * c) * 33 + n;
        u32x4 o; o.x = pk2(s[0 * 33], s[1 * 33]); o.y = pk2(s[2 * 33], s[3 * 33]); o.z = pk2(s[4 * 33], s[5 * 33]); o.w = pk2(s[6 * 33], s[7 * 33]);
        *(u32x4*)(WT + (size_t)(nd0 + n) * K + k0 + 8 * c) = o; }
    LDS_WAIT(); asm volatile("" ::: "memory");
}
__device__ __forceinline__ void moe_convert(const Args& a, int L, LAS float* scr, int gw, int NGW, int lane, int it0 = 0, int it1 = 12288) {
    bf16_t* W13T = (bf16_t*)(a.ws + WS_W13) + (size_t)L * 16 * 1024 * 1024; bf16_t* W2T = (bf16_t*)(a.ws + WS_W2) + (size_t)L * 16 * 1024 * 512;
    for (int it = it0 + gw; it < it1; it += NGW) {
        if (it < 8192) { const int e = it >> 9, r2 = it & 511, kb = r2 >> 5, nb = r2 & 31, nd0 = 32 * nb, t = nd0 >> 8, bj = (nd0 >> 7) & 1, i0 = nd0 & 127;
            const float* src = (bj ? a.in[I_W3] : a.in[I_W1]) + (size_t)(L * 16 + e) * 1024 * 512;
            tr_item(src, 512, 64 * kb, t * 128 + i0, W13T + (size_t)e * 1024 * 1024, 1024, nd0, scr, lane); }
        else { const int r = it - 8192, e = r >> 8, r2 = r & 255, kb = r2 >> 5, nb = r2 & 31;
            tr_item(a.in[I_W2] + (size_t)(L * 16 + e) * 512 * 1024, 1024, 64 * kb, 32 * nb, W2T + (size_t)e * 1024 * 512, 512, 32 * nb, scr, lane); }
    }
}
__device__ __forceinline__ void prologue_phase(const Args& a, unsigned char* lds) {
    const int tid = otid(), lane = tid & 63, wave = tid >> 6, gw = blockIdx.x * NWAVES + wave, NGW = gridDim.x * NWAVES;
    LAS float* scr = (LAS float*)((LAS unsigned char*)lds + wave * 8704);
    bf16_t* WinT = (bf16_t*)(a.ws + WS_WIN); bf16_t* WoutT = (bf16_t*)(a.ws + WS_WOUT);
    for (int it = gw; it < 3584; it += NGW) {
        if (it < 2560) { const int L = it / 1280, r = it % 1280, kb = r / 80, nb = r % 80, nd0 = 32 * nb; int n0 = nd0;
            if (nd0 >= 2048) { const int q = nd0 - 2048, t = q >> 8, bj = (q >> 7) & 1, i0 = q & 127; n0 = 2048 + bj * 256 + t * 128 + i0; }
            tr_item(a.in[I_WIN] + (size_t)L * 1024 * INW, INW, 64 * kb, n0, WinT + (size_t)L * INW * 1024, 1024, nd0, scr, lane); }
        else { const int r0 = it - 2560, L = r0 >> 9, r = r0 & 511, kb = r >> 5, nb = r & 31;
            tr_item(a.in[I_WOUT] + (size_t)L * 1024 * 1024, 1024, 64 * kb, 32 * nb, WoutT + (size_t)L * 1024 * 1024, 1024, 32 * nb, scr, lane); }
    }
    moe_convert(a, 0, scr, gw, NGW, lane, 0, 8192);
    __syncthreads();
    float* sc = (float*)(lds + 71680); float* scc = sc + 1024; float* red = scc + 1024;
    float* MOD = (float*)(a.ws + WS_MOD);
    for (int u = blockIdx.x; u < 192; u += gridDim.x) {
        const int L = u / 96, col0 = (u % 96) * 64;
        for (int k = tid; k < 1024; k += NTHREADS) { const float c = a.in[I_C][k], cc = a.in[I_CCTX][k]; sc[k] = c / (1.f + expf(-c)); scc[k] = cc / (1.f + expf(-cc)); }
        __syncthreads();
        const int cg = tid & 15, ks = tid >> 4;
        const float* w = a.in[I_WADA] + ((size_t)L * 1024 + ks * 32) * 6144 + col0 + cg * 4;
        f32x4 s1 = {0.f, 0.f, 0.f, 0.f}, s2 = {0.f, 0.f, 0.f, 0.f};
#pragma unroll 8
        for (int k = 0; k < 32; ++k) { const f32x4 wv = *(const f32x4*)(w + (size_t)k * 6144); s1 = s1 + wv * sc[ks * 32 + k]; s2 = s2 + wv * scc[ks * 32 + k]; }
        *(f32x4*)(red + (ks * 16 + cg) * 8) = s1; *(f32x4*)(red + (ks * 16 + cg) * 8 + 4) = s2;
        __syncthreads();
        if (tid < 128) { const int which = tid >> 6, c = tid & 63; float s = 0.f;
            for (int k = 0; k < 32; ++k) s += red[(k * 16 + (c >> 2)) * 8 + which * 4 + (c & 3)];
            MOD[(L * 2 + which) * 6144 + col0 + c] = s + a.in[I_BADA][L * 6144 + col0 + c]; }
        __syncthreads();
    }
    if (blockIdx.x >= 192 && tid < 64) {
        float* rc = (float*)(a.ws + WS_ROPEC); float* rs = (float*)(a.ws + WS_ROPES);
        const int i = ((int)blockIdx.x - 192) * 64 + tid; const int pos = i >> 4, f = i & 15; const float inv = powf(10000.f, -(float)f / 16.f), ang = (float)pos * inv; rc[i] = cosf(ang); rs[i] = sinf(ang);
    }
    if (blockIdx.x == gridDim.x - 2 && wave < 2) {
        const float* dl = a.in[I_DLAM] + wave * 256;
        const float s01 = wave_sum(dl[lane] * dl[64 + lane]), s23 = wave_sum(dl[128 + lane] * dl[192 + lane]);
        if (lane == 0) ((float*)(a.ws + WS_LAM))[wave] = expf(s01) - expf(s23) + LAMBDA_INIT[wave];
    }
}

__device__ __forceinline__ void norm1_phase(const Args& a, int l) {
    constexpr int NR = 4;
    const int tid = otid(), lane = tid & 63, wave = tid >> 6;
    const int nrows = (l == 2) ? SEQ : NROW, rpw = (nrows + gridDim.x - 1) / gridDim.x, r0 = blockIdx.x * rpw, r1 = min(nrows, r0 + rpw);
    const int rw = (rpw + NWAVES - 1) / NWAVES, wr0 = r0 + wave * rw, wr1 = min(r1, wr0 + rw);
    bf16_t* XB = (bf16_t*)(a.ws + WS_XB); bf16_t* HB = (bf16_t*)(a.ws + WS_HB); const bf16_t* YS = (const bf16_t*)(a.ws + WS_RA);
    const float* MOD = (const float*)(a.ws + WS_MOD);
    const int2* TOKP = (const int2*)(a.ws + WS_TOKP); const float2* TOKW = (const float2*)(a.ws + WS_TOKW);
    for (int rb = wr0; rb < wr1; rb += NR) {
        f32x4 v[NR][4]; int rowk[NR];
#pragma unroll
        for (int k = 0; k < NR; ++k) rowk[k] = min(rb + k, wr1 - 1);
        if (l == 0) {
#pragma unroll
            for (int k = 0; k < NR; ++k) { const int row = rowk[k]; const bool isctx = row >= SEQ;
                const f32x4* src = (const f32x4*)(isctx ? a.in[I_CTX] + (size_t)(row - SEQ) * DM : a.in[I_X] + (size_t)row * DM) + lane;
#pragma unroll
                for (int j = 0; j < 4; ++j) v[k][j] = src[64 * j]; }
        } else {
            int2 pp[NR]; float2 ww[NR];
#pragma unroll
            for (int k = 0; k < NR; ++k) { pp[k] = TOKP[rowk[k]]; ww[k] = TOKW[rowk[k]]; }
            { const int* tsg = (const int*)(a.ws + WS_TSG) + (l - 1) * 32;
#pragma unroll
              for (int k = 0; k < NR; ++k) { pp[k].x = tsg[pp[k].x >> 15] * 256 + (pp[k].x & 32767); pp[k].y = tsg[pp[k].y >> 15] * 256 + (pp[k].y & 32767); } }
            u32x2 y0[NR][4], y1[NR][4]; f32x4 gt[NR][4];
#pragma unroll
            for (int k = 0; k < NR; ++k) { const int row = rowk[k]; const bool isctx = row >= SEQ;
                const bf16_t* xb = XB + (size_t)row * DM + 4 * lane;
                const f32x4* gate = (const f32x4*)(MOD + ((l - 1) * 2 + (isctx ? 1 : 0)) * 6144 + 5 * 1024) + lane;
                const u32x2* q0 = (const u32x2*)(YS + (size_t)pp[k].x * DM) + lane; const u32x2* q1 = (const u32x2*)(YS + (size_t)pp[k].y * DM) + lane;
#pragma unroll
                for (int j = 0; j < 4; ++j) { v[k][j] = ld4bf(xb + 256 * j); gt[k][j] = gate[64 * j]; y0[k][j] = q0[64 * j]; y1[k][j] = q1[64 * j]; } }
#pragma unroll
            for (int k = 0; k < NR; ++k) { const bool st = (rb + k < wr1) && (l < 2); bf16_t* xb = XB + (size_t)rowk[k] * DM + 4 * lane;
#pragma unroll
                for (int j = 0; j < 4; ++j) { const u32x2 p0 = y0[k][j], p1 = y1[k][j];
                    const f32x4 ya = {bf2f((unsigned short)(p0.x & 0xffff)), bf2f((unsigned short)(p0.x >> 16)), bf2f((unsigned short)(p0.y & 0xffff)), bf2f((unsigned short)(p0.y >> 16))};
                    const f32x4 yb = {bf2f((unsigned short)(p1.x & 0xffff)), bf2f((unsigned short)(p1.x >> 16)), bf2f((unsigned short)(p1.y & 0xffff)), bf2f((unsigned short)(p1.y >> 16))};
                    v[k][j] = v[k][j] + gt[k][j] * (ya * ww[k].x + yb * ww[k].y);
                    if (st) st4bf(xb + 256 * j, v[k][j]); } }
        }
#pragma unroll
        for (int k = 0; k < NR; ++k) { const int row = rowk[k]; const bool isctx = row >= SEQ, st = rb + k < wr1;
            float ss = 0.f;
#pragma unroll
            for (int j = 0; j < 4; ++j) ss += (v[k][j].x * v[k][j].x + v[k][j].y * v[k][j].y) + (v[k][j].z * v[k][j].z + v[k][j].w * v[k][j].w);
            const float rstd = 1.f / sqrtf(wave_sum(ss) * (1.f / DM) + EPS);
            if (l < 2) {
                const f32x4* g = (const f32x4*)(a.in[I_GMIX] + l * DM) + lane; const float* md = MOD + (l * 2 + (isctx ? 1 : 0)) * 6144;
                const f32x4* sh = (const f32x4*)(md) + lane; const f32x4* sl = (const f32x4*)(md + 1024) + lane;
                u32x2* o8 = (u32x2*)(HB + (size_t)row * DM) + lane;
#pragma unroll
                for (int j = 0; j < 4; ++j) { const f32x4 h = v[k][j] * rstd * g[64 * j] * (sl[64 * j] + 1.f) + sh[64 * j];
                    u32x2 w; w.x = cvt_pk_bf16(h.x, h.y); w.y = cvt_pk_bf16(h.z, h.w); if (st) o8[64 * j] = w; }
            } else {
                const f32x4* g = (const f32x4*)(a.in[I_GFIN]) + lane; f32x4* o = (f32x4*)(a.out + (size_t)row * DM) + lane;
#pragma unroll
                for (int j = 0; j < 4; ++j) { const f32x4 r = v[k][j] * rstd * g[64 * j]; if (st) o[64 * j] = r; }
            }
        }
    }
}
__device__ __forceinline__ void norm2_phase(const Args& a, int l, unsigned char* lds) {
    const int tid = otid(), lane = tid & 63, wave = tid >> 6;
    const int b_ = blockIdx.x;
    const int nlat = (l == 1) ? 64 : (b_ < 16 ? 1 : 65), lat0 = (l == 1) ? b_ * 64 : (b_ < 16 ? 240 * 65 + b_ : (b_ - 16) * 65);
    const int nlate = (l == 1) ? 0 : 4, late0 = 61 * 256 + 4 * b_, tl = 61 + (b_ >> 6), nloc = nlat + nlate;
#define N2_ROW(i) ((i) < nlat ? lat0 + (i) : late0 + ((i) - nlat))
    float* hrow = (float*)lds;
    float* logit = (float*)(lds + 65536);
    int* e01 = (int*)(lds + 65536 + 8192);
    for (int i = tid; i < 128; i += NTHREADS) e01[i] = -1;
    gu32* cnt = (gu32*)(a.ws + WS_CTL) + CW_OPC + l * 128;
#define N2_WAIT(ta_, tb_) do { if (tid < 64) { for (unsigned s = 0; s < (1u << 20); ++s) { const unsigned c = __hip_atomic_load(cnt + ((lane & 1) ? (tb_) : (ta_)), __ATOMIC_RELAXED, __HIP_MEMORY_SCOPE_AGENT); \
              if (__all(c == 32u)) break; __builtin_amdgcn_s_sleep(2); } \
          __builtin_amdgcn_fence(__ATOMIC_ACQUIRE, "agent"); asm volatile("s_waitcnt vmcnt(0)" ::: "memory"); } \
      __syncthreads(); } while (0)
    N2_WAIT(lat0 >> 8, (lat0 + nlat - 1) >> 8);
    const bf16_t* XB = (const bf16_t*)(a.ws + WS_XB); bf16_t* HB = (bf16_t*)(a.ws + WS_HB); const float* MOD = (const float*)(a.ws + WS_MOD);
    int2* TOKE = (int2*)(a.ws + WS_TOKE); float2* TOKW = (float2*)(a.ws + WS_TOKW);
    const int eg = wave & 3, rh = wave >> 2;
    f32x4 wk[4][4];
#pragma unroll
    for (int j = 0; j < 4; ++j)
#pragma unroll
        for (int c = 0; c < 4; ++c) wk[j][c] = *(const f32x4*)(a.in[I_RW] + (size_t)(256 * j + 4 * lane + c) * 16 + 4 * eg);
    const f32x4* g = (const f32x4*)(a.in[I_GFFN] + l * DM) + lane;
    u32x2 xr[2][4];
#define N2_LOADX(rb_) do { _Pragma("unroll") for (int k = 0; k < 2; ++k) { const bf16_t* xb = XB + (size_t)N2_ROW(min((rb_) + 2 * wave + k, nloc - 1)) * DM + 4 * lane; \
        _Pragma("unroll") for (int j = 0; j < 4; ++j) xr[k][j] = *(const u32x2*)(xb + 256 * j); } } while (0)
    const bool cfirst = (l != 1) && nlat < 16;
    if (cfirst) N2_WAIT(tl, tl);
    N2_LOADX(0);
    for (int rb = 0; rb < nloc; rb += 16) {
        if ((l != 1) && !cfirst && rb <= nlat && nlat < rb + 16) { N2_WAIT(tl, tl); N2_LOADX(rb); }
        f32x4 vv[2][4];
#pragma unroll
        for (int k = 0; k < 2; ++k)
#pragma unroll
            for (int j = 0; j < 4; ++j) { const u32x2 w = xr[k][j]; vv[k][j] = (f32x4){__builtin_bit_cast(float, w.x << 16), __builtin_bit_cast(float, w.x & 0xffff0000u), __builtin_bit_cast(float, w.y << 16), __builtin_bit_cast(float, w.y & 0xffff0000u)}; }
#pragma unroll
        for (int k = 0; k < 2; ++k) { const int row = N2_ROW(min(rb + 2 * wave + k, nloc - 1)); const bool isctx = row >= SEQ, st = rb + 2 * wave + k < nloc;
            float ss = 0.f;
#pragma unroll
            for (int j = 0; j < 4; ++j) ss += (vv[k][j].x * vv[k][j].x + vv[k][j].y * vv[k][j].y) + (vv[k][j].z * vv[k][j].z + vv[k][j].w * vv[k][j].w);
            const float rstd = 1.f / sqrtf(wave_sum(ss) * (1.f / DM) + EPS);
            const float* md = MOD + (l * 2 + (isctx ? 1 : 0)) * 6144;
            const f32x4* sh = (const f32x4*)(md + 3 * 1024) + lane; const f32x4* sl = (const f32x4*)(md + 4 * 1024) + lane;
            u32x2* o8 = (u32x2*)(HB + (size_t)row * DM) + lane; f32x4* hr = (f32x4*)(hrow + (2 * wave + k) * 1024) + lane;
#pragma unroll
            for (int j = 0; j < 4; ++j) { const f32x4 h = vv[k][j] * rstd * g[64 * j] * (sl[64 * j] + 1.f) + sh[64 * j];
                hr[64 * j] = h; u32x2 w; w.x = cvt_pk_bf16(h.x, h.y); w.y = cvt_pk_bf16(h.z, h.w); if (st) o8[64 * j] = w; } }
        __syncthreads();
        if (rb + 16 < nloc && !((l != 1) && rb + 16 <= nlat && nlat < rb + 32)) N2_LOADX(rb + 16);
        float v32[32];
#pragma unroll
        for (int q = 0; q < 8; ++q) { const f32x4* hr = (const f32x4*)(hrow + (rh * 8 + q) * 1024) + lane; f32x4 acc = {0.f, 0.f, 0.f, 0.f};
#pragma unroll
            for (int j = 0; j < 4; ++j) { const f32x4 h = hr[64 * j];
#pragma unroll
                for (int e = 0; e < 4; ++e) { acc[e] = __builtin_fmaf(h.x, wk[j][0][e], acc[e]); acc[e] = __builtin_fmaf(h.y, wk[j][1][e], acc[e]); acc[e] = __builtin_fmaf(h.z, wk[j][2][e], acc[e]); acc[e] = __builtin_fmaf(h.w, wk[j][3][e], acc[e]); } }
            v32[q * 4] = acc[0]; v32[q * 4 + 1] = acc[1]; v32[q * 4 + 2] = acc[2]; v32[q * 4 + 3] = acc[3]; }
        float v16[16], v8[8], v4[4], v2[2], v1;
#pragma unroll
        for (int i = 0; i < 16; ++i) { const bool up = (lane & 32) != 0; v16[i] = (up ? v32[16 + i] : v32[i]) + __shfl_xor(up ? v32[i] : v32[16 + i], 32); }
#pragma unroll
        for (int i = 0; i < 8; ++i) { const bool up = (lane & 16) != 0; v8[i] = (up ? v16[8 + i] : v16[i]) + __shfl_xor(up ? v16[i] : v16[8 + i], 16); }
#pragma unroll
        for (int i = 0; i < 4; ++i) { const bool up = (lane & 8) != 0; v4[i] = (up ? v8[4 + i] : v8[i]) + __shfl_xor(up ? v8[i] : v8[4 + i], 8); }
#pragma unroll
        for (int i = 0; i < 2; ++i) { const bool up = (lane & 4) != 0; v2[i] = (up ? v4[2 + i] : v4[i]) + __shfl_xor(up ? v4[i] : v4[2 + i], 4); }
        { const bool up = (lane & 2) != 0; v1 = (up ? v2[1] : v2[0]) + __shfl_xor(up ? v2[0] : v2[1], 2); }
        v1 += __shfl_xor(v1, 1);
        { const int I = (lane >> 1) & 31, q = I >> 2, e = I & 3; const int rl = rh * 8 + q;
          if ((lane & 1) == 0 && rb + rl < nloc) logit[(rb + rl) * 16 + 4 * eg + e] = v1; }
        __syncthreads();
    }
#undef N2_LOADX
#undef N2_WAIT
    if (wave < 2) { const int rowl = wave * 64 + lane, row = N2_ROW(rowl);
      if (rowl < nloc) {
        float lg[16];
#pragma unroll
        for (int q = 0; q < 4; ++q) { const f32x4 t = *(const f32x4*)(logit + rowl * 16 + 4 * q); lg[4 * q] = t.x; lg[4 * q + 1] = t.y; lg[4 * q + 2] = t.z; lg[4 * q + 3] = t.w; }
        float sg[16], bs[16];
#pragma unroll
        for (int e = 0; e < 16; ++e) { sg[e] = sigmoid_f(lg[e]); bs[e] = sg[e] + a.in[I_RB][e]; }
        int gsel = 0; float best = 0.f;
#pragma unroll
        for (int gi = 0; gi < 4; ++gi) { const float p_ = bs[4 * gi], q_ = bs[4 * gi + 1], r_ = bs[4 * gi + 2], s_ = bs[4 * gi + 3];
            const float h1 = fmaxf(p_, q_), l1 = fminf(p_, q_), h2 = fmaxf(r_, s_), l2 = fminf(r_, s_);
            const float gsc = fmaxf(h1, h2) + fmaxf(fminf(h1, h2), fmaxf(l1, l2));
            if (gi == 0 || gsc > best) { best = gsc; gsel = gi; } }
        float gb[4], gs4[4];
#pragma unroll
        for (int i = 0; i < 4; ++i) { gb[i] = gsel == 0 ? bs[i] : gsel == 1 ? bs[4 + i] : gsel == 2 ? bs[8 + i] : bs[12 + i];
            gs4[i] = gsel == 0 ? sg[i] : gsel == 1 ? sg[4 + i] : gsel == 2 ? sg[8 + i] : sg[12 + i]; }
        int i0 = 0; float b0 = gb[0];
#pragma unroll
        for (int i = 1; i < 4; ++i) if (gb[i] > b0) { b0 = gb[i]; i0 = i; }
        int i1 = -1; float b1 = 0.f;
#pragma unroll
        for (int i = 0; i < 4; ++i) if (i != i0 && (i1 < 0 || gb[i] > b1)) { b1 = gb[i]; i1 = i; }
        const float s0 = i0 == 0 ? gs4[0] : i0 == 1 ? gs4[1] : i0 == 2 ? gs4[2] : gs4[3];
        const float s1 = i1 == 0 ? gs4[0] : i1 == 1 ? gs4[1] : i1 == 2 ? gs4[2] : gs4[3];
        const int e0 = gsel * 4 + i0, e1 = gsel * 4 + i1; const float inv = 1.f / (s0 + s1);
        TOKE[row] = make_int2(e0, e1); TOKW[row] = make_float2(s0 * inv, s1 * inv); e01[rowl] = e0 | (e1 << 8);
      } }
    __syncthreads();
    if (wave == 0) {
        int cnt = 0;
        for (int p = 0; p < 2; ++p) { const int pk = e01[p * 64 + lane]; const int e0 = pk < 0 ? -1 : (pk & 255), e1 = pk < 0 ? -1 : (pk >> 8);
#pragma unroll
            for (int e = 0; e < 16; ++e) { const int c = __popcll(__ballot(e0 == e)) + __popcll(__ballot(e1 == e)); if (lane == e) cnt += c; } }
        int base = 0;
        if (lane < 16) base = (int)__hip_atomic_fetch_add((unsigned*)(a.ws + WS_CTL) + CW_TOT + l * 64 + lane, (unsigned)cnt, __ATOMIC_RELAXED, __HIP_MEMORY_SCOPE_AGENT);
        int run[16];
#pragma unroll
        for (int e = 0; e < 16; ++e) run[e] = __builtin_amdgcn_readlane(base, e);
        int2* TOKP = (int2*)(a.ws + WS_TOKP); int* ROWTOK2 = (int*)(a.ws + WS_ROWTOK2) + (size_t)l * 16 * ROWCAP;
        for (int p = 0; p < 2; ++p) { const int i = p * 64 + lane, row = N2_ROW(i); const int pk = e01[i]; const bool ok = pk >= 0;
            const int ex = ok ? (pk & 255) : -1, ey = ok ? (pk >> 8) : -1;
            int pos0 = 0, pos1 = 0; const unsigned long long lt = (1ull << lane) - 1ull;
#pragma unroll
            for (int e = 0; e < 16; ++e) { const unsigned long long m0 = __ballot(ex == e), m1 = __ballot(ey == e);
                if (ex == e) pos0 = run[e] + __popcll(m0 & lt);
                if (ey == e) pos1 = run[e] + __popcll(m0) + __popcll(m1 & lt);
                run[e] += __popcll(m0) + __popcll(m1); }
            if (ok) { TOKP[row] = make_int2(ex * 32768 + pos0, ey * 32768 + pos1); ROWTOK2[ex * ROWCAP + pos0] = row; ROWTOK2[ey * ROWCAP + pos1] = row; } }
    }
    __syncthreads();
#undef N2_ROW
}
#ifndef ATT
#define ATT att2
#endif
#ifndef REP_INPROJ
#define REP_INPROJ 1
#endif
#ifndef REP_ATTN
#define REP_ATTN 1
#endif
#ifndef REP_OUTPROJ
#define REP_OUTPROJ 1
#endif
#ifndef REP_N2SC
#define REP_N2SC 1
#endif
#ifndef REP_MOE
#define REP_MOE 1
#endif
template <class Inner> struct RepOrder { Inner in; int ntot;
    __device__ __forceinline__ bool next(int i, pg8::Unit& u) const { if (i >= ntot) return false; const int nl = in.nloc(); return in.next(i % nl, u); }
    __device__ __forceinline__ unsigned row_off(int r) const { return in.row_off(r); }
    __device__ __forceinline__ void a_ready(const pg8::Unit&) const {}
    __device__ __forceinline__ void done(const pg8::Unit&) const {} };

__device__ __forceinline__ bool wg_any(bool pred, int* ws, int wid, int lane) {
    const int w = __any(pred) ? 1 : 0;
    __syncthreads();
    if (lane == 0) ws[wid] = w;
    __syncthreads();
    int r = 0;
#pragma unroll
    for (int i = 0; i < NWAVES; ++i) r |= ws[i];
    __syncthreads();
    return r != 0;
}
__device__ __forceinline__ void diff_unit(const Args& a, int l, int qt, int head, char* lds) {
    int tid_ = otid();
    const int tid = tid_, wid = tid >> 6, lane = tid & 63;
    const bool isctx = qt >= 64; const int q0 = qt * 256, nA = isctx ? 4 : 260, a0 = isctx ? SEQ : 0;
    const bf16_t* QA = (const bf16_t*)(a.ws + RA_QA); const bf16_t* KA = (const bf16_t*)(a.ws + RA_KA); const bf16_t* VA = (const bf16_t*)(a.ws + RA_VA);
    bf16_t* MIX = (bf16_t*)(a.ws + WS_HB);
    float* stash0 = (float*)(a.ws + WS_RB) + (size_t)blockIdx.x * 256 * 128;
    float* wsf = (float*)(lds + ATT::LDS_WS) + wid * 64;
    const float lam = ((const float*)(a.ws + WS_LAM))[l], post = 1.f - LAMBDA_INIT[l];
    for (int map = 0; map < 2; ++map) {
        f32x16 o[4]; float m_, l_;
        const bf16_t* Qw_ = QA + (size_t)(q0 + wid * 32 + (lane & 31)) * 512 + head * 128 + map * 64;
        ATT::attn_body<0, 512, 512, false>(Qw_, KA + head * 128 + map * 64, VA + head * 128, nA, a0, 0, nA, 0, lds, tid, o, m_, l_);
        if (wg_any(!(l_ < 1.0e18f), (int*)(lds + ATT::LDS_WS) + 8 * 64, wid, lane)) {
            ATT::attn_body<0, 512, 512, true>(Qw_, KA + head * 128 + map * 64, VA + head * 128, nA, a0, 0, nA, 0, lds, tid, o, m_, l_); }
        int lo_ = lane; asm volatile("" : "+v"(lo_));
        const int r32 = lo_ & 31, hi = lo_ >> 5;
        float* stashv = stash0 + (size_t)((wid << 6) | lo_) * 4;
        if (hi == 0) wsf[r32] = l_;
        LDS_WAIT();
        float rli[16];
#pragma unroll
        for (int r = 0; r < 16; ++r) rli[r] = __builtin_amdgcn_rcpf(wsf[ATT::crow(r, hi)]);
        if (map == 0) {
#pragma unroll
            for (int d0 = 0; d0 < 4; ++d0)
#pragma unroll
                for (int rq = 0; rq < 4; ++rq) *(f32x4*)(stashv + (size_t)((d0 * 4 + rq) * NTHREADS) * 4) =
                    (f32x4){o[d0][4 * rq] * rli[4 * rq], o[d0][4 * rq + 1] * rli[4 * rq + 1], o[d0][4 * rq + 2] * rli[4 * rq + 2], o[d0][4 * rq + 3] * rli[4 * rq + 3]};
        } else {
            const float* gn = a.in[I_DNG] + l * 128;
            float g4[4];
#pragma unroll
            for (int d0 = 0; d0 < 4; ++d0) g4[d0] = gn[d0 * 32 + r32] * post;
            float ss[16];
#pragma unroll
            for (int r = 0; r < 16; ++r) ss[r] = 0.f;
#pragma unroll
            for (int d0 = 0; d0 < 4; ++d0)
#pragma unroll
                for (int rq = 0; rq < 4; ++rq) { const f32x4 sv = *(const f32x4*)(stashv + (size_t)((d0 * 4 + rq) * NTHREADS) * 4);
#pragma unroll
                    for (int j = 0; j < 4; ++j) { const int r = 4 * rq + j; const float oc = sv[j] - lam * (o[d0][r] * rli[r]); o[d0][r] = oc; ss[r] += oc * oc; } }
            float s8[8], s4[4], s2[2], s1;
#pragma unroll
            for (int i = 0; i < 8; ++i) { const bool up = (lo_ & 16) != 0; s8[i] = (up ? ss[8 + i] : ss[i]) + __shfl_xor(up ? ss[i] : ss[8 + i], 16); }
#pragma unroll
            for (int i = 0; i < 4; ++i) { const bool up = (lo_ & 8) != 0; s4[i] = (up ? s8[4 + i] : s8[i]) + __shfl_xor(up ? s8[i] : s8[4 + i], 8); }
#pragma unroll
            for (int i = 0; i < 2; ++i) { const bool up = (lo_ & 4) != 0; s2[i] = (up ? s4[2 + i] : s4[i]) + __shfl_xor(up ? s4[i] : s4[2 + i], 4); }
            { const bool up = (lo_ & 2) != 0; s1 = (up ? s2[1] : s2[0]) + __shfl_xor(up ? s2[0] : s2[1], 2); }
            s1 += __shfl_xor(s1, 1);
            LDS_WAIT();
            if ((lo_ & 1) == 0) wsf[hi * 16 + ((lo_ >> 1) & 15)] = s1;
            LDS_WAIT();
#pragma unroll
            for (int r = 0; r < 16; ++r) { const float sc = __builtin_amdgcn_rsqf(wsf[hi * 16 + r] * (1.f / 128.f) + EPS);
                bf16_t* orow = MIX + (size_t)(q0 + wid * 32 + ATT::crow(r, hi)) * DM + head * 128 + r32;
#pragma unroll
                for (int d0 = 0; d0 < 4; ++d0) orow[d0 * 32] = (bf16_t)f2bf(o[d0][r] * sc * g4[d0]); }
        }
    }
}
__device__ __forceinline__ void win_unit(const Args& a, int l, int n, int g, char* lds) {
    int tid_ = otid();
    const int tid = tid_, wid = tid >> 6, lane = tid & 63;
    const bool isctx = n >= 128; const int h = 2 * g + (wid >> 2);
    const int rowq = (isctx ? SEQ + (n - 128) * 128 : n * 128) + (wid & 3) * 32;
    const int nB = isctx ? 0 : (6 - (n == 0 ? 2 : 0) - (n == 127 ? 2 : 0)), b0 = (n == 0) ? 0 : (n - 1) * 128;
    const bf16_t* QB = (const bf16_t*)(a.ws + RA_QB); const bf16_t* KB = (const bf16_t*)(a.ws + RA_KB); const bf16_t* VB = (const bf16_t*)(a.ws + RA_VB);
    bf16_t* MIX = (bf16_t*)(a.ws + WS_HB);
    float* wsf = (float*)(lds + ATT::LDS_WS) + wid * 64;
    f32x16 o[4]; float m_, l_;
    const bf16_t* Qw_ = QB + (size_t)(rowq + (lane & 31)) * 256 + h * 64;
    ATT::attn_body<1, 128, 256, false>(Qw_, KB + g * 64, VB + g * 128, 4, SEQ, b0, 4 + nB, rowq + (lane & 31), lds, tid, o, m_, l_);
    if (wg_any(!(l_ < 1.0e18f), (int*)(lds + ATT::LDS_WS) + 8 * 64, wid, lane)) {
        ATT::attn_body<1, 128, 256, true>(Qw_, KB + g * 64, VB + g * 128, 4, SEQ, b0, 4 + nB, rowq + (lane & 31), lds, tid, o, m_, l_); }
    const float ltot = l_ + __builtin_amdgcn_exp2f(a.in[I_SINK][l * 4 + h] * LOG2E - m_);
    int lo_ = lane; asm volatile("" : "+v"(lo_));
    const int r32 = lo_ & 31, hi = lo_ >> 5;
    if (hi == 0) wsf[r32] = ltot;
    LDS_WAIT();
#pragma unroll
    for (int r = 0; r < 16; ++r) { const float rl = __builtin_amdgcn_rcpf(wsf[ATT::crow(r, hi)]);
        bf16_t* orow = MIX + (size_t)(rowq + ATT::crow(r, hi)) * DM + 512 + h * 64 + r32;
        orow[0] = (bf16_t)f2bf(o[0][r] * rl); orow[32] = (bf16_t)f2bf(o[1][r] * rl); }
}
__device__ __forceinline__ void conv_unit(const Args& a, int l, int u, char* lds) {
    int tid_ = otid();
    const int tid = tid_, wid = tid >> 6, lane = tid & 63;
    const bool isctx = u >= 256; const int r0 = isctx ? (u - 256) * 64 : u * 64, rbase = isctx ? SEQ : 0, slen = isctx ? CTX : SEQ;
    const bf16_t* Z = (const bf16_t*)(a.ws + RA_Z); bf16_t* MIX = (bf16_t*)(a.ws + WS_HB);
    bf16_t* zt = (bf16_t*)lds; float* co = (float*)(lds + 49152);
    __syncthreads();
    for (int c = tid; c < 94 * 32; c += NTHREADS) { const int i = c >> 5, ch = c & 31, p = r0 - 15 + i;
        u32x4 v = {0u, 0u, 0u, 0u}; if (p >= 0 && p < slen) v = *(const u32x4*)(Z + (size_t)(rbase + p) * 256 + ch * 8);
        *(u32x4*)(zt + i * 256 + ch * 8) = v; }
    __syncthreads();
    { const int c = tid & 255, t0 = (tid >> 8) * 32; float w[31];
#pragma unroll
      for (int j = 0; j < 31; ++j) w[j] = a.in[I_CONVW][(size_t)(l * 31 + j) * 256 + c];
      const float bias = a.in[I_CONVB][l * 256 + c];
#pragma unroll
      for (int tb = 0; tb < 32; tb += 8) {
          float zr[38];
#pragma unroll
          for (int i = 0; i < 38; ++i) zr[i] = bf2f(zt[(t0 + tb + i) * 256 + c]);
#pragma unroll
          for (int t = 0; t < 8; ++t) { float acc = bias;
#pragma unroll
              for (int j = 0; j < 31; ++j) acc += zr[t + j] * w[j];
              co[(t0 + tb + t) * 256 + c] = acc; } } }
    __syncthreads();
    const f32x4 lg = *(const f32x4*)(a.in[I_LNG] + l * 256 + 4 * lane), lb = *(const f32x4*)(a.in[I_LNB] + l * 256 + 4 * lane);
#pragma unroll
    for (int ti = 0; ti < 8; ++ti) { const int t = wid + ti * NWAVES; const f32x4 v = *(const f32x4*)(co + t * 256 + 4 * lane);
        const float mu = wave_sum((v.x + v.y) + (v.z + v.w)) * (1.f / 256.f); const f32x4 d = v - mu;
        const float var = wave_sum((d.x * d.x + d.y * d.y) + (d.z * d.z + d.w * d.w)) * (1.f / 256.f); const float rs = 1.f / sqrtf(var + EPS);
        const f32x4 zn = d * rs * lg + lb;
        u32x2 w; w.x = cvt_pk_bf16(silu_f(zn.x), silu_f(zn.y)); w.y = cvt_pk_bf16(silu_f(zn.z), silu_f(zn.w));
        *(u32x2*)(MIX + (size_t)(rbase + r0 + t) * DM + 768 + 4 * lane) = w; }
    __syncthreads();
}
__device__ __forceinline__ void attn_phase(const Args& a, int l, char* lds, int pass) {
    const int b = blockIdx.x, G = gridDim.x, BIG = 1 << 20;
#ifndef AT_MASK
#define AT_MASK 7
#endif
    const int dst = pass == 0 ? b : (b < 4) ? 256 + b : BIG, wst = pass == 0 ? b : (b >= 4 && b < 8) ? 256 + (b - 4) : BIG, cst = pass == 0 ? b : (b >= 8 && b < 12) ? 256 + (b - 8) : BIG;
    const int uend = pass == 0 ? 256 : 260;
    if (AT_MASK & 1) for (int u = dst; u < uend; u += G) { const int qt = u < 256 ? (u >> 2) : 64, hd = u < 256 ? (u & 3) : (u - 256); diff_unit(a, l, qt, hd, lds); }
    if (AT_MASK & 2) for (int v = wst; v < uend; v += G) { const int n = v < 256 ? (v & 127) : 128 + ((v - 256) & 1), g = v < 256 ? (v >> 7) : ((v - 256) >> 1); win_unit(a, l, n, g, lds); }
    if (AT_MASK & 4) for (int v = cst; v < uend; v += G) conv_unit(a, l, v, lds);
    if (pass == 1 && b < 12) {
        asm volatile("s_waitcnt vmcnt(0)" ::: "memory"); __syncthreads();
        const int tid = otid(); if (tid < 64) { __builtin_amdgcn_fence(__ATOMIC_RELEASE, "agent"); asm volatile("s_waitcnt vmcnt(0)" ::: "memory");
            if (tid == 0) __hip_atomic_fetch_add((gu32*)(a.ws + WS_CTL) + CW_CTXC, 1u, __ATOMIC_RELAXED, __HIP_MEMORY_SCOPE_AGENT); } }
}

#ifndef MK_PER_PHASE
#define MK_PER_PHASE 0
#endif
#if defined(__HIP_DEVICE_COMPILE__)
#define KARGS(A) Args A; { const __attribute__((address_space(4))) Args* kp_ = (const __attribute__((address_space(4))) Args*)__builtin_amdgcn_kernarg_segment_ptr(); asm volatile("" : "+s"(kp_)); A = *kp_; }
#else
#define KARGS(A) Args A = a_unused;
#endif
__global__ void __launch_bounds__(NTHREADS, 2) hybrid_fwd(Args a_unused) {
    unsigned char* lds = g_lds;
    volatile LAS unsigned* MISC = (volatile LAS unsigned*)((LAS unsigned char*)lds + MISC_OFF);
    { const int tid0 = threadIdx.x; if (tid0 < 64) MISC[tid0] = 0u;
      if ((tid0 & 63) == 0) MISC[64 + ((unsigned)__builtin_amdgcn_s_getreg((5 << 11) | 4) & 63u)] = (unsigned)(tid0 >> 6); }
    __syncthreads();
    XcdBarrier bar; int lo, hi;
    { KARGS(a); lo = a.ph_lo; hi = a.ph_hi; gu32* ctl = (gu32*)(a.ws + WS_CTL);
      bar.bar = (unsigned*)(ctl + CW_BAR); bar.x = 0; bar.st = nullptr;
      if (!MK_PER_PHASE) bar = xcd_barrier_post((unsigned*)(ctl + CW_BAR), MISC); }
#ifndef PHMASK
#define PHMASK 0x3ffff
#endif
#define PHK(k) ((k) == 0 ? 0 : (k) == 17 ? 9 : (((k) - 1) & 7) + 1)
#define IN(k) (((PHMASK >> PHK(k)) & 1) && lo <= (k) && (k) < hi)
#define SEAM(k) do { if (!MK_PER_PHASE && IN(k) && IN((k) + 1)) xcd_barrier(bar); } while (0)
    LAS unsigned char* ldsl = (LAS unsigned char*)lds;
    const int G = gridDim.x, vcu = (G % 8 == 0) ? ((int)blockIdx.x % 8) * (G / 8) + (int)blockIdx.x / 8 : (int)blockIdx.x;

#ifndef REP_N1
#define REP_N1 1
#endif
#ifndef REP_SC
#define REP_SC 1
#endif
#ifndef REP_PRO
#define REP_PRO 1
#endif
    if (IN(0)) { KARGS(a); int nrep_ = REP_PRO; asm volatile("" : "+s"(nrep_)); for (int rp_ = 0; rp_ < nrep_; ++rp_) prologue_phase(a, lds); SEAM(0); }
    for (int l = 0; l < DEPTH; ++l) {
        const int pb = 1 + 8 * l;
        if (IN(pb + 0)) {
            KARGS(a);
            { int nrep_ = (l == 0) ? REP_N1 : 1; asm volatile("" : "+s"(nrep_)); for (int rp_ = 0; rp_ < nrep_; ++rp_) norm1_phase(a, l); }
            SEAM(pb + 0);
        }
        if (IN(pb + 1)) {
            KARGS(a);
            pg8::Gemm g{(const bf16_t*)(a.ws + WS_HB), (const bf16_t*)(a.ws + WS_WIN) + (size_t)l * INW * 1024, NROW, INW, DM};
            pg8::StaticOrder S; S.init(NROW, INW, G, (int)blockIdx.x);
            EpiInProj E{a.ws, (const float*)(a.ws + WS_ROPEC), (const float*)(a.ws + WS_ROPES)};
            RepOrder<pg8::StaticOrder> SR{S, REP_INPROJ * S.nloc()}; pg8::gemm_phase<EpiInProj, RepOrder<pg8::StaticOrder>, true, true>(ldsl, g, SR, E);
            if ((int)blockIdx.x >= 650 - 2 * G) {
                const int tid = otid(), c0 = 650 - 2 * G; moe_convert(a, l, (LAS float*)(ldsl + (tid >> 6) * 8704), ((int)blockIdx.x - c0) * NWAVES + (tid >> 6), (G - c0) * NWAVES, tid & 63, 8192, 12288); }
            SEAM(pb + 1);
        }
        if (IN(pb + 2)) { KARGS(a); int npass_ = (l == 0) ? 2 : 1; asm volatile("" : "+s"(npass_)); for (int ps_ = 0; ps_ < npass_; ++ps_) { attn_phase(a, l, (char*)lds, ps_); if (ps_ == 0) SEAM(pb + 2); } }
        if (IN(pb + 3)) {
            KARGS(a);
            const float* MOD = (const float*)(a.ws + WS_MOD);
            const int M = (l == DEPTH - 1) ? SEQ : NROW;
            pg8::Gemm g{(const bf16_t*)(a.ws + WS_HB), (const bf16_t*)(a.ws + WS_WOUT) + (size_t)l * 1024 * 1024, M, DM, DM};
            pg8::StaticOrder S; if (l == 0) S.init(61 * 256, DM, G - 12, (int)blockIdx.x - 12); else S.init(SEQ, DM, G, (int)blockIdx.x);
            EpiOutProj E{a.in[I_X], a.in[I_CTX], (bf16_t*)(a.ws + WS_XB), MOD + (l * 2) * 6144 + 2 * 1024, MOD + (l * 2 + 1) * 6144 + 2 * 1024, l};
            OutOrder SO{S, (gu32*)(a.ws + WS_CTL) + CW_OPC + l * 128, (l == 0) ? (gu32*)(a.ws + WS_CTL) + CW_CTXC : nullptr}; pg8::gemm_phase<EpiOutProj, OutOrder, true, true>(ldsl, g, SO, E);
            if (l == 0 && (int)blockIdx.x >= 16) {
                const int tid = otid(), nidle = G - 16; moe_convert(a, 1, (LAS float*)(ldsl + (tid >> 6) * 8704), ((int)blockIdx.x - 16) * NWAVES + (tid >> 6), nidle * NWAVES, tid & 63, 0, 8192); }
            __syncthreads();
        }
        if (IN(pb + 4)) { KARGS(a); int nrep_ = REP_N2SC; asm volatile("" : "+s"(nrep_)); for (int rp_ = 0; rp_ < nrep_; ++rp_) norm2_phase(a, l, lds); SEAM(pb + 4); }
        if (IN(pb + 6)) {
            KARGS(a);
            MoeOrder S; S.G = G; S.vcu = vcu;
            { const int tid = otid(); const unsigned* tot = (const unsigned*)(a.ws + WS_CTL) + CW_TOT + l * 64;
              if (tid == 0) { int t = 0; int* tsg = (int*)(a.ws + WS_TSG) + l * 32;
                  for (int e = 0; e < 16; ++e) { MISC[16 + e] = (unsigned)t; if (blockIdx.x == 0) tsg[e] = t; t += ((int)tot[e] + 255) >> 8; }
                  MISC[32] = (unsigned)t; if (blockIdx.x == 0) tsg[16] = t; }
              __syncthreads();
#pragma unroll
              for (int k = 0; k < 16; ++k) S.ts[k] = __builtin_amdgcn_readfirstlane((int)MISC[16 + k]);
              S.nunits = 4 * __builtin_amdgcn_readfirstlane((int)MISC[16 + 16]); }
            S.rowtok = (const int*)(a.ws + WS_ROWTOK2) + (size_t)l * 16 * ROWCAP;
            pg8::Gemm g{(const bf16_t*)(a.ws + WS_HB), (const bf16_t*)(a.ws + WS_W13) + (size_t)l * 16 * 1024 * 1024, XS_ROWS, 1024, DM};
            EpiMoe1 E{(bf16_t*)(a.ws + WS_RB)};
            pg8::gemm_phase<EpiMoe1, MoeOrder, true, true, true>(ldsl, g, S, E);
            gu32* flag = (gu32*)(a.ws + WS_CTL) + CW_MOEF + l * 256;
            { const int tid = otid(); if (tid == 0) __hip_atomic_store(flag + vcu, 1u, __ATOMIC_RELAXED, __HIP_MEMORY_SCOPE_AGENT); }
            MoeOrder2 S2; S2.vcu = vcu; S2.nunits = S.nunits;
#pragma unroll
            for (int k2 = 0; k2 < 16; ++k2) S2.ts[k2] = S.ts[k2];
            pg8::Gemm g2{(const bf16_t*)(a.ws + WS_RB), (const bf16_t*)(a.ws + WS_W2) + (size_t)l * 16 * 1024 * 512, XS_ROWS, 1024, FFE};
            EpiMoe2 E2{(bf16_t*)(a.ws + WS_RA)};
            const int r_ = S.nunits & 255;
            if (vcu >= r_ && S.nunits >= 256) { moe_wait(flag, vcu & ~3, 4); S2.part = 0; pg8::gemm_phase<EpiMoe2, MoeOrder2, true, true>(ldsl, g2, S2, E2); }
            if (r_ != 0) { moe_wait(flag, 0, r_); S2.part = 1; pg8::gemm_phase<EpiMoe2, MoeOrder2, true, true>(ldsl, g2, S2, E2); }
            SEAM(pb + 6);
        }
    }
    if (IN(17)) { KARGS(a); int nrep_ = REP_N1; asm volatile("" : "+s"(nrep_)); for (int rp_ = 0; rp_ < nrep_; ++rp_) norm1_phase(a, 2); }
#undef IN
#undef SEAM
}

extern "C" void kernel_launch(void* const* d_in, const int* in_sizes, int n_in, void* d_out, int out_size, void* d_ws, size_t ws_size, hipStream_t stream) {
    static int grid = 0;
    if (grid == 0) {
        if (n_in != 23 || in_sizes[0] != SEQ * DM || out_size != SEQ * DM || ws_size < WS_END) {
            fprintf(stderr, "kernel_launch: shape mismatch (n_in %d, in0 %d, out %d, ws %zu, need ws >= %zu); nothing launched\n", n_in, n_in > 0 ? in_sizes[0] : -1, out_size, ws_size, (size_t)WS_END); grid = -1; return; }
        int dev = 0, cus = 0, per_cu = 0;
        if (hipGetDevice(&dev) != hipSuccess || hipDeviceGetAttribute(&cus, hipDeviceAttributeMultiprocessorCount, dev) != hipSuccess) { fprintf(stderr, "kernel_launch: device query failed\n"); grid = -1; return; }
        if (hipFuncSetAttribute((const void*)hybrid_fwd, hipFuncAttributeMaxDynamicSharedMemorySize, LDS_BYTES) != hipSuccess) { fprintf(stderr, "kernel_launch: hipFuncSetAttribute failed\n"); grid = -1; return; }
        if (hipOccupancyMaxActiveBlocksPerMultiprocessor(&per_cu, (const void*)hybrid_fwd, NTHREADS, LDS_BYTES) != hipSuccess || per_cu < 1) { fprintf(stderr, "kernel_launch: occupancy query reports %d blocks per CU\n", per_cu); grid = -1; (void)hipGetLastError(); return; }
        if (cus != 256) { fprintf(stderr, "kernel_launch: built for 256 CUs, device has %d\n", cus); grid = -1; return; }
        grid = cus;
    }
    if (grid < 0) return;
    if (hipMemsetAsync((char*)d_ws + WS_CTL, 0, CTL_ZERO_BYTES, stream) != hipSuccess) { fprintf(stderr, "kernel_launch: memset failed\n"); return; }
    Args a{};
    for (int i = 0; i < 23; ++i) a.in[i] = (const float*)d_in[i];
    a.out = (float*)d_out; a.ws = (unsigned char*)d_ws;
#if MK_PER_PHASE
    for (int p = 0; p < N_PHASES; ++p) { a.ph_lo = p; a.ph_hi = p + 1; hipLaunchKernelGGL(hybrid_fwd, dim3(grid), dim3(NTHREADS), LDS_BYTES, stream, a); }
#else
    a.ph_lo = 0; a.ph_hi = N_PHASES;
    hipLaunchKernelGGL(hybrid_fwd, dim3(grid), dim3(NTHREADS), LDS_BYTES, stream, a);
#endif
    const hipError_t le = hipPeekAtLastError();
    if (le != hipSuccess) fprintf(stderr, "kernel_launch: launch failed: %s\n", hipGetErrorName(le));
}
```

```cpp
#define MK_PER_PHASE 0
#include <hip/hip_runtime.h>
#include <cstdio>
#include <cstdint>

#define GAS __attribute__((address_space(1)))
#define LAS __attribute__((address_space(3)))
typedef unsigned short bf16_t;
typedef short bf16x8 __attribute__((ext_vector_type(8)));
typedef short s16x4 __attribute__((ext_vector_type(4)));
typedef float f32x2 __attribute__((ext_vector_type(2)));
typedef float f32x4 __attribute__((ext_vector_type(4)));
typedef float f32x16 __attribute__((ext_vector_type(16)));
typedef unsigned u32x2 __attribute__((ext_vector_type(2)));
typedef unsigned u32x4 __attribute__((ext_vector_type(4)));
typedef GAS unsigned gu32;

constexpr int SEQ = 16384, CTX = 256, NROW = SEQ + CTX, DM = 1024, INW = 2560, NEXP = 16, FFE = 512, DEPTH = 2;
constexpr int XS_ROWS = 37376;
constexpr float EPS = 1e-6f, LOG2E = 1.4426950408889634f, QSCALE = 0.125f * 1.4426950408889634f;
constexpr int NWAVES = 8, NTHREADS = 512;

constexpr size_t MiB = 1u << 20;
constexpr size_t WS_CTL = 0, CTL_ZERO_BYTES = 128 * 1024;
constexpr size_t WS_MOD = 1 * MiB;
constexpr size_t WS_ROPEC = WS_MOD + 128 * 1024, WS_ROPES = WS_MOD + 192 * 1024;
constexpr size_t WS_LAM = WS_MOD + 256 * 1024;
constexpr size_t WS_CNT = WS_MOD + 320 * 1024;
constexpr size_t WS_TSG = WS_MOD + 384 * 1024;
constexpr size_t WS_TOKE = 2 * MiB, WS_TOKW = 2 * MiB + 256 * 1024, WS_TOKP = 2 * MiB + 512 * 1024;
constexpr size_t WS_ROWTOK = 3 * MiB;
constexpr size_t WS_WIN = 4 * MiB;
constexpr size_t WS_WOUT = 14 * MiB;
constexpr size_t WS_W13 = 18 * MiB;
constexpr size_t WS_W2 = 82 * MiB;
constexpr size_t WS_XB = 114 * MiB;
constexpr size_t WS_HB = 179 * MiB;
constexpr size_t WS_RA = 212 * MiB;
constexpr size_t RA_QA = WS_RA, RA_KA = RA_QA + (size_t)NROW * 512 * 2, RA_VA = RA_KA + (size_t)NROW * 512 * 2;
constexpr size_t RA_QB = RA_VA + (size_t)NROW * 512 * 2, RA_KB = RA_QB + (size_t)NROW * 256 * 2, RA_VB = RA_KB + (size_t)NROW * 128 * 2;
constexpr size_t RA_Z = RA_VB + (size_t)NROW * 256 * 2, RA_END = RA_Z + (size_t)NROW * 256 * 2;
constexpr size_t WS_RB = 290 * MiB;
constexpr size_t WS_ROWTOK2 = 327 * MiB;
constexpr size_t WS_END = 330 * MiB;
static_assert(RA_END <= WS_RB && WS_RA + (size_t)XS_ROWS * 2048 <= WS_RB && WS_RB + (size_t)XS_ROWS * 1024 <= WS_END && WS_RB + (size_t)256 * 256 * 128 * 4 <= WS_END, "ws map");
static_assert(WS_XB + (size_t)NROW * DM * 4 <= WS_HB && WS_HB + (size_t)NROW * DM * 2 <= WS_RA && WS_W13 + (size_t)2 * 16 * 1024 * 1024 * 2 <= WS_W2 && WS_W2 + (size_t)2 * 16 * 1024 * 512 * 2 <= WS_XB, "ws map 2");
constexpr int ROWCAP = 16640;
constexpr int CW_TOT = 24576;
constexpr int CW_MOEF = 28672;
constexpr int CW_OPC = 30720;
constexpr int CW_CTXC = 31232;
constexpr int CW_BAR = 4096;

constexpr int RING_BYTES = 131072;
constexpr int MISC_OFF = RING_BYTES;
constexpr int LDS_BYTES = 147456;

#define LDS_WAIT() asm volatile("s_waitcnt lgkmcnt(0)" ::: "memory")
#define VM_WAIT() asm volatile("s_waitcnt vmcnt(0)" ::: "memory")
__device__ __forceinline__ unsigned f2bf(float f) { unsigned u = __builtin_bit_cast(unsigned, f); return (u + 0x7fffu + ((u >> 16) & 1u)) >> 16; }
__device__ __forceinline__ unsigned pk2(float lo, float hi) { return f2bf(lo) | (f2bf(hi) << 16); }
__device__ __forceinline__ float bf2f(unsigned short b) { return __builtin_bit_cast(float, (unsigned)b << 16); }
__device__ __forceinline__ unsigned cvt_pk_bf16(float lo, float hi) { unsigned r; asm volatile("v_cvt_pk_bf16_f32 %0, %1, %2" : "=v"(r) : "v"(lo), "v"(hi)); return r; }
__device__ __forceinline__ float wave_sum(float v) {
#pragma unroll
    for (int o = 1; o < 64; o <<= 1) v += __shfl_xor(v, o);
    return v;
}
__device__ __forceinline__ f32x4 ld4bf(const bf16_t* p) { const u32x2 w = *(const u32x2*)p; return (f32x4){__builtin_bit_cast(float, w.x << 16), __builtin_bit_cast(float, w.x & 0xffff0000u), __builtin_bit_cast(float, w.y << 16), __builtin_bit_cast(float, w.y & 0xffff0000u)}; }
__device__ __forceinline__ void st4bf(bf16_t* p, const f32x4 v) { u32x2 w; w.x = cvt_pk_bf16(v.x, v.y); w.y = cvt_pk_bf16(v.z, v.w); *(u32x2*)p = w; }
__device__ __forceinline__ float silu_f(float a) { return a * __builtin_amdgcn_rcpf(1.f + __builtin_amdgcn_exp2f(-a * LOG2E)); }
__device__ __forceinline__ float sigmoid_f(float a) { return __builtin_amdgcn_rcpf(1.f + __builtin_amdgcn_exp2f(-a * LOG2E)); }
extern __shared__ __attribute__((aligned(16))) unsigned char g_lds[];
__device__ __forceinline__ int otid() {
    const unsigned slot = (unsigned)__builtin_amdgcn_s_getreg((5 << 11) | 4) & 63u;
    const int wave = ((const volatile LAS int*)((LAS unsigned char*)g_lds + MISC_OFF + 256))[slot];
    int ln; asm volatile("v_mbcnt_lo_u32_b32 %0, -1, 0\n\tv_mbcnt_hi_u32_b32 %0, -1, %0" : "=v"(ln));
    int t = (wave << 6) | ln;
    asm volatile("" : "+v"(t)); return t; }
namespace pg8 {
#define PG8_LAS __attribute__((address_space(3)))
constexpr int BM = 256, BK = 64, HALF = 128, HTB = HALF * BK * 2  , STAGE_BYTES = 8 * HTB, NXCD = 8, WGM = 8;

__host__ __device__ __forceinline__ int lds_byte(int r, int c) { const int st = (r >> 4) * 2 + (c >> 5), rr = r & 15, cc = c & 31, ob = rr * 64 + cc * 2; return st * 1024 + (ob ^ (((ob >> 9) & 1) << 5)); }
__host__ __device__ __forceinline__ void stage_rc(int b, int& R, int& C) { const int st = b / 1024, sb = b % 1024, swz = sb ^ (((sb >> 9) & 1) << 5); R = (st >> 1) * 16 + swz / 64; C = (st & 1) * 32 + (swz % 64) / 2; }
__host__ __device__ __forceinline__ int perm32(int rho) { const int n = rho >> 4, i = rho & 15; return 8 * (i >> 2) + 4 * n + (i & 3); }

struct Unit { int pm, pn, aux; };
struct Gemm { const bf16_t* A; const bf16_t* Bt; int M, N, K; };

struct StaticOrder {
    int nM, nN, nwg, G, c;
    __host__ __device__ void init(int M, int N, int G_, int c_) { nM = M / BM; nN = N / BM; nwg = nM * nN; G = G_; c = c_; }
    __host__ __device__ bool next(int i, Unit& u) const {
        const long L = (long)i * G + c; if (L >= nwg) return false;
        int wgid = (int)L; { const int q = nwg / NXCD, r = nwg % NXCD, xcd = wgid % NXCD, off = wgid / NXCD; wgid = (xcd < r ? xcd * (q + 1) : r * (q + 1) + (xcd - r) * q) + off; }
        const int nig = WGM * nN, gid = wgid / nig, fm = gid * WGM, gsz = (nM - fm) < WGM ? (nM - fm) : WGM;
        u.pm = fm + ((wgid % nig) % gsz); u.pn = (wgid % nig) / gsz; return true;
    }
    __host__ __device__ __forceinline__ int nloc() const { return c < nwg ? (nwg - c + G - 1) / G : 0; }
    __device__ __forceinline__ void a_ready(const Unit&) const {}
    __device__ __forceinline__ void done(const Unit&) const {}
};
template <class Epi, class Sched, bool ALIGN_EPI = false, bool SP2 = false, bool GATHER = false>
__device__ __forceinline__ void gemm_phase(PG8_LAS unsigned char* lds, const Gemm g, const Sched& S, const Epi& E) {
    const int tid = otid(), wid = __builtin_amdgcn_readfirstlane(tid >> 6), lane = tid & 63, wr = wid >> 2, wc = wid & 3, fr = lane & 15, fq = lane >> 4;
    const int K = g.K, nt = K / BK;
    unsigned voffA[2], voffB[2]; int rowA[2]; unsigned colA[2];
#pragma unroll
    for (int i = 0; i < 2; ++i) { int R, C; stage_rc(tid * 16 + i * 8192, R, C); const int Rb = Epi::PERM ? ((R & ~31) + perm32(R & 31)) : R;
        voffA[i] = (unsigned)(R * K + C) * 2u; voffB[i] = (unsigned)(Rb * K + C) * 2u; rowA[i] = R; colA[i] = (unsigned)C * 2u; }
    unsigned gc[2][2], gn[2][2];
#define PG8_GOFFS(dst, u) do { _Pragma("unroll") for (int h_ = 0; h_ < 2; ++h_) _Pragma("unroll") for (int i_ = 0; i_ < 2; ++i_) dst[h_][i_] = S.row_off((u), h_ * HALF + rowA[i_]) + colA[i_]; } while (0)
    const size_t kstep = (size_t)(BK * 2);
    const size_t hstep = (size_t)HALF * K * 2;
    const size_t tstep = 2 * hstep;
    const unsigned ldsw = (unsigned)wid * 1024u;
    const int aoff = lds_byte(wr * 64 + fr, fq * 8), boff = lds_byte(wc * 32 + fr, fq * 8);
#define PG8_SA(b, h) (((b) * 2 + (h)) * HTB)
#define PG8_SB(b, h) ((4 + (b) * 2 + (h)) * HTB)
#define PG8_STAGE(bufoff, gbase, voff) do { _Pragma("unroll") for (int _i = 0; _i < 2; ++_i) \
        __builtin_amdgcn_global_load_lds((const unsigned*)((const char*)(gbase) + (voff)[_i]), (PG8_LAS unsigned*)(lds + (bufoff) + ldsw + _i * 8192), 16, 0, 0); } while (0)
#define PG8_STAGE_A(bufoff, gbase, h, NX) do { _Pragma("unroll") for (int _i = 0; _i < 2; ++_i) { \
        const char* p_; if constexpr (GATHER) p_ = (const char*)(gbase) + ((NX) ? gn[h][_i] : gc[h][_i]); else p_ = (const char*)(gbase) + (h) * hstep + voffA[_i]; \
        __builtin_amdgcn_global_load_lds((const unsigned*)p_, (PG8_LAS unsigned*)(lds + (bufoff) + ldsw + _i * 8192), 16, 0, 0); } } while (0)
#define PG8_LDA(dst, b, h) do { _Pragma("unroll") for (int m = 0; m < 4; ++m) _Pragma("unroll") for (int k = 0; k < 2; ++k) dst[m][k] = *(const PG8_LAS bf16x8*)(lds + PG8_SA(b, h) + aoff + m * 2048 + k * 1024); } while (0)
#define PG8_LDB(dst, b, h) do { _Pragma("unroll") for (int n = 0; n < 2; ++n) _Pragma("unroll") for (int k = 0; k < 2; ++k) dst[n][k] = *(const PG8_LAS bf16x8*)(lds + PG8_SB(b, h) + boff + n * 2048 + k * 1024); } while (0)
#define PG8_MMA(ai, bj, At, Bt) do { __builtin_amdgcn_s_setprio(1); _Pragma("unroll") for (int m = 0; m < 4; ++m) _Pragma("unroll") for (int n = 0; n < 2; ++n) _Pragma("unroll") for (int k = 0; k < 2; ++k) \
        acc[ai][bj][m][n] = __builtin_amdgcn_mfma_f32_16x16x32_bf16(Bt[n][k], At[m][k], acc[ai][bj][m][n], 0, 0, 0); __builtin_amdgcn_s_setprio(0); } while (0)
#define PG8_WAIT_V(n) asm volatile("s_waitcnt vmcnt(" #n ")" ::: "memory")
#define PG8_WAIT_L(n) asm volatile("s_waitcnt lgkmcnt(" #n ")" ::: "memory")
#define PG8_BAR __builtin_amdgcn_s_barrier()
#define PG8_SCHED __builtin_amdgcn_sched_barrier(0)
    Unit cur, nxt; int ui = 0;
    if (!S.next(0, cur)) return;
    f32x4 acc[2][2][4][2];
#pragma unroll
    for (int a = 0; a < 2; ++a)
#pragma unroll
        for (int b = 0; b < 2; ++b)
#pragma unroll
            for (int m = 0; m < 4; ++m)
#pragma unroll
                for (int n = 0; n < 2; ++n) acc[a][b][m][n] = (f32x4){0.f, 0.f, 0.f, 0.f};
    bf16x8 At[4][2], B0[2][2], B1[2][2];
    const char* cA = GATHER ? (const char*)g.A : (const char*)g.A + (size_t)cur.pm * tstep; const char* cB = (const char*)g.Bt + (size_t)cur.pn * tstep;
    if constexpr (GATHER) { PG8_GOFFS(gc, cur); }
    S.a_ready(cur);
    if constexpr (SP2) {
        PG8_STAGE(PG8_SB(0, 0), cB, voffB); PG8_STAGE(PG8_SB(0, 1), cB + hstep, voffB); PG8_STAGE_A(PG8_SA(0, 0), cA, 0, false); PG8_STAGE_A(PG8_SA(0, 1), cA, 1, false);
        if (wr == 1) PG8_BAR;
        PG8_WAIT_V(2); PG8_BAR;
        PG8_STAGE(PG8_SB(1, 0), cB + kstep, voffB); PG8_STAGE_A(PG8_SA(1, 0), cA + kstep, 0, false); PG8_STAGE(PG8_SB(1, 1), cB + hstep + kstep, voffB);
        PG8_WAIT_V(6); PG8_BAR;
    } else {
        PG8_STAGE(PG8_SB(0, 0), cB, voffB); PG8_STAGE_A(PG8_SA(0, 0), cA, 0, false); PG8_STAGE(PG8_SB(0, 1), cB + hstep, voffB); PG8_STAGE_A(PG8_SA(0, 1), cA, 1, false);
        if (wr == 1) PG8_BAR;
        PG8_WAIT_V(4); PG8_BAR;
        PG8_STAGE(PG8_SB(1, 0), cB + kstep, voffB); PG8_STAGE_A(PG8_SA(1, 0), cA + kstep, 0, false); PG8_STAGE(PG8_SB(1, 1), cB + hstep + kstep, voffB);
        PG8_WAIT_V(6); PG8_BAR;
    }
    for (;;) {
        const bool has_next = S.next(ui + 1, nxt);
        if constexpr (GATHER) { if (has_next) { PG8_GOFFS(gn, nxt); } else {
#pragma unroll
            for (int h_ = 0; h_ < 2; ++h_) { gn[h_][0] = gc[h_][0]; gn[h_][1] = gc[h_][1]; } } }
        const char* nA = GATHER ? (const char*)g.A : has_next ? (const char*)g.A + (size_t)nxt.pm * tstep : cA; const char* nB = has_next ? (const char*)g.Bt + (size_t)nxt.pn * tstep : cB;
        for (int t = 0; t < nt; t += 2) {
            const bool last = (t == nt - 2);
            const char* a1 = cA + (size_t)(t + 1) * kstep;
            const char* a2 = last ? nA : cA + (size_t)(t + 2) * kstep; const char* b2 = last ? nB : cB + (size_t)(t + 2) * kstep;
            const char* a3 = a2 + kstep; const char* b3 = b2 + kstep;
            if (last && has_next) S.a_ready(nxt);
            if constexpr (SP2) {
            PG8_LDB(B0, 0, 0); PG8_LDB(B1, 0, 1); PG8_SCHED; PG8_LDA(At, 0, 0); PG8_STAGE_A(PG8_SA(1, 1), a1, 1, false);
            PG8_WAIT_V(8); PG8_WAIT_L(0); PG8_BAR; PG8_MMA(0, 0, At, B0); PG8_MMA(0, 1, At, B1); PG8_BAR; PG8_SCHED;
            PG8_LDA(At, 0, 1); PG8_STAGE(PG8_SB(0, 0), b2, voffB); PG8_STAGE(PG8_SB(0, 1), b2 + hstep, voffB); PG8_STAGE_A(PG8_SA(0, 0), a2, 0, last);
            PG8_WAIT_V(8); PG8_WAIT_L(0); PG8_BAR; PG8_MMA(1, 0, At, B0); PG8_MMA(1, 1, At, B1); PG8_BAR; PG8_SCHED;
            PG8_LDB(B0, 1, 0); PG8_LDB(B1, 1, 1); PG8_SCHED; PG8_LDA(At, 1, 0); PG8_STAGE_A(PG8_SA(0, 1), a2, 1, last);
            PG8_WAIT_V(8); PG8_WAIT_L(0); PG8_BAR; PG8_MMA(0, 0, At, B0); PG8_MMA(0, 1, At, B1); PG8_BAR; PG8_SCHED;
            PG8_LDA(At, 1, 1); PG8_STAGE(PG8_SB(1, 0), b3, voffB); PG8_STAGE(PG8_SB(1, 1), b3 + hstep, voffB); PG8_STAGE_A(PG8_SA(1, 0), a3, 0, last);
            PG8_WAIT_V(8); PG8_WAIT_L(0); PG8_BAR; PG8_MMA(1, 0, At, B0); PG8_MMA(1, 1, At, B1); PG8_BAR; PG8_SCHED;
            } else {
            PG8_LDB(B0, 0, 0); PG8_SCHED; PG8_LDA(At, 0, 0); PG8_STAGE_A(PG8_SA(1, 1), a1, 1, false);
            PG8_WAIT_L(8); PG8_BAR; PG8_WAIT_L(0); PG8_MMA(0, 0, At, B0); PG8_BAR; PG8_SCHED;
            PG8_LDB(B1, 0, 1); PG8_STAGE(PG8_SB(0, 0), b2, voffB);
            PG8_BAR; PG8_WAIT_L(0); PG8_MMA(0, 1, At, B1); PG8_BAR;
            PG8_LDA(At, 0, 1); PG8_STAGE_A(PG8_SA(0, 0), a2, 0, last);
            PG8_BAR; PG8_WAIT_L(0); PG8_MMA(1, 0, At, B0); PG8_BAR; PG8_SCHED;
            PG8_STAGE(PG8_SB(0, 1), b2 + hstep, voffB);
            PG8_WAIT_V(6); PG8_BAR; PG8_MMA(1, 1, At, B1); PG8_BAR;
            PG8_LDB(B0, 1, 0); PG8_SCHED; PG8_LDA(At, 1, 0); PG8_STAGE_A(PG8_SA(0, 1), a2, 1, last);
            PG8_WAIT_L(8); PG8_BAR; PG8_WAIT_L(0); PG8_MMA(0, 0, At, B0); PG8_BAR; PG8_SCHED;
            PG8_LDB(B1, 1, 1); PG8_STAGE(PG8_SB(1, 0), b3, voffB);
            PG8_BAR; PG8_WAIT_L(0); PG8_MMA(0, 1, At, B1); PG8_BAR;
            PG8_LDA(At, 1, 1); PG8_STAGE_A(PG8_SA(1, 0), a3, 0, last);
            PG8_BAR; PG8_WAIT_L(0); PG8_MMA(1, 0, At, B0); PG8_BAR; PG8_SCHED;
            PG8_STAGE(PG8_SB(1, 1), b3 + hstep, voffB);
            PG8_WAIT_V(6); PG8_BAR; PG8_MMA(1, 1, At, B1); PG8_BAR;
            }
        }
        if constexpr (ALIGN_EPI) { if (wr == 0) PG8_BAR; }
        if constexpr (!Epi::AFTER_DRAIN) { E(acc, cur, wr, wc, fr, fq); S.done(cur); }
        if (!has_next) break;
#pragma unroll
        for (int a = 0; a < 2; ++a)
#pragma unroll
            for (int b = 0; b < 2; ++b)
#pragma unroll
                for (int m = 0; m < 4; ++m)
#pragma unroll
                    for (int n = 0; n < 2; ++n) acc[a][b][m][n] = (f32x4){0.f, 0.f, 0.f, 0.f};
        cur = nxt; cA = nA; cB = nB; ++ui;
        if constexpr (GATHER) {
#pragma unroll
            for (int h_ = 0; h_ < 2; ++h_) { gc[h_][0] = gn[h_][0]; gc[h_][1] = gn[h_][1]; } }
        if constexpr (ALIGN_EPI) { if (wr == 1) PG8_BAR; }
    }
    PG8_WAIT_V(0);
    if constexpr (!ALIGN_EPI) { if (wr == 0) PG8_BAR; }
    PG8_BAR;
    if constexpr (Epi::AFTER_DRAIN) { E.fused(acc, cur, wr, wc, fr, fq, lds, wid, lane); S.done(cur); }
#undef PG8_SA
#undef PG8_SB
#undef PG8_STAGE
#undef PG8_STAGE_A
#undef PG8_GOFFS
#undef PG8_LDA
#undef PG8_LDB
#undef PG8_MMA
#undef PG8_WAIT_V
#undef PG8_WAIT_L
#undef PG8_BAR
#undef PG8_SCHED
}
}

namespace att2 {
constexpr int KSLOT = 8192, VSLOT = 16384, LDS_K = 0, LDS_V = 3 * KSLOT, LDS_WS = LDS_V + 3 * VSLOT, LDS_BYTES = LDS_WS + NWAVES * 256;
constexpr float THR = 8.f;
typedef LAS const char* lds_cptr;
typedef short v4i16_t __attribute__((ext_vector_type(4)));
typedef __bf16 bf2_t __attribute__((ext_vector_type(2)));
#define SBAR() __builtin_amdgcn_sched_barrier(0)
#define PIN(x) asm volatile("" : "+v"(x))
__device__ __forceinline__ int crow(int r, int hi) { return (r & 3) + 8 * (r >> 2) + 4 * hi; }
__device__ __forceinline__ f32x16 zero16() { float z = 0.f; asm volatile("" : "+v"(z)); f32x16 v;
#pragma unroll
    for (int r = 0; r < 16; ++r) v[r] = z;
    return v; }
__device__ __forceinline__ void glds16(const void* gsrc, unsigned lds_dst) { unsigned keep;
    asm volatile("s_mov_b32 %0, m0\n\ts_mov_b32 m0, %2\n\ts_nop 0\n\tglobal_load_lds_dwordx4 %1, off\n\ts_mov_b32 m0, %0" : "=&s"(keep) : "v"(gsrc), "s"(lds_dst) : "memory"); }
__device__ __forceinline__ bf16x8 kfrag(lds_cptr p) { return *(const LAS bf16x8*)p; }
__device__ __forceinline__ s16x4 vtr(lds_cptr p) { return __builtin_bit_cast(s16x4, __builtin_amdgcn_ds_read_tr16_b64_v4i16((LAS v4i16_t*)p)); }
__device__ __forceinline__ unsigned cvtpk_s(float lo, float hi) { typedef float f2 __attribute__((ext_vector_type(2))); typedef __bf16 b2 __attribute__((ext_vector_type(2)));
    f2 v = {lo, hi}; b2 b = __builtin_convertvector(v, b2); return __builtin_bit_cast(unsigned, b); }
#define MX3(a, b, c) __builtin_fmaxf(__builtin_fmaxf((a), (b)), (c))
__device__ __forceinline__ float rowmax(const f32x16& p0, const f32x16& p1) {
    float a = MX3(p0[0], p0[1], p1[0]), b = MX3(p0[2], p0[3], p1[1]); a = MX3(a, p1[2], p1[3]);
#pragma unroll
    for (int r = 4; r < 16; r += 4) { a = MX3(a, p0[r], p0[r + 1]); b = MX3(b, p0[r + 2], p0[r + 3]); a = MX3(a, p1[r], p1[r + 1]); b = MX3(b, p1[r + 2], p1[r + 3]); }
    float m = __builtin_fmaxf(a, b); auto rr = __builtin_amdgcn_permlane32_swap(__float_as_uint(m), __float_as_uint(m), false, false);
    return __builtin_fmaxf(__uint_as_float(rr[0]), __uint_as_float(rr[1])); }
__device__ __forceinline__ void wmask(f32x16& p0, f32x16& p1, int dk, int hi) {
#pragma unroll
    for (int r = 0; r < 16; ++r) { const int d = dk + crow(r, hi);
        if (d > 128 || d < -128) p0[r] = -1e30f;
        if (d + 32 > 128 || d + 32 < -128) p1[r] = -1e30f; } }
#define MFMA32(a, b, c) __builtin_amdgcn_mfma_f32_32x32x16_bf16(a, b, c, 0, 0, 0)
#define WAIT_BAR(N) asm volatile("s_waitcnt vmcnt(" #N ") lgkmcnt(0)\n\ts_barrier" ::: "memory")

template <int MODE, int LDK, int LDV, bool SAFE>
__device__ __forceinline__ void attn_body(const bf16_t* Qw, const bf16_t* Kh, const bf16_t* Vh, const int nA, const int a0, const int b0, const int NT, const int qpos,
                                          char* lds, const int tid, f32x16 (&o)[4], float& m_out, float& l_out) {
    constexpr int ND = (MODE == 1) ? 2 : 4, NVP = ND / 2;
    const int lane = tid & 63, r32 = lane & 31, hi = lane >> 5; const int wid = __builtin_amdgcn_readfirstlane(tid >> 6);
    const unsigned lds0 = (unsigned)(uintptr_t)lds; float* wsf = (float*)(lds + LDS_WS) + wid * 64;
#define KROW(t) ((t) < nA ? a0 + 64 * (t) : b0 + 64 * ((t) - nA))
    const bf16_t* ksrc = Kh + (size_t)lane * LDK + wid * 8;
    const bf16_t* vsrc = Vh + (size_t)(16 * (wid & 3) + (lane >> 2)) * LDV + (wid >> 2) * 32 + (lane & 3) * 8;
    const unsigned kdst = lds0 + LDS_K + wid * 1024, vdst = lds0 + LDS_V + (wid >> 2) * 4096 + (wid & 3) * 1024;
#define DMA_K(t, slot) glds16(ksrc + (size_t)KROW(t) * LDK, (unsigned)__builtin_amdgcn_readfirstlane(kdst + (slot) * KSLOT))
#define DMA_V(t, slot) do { const bf16_t* vs_ = vsrc + (size_t)KROW(t) * LDV; glds16(vs_, (unsigned)__builtin_amdgcn_readfirstlane(vdst + (slot) * VSLOT)); \
        if constexpr (NVP == 2) glds16(vs_ + 64, (unsigned)__builtin_amdgcn_readfirstlane(vdst + (slot) * VSLOT + 8192)); } while (0)
    const lds_cptr shm3 = (lds_cptr)(LAS char*)lds;
    const lds_cptr kp0 = shm3 + LDS_K + hi * 1024 + r32 * 16;
    const lds_cptr vp0 = shm3 + LDS_V + ((lane >> 4) & 1) * 32 + (lane & 3) * 8 + (4 * hi + ((lane & 15) >> 2)) * 64;
    bf16x8 qr[4];
#pragma unroll
    for (int d0 = 0; d0 < 4; ++d0) qr[d0] = *reinterpret_cast<const bf16x8*>(Qw + d0 * 16 + hi * 8);
    __syncthreads();
    if (wid >= 4) __builtin_amdgcn_s_setprio(1);
    DMA_K(0, 0); DMA_K(1, 1); DMA_V(0, 0);
    float mhat = 0.f, l_reg = 0.f;
#pragma unroll
    for (int d = 0; d < 4; ++d) o[d] = zero16();
    f32x16 negm = zero16(); PIN(negm);
    bool resc = false;
    if constexpr (NVP == 2) { WAIT_BAR(3); } else { WAIT_BAR(2); }
    f32x16 pA0, pA1, pB0, pB1;
    DMA_K(2, 2); DMA_V(1, 1);
    { bf16x8 kf[8];
#pragma unroll
      for (int i = 0; i < 8; ++i) kf[i] = kfrag(kp0 + (i >> 1) * 2048 + (i & 1) * 512);
      pA0 = MFMA32(kf[0], qr[0], negm); pA1 = MFMA32(kf[1], qr[0], negm); pA0 = MFMA32(kf[2], qr[1], pA0); pA1 = MFMA32(kf[3], qr[1], pA1);
      pA0 = MFMA32(kf[4], qr[2], pA0); pA1 = MFMA32(kf[5], qr[2], pA1); pA0 = MFMA32(kf[6], qr[3], pA0); pA1 = MFMA32(kf[7], qr[3], pA1); }
    if constexpr (MODE == 1) { if (0 >= nA) wmask(pA0, pA1, KROW(0) - qpos, hi); }
    { const float rm = rowmax(pA0, pA1); mhat = rm;
#pragma unroll
      for (int r = 0; r < 16; ++r) { pA0[r] = __builtin_amdgcn_exp2f(pA0[r] - rm); pA1[r] = __builtin_amdgcn_exp2f(pA1[r] - rm); }
#pragma unroll
      for (int r = 0; r < 16; ++r) negm[r] = -mhat;
      PIN(negm);
      if constexpr (!SAFE) { float s0 = 0.f, s1 = 0.f;
#pragma unroll
        for (int r = 0; r < 16; ++r) { s0 += pA0[r]; s1 += pA1[r]; }
        l_reg = s0 + s1; } }
    if constexpr (NVP == 2) { WAIT_BAR(3); } else { WAIT_BAR(2); }
    int sl_prev = 0, sl_cur = 1, sl_next = 2;
#define ROT() do { const int s_ = sl_prev; sl_prev = sl_cur; sl_cur = sl_next; sl_next = s_; } while (0)
#define RESC() do { if (resc) { asm volatile("s_waitcnt lgkmcnt(0)" ::: "memory"); \
        _Pragma("unroll") for (int d_ = 0; d_ < ND; ++d_) _Pragma("unroll") for (int r = 0; r < 16; ++r) o[d_][r] *= wsf[crow(r, hi)]; } } while (0)
    u32x4 pw0, pw1, pw2, pw3; s16x4 vl[16], vh[16]; bf16x8 kf[8]; float dummy_ = 0.f;
#define PAF(k) __builtin_bit_cast(bf16x8, pw##k)
#define VFR(i) (bf16x8){vl[i][0], vl[i][1], vl[i][2], vl[i][3], vh[i][0], vh[i][1], vh[i][2], vh[i][3]}
#define VRD(q, ks) do { if constexpr ((q) < ND) { vl[(q) * 4 + (ks)] = vtr(vp_ + ((q) * 4096 + (ks) * 1024)); vh[(q) * 4 + (ks)] = vtr(vp_ + ((q) * 4096 + (ks) * 1024 + 512)); } } while (0)
#define KRD(i) do { kf[i] = kfrag(kp_ + ((i) >> 1) * 2048 + ((i) & 1) * 512); } while (0)
#define PKW(P, i) cvtpk_s(P[i], P[i + 1])
#ifndef PROBE_VALU
#define PROBE_VALU 0
#endif
#ifndef ROWSUM_DOT2
#define ROWSUM_DOT2 0
#endif
#define DOT2(w, acc) __builtin_amdgcn_fdot2_f32_bf16(__builtin_bit_cast(bf2_t, (unsigned)(w)), __builtin_bit_cast(bf2_t, 0x3f803f80u), acc, false)
#define GAPA(MF, a0_, a1_, a2_, a3_, W0, W1, PW, i0_) do { MF; if (SAFE && !ROWSUM_DOT2) { sacc += a0_; sacb += a1_; sacc += a2_; sacb += a3_; PIN(sacc); PIN(sacb); } W0; W1; PIN(PW); \
        if (ROWSUM_DOT2) { sacc = DOT2(PW[i0_], sacc); sacb = DOT2(PW[(i0_) + 1], sacb); PIN(sacc); PIN(sacb); } SBAR(); } while (0)
#define EX(v) __builtin_amdgcn_exp2f(v)
#define GAPB(q, ks, X, i) do { if constexpr ((q) < ND) { o[q] = MFMA32(PAF(ks), VFR((q) * 4 + (ks)), o[q]); } X[i] = EX(X[i]); X[(i) + 1] = EX(X[(i) + 1]); X[(i) + 2] = EX(X[(i) + 2]); X[(i) + 3] = EX(X[(i) + 3]); PIN(X); SBAR(); } while (0)
#define GAPG(q, ks, ...) do { if constexpr ((q) < ND) { o[q] = MFMA32(PAF(ks), VFR((q) * 4 + (ks)), o[q]); } __VA_ARGS__; SBAR(); } while (0)
#define STEP(C0, C1, P0, P1, t, GK, GV) do { SBAR(); \
    const lds_cptr vp_ = vp0 + sl_prev * VSLOT; const lds_cptr kp_ = kp0 + sl_cur * KSLOT; \
    KRD(0); KRD(1); KRD(2); SBAR(); float sacc = (ROWSUM_DOT2 || !SAFE) ? 0.f : P0[0], sacb = (ROWSUM_DOT2 || !SAFE) ? 0.f : P0[1]; \
    KRD(3); SBAR();            GAPA(C0 = MFMA32(kf[0], qr[0], negm), P0[2], P0[3], P0[4], P0[5],     pw0[0] = PKW(P0, 0),  pw0[1] = PKW(P0, 2),  pw0, 0); \
    KRD(4); SBAR();            GAPA(C1 = MFMA32(kf[1], qr[0], negm), P0[6], P0[7], P0[8], P0[9],     pw0[2] = PKW(P0, 4),  pw0[3] = PKW(P0, 6),  pw0, 2); \
    KRD(5); SBAR();            GAPA(C0 = MFMA32(kf[2], qr[1], C0),   P0[10], P0[11], P0[12], P0[13], pw1[0] = PKW(P0, 8),  pw1[1] = PKW(P0, 10), pw1, 0); \
    KRD(6); SBAR();            GAPA(C1 = MFMA32(kf[3], qr[1], C1),   P0[14], P0[15], P1[0], P1[1],   pw1[2] = PKW(P0, 12), pw1[3] = PKW(P0, 14), pw1, 2); \
    KRD(7); VRD(0, 0); SBAR(); GAPA(C0 = MFMA32(kf[4], qr[2], C0),   P1[2], P1[3], P1[4], P1[5],     pw2[0] = PKW(P1, 0),  pw2[1] = PKW(P1, 2),  pw2, 0); \
            VRD(1, 0); SBAR(); GAPA(C1 = MFMA32(kf[5], qr[2], C1),   P1[6], P1[7], P1[8], P1[9],     pw2[2] = PKW(P1, 4),  pw2[3] = PKW(P1, 6),  pw2, 2); \
            VRD(2, 0); SBAR(); GAPA(C0 = MFMA32(kf[6], qr[3], C0),   P1[10], P1[11], P1[12], P1[13], pw3[0] = PKW(P1, 8),  pw3[1] = PKW(P1, 10), pw3, 0); \
            VRD(3, 0); SBAR(); GAPA(C1 = MFMA32(kf[7], qr[3], C1),   P1[14], P1[15], 0.f, 0.f,       pw3[2] = PKW(P1, 12), pw3[3] = PKW(P1, 14), pw3, 2); \
    if constexpr (SAFE) l_reg += sacc + sacb; \
    if constexpr (MODE == 1) { if ((t) >= nA) wmask(C0, C1, KROW(t) - qpos, hi); } \
    SBAR(); \
      \
      \
    if constexpr (!SAFE) { \
      \
    VRD(0, 1); SBAR(); GAPG(0, 0, C0[0] = EX(C0[0]); C0[1] = EX(C0[1]); PIN(C0)); \
    VRD(1, 1); SBAR(); GAPG(1, 0, C0[2] = EX(C0[2]); C0[3] = EX(C0[3]); sacc += C0[0]; sacb += C0[1]; PIN(C0); PIN(sacc); PIN(sacb)); \
    VRD(2, 1); SBAR(); GAPG(2, 0, C0[4] = EX(C0[4]); C0[5] = EX(C0[5]); sacc += C0[2]; sacb += C0[3]; PIN(C0); PIN(sacc); PIN(sacb)); \
    VRD(3, 1); SBAR(); GAPG(3, 0, C0[6] = EX(C0[6]); C0[7] = EX(C0[7]); sacc += C0[4]; sacb += C0[5]; PIN(C0); PIN(sacc); PIN(sacb)); \
    VRD(0, 2); SBAR(); GAPG(0, 1, C0[8] = EX(C0[8]); C0[9] = EX(C0[9]); sacc += C0[6]; sacb += C0[7]; PIN(C0); PIN(sacc); PIN(sacb)); \
    VRD(1, 2); SBAR(); GAPG(1, 1, C0[10] = EX(C0[10]); C0[11] = EX(C0[11]); sacc += C0[8]; sacb += C0[9]; PIN(C0); PIN(sacc); PIN(sacb)); \
    VRD(2, 2); SBAR(); GAPG(2, 1, C0[12] = EX(C0[12]); C0[13] = EX(C0[13]); sacc += C0[10]; sacb += C0[11]; PIN(C0); PIN(sacc); PIN(sacb)); \
    VRD(3, 2); SBAR(); GAPG(3, 1, C0[14] = EX(C0[14]); C0[15] = EX(C0[15]); sacc += C0[12]; sacb += C0[13]; PIN(C0); PIN(sacc); PIN(sacb)); \
    VRD(0, 3); SBAR(); GAPG(0, 2, C1[0] = EX(C1[0]); C1[1] = EX(C1[1]); sacc += C0[14]; sacb += C0[15]; PIN(C1); PIN(sacc); PIN(sacb)); \
    VRD(1, 3); SBAR(); GAPG(1, 2, C1[2] = EX(C1[2]); C1[3] = EX(C1[3]); sacc += C1[0]; sacb += C1[1]; PIN(C1); PIN(sacc); PIN(sacb)); \
    VRD(2, 3); SBAR(); GAPG(2, 2, C1[4] = EX(C1[4]); C1[5] = EX(C1[5]); sacc += C1[2]; sacb += C1[3]; PIN(C1); PIN(sacc); PIN(sacb)); \
    VRD(3, 3); SBAR(); GAPG(3, 2, C1[6] = EX(C1[6]); C1[7] = EX(C1[7]); sacc += C1[4]; sacb += C1[5]; PIN(C1); PIN(sacc); PIN(sacb)); \
    if (GK) { DMA_K((t) + 2, sl_prev); } SBAR(); GAPG(0, 3, C1[8] = EX(C1[8]); C1[9] = EX(C1[9]); sacc += C1[6]; sacb += C1[7]; PIN(C1); PIN(sacc); PIN(sacb)); \
    if (GV) { DMA_V((t) + 1, sl_next); } SBAR(); GAPG(1, 3, C1[10] = EX(C1[10]); C1[11] = EX(C1[11]); sacc += C1[8]; sacb += C1[9]; PIN(C1); PIN(sacc); PIN(sacb)); \
    GAPG(2, 3, C1[12] = EX(C1[12]); C1[13] = EX(C1[13]); sacc += C1[10]; sacb += C1[11]; PIN(C1); PIN(sacc); PIN(sacb)); \
    GAPG(3, 3, C1[14] = EX(C1[14]); C1[15] = EX(C1[15]); sacc += C1[12]; sacb += C1[13]; PIN(C1); PIN(sacc); PIN(sacb)); \
    sacc += C1[14]; sacb += C1[15]; l_reg += sacc + sacb; \
    } else { \
    float mxa, mxb; \
    VRD(0, 1); SBAR(); GAPG(0, 0, mxa = MX3(C0[0], C0[1], C0[2]); mxb = MX3(C0[3], C0[4], C0[5]); mxa = MX3(mxa, C0[6], C0[7]); mxb = MX3(mxb, C0[8], C0[9]); PIN(mxa); PIN(mxb)); \
    VRD(1, 1); SBAR(); GAPG(1, 0, mxa = MX3(mxa, C0[10], C0[11]); mxb = MX3(mxb, C0[12], C0[13]); mxa = MX3(mxa, C0[14], C0[15]); mxb = MX3(mxb, C1[0], C1[1]); PIN(mxa); PIN(mxb)); \
    VRD(2, 1); SBAR(); GAPG(2, 0, mxa = MX3(mxa, C1[2], C1[3]); mxb = MX3(mxb, C1[4], C1[5]); mxa = MX3(mxa, C1[6], C1[7]); mxb = MX3(mxb, C1[8], C1[9]); PIN(mxa); PIN(mxb)); \
    VRD(3, 1); SBAR(); GAPG(3, 0, mxa = MX3(mxa, C1[10], C1[11]); mxb = MX3(mxb, C1[12], C1[13]); mxa = MX3(mxa, C1[14], C1[15]); PIN(mxa); PIN(mxb)); \
    { float rm = __builtin_fmaxf(mxa, mxb); { auto rr = __builtin_amdgcn_permlane32_swap(__float_as_uint(rm), __float_as_uint(rm), false, false); rm = __builtin_fmaxf(__uint_as_float(rr[0]), __uint_as_float(rr[1])); } \
      resc = false; \
      if (__builtin_expect(__any(rm > THR), 0)) { const float dl = __builtin_fmaxf(rm, 0.f); mhat += dl; \
          _Pragma("unroll") for (int r = 0; r < 16; ++r) { C0[r] -= dl; C1[r] -= dl; } \
          _Pragma("unroll") for (int r = 0; r < 16; ++r) negm[r] = -mhat; PIN(negm); \
          const float f = __builtin_amdgcn_exp2f(-dl); l_reg *= f; if (hi == 0) wsf[r32] = f; resc = true; } } \
    SBAR(); \
    VRD(0, 2); SBAR(); GAPG(0, 1, C0[0] = EX(C0[0]); C0[1] = EX(C0[1]); C0[2] = EX(C0[2]); PIN(C0)); \
    VRD(1, 2); SBAR(); GAPG(1, 1, C0[3] = EX(C0[3]); C0[4] = EX(C0[4]); C0[5] = EX(C0[5]); PIN(C0)); \
    VRD(2, 2); SBAR(); GAPG(2, 1, C0[6] = EX(C0[6]); C0[7] = EX(C0[7]); C0[8] = EX(C0[8]); PIN(C0)); \
    VRD(3, 2); SBAR(); GAPG(3, 1, C0[9] = EX(C0[9]); C0[10] = EX(C0[10]); C0[11] = EX(C0[11]); PIN(C0)); \
    VRD(0, 3); SBAR(); GAPG(0, 2, C0[12] = EX(C0[12]); C0[13] = EX(C0[13]); C0[14] = EX(C0[14]); PIN(C0)); \
    VRD(1, 3); SBAR(); GAPG(1, 2, C0[15] = EX(C0[15]); C1[0] = EX(C1[0]); C1[1] = EX(C1[1]); PIN(C0); PIN(C1)); \
    VRD(2, 3); SBAR(); GAPG(2, 2, C1[2] = EX(C1[2]); C1[3] = EX(C1[3]); C1[4] = EX(C1[4]); PIN(C1)); \
    VRD(3, 3); SBAR(); GAPG(3, 2, C1[5] = EX(C1[5]); C1[6] = EX(C1[6]); C1[7] = EX(C1[7]); PIN(C1)); \
    if (GK) { DMA_K((t) + 2, sl_prev); if (PROBE_DUPK) DMA_K((t) + 2, sl_prev); } SBAR(); GAPG(0, 3, C1[8] = EX(C1[8]); C1[9] = EX(C1[9]); PIN(C1)); \
    if (GV) { DMA_V((t) + 1, sl_next); if (PROBE_DUPV) DMA_V((t) + 1, sl_next); } SBAR(); GAPG(1, 3, C1[10] = EX(C1[10]); C1[11] = EX(C1[11]); PIN(C1)); \
    GAPG(2, 3, C1[12] = EX(C1[12]); C1[13] = EX(C1[13]); PIN(C1)); \
    GAPG(3, 3, C1[14] = EX(C1[14]); C1[15] = EX(C1[15]); PIN(C1)); \
    } \
    } while (0)
#ifndef PROBE_DUPK
#define PROBE_DUPK 0
#endif
#ifndef PROBE_DUPV
#define PROBE_DUPV 0
#endif
#define WAIT_N(n_) do { if ((n_) == 6) { WAIT_BAR(6); } else if ((n_) == 5) { WAIT_BAR(5); } else if ((n_) == 4) { WAIT_BAR(4); } else if ((n_) == 3) { WAIT_BAR(3); } else if ((n_) == 2) { WAIT_BAR(2); } else if ((n_) == 1) { WAIT_BAR(1); } else { WAIT_BAR(0); } } while (0)
#define ENDW(tt) do { const int nk_ = ((tt) + 2 < NT) ? 1 + PROBE_DUPK : 0, nv_ = ((tt) + 1 < NT) ? NVP * (1 + PROBE_DUPV) : 0; WAIT_N(nk_ + nv_); } while (0)
    int t = 1;
    for (; t + 3 < NT; t += 2) {
        STEP(pB0, pB1, pA0, pA1, t, true, true);     WAIT_N(1 + PROBE_DUPK + NVP * (1 + PROBE_DUPV)); RESC(); ROT();
        STEP(pA0, pA1, pB0, pB1, t + 1, true, true); WAIT_N(1 + PROBE_DUPK + NVP * (1 + PROBE_DUPV)); RESC(); ROT();
    }
    for (; t + 1 < NT; t += 2) {
        STEP(pB0, pB1, pA0, pA1, t, (t + 2 < NT), (t + 1 < NT));         ENDW(t);     RESC(); ROT();
        STEP(pA0, pA1, pB0, pB1, t + 1, (t + 3 < NT), (t + 2 < NT));     ENDW(t + 1); RESC(); ROT();
    }
    STEP(pB0, pB1, pA0, pA1, NT - 1, false, false); WAIT_BAR(0); RESC(); ROT();
    { if constexpr (SAFE) { float sacc = pB0[0] + pB0[1];
#pragma unroll
      for (int r = 2; r < 16; ++r) sacc += pB0[r];
#pragma unroll
      for (int r = 0; r < 16; ++r) sacc += pB1[r];
      l_reg += sacc; }
      pw0 = (u32x4){PKW(pB0, 0), PKW(pB0, 2), PKW(pB0, 4), PKW(pB0, 6)}; pw1 = (u32x4){PKW(pB0, 8), PKW(pB0, 10), PKW(pB0, 12), PKW(pB0, 14)};
      pw2 = (u32x4){PKW(pB1, 0), PKW(pB1, 2), PKW(pB1, 4), PKW(pB1, 6)}; pw3 = (u32x4){PKW(pB1, 8), PKW(pB1, 10), PKW(pB1, 12), PKW(pB1, 14)};
      const lds_cptr vp_ = vp0 + sl_prev * VSLOT;
#pragma unroll
      for (int q = 0; q < ND; ++q) {
          s16x4 l0 = vtr(vp_ + q * 4096), h0 = vtr(vp_ + q * 4096 + 512), l1 = vtr(vp_ + q * 4096 + 1024), h1 = vtr(vp_ + q * 4096 + 1024 + 512);
          s16x4 l2 = vtr(vp_ + q * 4096 + 2048), h2 = vtr(vp_ + q * 4096 + 2048 + 512), l3 = vtr(vp_ + q * 4096 + 3072), h3 = vtr(vp_ + q * 4096 + 3072 + 512);
#define PKV(L, H) (bf16x8){L[0], L[1], L[2], L[3], H[0], H[1], H[2], H[3]}
          o[q] = MFMA32(PAF(0), PKV(l0, h0), o[q]); o[q] = MFMA32(PAF(1), PKV(l1, h1), o[q]); o[q] = MFMA32(PAF(2), PKV(l2, h2), o[q]); o[q] = MFMA32(PAF(3), PKV(l3, h3), o[q]);
#undef PKV
      } }
    { auto rr = __builtin_amdgcn_permlane32_swap(__float_as_uint(l_reg), __float_as_uint(l_reg), false, false); l_reg = __uint_as_float(rr[0]) + __uint_as_float(rr[1]); }
    if (PROBE_VALU) asm volatile("" :: "v"(dummy_));
    __builtin_amdgcn_s_setprio(0);
    m_out = mhat; l_out = l_reg;
#undef KROW
#undef DMA_K
#undef DMA_V
#undef ROT
#undef RESC
#undef PAF
#undef VFR
#undef VRD
#undef KRD
#undef PKW
#undef GAPA
#undef DOT2
#undef GAPB
#undef GAPG
#undef EX
#undef STEP
#undef ENDW
#undef WAIT_N
}
#undef SBAR
#undef PIN
#undef MX3
#undef MFMA32
#undef WAIT_BAR
}

#define XB_TMO      128
#define XB_XCNT(j)  (256  + 64 * (j))
#define XB_XSUB(j)  (1280 + 64 * (j))
#define XB_XGEN(j)  (2304 + 64 * (j))
#define XB_TOP      3328
#define XB_TOPGEN   3392
#define XCD_BAR_WORDS 3456
#define XB_SPIN_CAP (1u << 18)

__device__ __forceinline__ unsigned xb_ld(unsigned* p)              { return __hip_atomic_load(p, __ATOMIC_RELAXED, __HIP_MEMORY_SCOPE_AGENT); }
__device__ __forceinline__ unsigned xb_add(unsigned* p, unsigned v) { return __hip_atomic_fetch_add(p, v, __ATOMIC_RELAXED, __HIP_MEMORY_SCOPE_AGENT); }
__device__ __forceinline__ unsigned xb_xcc_id() { return (unsigned)__builtin_amdgcn_s_getreg((3 << 11) | 20) & 0xFu; }
#define XB_SPIN(cond, bar) do { unsigned _sp = 0; while (cond) { __builtin_amdgcn_s_sleep(1); \
    if ((++_sp & 255u) == 0u) { if (xb_ld(&(bar)[XB_TMO])) break; if (_sp > XB_SPIN_CAP) { atomicAdd(&(bar)[XB_TMO], 1u); break; } } } } while (0)

struct XcdBarrier {
    unsigned* bar; unsigned x;
    volatile LAS unsigned* st;
};

__device__ __forceinline__ XcdBarrier xcd_barrier_post(unsigned* bar, volatile LAS unsigned* st) {
    XcdBarrier b; b.bar = bar; b.x = xb_xcc_id(); b.st = st;
    if (threadIdx.x == 0) (void)xb_add(&bar[XB_XCNT(b.x)], 1u);
    return b;
}
__device__ __forceinline__ void xcd_barrier_complete(unsigned* bar, unsigned x, unsigned& nloc, unsigned& nx) {
    const unsigned G = gridDim.x * gridDim.y * gridDim.z;
    unsigned sum, cnt, mine, sp = 0u;
    for (;;) {
        sum = 0u; cnt = 0u; mine = 0u;
#pragma unroll
        for (unsigned j = 0; j < 16; ++j) { const unsigned c = xb_ld(&bar[XB_XCNT(j)]); sum += c; cnt += (c > 0u) ? 1u : 0u; mine = (j == x) ? c : mine; }
        if (sum == G) break;
        __builtin_amdgcn_s_sleep(1);
        if ((++sp & 255u) == 0u) { if (xb_ld(&bar[XB_TMO])) break; if (sp > XB_SPIN_CAP) { atomicAdd(&bar[XB_TMO], 1u); break; } }
    }
    nloc = mine > 0u ? mine : 1u; nx = cnt > 0u ? cnt : 1u;
}

__device__ __forceinline__ void xcd_barrier(const XcdBarrier& b) {
    asm volatile("s_waitcnt vmcnt(0)" ::: "memory");
    __syncthreads();
    if (threadIdx.x == 0) {
        unsigned* bar = b.bar;
        __builtin_amdgcn_s_waitcnt(0);
        unsigned nloc = b.st[0], nx = b.st[1];
        if (nloc == 0u) { xcd_barrier_complete(bar, b.x, nloc, nx); b.st[0] = nloc; b.st[1] = nx; }
        const unsigned old = xb_add(&bar[XB_XSUB(b.x)], 1u);
        const unsigned gen = old / nloc;
        if (old + 1u == (gen + 1u) * nloc) {
            __builtin_amdgcn_fence(__ATOMIC_RELEASE, "agent");
            asm volatile("s_waitcnt vmcnt(0)" ::: "memory");
            const unsigned og = xb_add(&bar[XB_TOP], 1u);
            const unsigned tg = og / nx;
            if (og + 1u == (tg + 1u) * nx) xb_add(&bar[XB_TOPGEN], 1u);
            else XB_SPIN(xb_ld(&bar[XB_TOPGEN]) == tg, bar);
            __builtin_amdgcn_fence(__ATOMIC_ACQUIRE, "agent");
            xb_add(&bar[XB_XGEN(b.x)], 1u);
            asm volatile("s_waitcnt vmcnt(0)" ::: "memory");
        } else {
            XB_SPIN(xb_ld(&bar[XB_XGEN(b.x)]) == gen, bar);
            __builtin_amdgcn_fence(__ATOMIC_ACQUIRE, "agent");
            asm volatile("s_waitcnt vmcnt(0)" ::: "memory");
        }
    }
    __syncthreads();
}

struct Args { const float* in[23]; float* out; unsigned char* ws; int ph_lo, ph_hi; };
enum { I_X = 0, I_C, I_CTX, I_CCTX, I_WADA, I_BADA, I_GMIX, I_WIN, I_DLAM, I_DNG, I_SINK, I_CONVW, I_CONVB, I_LNG, I_LNB, I_WOUT, I_GFFN, I_RW, I_RB, I_W1, I_W3, I_W2, I_GFIN };
constexpr int N_PHASES = 18;
__device__ __constant__ const float LAMBDA_INIT[2] = {0.2f, 0.35550906759097f};

struct EpiInProj {
    static constexpr bool PERM = true, AFTER_DRAIN = false;
    unsigned char* ws; const float* ropeC; const float* ropeS;
    __device__ __forceinline__ void operator()(const f32x4 (&acc)[2][2][4][2], const pg8::Unit& u, int wr, int wc, int fr, int fq) const {
        const int pn = u.pn; const bool latent = u.pm < 64; const int rowb = u.pm * 256 + wr * 64 + fr;
        if (pn >= 8) {
            bf16_t* Z = (bf16_t*)(ws + RA_Z); const int ch0 = (pn - 8) * 128 + wc * 32 + 8 * fq;
#pragma unroll
            for (int ai = 0; ai < 2; ++ai)
#pragma unroll
                for (int m = 0; m < 4; ++m) { const int row = rowb + ai * 128 + m * 16;
                    const f32x4 a0 = acc[ai][0][m][0], a1 = acc[ai][0][m][1], g0 = acc[ai][1][m][0], g1 = acc[ai][1][m][1];
                    u32x4 w; w.x = cvt_pk_bf16(a0[0] * sigmoid_f(g0[0]), a0[1] * sigmoid_f(g0[1])); w.y = cvt_pk_bf16(a0[2] * sigmoid_f(g0[2]), a0[3] * sigmoid_f(g0[3]));
                    w.z = cvt_pk_bf16(a1[0] * sigmoid_f(g1[0]), a1[1] * sigmoid_f(g1[1])); w.w = cvt_pk_bf16(a1[2] * sigmoid_f(g1[2]), a1[3] * sigmoid_f(g1[3]));
                    *(u32x4*)(Z + (size_t)row * 256 + ch0) = w; }
            return;
        }
        const float sgn = (fq < 2) ? -1.f : 1.f;
        const bool anyrope = latent && (pn < 4 || pn >= 6);
#pragma unroll
        for (int ai = 0; ai < 2; ++ai)
#pragma unroll
            for (int m = 0; m < 4; ++m) { const int row = rowb + ai * 128 + m * 16;
                f32x4 c0, c1, s0, s1;
                if (anyrope) { const int pos = (wc & 1) ? (row & 63) : (row >> 6); const int fo = pos * 16 + 8 * (fq & 1);
                    c0 = *(const f32x4*)(ropeC + fo); c1 = *(const f32x4*)(ropeC + fo + 4); s0 = *(const f32x4*)(ropeS + fo) * sgn; s1 = *(const f32x4*)(ropeS + fo + 4) * sgn; }
#pragma unroll
                for (int bj = 0; bj < 2; ++bj) {
                    bf16_t* dst; int ld, dcol; bool rope; float sc = 1.f; bool isvb = false;
                    if (pn < 2)       { dst = (bf16_t*)(ws + RA_QA); ld = 512; dcol = pn * 256 + bj * 128 + wc * 32; rope = true; sc = QSCALE; }
                    else if (pn < 4)  { dst = (bf16_t*)(ws + RA_KA); ld = 512; dcol = (pn - 2) * 256 + bj * 128 + wc * 32; rope = true; }
                    else if (pn < 6)  { dst = (bf16_t*)(ws + RA_VA); ld = 512; dcol = (pn - 4) * 256 + bj * 128 + wc * 32; rope = false; }
                    else if (pn == 6) { dst = (bf16_t*)(ws + RA_QB); ld = 256; dcol = bj * 128 + wc * 32; rope = true; sc = QSCALE; }
                    else if (bj == 0) { dst = (bf16_t*)(ws + RA_KB); ld = 128; dcol = wc * 32; rope = true; }
                    else              { dst = (bf16_t*)(ws + RA_VB); ld = 256; dcol = (wc >> 1) * 128 + (wc & 1) * 32; rope = false; isvb = true; }
                    rope = rope && latent;
                    f32x4 x0 = acc[ai][bj][m][0], x1 = acc[ai][bj][m][1];
                    if (rope) { f32x4 p0, p1;
#pragma unroll
                        for (int j = 0; j < 4; ++j) {
                            auto s0_ = __builtin_amdgcn_permlane32_swap(__float_as_uint(x0[j]), __float_as_uint(x0[j]), false, false); p0[j] = __uint_as_float(fq < 2 ? s0_[1] : s0_[0]);
                            auto s1_ = __builtin_amdgcn_permlane32_swap(__float_as_uint(x1[j]), __float_as_uint(x1[j]), false, false); p1[j] = __uint_as_float(fq < 2 ? s1_[1] : s1_[0]); }
                        x0 = x0 * c0 + p0 * s0; x1 = x1 * c1 + p1 * s1; }
                    x0 = x0 * sc; x1 = x1 * sc;
                    bf16_t* p = dst + (size_t)row * ld + dcol + 8 * fq;
                    u32x4 w; w.x = cvt_pk_bf16(x0[0], x0[1]); w.y = cvt_pk_bf16(x0[2], x0[3]); w.z = cvt_pk_bf16(x1[0], x1[1]); w.w = cvt_pk_bf16(x1[2], x1[3]);
                    *(u32x4*)p = w;
                    if (isvb) { unsigned zz = 0u; asm volatile("" : "+v"(zz)); const u32x4 z = {zz, zz, zz, zz}; *(u32x4*)(p + 64) = z; } }
            }
    }
};
__device__ __forceinline__ void st16_wt(void* p, const u32x4 v) { asm volatile("global_store_dwordx4 %0, %1, off sc1\n\ts_nop 1" :: "v"(p), "v"(v) : "memory"); }
__device__ __forceinline__ void st4bf_wt(bf16_t* p, const f32x4 v) { u32x2 w; w.x = cvt_pk_bf16(v.x, v.y); w.y = cvt_pk_bf16(v.z, v.w); asm volatile("global_store_dwordx2 %0, %1, off sc1\n\ts_nop 0" :: "v"(p), "v"(w) : "memory"); }
struct OutOrder {
    pg8::StaticOrder in; gu32* cnt; gu32* ctxc;
    __device__ __forceinline__ bool next(int i, pg8::Unit& u) const {
        if (ctxc == nullptr) { if (i != 0) return false; return in.next(0, u); }
        const int c = blockIdx.x;
        if (c < 12) { if (i != 0) return false; u.pm = 61 + (c >> 2); u.pn = c & 3; u.aux = 0; return true; }
        if (i == 0) return in.next(0, u);
        if (i == 1 && c < 16) { u.pm = 64; u.pn = c - 12; u.aux = 0; return true; }
        return false; }
    __device__ __forceinline__ void a_ready(const pg8::Unit& u) const {
        if (ctxc != nullptr && u.pm >= 64) { for (unsigned s = 0; s < (1u << 20); ++s) { if ((unsigned)__builtin_amdgcn_readfirstlane((int)__hip_atomic_load(ctxc, __ATOMIC_RELAXED, __HIP_MEMORY_SCOPE_AGENT)) == 12u) break; __builtin_amdgcn_s_sleep(2); }
            __builtin_amdgcn_fence(__ATOMIC_ACQUIRE, "agent"); } }
    __device__ __forceinline__ void done(const pg8::Unit& u) const {
        asm volatile("s_waitcnt vmcnt(0)" ::: "memory");
        int ln; asm volatile("v_mbcnt_lo_u32_b32 %0, -1, 0\n\tv_mbcnt_hi_u32_b32 %0, -1, %0" : "=v"(ln));
        if (ln == 0) __hip_atomic_fetch_add(cnt + u.pm, 1u, __ATOMIC_RELAXED, __HIP_MEMORY_SCOPE_AGENT); }
};
struct EpiOutProj {
    static constexpr bool PERM = true, AFTER_DRAIN = false;
    const float* xin; const float* ctxin; bf16_t* XB; const float* gate_lat; const float* gate_ctx; int layer;
    __device__ __forceinline__ void operator()(const f32x4 (&acc)[2][2][4][2], const pg8::Unit& u, int wr, int wc, int fr, int fq) const {
        const bool isctx = u.pm >= 64; const float* gate = isctx ? gate_ctx : gate_lat; const int col8 = u.pn * 256 + wc * 32 + 8 * fq;
#pragma unroll
        for (int ai = 0; ai < 2; ++ai)
#pragma unroll
            for (int m = 0; m < 4; ++m) { const int row = u.pm * 256 + ai * 128 + wr * 64 + m * 16 + fr;
                const float* xo = isctx ? ctxin + (size_t)(row - SEQ) * DM : xin + (size_t)row * DM;
                bf16_t* xn = XB + (size_t)row * DM;
#pragma unroll
                for (int bj = 0; bj < 2; ++bj) { const int col = col8 + bj * 128;
                    f32x4 x0, x1;
                    if (layer == 0) { x0 = *(const f32x4*)(xo + col); x1 = *(const f32x4*)(xo + col + 4); }
                    else { const u32x4 w = *(const u32x4*)(xn + col);
                        x0 = (f32x4){__builtin_bit_cast(float, w.x << 16), __builtin_bit_cast(float, w.x & 0xffff0000u), __builtin_bit_cast(float, w.y << 16), __builtin_bit_cast(float, w.y & 0xffff0000u)};
                        x1 = (f32x4){__builtin_bit_cast(float, w.z << 16), __builtin_bit_cast(float, w.z & 0xffff0000u), __builtin_bit_cast(float, w.w << 16), __builtin_bit_cast(float, w.w & 0xffff0000u)}; }
                    const f32x4 g0 = *(const f32x4*)(gate + col), g1 = *(const f32x4*)(gate + col + 4);
                    const f32x4 y0 = x0 + g0 * acc[ai][bj][m][0], y1 = x1 + g1 * acc[ai][bj][m][1];
                    u32x4 o; o.x = cvt_pk_bf16(y0.x, y0.y); o.y = cvt_pk_bf16(y0.z, y0.w); o.z = cvt_pk_bf16(y1.x, y1.y); o.w = cvt_pk_bf16(y1.z, y1.w);
                    st16_wt(xn + col, o); } }
    }
};
struct EpiMoe1 {
    static constexpr bool PERM = true, AFTER_DRAIN = false;
    bf16_t* HS;
    __device__ __forceinline__ void operator()(const f32x4 (&acc)[2][2][4][2], const pg8::Unit& u, int wr, int wc, int fr, int fq) const {
        const int col8 = (u.pn & 3) * 128 + wc * 32 + 8 * fq;
#pragma unroll
        for (int ai = 0; ai < 2; ++ai)
#pragma unroll
            for (int m = 0; m < 4; ++m) { const int row = u.pm * 256 + ai * 128 + wr * 64 + m * 16 + fr;
                const f32x4 a0 = acc[ai][0][m][0], a1 = acc[ai][0][m][1], b0 = acc[ai][1][m][0], b1 = acc[ai][1][m][1];
                u32x4 w; w.x = cvt_pk_bf16(silu_f(a0[0]) * b0[0], silu_f(a0[1]) * b0[1]); w.y = cvt_pk_bf16(silu_f(a0[2]) * b0[2], silu_f(a0[3]) * b0[3]);
                w.z = cvt_pk_bf16(silu_f(a1[0]) * b1[0], silu_f(a1[1]) * b1[1]); w.w = cvt_pk_bf16(silu_f(a1[2]) * b1[2], silu_f(a1[3]) * b1[3]);
                st16_wt(HS + (size_t)row * FFE + col8, w); }
    }
};
struct EpiMoe2 {
    static constexpr bool PERM = true, AFTER_DRAIN = false;
    bf16_t* YS;
    __device__ __forceinline__ void operator()(const f32x4 (&acc)[2][2][4][2], const pg8::Unit& u, int wr, int wc, int fr, int fq) const {
        const int col8 = (u.pn & 3) * 256 + wc * 32 + 8 * fq;
#pragma unroll
        for (int ai = 0; ai < 2; ++ai)
#pragma unroll
            for (int m = 0; m < 4; ++m) { const int row = u.pm * 256 + ai * 128 + wr * 64 + m * 16 + fr;
#pragma unroll
                for (int bj = 0; bj < 2; ++bj) { const f32x4 v0 = acc[ai][bj][m][0], v1 = acc[ai][bj][m][1];
                    u32x4 w; w.x = cvt_pk_bf16(v0[0], v0[1]); w.y = cvt_pk_bf16(v0[2], v0[3]); w.z = cvt_pk_bf16(v1[0], v1[1]); w.w = cvt_pk_bf16(v1[2], v1[3]);
                    *(u32x4*)(YS + (size_t)row * DM + col8 + bj * 128) = w; } }
    }
};
struct MoeOrder {
    int G, vcu, nunits; int ts[16]; const int* rowtok;
    __device__ __forceinline__ unsigned row_off(const pg8::Unit& u, int r) const { return (unsigned)min((unsigned)rowtok[u.aux + r], (unsigned)(NROW - 1)) * (unsigned)(DM * 2); }
    __device__ __forceinline__ bool next(int i, pg8::Unit& u) const {
        const int L = i * G + vcu; if (L >= nunits) return false;
        const int rt = L >> 2, ct = L & 3; int e = 0, tb = ts[0];
#pragma unroll
        for (int k = 1; k < 16; ++k) { const bool ge = rt >= ts[k]; e += ge ? 1 : 0; tb = ge ? ts[k] : tb; }
        u.pm = rt; u.pn = e * 4 + ct; u.aux = e * ROWCAP + (rt - tb) * 256; return true;
    }
    __device__ __forceinline__ int nloc() const { return vcu < nunits ? (nunits - vcu + G - 1) / G : 0; }
    __device__ __forceinline__ void a_ready(const pg8::Unit&) const {}
    __device__ __forceinline__ void done(const pg8::Unit&) const {}
};

struct MoeOrder2 {
    int vcu, nunits, part; int ts[16];
    __device__ __forceinline__ bool next(int i, pg8::Unit& u) const {
        const int U = nunits, q = U >> 8, r = U & 255; int L;
        if (part == 0) { if (vcu < r || i >= q) return false; L = i * 256 + vcu; }
        else { int b = vcu + i * 256; if (b >= (q + 1) * r) return false; int k = 0; while (b >= r) { b -= r; ++k; } L = k * 256 + b; }
        const int rt = L >> 2, ct = L & 3; int e = 0;
#pragma unroll
        for (int k = 1; k < 16; ++k) e += (rt >= ts[k]) ? 1 : 0;
        u.pm = rt; u.pn = e * 4 + ct; u.aux = 0; return true; }
    __device__ __forceinline__ void a_ready(const pg8::Unit&) const {}
    __device__ __forceinline__ void done(const pg8::Unit&) const {}
};
__device__ __forceinline__ void moe_wait(gu32* flag, int base, int n) {
    const int tid = otid();
    if (tid < 64) { for (unsigned s = 0; s < (1u << 20); ++s) { bool ok = true;
            for (int j = tid; j < n; j += 64) ok = ok && (__hip_atomic_load(flag + base + j, __ATOMIC_RELAXED, __HIP_MEMORY_SCOPE_AGENT) == 1u);
            if (__all(ok)) break; __builtin_amdgcn_s_sleep(2); }
        __builtin_amdgcn_fence(__ATOMIC_ACQUIRE, "agent"); asm volatile("s_waitcnt vmcnt(0)" ::: "memory"); }
    __syncthreads();
}

__device__ __forceinline__ void tr_item(const float* W, int ldw, int k0, int n0, bf16_t* WT, int K, int nd0, LAS float* scr, int lane) {
    f32x4 v[8];
#pragma unroll
    for (int i = 0; i < 8; ++i) v[i] = *(const f32x4*)(W + (size_t)(k0 + 8 * i + (lane >> 3)) * ldw + n0 + (lane & 7) * 4);
#pragma unroll
    for (int i = 0; i < 8; ++i) { LAS float* d = scr + (8 * i + (lane >> 3)) * 33 + (lane & 7) * 4; d[0] = v[i].x; d[1] = v[i].y; d[2] = v[i].z; d[3] = v[i].w; }
    LDS_WAIT(); asm volatile("" ::: "memory");
    const int c = lane & 7;
#pragma unroll
    for (int j = 0; j < 4; ++j) { const int n = (lane >> 3) + 8 * j; const LAS float* s = scr + (8 * c) * 33 + n;
        u32x4 o; o.x = pk2(s[0 * 33], s[1 * 33]); o.y = pk2(s[2 * 33], s[3 * 33]); o.z = pk2(s[4 * 33], s[5 * 33]); o.w = pk2(s[6 * 33], s[7 * 33]);
        *(u32x4*)(WT + (size_t)(nd0 + n) * K + k0 + 8 * c) = o; }
    LDS_WAIT(); asm volatile("" ::: "memory");
}
__device__ __forceinline__ void moe_convert(const Args& a, int L, LAS float* scr, int gw, int NGW, int lane, int it0 = 0, int it1 = 12288) {
    bf16_t* W13T = (bf16_t*)(a.ws + WS_W13) + (size_t)L * 16 * 1024 * 1024; bf16_t* W2T = (bf16_t*)(a.ws + WS_W2) + (size_t)L * 16 * 1024 * 512;
    for (int it = it0 + gw; it < it1; it += NGW) {
        if (it < 8192) { const int e = it >> 9, r2 = it & 511, kb = r2 >> 5, nb = r2 & 31, nd0 = 32 * nb, t = nd0 >> 8, bj = (nd0 >> 7) & 1, i0 = nd0 & 127;
            const float* src = (bj ? a.in[I_W3] : a.in[I_W1]) + (size_t)(L * 16 + e) * 1024 * 512;
            tr_item(src, 512, 64 * kb, t * 128 + i0, W13T + (size_t)e * 1024 * 1024, 1024, nd0, scr, lane); }
        else { const int r = it - 8192, e = r >> 8, r2 = r & 255, kb = r2 >> 5, nb = r2 & 31;
            tr_item(a.in[I_W2] + (size_t)(L * 16 + e) * 512 * 1024, 1024, 64 * kb, 32 * nb, W2T + (size_t)e * 1024 * 512, 512, 32 * nb, scr, lane); }
    }
}
__device__ __forceinline__ void prologue_phase(const Args& a, unsigned char* lds) {
    const int tid = otid(), lane = tid & 63, wave = tid >> 6, gw = blockIdx.x * NWAVES + wave, NGW = gridDim.x * NWAVES;
    LAS float* scr = (LAS float*)((LAS unsigned char*)lds + wave * 8704);
    bf16_t* WinT = (bf16_t*)(a.ws + WS_WIN); bf16_t* WoutT = (bf16_t*)(a.ws + WS_WOUT);
    for (int it = gw; it < 3584; it += NGW) {
        if (it < 2560) { const int L = it / 1280, r = it % 1280, kb = r / 80, nb = r % 80, nd0 = 32 * nb; int n0 = nd0;
            if (nd0 >= 2048) { const int q = nd0 - 2048, t = q >> 8, bj = (q >> 7) & 1, i0 = q & 127; n0 = 2048 + bj * 256 + t * 128 + i0; }
            tr_item(a.in[I_WIN] + (size_t)L * 1024 * INW, INW, 64 * kb, n0, WinT + (size_t)L * INW * 1024, 1024, nd0, scr, lane); }
        else { const int r0 = it - 2560, L = r0 >> 9, r = r0 & 511, kb = r >> 5, nb = r & 31;
            tr_item(a.in[I_WOUT] + (size_t)L * 1024 * 1024, 1024, 64 * kb, 32 * nb, WoutT + (size_t)L * 1024 * 1024, 1024, 32 * nb, scr, lane); }
    }
    moe_convert(a, 0, scr, gw, NGW, lane, 0, 8192);
    __syncthreads();
    float* sc = (float*)(lds + 71680); float* scc = sc + 1024; float* red = scc + 1024;
    float* MOD = (float*)(a.ws + WS_MOD);
    for (int u = blockIdx.x; u < 192; u += gridDim.x) {
        const int L = u / 96, col0 = (u % 96) * 64;
        for (int k = tid; k < 1024; k += NTHREADS) { const float c = a.in[I_C][k], cc = a.in[I_CCTX][k]; sc[k] = c / (1.f + expf(-c)); scc[k] = cc / (1.f + expf(-cc)); }
        __syncthreads();
        const int cg = tid & 15, ks = tid >> 4;
        const float* w = a.in[I_WADA] + ((size_t)L * 1024 + ks * 32) * 6144 + col0 + cg * 4;
        f32x4 s1 = {0.f, 0.f, 0.f, 0.f}, s2 = {0.f, 0.f, 0.f, 0.f};
#pragma unroll 8
        for (int k = 0; k < 32; ++k) { const f32x4 wv = *(const f32x4*)(w + (size_t)k * 6144); s1 = s1 + wv * sc[ks * 32 + k]; s2 = s2 + wv * scc[ks * 32 + k]; }
        *(f32x4*)(red + (ks * 16 + cg) * 8) = s1; *(f32x4*)(red + (ks * 16 + cg) * 8 + 4) = s2;
        __syncthreads();
        if (tid < 128) { const int which = tid >> 6, c = tid & 63; float s = 0.f;
            for (int k = 0; k < 32; ++k) s += red[(k * 16 + (c >> 2)) * 8 + which * 4 + (c & 3)];
            MOD[(L * 2 + which) * 6144 + col0 + c] = s + a.in[I_BADA][L * 6144 + col0 + c]; }
        __syncthreads();
    }
    if (blockIdx.x >= 192 && tid < 64) {
        float* rc = (float*)(a.ws + WS_ROPEC); float* rs = (float*)(a.ws + WS_ROPES);
        const int i = ((int)blockIdx.x - 192) * 64 + tid; const int pos = i >> 4, f = i & 15; const float inv = powf(10000.f, -(float)f / 16.f), ang = (float)pos * inv; rc[i] = cosf(ang); rs[i] = sinf(ang);
    }
    if (blockIdx.x == gridDim.x - 2 && wave < 2) {
        const float* dl = a.in[I_DLAM] + wave * 256;
        const float s01 = wave_sum(dl[lane] * dl[64 + lane]), s23 = wave_sum(dl[128 + lane] * dl[192 + lane]);
        if (lane == 0) ((float*)(a.ws + WS_LAM))[wave] = expf(s01) - expf(s23) + LAMBDA_INIT[wave];
    }
}

__device__ __forceinline__ void norm1_phase(const Args& a, int l) {
    constexpr int NR = 4;
    const int tid = otid(), lane = tid & 63, wave = tid >> 6;
    const int nrows = (l == 2) ? SEQ : NROW, rpw = (nrows + gridDim.x - 1) / gridDim.x, r0 = blockIdx.x * rpw, r1 = min(nrows, r0 + rpw);
    const int rw = (rpw + NWAVES - 1) / NWAVES, wr0 = r0 + wave * rw, wr1 = min(r1, wr0 + rw);
    bf16_t* XB = (bf16_t*)(a.ws + WS_XB); bf16_t* HB = (bf16_t*)(a.ws + WS_HB); const bf16_t* YS = (const bf16_t*)(a.ws + WS_RA);
    const float* MOD = (const float*)(a.ws + WS_MOD);
    const int2* TOKP = (const int2*)(a.ws + WS_TOKP); const float2* TOKW = (const float2*)(a.ws + WS_TOKW);
    for (int rb = wr0; rb < wr1; rb += NR) {
        f32x4 v[NR][4]; int rowk[NR];
#pragma unroll
        for (int k = 0; k < NR; ++k) rowk[k] = min(rb + k, wr1 - 1);
        if (l == 0) {
#pragma unroll
            for (int k = 0; k < NR; ++k) { const int row = rowk[k]; const bool isctx = row >= SEQ;
                const f32x4* src = (const f32x4*)(isctx ? a.in[I_CTX] + (size_t)(row - SEQ) * DM : a.in[I_X] + (size_t)row * DM) + lane;
#pragma unroll
                for (int j = 0; j < 4; ++j) v[k][j] = src[64 * j]; }
        } else {
            int2 pp[NR]; float2 ww[NR];
#pragma unroll
            for (int k = 0; k < NR; ++k) { pp[k] = TOKP[rowk[k]]; ww[k] = TOKW[rowk[k]]; }
            { const int* tsg = (const int*)(a.ws + WS_TSG) + (l - 1) * 32;
#pragma unroll
              for (int k = 0; k < NR; ++k) { pp[k].x = tsg[pp[k].x >> 15] * 256 + (pp[k].x & 32767); pp[k].y = tsg[pp[k].y >> 15] * 256 + (pp[k].y & 32767); } }
            u32x2 y0[NR][4], y1[NR][4]; f32x4 gt[NR][4];
#pragma unroll
            for (int k = 0; k < NR; ++k) { const int row = rowk[k]; const bool isctx = row >= SEQ;
                const bf16_t* xb = XB + (size_t)row * DM + 4 * lane;
                const f32x4* gate = (const f32x4*)(MOD + ((l - 1) * 2 + (isctx ? 1 : 0)) * 6144 + 5 * 1024) + lane;
                const u32x2* q0 = (const u32x2*)(YS + (size_t)pp[k].x * DM) + lane; const u32x2* q1 = (const u32x2*)(YS + (size_t)pp[k].y * DM) + lane;
#pragma unroll
                for (int j = 0; j < 4; ++j) { v[k][j] = ld4bf(xb + 256 * j); gt[k][j] = gate[64 * j]; y0[k][j] = q0[64 * j]; y1[k][j] = q1[64 * j]; } }
#pragma unroll
            for (int k = 0; k < NR; ++k) { const bool st = (rb + k < wr1) && (l < 2); bf16_t* xb = XB + (size_t)rowk[k] * DM + 4 * lane;
#pragma unroll
                for (int j = 0; j < 4; ++j) { const u32x2 p0 = y0[k][j], p1 = y1[k][j];
                    const f32x4 ya = {bf2f((unsigned short)(p0.x & 0xffff)), bf2f((unsigned short)(p0.x >> 16)), bf2f((unsigned short)(p0.y & 0xffff)), bf2f((unsigned short)(p0.y >> 16))};
                    const f32x4 yb = {bf2f((unsigned short)(p1.x & 0xffff)), bf2f((unsigned short)(p1.x >> 16)), bf2f((unsigned short)(p1.y & 0xffff)), bf2f((unsigned short)(p1.y >> 16))};
                    v[k][j] = v[k][j] + gt[k][j] * (ya * ww[k].x + yb * ww[k].y);
                    if (st) st4bf(xb + 256 * j, v[k][j]); } }
        }
#pragma unroll
        for (int k = 0; k < NR; ++k) { const int row = rowk[k]; const bool isctx = row >= SEQ, st = rb + k < wr1;
            float ss = 0.f;
#pragma unroll
            for (int j = 0; j < 4; ++j) ss += (v[k][j].x * v[k][j].x + v[k][j].y * v[k][j].y) + (v[k][j].z * v[k][j].z + v[k][j].w * v[k][j].w);
            const float rstd = 1.f / sqrtf(wave_sum(ss) * (1.f / DM) + EPS);
            if (l < 2) {
                const f32x4* g = (const f32x4*)(a.in[I_GMIX] + l * DM) + lane; const float* md = MOD + (l * 2 + (isctx ? 1 : 0)) * 6144;
                const f32x4* sh = (const f32x4*)(md) + lane; const f32x4* sl = (const f32x4*)(md + 1024) + lane;
                u32x2* o8 = (u32x2*)(HB + (size_t)row * DM) + lane;
#pragma unroll
                for (int j = 0; j < 4; ++j) { const f32x4 h = v[k][j] * rstd * g[64 * j] * (sl[64 * j] + 1.f) + sh[64 * j];
                    u32x2 w; w.x = cvt_pk_bf16(h.x, h.y); w.y = cvt_pk_bf16(h.z, h.w); if (st) o8[64 * j] = w; }
            } else {
                const f32x4* g = (const f32x4*)(a.in[I_GFIN]) + lane; f32x4* o = (f32x4*)(a.out + (size_t)row * DM) + lane;
#pragma unroll
                for (int j = 0; j < 4; ++j) { const f32x4 r = v[k][j] * rstd * g[64 * j]; if (st) o[64 * j] = r; }
            }
        }
    }
}
__device__ __forceinline__ void norm2_phase(const Args& a, int l, unsigned char* lds) {
    const int tid = otid(), lane = tid & 63, wave = tid >> 6;
    const int b_ = blockIdx.x;
    const int nlat = (l == 1) ? 64 : (b_ < 16 ? 1 : 65), lat0 = (l == 1) ? b_ * 64 : (b_ < 16 ? 240 * 65 + b_ : (b_ - 16) * 65);
    const int nlate = (l == 1) ? 0 : 4, late0 = 61 * 256 + 4 * b_, tl = 61 + (b_ >> 6), nloc = nlat + nlate;
#define N2_ROW(i) ((i) < nlat ? lat0 + (i) : late0 + ((i) - nlat))
    float* hrow = (float*)lds;
    float* logit = (float*)(lds + 65536);
    int* e01 = (int*)(lds + 65536 + 8192);
    for (int i = tid; i < 128; i += NTHREADS) e01[i] = -1;
    gu32* cnt = (gu32*)(a.ws + WS_CTL) + CW_OPC + l * 128;
#define N2_WAIT(ta_, tb_) do { if (tid < 64) { for (unsigned s = 0; s < (1u << 20); ++s) { const unsigned c = __hip_atomic_load(cnt + ((lane & 1) ? (tb_) : (ta_)), __ATOMIC_RELAXED, __HIP_MEMORY_SCOPE_AGENT); \
              if (__all(c == 32u)) break; __builtin_amdgcn_s_sleep(2); } \
          __builtin_amdgcn_fence(__ATOMIC_ACQUIRE, "agent"); asm volatile("s_waitcnt vmcnt(0)" ::: "memory"); } \
      __syncthreads(); } while (0)
    N2_WAIT(lat0 >> 8, (lat0 + nlat - 1) >> 8);
    const bf16_t* XB = (const bf16_t*)(a.ws + WS_XB); bf16_t* HB = (bf16_t*)(a.ws + WS_HB); const float* MOD = (const float*)(a.ws + WS_MOD);
    int2* TOKE = (int2*)(a.ws + WS_TOKE); float2* TOKW = (float2*)(a.ws + WS_TOKW);
    const int eg = wave & 3, rh = wave >> 2;
    f32x4 wk[4][4];
#pragma unroll
    for (int j = 0; j < 4; ++j)
#pragma unroll
        for (int c = 0; c < 4; ++c) wk[j][c] = *(const f32x4*)(a.in[I_RW] + (size_t)(256 * j + 4 * lane + c) * 16 + 4 * eg);
    const f32x4* g = (const f32x4*)(a.in[I_GFFN] + l * DM) + lane;
    u32x2 xr[2][4];
#define N2_LOADX(rb_) do { _Pragma("unroll") for (int k = 0; k < 2; ++k) { const bf16_t* xb = XB + (size_t)N2_ROW(min((rb_) + 2 * wave + k, nloc - 1)) * DM + 4 * lane; \
        _Pragma("unroll") for (int j = 0; j < 4; ++j) xr[k][j] = *(const u32x2*)(xb + 256 * j); } } while (0)
    const bool cfirst = (l != 1) && nlat < 16;
    if (cfirst) N2_WAIT(tl, tl);
    N2_LOADX(0);
    for (int rb = 0; rb < nloc; rb += 16) {
        if ((l != 1) && !cfirst && rb <= nlat && nlat < rb + 16) { N2_WAIT(tl, tl); N2_LOADX(rb); }
        f32x4 vv[2][4];
#pragma unroll
        for (int k = 0; k < 2; ++k)
#pragma unroll
            for (int j = 0; j < 4; ++j) { const u32x2 w = xr[k][j]; vv[k][j] = (f32x4){__builtin_bit_cast(float, w.x << 16), __builtin_bit_cast(float, w.x & 0xffff0000u), __builtin_bit_cast(float, w.y << 16), __builtin_bit_cast(float, w.y & 0xffff0000u)}; }
#pragma unroll
        for (int k = 0; k < 2; ++k) { const int row = N2_ROW(min(rb + 2 * wave + k, nloc - 1)); const bool isctx = row >= SEQ, st = rb + 2 * wave + k < nloc;
            float ss = 0.f;
#pragma unroll
            for (int j = 0; j < 4; ++j) ss += (vv[k][j].x * vv[k][j].x + vv[k][j].y * vv[k][j].y) + (vv[k][j].z * vv[k][j].z + vv[k][j].w * vv[k][j].w);
            const float rstd = 1.f / sqrtf(wave_sum(ss) * (1.f / DM) + EPS);
            const float* md = MOD + (l * 2 + (isctx ? 1 : 0)) * 6144;
            const f32x4* sh = (const f32x4*)(md + 3 * 1024) + lane; const f32x4* sl = (const f32x4*)(md + 4 * 1024) + lane;
            u32x2* o8 = (u32x2*)(HB + (size_t)row * DM) + lane; f32x4* hr = (f32x4*)(hrow + (2 * wave + k) * 1024) + lane;
#pragma unroll
            for (int j = 0; j < 4; ++j) { const f32x4 h = vv[k][j] * rstd * g[64 * j] * (sl[64 * j] + 1.f) + sh[64 * j];
                hr[64 * j] = h; u32x2 w; w.x = cvt_pk_bf16(h.x, h.y); w.y = cvt_pk_bf16(h.z, h.w); if (st) o8[64 * j] = w; } }
        __syncthreads();
        if (rb + 16 < nloc && !((l != 1) && rb + 16 <= nlat && nlat < rb + 32)) N2_LOADX(rb + 16);
        float v32[32];
#pragma unroll
        for (int q = 0; q < 8; ++q) { const f32x4* hr = (const f32x4*)(hrow + (rh * 8 + q) * 1024) + lane; f32x4 acc = {0.f, 0.f, 0.f, 0.f};
#pragma unroll
            for (int j = 0; j < 4; ++j) { const f32x4 h = hr[64 * j];
#pragma unroll
                for (int e = 0; e < 4; ++e) { acc[e] = __builtin_fmaf(h.x, wk[j][0][e], acc[e]); acc[e] = __builtin_fmaf(h.y, wk[j][1][e], acc[e]); acc[e] = __builtin_fmaf(h.z, wk[j][2][e], acc[e]); acc[e] = __builtin_fmaf(h.w, wk[j][3][e], acc[e]); } }
            v32[q * 4] = acc[0]; v32[q * 4 + 1] = acc[1]; v32[q * 4 + 2] = acc[2]; v32[q * 4 + 3] = acc[3]; }
        float v16[16], v8[8], v4[4], v2[2], v1;
#pragma unroll
        for (int i = 0; i < 16; ++i) { const bool up = (lane & 32) != 0; v16[i] = (up ? v32[16 + i] : v32[i]) + __shfl_xor(up ? v32[i] : v32[16 + i], 32); }
#pragma unroll
        for (int i = 0; i < 8; ++i) { const bool up = (lane & 16) != 0; v8[i] = (up ? v16[8 + i] : v16[i]) + __shfl_xor(up ? v16[i] : v16[8 + i], 16); }
#pragma unroll
        for (int i = 0; i < 4; ++i) { const bool up = (lane & 8) != 0; v4[i] = (up ? v8[4 + i] : v8[i]) + __shfl_xor(up ? v8[i] : v8[4 + i], 8); }
#pragma unroll
        for (int i = 0; i < 2; ++i) { const bool up = (lane & 4) != 0; v2[i] = (up ? v4[2 + i] : v4[i]) + __shfl_xor(up ? v4[i] : v4[2 + i], 4); }
        { const bool up = (lane & 2) != 0; v1 = (up ? v2[1] : v2[0]) + __shfl_xor(up ? v2[0] : v2[1], 2); }
        v1 += __shfl_xor(v1, 1);
        { const int I = (lane >> 1) & 31, q = I >> 2, e = I & 3; const int rl = rh * 8 + q;
          if ((lane & 1) == 0 && rb + rl < nloc) logit[(rb + rl) * 16 + 4 * eg + e] = v1; }
        __syncthreads();
    }
#undef N2_LOADX
#undef N2_WAIT
    if (wave < 2) { const int rowl = wave * 64 + lane, row = N2_ROW(rowl);
      if (rowl < nloc) {
        float lg[16];
#pragma unroll
        for (int q = 0; q < 4; ++q) { const f32x4 t = *(const f32x4*)(logit + rowl * 16 + 4 * q); lg[4 * q] = t.x; lg[4 * q + 1] = t.y; lg[4 * q + 2] = t.z; lg[4 * q + 3] = t.w; }
        float sg[16], bs[16];
#pragma unroll
        for (int e = 0; e < 16; ++e) { sg[e] = sigmoid_f(lg[e]); bs[e] = sg[e] + a.in[I_RB][e]; }
        int gsel = 0; float best = 0.f;
#pragma unroll
        for (int gi = 0; gi < 4; ++gi) { const float p_ = bs[4 * gi], q_ = bs[4 * gi + 1], r_ = bs[4 * gi + 2], s_ = bs[4 * gi + 3];
            const float h1 = fmaxf(p_, q_), l1 = fminf(p_, q_), h2 = fmaxf(r_, s_), l2 = fminf(r_, s_);
            const float gsc = fmaxf(h1, h2) + fmaxf(fminf(h1, h2), fmaxf(l1, l2));
            if (gi == 0 || gsc > best) { best = gsc; gsel = gi; } }
        float gb[4], gs4[4];
#pragma unroll
        for (int i = 0; i < 4; ++i) { gb[i] = gsel == 0 ? bs[i] : gsel == 1 ? bs[4 + i] : gsel == 2 ? bs[8 + i] : bs[12 + i];
            gs4[i] = gsel == 0 ? sg[i] : gsel == 1 ? sg[4 + i] : gsel == 2 ? sg[8 + i] : sg[12 + i]; }
        int i0 = 0; float b0 = gb[0];
#pragma unroll
        for (int i = 1; i < 4; ++i) if (gb[i] > b0) { b0 = gb[i]; i0 = i; }
        int i1 = -1; float b1 = 0.f;
#pragma unroll
        for (int i = 0; i < 4; ++i) if (i != i0 && (i1 < 0 || gb[i] > b1)) { b1 = gb[i]; i1 = i; }
        const float s0 = i0 == 0 ? gs4[0] : i0 == 1 ? gs4[1] : i0 == 2 ? gs4[2] : gs4[3];
        const float s1 = i1 == 0 ? gs4[0] : i1 == 1 ? gs4[1] : i1 == 2 ? gs4[2] : gs4[3];
        const int e0 = gsel * 4 + i0, e1 = gsel * 4 + i1; const float inv = 1.f / (s0 + s1);
        TOKE[row] = make_int2(e0, e1); TOKW[row] = make_float2(s0 * inv, s1 * inv); e01[rowl] = e0 | (e1 << 8);
      } }
    __syncthreads();
    if (wave == 0) {
        int cnt = 0;
        for (int p = 0; p < 2; ++p) { const int pk = e01[p * 64 + lane]; const int e0 = pk < 0 ? -1 : (pk & 255), e1 = pk < 0 ? -1 : (pk >> 8);
#pragma unroll
            for (int e = 0; e < 16; ++e) { const int c = __popcll(__ballot(e0 == e)) + __popcll(__ballot(e1 == e)); if (lane == e) cnt += c; } }
        int base = 0;
        if (lane < 16) base = (int)__hip_atomic_fetch_add((unsigned*)(a.ws + WS_CTL) + CW_TOT + l * 64 + lane, (unsigned)cnt, __ATOMIC_RELAXED, __HIP_MEMORY_SCOPE_AGENT);
        int run[16];
#pragma unroll
        for (int e = 0; e < 16; ++e) run[e] = __builtin_amdgcn_readlane(base, e);
        int2* TOKP = (int2*)(a.ws + WS_TOKP); int* ROWTOK2 = (int*)(a.ws + WS_ROWTOK2) + (size_t)l * 16 * ROWCAP;
        for (int p = 0; p < 2; ++p) { const int i = p * 64 + lane, row = N2_ROW(i); const int pk = e01[i]; const bool ok = pk >= 0;
            const int ex = ok ? (pk & 255) : -1, ey = ok ? (pk >> 8) : -1;
            int pos0 = 0, pos1 = 0; const unsigned long long lt = (1ull << lane) - 1ull;
#pragma unroll
            for (int e = 0; e < 16; ++e) { const unsigned long long m0 = __ballot(ex == e), m1 = __ballot(ey == e);
                if (ex == e) pos0 = run[e] + __popcll(m0 & lt);
                if (ey == e) pos1 = run[e] + __popcll(m0) + __popcll(m1 & lt);
                run[e] += __popcll(m0) + __popcll(m1); }
            if (ok) { TOKP[row] = make_int2(ex * 32768 + pos0, ey * 32768 + pos1); ROWTOK2[ex * ROWCAP + pos0] = row; ROWTOK2[ey * ROWCAP + pos1] = row; } }
    }
    __syncthreads();
#undef N2_ROW
}
#ifndef ATT
#define ATT att2
#endif
#ifndef REP_INPROJ
#define REP_INPROJ 1
#endif
#ifndef REP_ATTN
#define REP_ATTN 1
#endif
#ifndef REP_OUTPROJ
#define REP_OUTPROJ 1
#endif
#ifndef REP_N2SC
#define REP_N2SC 1
#endif
#ifndef REP_MOE
#define REP_MOE 1
#endif
template <class Inner> struct RepOrder { Inner in; int ntot;
    __device__ __forceinline__ bool next(int i, pg8::Unit& u) const { if (i >= ntot) return false; const int nl = in.nloc(); return in.next(i % nl, u); }
    __device__ __forceinline__ unsigned row_off(int r) const { return in.row_off(r); }
    __device__ __forceinline__ void a_ready(const pg8::Unit&) const {}
    __device__ __forceinline__ void done(const pg8::Unit&) const {} };

__device__ __forceinline__ bool wg_any(bool pred, int* ws, int wid, int lane) {
    const int w = __any(pred) ? 1 : 0;
    __syncthreads();
    if (lane == 0) ws[wid] = w;
    __syncthreads();
    int r = 0;
#pragma unroll
    for (int i = 0; i < NWAVES; ++i) r |= ws[i];
    __syncthreads();
    return r != 0;
}
__device__ __forceinline__ void diff_unit(const Args& a, int l, int qt, int head, char* lds) {
    int tid_ = otid();
    const int tid = tid_, wid = tid >> 6, lane = tid & 63;
    const bool isctx = qt >= 64; const int q0 = qt * 256, nA = isctx ? 4 : 260, a0 = isctx ? SEQ : 0;
    const bf16_t* QA = (const bf16_t*)(a.ws + RA_QA); const bf16_t* KA = (const bf16_t*)(a.ws + RA_KA); const bf16_t* VA = (const bf16_t*)(a.ws + RA_VA);
    bf16_t* MIX = (bf16_t*)(a.ws + WS_HB);
    float* stash0 = (float*)(a.ws + WS_RB) + (size_t)blockIdx.x * 256 * 128;
    float* wsf = (float*)(lds + ATT::LDS_WS) + wid * 64;
    const float lam = ((const float*)(a.ws + WS_LAM))[l], post = 1.f - LAMBDA_INIT[l];
    for (int map = 0; map < 2; ++map) {
        f32x16 o[4]; float m_, l_;
        const bf16_t* Qw_ = QA + (size_t)(q0 + wid * 32 + (lane & 31)) * 512 + head * 128 + map * 64;
        ATT::attn_body<0, 512, 512, false>(Qw_, KA + head * 128 + map * 64, VA + head * 128, nA, a0, 0, nA, 0, lds, tid, o, m_, l_);
        if (wg_any(!(l_ < 1.0e18f), (int*)(lds + ATT::LDS_WS) + 8 * 64, wid, lane)) {
            ATT::attn_body<0, 512, 512, true>(Qw_, KA + head * 128 + map * 64, VA + head * 128, nA, a0, 0, nA, 0, lds, tid, o, m_, l_); }
        int lo_ = lane; asm volatile("" : "+v"(lo_));
        const int r32 = lo_ & 31, hi = lo_ >> 5;
        float* stashv = stash0 + (size_t)((wid << 6) | lo_) * 4;
        if (hi == 0) wsf[r32] = l_;
        LDS_WAIT();
        float rli[16];
#pragma unroll
        for (int r = 0; r < 16; ++r) rli[r] = __builtin_amdgcn_rcpf(wsf[ATT::crow(r, hi)]);
        if (map == 0) {
#pragma unroll
            for (int d0 = 0; d0 < 4; ++d0)
#pragma unroll
                for (int rq = 0; rq < 4; ++rq) *(f32x4*)(stashv + (size_t)((d0 * 4 + rq) * NTHREADS) * 4) =
                    (f32x4){o[d0][4 * rq] * rli[4 * rq], o[d0][4 * rq + 1] * rli[4 * rq + 1], o[d0][4 * rq + 2] * rli[4 * rq + 2], o[d0][4 * rq + 3] * rli[4 * rq + 3]};
        } else {
            const float* gn = a.in[I_DNG] + l * 128;
            float g4[4];
#pragma unroll
            for (int d0 = 0; d0 < 4; ++d0) g4[d0] = gn[d0 * 32 + r32] * post;
            float ss[16];
#pragma unroll
            for (int r = 0; r < 16; ++r) ss[r] = 0.f;
#pragma unroll
            for (int d0 = 0; d0 < 4; ++d0)
#pragma unroll
                for (int rq = 0; rq < 4; ++rq) { const f32x4 sv = *(const f32x4*)(stashv + (size_t)((d0 * 4 + rq) * NTHREADS) * 4);
#pragma unroll
                    for (int j = 0; j < 4; ++j) { const int r = 4 * rq + j; const float oc = sv[j] - lam * (o[d0][r] * rli[r]); o[d0][r] = oc; ss[r] += oc * oc; } }
            float s8[8], s4[4], s2[2], s1;
#pragma unroll
            for (int i = 0; i < 8; ++i) { const bool up = (lo_ & 16) != 0; s8[i] = (up ? ss[8 + i] : ss[i]) + __shfl_xor(up ? ss[i] : ss[8 + i], 16); }
#pragma unroll
            for (int i = 0; i < 4; ++i) { const bool up = (lo_ & 8) != 0; s4[i] = (up ? s8[4 + i] : s8[i]) + __shfl_xor(up ? s8[i] : s8[4 + i], 8); }
#pragma unroll
            for (int i = 0; i < 2; ++i) { const bool up = (lo_ & 4) != 0; s2[i] = (up ? s4[2 + i] : s4[i]) + __shfl_xor(up ? s4[i] : s4[2 + i], 4); }
            { const bool up = (lo_ & 2) != 0; s1 = (up ? s2[1] : s2[0]) + __shfl_xor(up ? s2[0] : s2[1], 2); }
            s1 += __shfl_xor(s1, 1);
            LDS_WAIT();
            if ((lo_ & 1) == 0) wsf[hi * 16 + ((lo_ >> 1) & 15)] = s1;
            LDS_WAIT();
#pragma unroll
            for (int r = 0; r < 16; ++r) { const float sc = __builtin_amdgcn_rsqf(wsf[hi * 16 + r] * (1.f / 128.f) + EPS);
                bf16_t* orow = MIX + (size_t)(q0 + wid * 32 + ATT::crow(r, hi)) * DM + head * 128 + r32;
#pragma unroll
                for (int d0 = 0; d0 < 4; ++d0) orow[d0 * 32] = (bf16_t)f2bf(o[d0][r] * sc * g4[d0]); }
        }
    }
}
__device__ __forceinline__ void win_unit(const Args& a, int l, int n, int g, char* lds) {
    int tid_ = otid();
    const int tid = tid_, wid = tid >> 6, lane = tid & 63;
    const bool isctx = n >= 128; const int h = 2 * g + (wid >> 2);
    const int rowq = (isctx ? SEQ + (n - 128) * 128 : n * 128) + (wid & 3) * 32;
    const int nB = isctx ? 0 : (6 - (n == 0 ? 2 : 0) - (n == 127 ? 2 : 0)), b0 = (n == 0) ? 0 : (n - 1) * 128;
    const bf16_t* QB = (const bf16_t*)(a.ws + RA_QB); const bf16_t* KB = (const bf16_t*)(a.ws + RA_KB); const bf16_t* VB = (const bf16_t*)(a.ws + RA_VB);
    bf16_t* MIX = (bf16_t*)(a.ws + WS_HB);
    float* wsf = (float*)(lds + ATT::LDS_WS) + wid * 64;
    f32x16 o[4]; float m_, l_;
    const bf16_t* Qw_ = QB + (size_t)(rowq + (lane & 31)) * 256 + h * 64;
    ATT::attn_body<1, 128, 256, false>(Qw_, KB + g * 64, VB + g * 128, 4, SEQ, b0, 4 + nB, rowq + (lane & 31), lds, tid, o, m_, l_);
    if (wg_any(!(l_ < 1.0e18f), (int*)(lds + ATT::LDS_WS) + 8 * 64, wid, lane)) {
        ATT::attn_body<1, 128, 256, true>(Qw_, KB + g * 64, VB + g * 128, 4, SEQ, b0, 4 + nB, rowq + (lane & 31), lds, tid, o, m_, l_); }
    const float ltot = l_ + __builtin_amdgcn_exp2f(a.in[I_SINK][l * 4 + h] * LOG2E - m_);
    int lo_ = lane; asm volatile("" : "+v"(lo_));
    const int r32 = lo_ & 31, hi = lo_ >> 5;
    if (hi == 0) wsf[r32] = ltot;
    LDS_WAIT();
#pragma unroll
    for (int r = 0; r < 16; ++r) { const float rl = __builtin_amdgcn_rcpf(wsf[ATT::crow(r, hi)]);
        bf16_t* orow = MIX + (size_t)(rowq + ATT::crow(r, hi)) * DM + 512 + h * 64 + r32;
        orow[0] = (bf16_t)f2bf(o[0][r] * rl); orow[32] = (bf16_t)f2bf(o[1][r] * rl); }
}
__device__ __forceinline__ void conv_unit(const Args& a, int l, int u, char* lds) {
    int tid_ = otid();
    const int tid = tid_, wid = tid >> 6, lane = tid & 63;
    const bool isctx = u >= 256; const int r0 = isctx ? (u - 256) * 64 : u * 64, rbase = isctx ? SEQ : 0, slen = isctx ? CTX : SEQ;
    const bf16_t* Z = (const bf16_t*)(a.ws + RA_Z); bf16_t* MIX = (bf16_t*)(a.ws + WS_HB);
    bf16_t* zt = (bf16_t*)lds; float* co = (float*)(lds + 49152);
    __syncthreads();
    for (int c = tid; c < 94 * 32; c += NTHREADS) { const int i = c >> 5, ch = c & 31, p = r0 - 15 + i;
        u32x4 v = {0u, 0u, 0u, 0u}; if (p >= 0 && p < slen) v = *(const u32x4*)(Z + (size_t)(rbase + p) * 256 + ch * 8);
        *(u32x4*)(zt + i * 256 + ch * 8) = v; }
    __syncthreads();
    { const int c = tid & 255, t0 = (tid >> 8) * 32; float w[31];
#pragma unroll
      for (int j = 0; j < 31; ++j) w[j] = a.in[I_CONVW][(size_t)(l * 31 + j) * 256 + c];
      const float bias = a.in[I_CONVB][l * 256 + c];
#pragma unroll
      for (int tb = 0; tb < 32; tb += 8) {
          float zr[38];
#pragma unroll
          for (int i = 0; i < 38; ++i) zr[i] = bf2f(zt[(t0 + tb + i) * 256 + c]);
#pragma unroll
          for (int t = 0; t < 8; ++t) { float acc = bias;
#pragma unroll
              for (int j = 0; j < 31; ++j) acc += zr[t + j] * w[j];
              co[(t0 + tb + t) * 256 + c] = acc; } } }
    __syncthreads();
    const f32x4 lg = *(const f32x4*)(a.in[I_LNG] + l * 256 + 4 * lane), lb = *(const f32x4*)(a.in[I_LNB] + l * 256 + 4 * lane);
#pragma unroll
    for (int ti = 0; ti < 8; ++ti) { const int t = wid + ti * NWAVES; const f32x4 v = *(const f32x4*)(co + t * 256 + 4 * lane);
        const float mu = wave_sum((v.x + v.y) + (v.z + v.w)) * (1.f / 256.f); const f32x4 d = v - mu;
        const float var = wave_sum((d.x * d.x + d.y * d.y) + (d.z * d.z + d.w * d.w)) * (1.f / 256.f); const float rs = 1.f / sqrtf(var + EPS);
        const f32x4 zn = d * rs * lg + lb;
        u32x2 w; w.x = cvt_pk_bf16(silu_f(zn.x), silu_f(zn.y)); w.y = cvt_pk_bf16(silu_f(zn.z), silu_f(zn.w));
        *(u32x2*)(MIX + (size_t)(rbase + r0 + t) * DM + 768 + 4 * lane) = w; }
    __syncthreads();
}
__device__ __forceinline__ void attn_phase(const Args& a, int l, char* lds, int pass) {
    const int b = blockIdx.x, G = gridDim.x, BIG = 1 << 20;
#ifndef AT_MASK
#define AT_MASK 7
#endif
    const int dst = pass == 0 ? b : (b < 4) ? 256 + b : BIG, wst = pass == 0 ? b : (b >= 4 && b < 8) ? 256 + (b - 4) : BIG, cst = pass == 0 ? b : (b >= 8 && b < 12) ? 256 + (b - 8) : BIG;
    const int uend = pass == 0 ? 256 : 260;
    if (AT_MASK & 1) for (int u = dst; u < uend; u += G) { const int qt = u < 256 ? (u >> 2) : 64, hd = u < 256 ? (u & 3) : (u - 256); diff_unit(a, l, qt, hd, lds); }
    if (AT_MASK & 2) for (int v = wst; v < uend; v += G) { const int n = v < 256 ? (v & 127) : 128 + ((v - 256) & 1), g = v < 256 ? (v >> 7) : ((v - 256) >> 1); win_unit(a, l, n, g, lds); }
    if (AT_MASK & 4) for (int v = cst; v < uend; v += G) conv_unit(a, l, v, lds);
    if (pass == 1 && b < 12) {
        asm volatile("s_waitcnt vmcnt(0)" ::: "memory"); __syncthreads();
        const int tid = otid(); if (tid < 64) { __builtin_amdgcn_fence(__ATOMIC_RELEASE, "agent"); asm volatile("s_waitcnt vmcnt(0)" ::: "memory");
            if (tid == 0) __hip_atomic_fetch_add((gu32*)(a.ws + WS_CTL) + CW_CTXC, 1u, __ATOMIC_RELAXED, __HIP_MEMORY_SCOPE_AGENT); } }
}

#ifndef MK_PER_PHASE
#define MK_PER_PHASE 0
#endif
#if defined(__HIP_DEVICE_COMPILE__)
#define KARGS(A) Args A; { const __attribute__((address_space(4))) Args* kp_ = (const __attribute__((address_space(4))) Args*)__builtin_amdgcn_kernarg_segment_ptr(); asm volatile("" : "+s"(kp_)); A = *kp_; }
#else
#define KARGS(A) Args A = a_unused;
#endif
__global__ void __launch_bounds__(NTHREADS, 2) hybrid_fwd(Args a_unused) {
    unsigned char* lds = g_lds;
    volatile LAS unsigned* MISC = (volatile LAS unsigned*)((LAS unsigned char*)lds + MISC_OFF);
    { const int tid0 = threadIdx.x; if (tid0 < 64) MISC[tid0] = 0u;
      if ((tid0 & 63) == 0) MISC[64 + ((unsigned)__builtin_amdgcn_s_getreg((5 << 11) | 4) & 63u)] = (unsigned)(tid0 >> 6); }
    __syncthreads();
    XcdBarrier bar; int lo, hi;
    { KARGS(a); lo = a.ph_lo; hi = a.ph_hi; gu32* ctl = (gu32*)(a.ws + WS_CTL);
      bar.bar = (unsigned*)(ctl + CW_BAR); bar.x = 0; bar.st = nullptr;
      if (!MK_PER_PHASE) bar = xcd_barrier_post((unsigned*)(ctl + CW_BAR), MISC); }
#ifndef PHMASK
#define PHMASK 0x3ffff
#endif
#define PHK(k) ((k) == 0 ? 0 : (k) == 17 ? 9 : (((k) - 1) & 7) + 1)
#define IN(k) (((PHMASK >> PHK(k)) & 1) && lo <= (k) && (k) < hi)
#define SEAM(k) do { if (!MK_PER_PHASE && IN(k) && IN((k) + 1)) xcd_barrier(bar); } while (0)
    LAS unsigned char* ldsl = (LAS unsigned char*)lds;
    const int G = gridDim.x, vcu = (G % 8 == 0) ? ((int)blockIdx.x % 8) * (G / 8) + (int)blockIdx.x / 8 : (int)blockIdx.x;

#ifndef REP_N1
#define REP_N1 1
#endif
#ifndef REP_SC
#define REP_SC 1
#endif
#ifndef REP_PRO
#define REP_PRO 1
#endif
    if (IN(0)) { KARGS(a); int nrep_ = REP_PRO; asm volatile("" : "+s"(nrep_)); for (int rp_ = 0; rp_ < nrep_; ++rp_) prologue_phase(a, lds); SEAM(0); }
    for (int l = 0; l < DEPTH; ++l) {
        const int pb = 1 + 8 * l;
        if (IN(pb + 0)) {
            KARGS(a);
            { int nrep_ = (l == 0) ? REP_N1 : 1; asm volatile("" : "+s"(nrep_)); for (int rp_ = 0; rp_ < nrep_; ++rp_) norm1_phase(a, l); }
            SEAM(pb + 0);
        }
        if (IN(pb + 1)) {
            KARGS(a);
            pg8::Gemm g{(const bf16_t*)(a.ws + WS_HB), (const bf16_t*)(a.ws + WS_WIN) + (size_t)l * INW * 1024, NROW, INW, DM};
            pg8::StaticOrder S; S.init(NROW, INW, G, (int)blockIdx.x);
            EpiInProj E{a.ws, (const float*)(a.ws + WS_ROPEC), (const float*)(a.ws + WS_ROPES)};
            RepOrder<pg8::StaticOrder> SR{S, REP_INPROJ * S.nloc()}; pg8::gemm_phase<EpiInProj, RepOrder<pg8::StaticOrder>, true, true>(ldsl, g, SR, E);
            if ((int)blockIdx.x >= 650 - 2 * G) {
                const int tid = otid(), c0 = 650 - 2 * G; moe_convert(a, l, (LAS float*)(ldsl + (tid >> 6) * 8704), ((int)blockIdx.x - c0) * NWAVES + (tid >> 6), (G - c0) * NWAVES, tid & 63, 8192, 12288); }
            SEAM(pb + 1);
        }
        if (IN(pb + 2)) { KARGS(a); int npass_ = (l == 0) ? 2 : 1; asm volatile("" : "+s"(npass_)); for (int ps_ = 0; ps_ < npass_; ++ps_) { attn_phase(a, l, (char*)lds, ps_); if (ps_ == 0) SEAM(pb + 2); } }
        if (IN(pb + 3)) {
            KARGS(a);
            const float* MOD = (const float*)(a.ws + WS_MOD);
            const int M = (l == DEPTH - 1) ? SEQ : NROW;
            pg8::Gemm g{(const bf16_t*)(a.ws + WS_HB), (const bf16_t*)(a.ws + WS_WOUT) + (size_t)l * 1024 * 1024, M, DM, DM};
            pg8::StaticOrder S; if (l == 0) S.init(61 * 256, DM, G - 12, (int)blockIdx.x - 12); else S.init(SEQ, DM, G, (int)blockIdx.x);
            EpiOutProj E{a.in[I_X], a.in[I_CTX], (bf16_t*)(a.ws + WS_XB), MOD + (l * 2) * 6144 + 2 * 1024, MOD + (l * 2 + 1) * 6144 + 2 * 1024, l};
            OutOrder SO{S, (gu32*)(a.ws + WS_CTL) + CW_OPC + l * 128, (l == 0) ? (gu32*)(a.ws + WS_CTL) + CW_CTXC : nullptr}; pg8::gemm_phase<EpiOutProj, OutOrder, true, true>(ldsl, g, SO, E);
            if (l == 0 && (int)blockIdx.x >= 16) {
                const int tid = otid(), nidle = G - 16; moe_convert(a, 1, (LAS float*)(ldsl + (tid >> 6) * 8704), ((int)blockIdx.x - 16) * NWAVES + (tid >> 6), nidle * NWAVES, tid & 63, 0, 8192); }
            __syncthreads();
        }
        if (IN(pb + 4)) { KARGS(a); int nrep_ = REP_N2SC; asm volatile("" : "+s"(nrep_)); for (int rp_ = 0; rp_ < nrep_; ++rp_) norm2_phase(a, l, lds); SEAM(pb + 4); }
        if (IN(pb + 6)) {
            KARGS(a);
            MoeOrder S; S.G = G; S.vcu = vcu;
            { const int tid = otid(); const unsigned* tot = (const unsigned*)(a.ws + WS_CTL) + CW_TOT + l * 64;
              if (tid == 0) { int t = 0; int* tsg = (int*)(a.ws + WS_TSG) + l * 32;
                  for (int e = 0; e < 16; ++e) { MISC[16 + e] = (unsigned)t; if (blockIdx.x == 0) tsg[e] = t; t += ((int)tot[e] + 255) >> 8; }
                  MISC[32] = (unsigned)t; if (blockIdx.x == 0) tsg[16] = t; }
              __syncthreads();
#pragma unroll
              for (int k = 0; k < 16; ++k) S.ts[k] = __builtin_amdgcn_readfirstlane((int)MISC[16 + k]);
              S.nunits = 4 * __builtin_amdgcn_readfirstlane((int)MISC[16 + 16]); }
            S.rowtok = (const int*)(a.ws + WS_ROWTOK2) + (size_t)l * 16 * ROWCAP;
            pg8::Gemm g{(const bf16_t*)(a.ws + WS_HB), (const bf16_t*)(a.ws + WS_W13) + (size_t)l * 16 * 1024 * 1024, XS_ROWS, 1024, DM};
            EpiMoe1 E{(bf16_t*)(a.ws + WS_RB)};
            pg8::gemm_phase<EpiMoe1, MoeOrder, true, true, true>(ldsl, g, S, E);
            gu32* flag = (gu32*)(a.ws + WS_CTL) + CW_MOEF + l * 256;
            { const int tid = otid(); if (tid == 0) __hip_atomic_store(flag + vcu, 1u, __ATOMIC_RELAXED, __HIP_MEMORY_SCOPE_AGENT); }
            MoeOrder2 S2; S2.vcu = vcu; S2.nunits = S.nunits;
#pragma unroll
            for (int k2 = 0; k2 < 16; ++k2) S2.ts[k2] = S.ts[k2];
            pg8::Gemm g2{(const bf16_t*)(a.ws + WS_RB), (const bf16_t*)(a.ws + WS_W2) + (size_t)l * 16 * 1024 * 512, XS_ROWS, 1024, FFE};
            EpiMoe2 E2{(bf16_t*)(a.ws + WS_RA)};
            const int r_ = S.nunits & 255;
            if (vcu >= r_ && S.nunits >= 256) { moe_wait(flag, vcu & ~3, 4); S2.part = 0; pg8::gemm_phase<EpiMoe2, MoeOrder2, true, true>(ldsl, g2, S2, E2); }
            if (r_ != 0) { moe_wait(flag, 0, r_); S2.part = 1; pg8::gemm_phase<EpiMoe2, MoeOrder2, true, true>(ldsl, g2, S2, E2); }
            SEAM(pb + 6);
        }
    }
    if (IN(17)) { KARGS(a); int nrep_ = REP_N1; asm volatile("" : "+s"(nrep_)); for (int rp_ = 0; rp_ < nrep_; ++rp_) norm1_phase(a, 2); }
#undef IN
#undef SEAM
}

extern "C" void kernel_launch(void* const* d_in, const int* in_sizes, int n_in, void* d_out, int out_size, void* d_ws, size_t ws_size, hipStream_t stream) {
    static int grid = 0;
    if (grid == 0) {
        if (n_in != 23 || in_sizes[0] != SEQ * DM || out_size != SEQ * DM || ws_size < WS_END) {
            fprintf(stderr, "kernel_launch: shape mismatch (n_in %d, in0 %d, out %d, ws %zu, need ws >= %zu); nothing launched\n", n_in, n_in > 0 ? in_sizes[0] : -1, out_size, ws_size, (size_t)WS_END); grid = -1; return; }
        int dev = 0, cus = 0, per_cu = 0;
        if (hipGetDevice(&dev) != hipSuccess || hipDeviceGetAttribute(&cus, hipDeviceAttributeMultiprocessorCount, dev) != hipSuccess) { fprintf(stderr, "kernel_launch: device query failed\n"); grid = -1; return; }
        if (hipFuncSetAttribute((const void*)hybrid_fwd, hipFuncAttributeMaxDynamicSharedMemorySize, LDS_BYTES) != hipSuccess) { fprintf(stderr, "kernel_launch: hipFuncSetAttribute failed\n"); grid = -1; return; }
        if (hipOccupancyMaxActiveBlocksPerMultiprocessor(&per_cu, (const void*)hybrid_fwd, NTHREADS, LDS_BYTES) != hipSuccess || per_cu < 1) { fprintf(stderr, "kernel_launch: occupancy query reports %d blocks per CU\n", per_cu); grid = -1; (void)hipGetLastError(); return; }
        if (cus != 256) { fprintf(stderr, "kernel_launch: built for 256 CUs, device has %d\n", cus); grid = -1; return; }
        grid = cus;
    }
    if (grid < 0) return;
    if (hipMemsetAsync((char*)d_ws + WS_CTL, 0, CTL_ZERO_BYTES, stream) != hipSuccess) { fprintf(stderr, "kernel_launch: memset failed\n"); return; }
    Args a{};
    for (int i = 0; i < 23; ++i) a.in[i] = (const float*)d_in[i];
    a.out = (float*)d_out; a.ws = (unsigned char*)d_ws;
#if MK_PER_PHASE
    for (int p = 0; p < N_PHASES; ++p) { a.ph_lo = p; a.ph_hi = p + 1; hipLaunchKernelGGL(hybrid_fwd, dim3(grid), dim3(NTHREADS), LDS_BYTES, stream, a); }
#else
    a.ph_lo = 0; a.ph_hi = N_PHASES;
    hipLaunchKernelGGL(hybrid_fwd, dim3(grid), dim3(NTHREADS), LDS_BYTES, stream, a);
#endif
    const hipError_t le = hipPeekAtLastError();
    if (le != hipSuccess) fprintf(stderr, "kernel_launch: launch failed: %s\n", hipGetErrorName(le));
}
```

```cpp
#define MK_PER_PHASE 0
#include <hip/hip_runtime.h>
#include <cstdio>
#include <cstdint>

#define GAS __attribute__((address_space(1)))
#define LAS __attribute__((address_space(3)))
typedef unsigned short bf16_t;
typedef short bf16x8 __attribute__((ext_vector_type(8)));
typedef short s16x4 __attribute__((ext_vector_type(4)));
typedef float f32x2 __attribute__((ext_vector_type(2)));
typedef float f32x4 __attribute__((ext_vector_type(4)));
typedef float f32x16 __attribute__((ext_vector_type(16)));
typedef unsigned u32x2 __attribute__((ext_vector_type(2)));
typedef unsigned u32x4 __attribute__((ext_vector_type(4)));
typedef GAS unsigned gu32;

constexpr int SEQ = 16384, CTX = 256, NROW = SEQ + CTX, DM = 1024, INW = 2560, NEXP = 16, FFE = 512, DEPTH = 2;
constexpr int XS_ROWS = 37376;
constexpr float EPS = 1e-6f, LOG2E = 1.4426950408889634f, QSCALE = 0.125f * 1.4426950408889634f;
constexpr int NWAVES = 8, NTHREADS = 512;

constexpr size_t MiB = 1u << 20;
constexpr size_t WS_CTL = 0, CTL_ZERO_BYTES = 128 * 1024;
constexpr size_t WS_MOD = 1 * MiB;
constexpr size_t WS_ROPEC = WS_MOD + 128 * 1024, WS_ROPES = WS_MOD + 192 * 1024;
constexpr size_t WS_LAM = WS_MOD + 256 * 1024;
constexpr size_t WS_CNT = WS_MOD + 320 * 1024;
constexpr size_t WS_TSG = WS_MOD + 384 * 1024;
constexpr size_t WS_TOKE = 2 * MiB, WS_TOKW = 2 * MiB + 256 * 1024, WS_TOKP = 2 * MiB + 512 * 1024;
constexpr size_t WS_ROWTOK = 3 * MiB;
constexpr size_t WS_WIN = 4 * MiB;
constexpr size_t WS_WOUT = 14 * MiB;
constexpr size_t WS_W13 = 18 * MiB;
constexpr size_t WS_W2 = 82 * MiB;
constexpr size_t WS_XB = 114 * MiB;
constexpr size_t WS_HB = 179 * MiB;
constexpr size_t WS_RA = 212 * MiB;
constexpr size_t RA_QA = WS_RA, RA_KA = RA_QA + (size_t)NROW * 512 * 2, RA_VA = RA_KA + (size_t)NROW * 512 * 2;
constexpr size_t RA_QB = RA_VA + (size_t)NROW * 512 * 2, RA_KB = RA_QB + (size_t)NROW * 256 * 2, RA_VB = RA_KB + (size_t)NROW * 128 * 2;
constexpr size_t RA_Z = RA_VB + (size_t)NROW * 256 * 2, RA_END = RA_Z + (size_t)NROW * 256 * 2;
constexpr size_t WS_RB = 290 * MiB;
constexpr size_t WS_ROWTOK2 = 327 * MiB;
constexpr size_t WS_END = 330 * MiB;
static_assert(RA_END <= WS_RB && WS_RA + (size_t)XS_ROWS * 2048 <= WS_RB && WS_RB + (size_t)XS_ROWS * 1024 <= WS_END && WS_RB + (size_t)256 * 256 * 128 * 4 <= WS_END, "ws map");
static_assert(WS_XB + (size_t)NROW * DM * 4 <= WS_HB && WS_HB + (size_t)NROW * DM * 2 <= WS_RA && WS_W13 + (size_t)2 * 16 * 1024 * 1024 * 2 <= WS_W2 && WS_W2 + (size_t)2 * 16 * 1024 * 512 * 2 <= WS_XB, "ws map 2");
constexpr int ROWCAP = 16640;
constexpr int CW_TOT = 24576;
constexpr int CW_MOEF = 28672;
constexpr int CW_OPC = 30720;
constexpr int CW_CTXC = 31232;
constexpr int CW_BAR = 4096;

constexpr int RING_BYTES = 131072;
constexpr int MISC_OFF = RING_BYTES;
constexpr int LDS_BYTES = 147456;

#define LDS_WAIT() asm volatile("s_waitcnt lgkmcnt(0)" ::: "memory")
#define VM_WAIT() asm volatile("s_waitcnt vmcnt(0)" ::: "memory")
__device__ __forceinline__ unsigned f2bf(float f) { unsigned u = __builtin_bit_cast(unsigned, f); return (u + 0x7fffu + ((u >> 16) & 1u)) >> 16; }
__device__ __forceinline__ unsigned pk2(float lo, float hi) { return f2bf(lo) | (f2bf(hi) << 16); }
__device__ __forceinline__ float bf2f(unsigned short b) { return __builtin_bit_cast(float, (unsigned)b << 16); }
__device__ __forceinline__ unsigned cvt_pk_bf16(float lo, float hi) { unsigned r; asm volatile("v_cvt_pk_bf16_f32 %0, %1, %2" : "=v"(r) : "v"(lo), "v"(hi)); return r; }
__device__ __forceinline__ float wave_sum(float v) {
#pragma unroll
    for (int o = 1; o < 64; o <<= 1) v += __shfl_xor(v, o);
    return v;
}
__device__ __forceinline__ f32x4 ld4bf(const bf16_t* p) { const u32x2 w = *(const u32x2*)p; return (f32x4){__builtin_bit_cast(float, w.x << 16), __builtin_bit_cast(float, w.x & 0xffff0000u), __builtin_bit_cast(float, w.y << 16), __builtin_bit_cast(float, w.y & 0xffff0000u)}; }
__device__ __forceinline__ void st4bf(bf16_t* p, const f32x4 v) { u32x2 w; w.x = cvt_pk_bf16(v.x, v.y); w.y = cvt_pk_bf16(v.z, v.w); *(u32x2*)p = w; }
__device__ __forceinline__ float silu_f(float a) { return a * __builtin_amdgcn_rcpf(1.f + __builtin_amdgcn_exp2f(-a * LOG2E)); }
__device__ __forceinline__ float sigmoid_f(float a) { return __builtin_amdgcn_rcpf(1.f + __builtin_amdgcn_exp2f(-a * LOG2E)); }
extern __shared__ __attribute__((aligned(16))) unsigned char g_lds[];
__device__ __forceinline__ int otid() {
    const unsigned slot = (unsigned)__builtin_amdgcn_s_getreg((5 << 11) | 4) & 63u;
    const int wave = ((const volatile LAS int*)((LAS unsigned char*)g_lds + MISC_OFF + 256))[slot];
    int ln; asm volatile("v_mbcnt_lo_u32_b32 %0, -1, 0\n\tv_mbcnt_hi_u32_b32 %0, -1, %0" : "=v"(ln));
    int t = (wave << 6) | ln;
    asm volatile("" : "+v"(t)); return t; }
namespace pg8 {
#define PG8_LAS __attribute__((address_space(3)))
constexpr int BM = 256, BK = 64, HALF = 128, HTB = HALF * BK * 2  , STAGE_BYTES = 8 * HTB, NXCD = 8, WGM = 8;

__host__ __device__ __forceinline__ int lds_byte(int r, int c) { const int st = (r >> 4) * 2 + (c >> 5), rr = r & 15, cc = c & 31, ob = rr * 64 + cc * 2; return st * 1024 + (ob ^ (((ob >> 9) & 1) << 5)); }
__host__ __device__ __forceinline__ void stage_rc(int b, int& R, int& C) { const int st = b / 1024, sb = b % 1024, swz = sb ^ (((sb >> 9) & 1) << 5); R = (st >> 1) * 16 + swz / 64; C = (st & 1) * 32 + (swz % 64) / 2; }
__host__ __device__ __forceinline__ int perm32(int rho) { const int n = rho >> 4, i = rho & 15; return 8 * (i >> 2) + 4 * n + (i & 3); }

struct Unit { int pm, pn, aux; };
struct Gemm { const bf16_t* A; const bf16_t* Bt; int M, N, K; };

struct StaticOrder {
    int nM, nN, nwg, G, c;
    __host__ __device__ void init(int M, int N, int G_, int c_) { nM = M / BM; nN = N / BM; nwg = nM * nN; G = G_; c = c_; }
    __host__ __device__ bool next(int i, Unit& u) const {
        const long L = (long)i * G + c; if (L >= nwg) return false;
        int wgid = (int)L; { const int q = nwg / NXCD, r = nwg % NXCD, xcd = wgid % NXCD, off = wgid / NXCD; wgid = (xcd < r ? xcd * (q + 1) : r * (q + 1) + (xcd - r) * q) + off; }
        const int nig = WGM * nN, gid = wgid / nig, fm = gid * WGM, gsz = (nM - fm) < WGM ? (nM - fm) : WGM;
        u.pm = fm + ((wgid % nig) % gsz); u.pn = (wgid % nig) / gsz; return true;
    }
    __host__ __device__ __forceinline__ int nloc() const { return c < nwg ? (nwg - c + G - 1) / G : 0; }
    __device__ __forceinline__ void a_ready(const Unit&) const {}
    __device__ __forceinline__ void done(const Unit&) const {}
};
template <class Epi, class Sched, bool ALIGN_EPI = false, bool SP2 = false, bool GATHER = false>
__device__ __forceinline__ void gemm_phase(PG8_LAS unsigned char* lds, const Gemm g, const Sched& S, const Epi& E) {
    const int tid = otid(), wid = __builtin_amdgcn_readfirstlane(tid >> 6), lane = tid & 63, wr = wid >> 2, wc = wid & 3, fr = lane & 15, fq = lane >> 4;
    const int K = g.K, nt = K / BK;
    unsigned voffA[2], voffB[2]; int rowA[2]; unsigned colA[2];
#pragma unroll
    for (int i = 0; i < 2; ++i) { int R, C; stage_rc(tid * 16 + i * 8192, R, C); const int Rb = Epi::PERM ? ((R & ~31) + perm32(R & 31)) : R;
        voffA[i] = (unsigned)(R * K + C) * 2u; voffB[i] = (unsigned)(Rb * K + C) * 2u; rowA[i] = R; colA[i] = (unsigned)C * 2u; }
    unsigned gc[2][2], gn[2][2];
#define PG8_GOFFS(dst, u) do { _Pragma("unroll") for (int h_ = 0; h_ < 2; ++h_) _Pragma("unroll") for (int i_ = 0; i_ < 2; ++i_) dst[h_][i_] = S.row_off((u), h_ * HALF + rowA[i_]) + colA[i_]; } while (0)
    const size_t kstep = (size_t)(BK * 2);
    const size_t hstep = (size_t)HALF * K * 2;
    const size_t tstep = 2 * hstep;
    const unsigned ldsw = (unsigned)wid * 1024u;
    const int aoff = lds_byte(wr * 64 + fr, fq * 8), boff = lds_byte(wc * 32 + fr, fq * 8);
#define PG8_SA(b, h) (((b) * 2 + (h)) * HTB)
#define PG8_SB(b, h) ((4 + (b) * 2 + (h)) * HTB)
#define PG8_STAGE(bufoff, gbase, voff) do { _Pragma("unroll") for (int _i = 0; _i < 2; ++_i) \
        __builtin_amdgcn_global_load_lds((const unsigned*)((const char*)(gbase) + (voff)[_i]), (PG8_LAS unsigned*)(lds + (bufoff) + ldsw + _i * 8192), 16, 0, 0); } while (0)
#define PG8_STAGE_A(bufoff, gbase, h, NX) do { _Pragma("unroll") for (int _i = 0; _i < 2; ++_i) { \
        const char* p_; if constexpr (GATHER) p_ = (const char*)(gbase) + ((NX) ? gn[h][_i] : gc[h][_i]); else p_ = (const char*)(gbase) + (h) * hstep + voffA[_i]; \
        __builtin_amdgcn_global_load_lds((const unsigned*)p_, (PG8_LAS unsigned*)(lds + (bufoff) + ldsw + _i * 8192), 16, 0, 0); } } while (0)
#define PG8_LDA(dst, b, h) do { _Pragma("unroll") for (int m = 0; m < 4; ++m) _Pragma("unroll") for (int k = 0; k < 2; ++k) dst[m][k] = *(const PG8_LAS bf16x8*)(lds + PG8_SA(b, h) + aoff + m * 2048 + k * 1024); } while (0)
#define PG8_LDB(dst, b, h) do { _Pragma("unroll") for (int n = 0; n < 2; ++n) _Pragma("unroll") for (int k = 0; k < 2; ++k) dst[n][k] = *(const PG8_LAS bf16x8*)(lds + PG8_SB(b, h) + boff + n * 2048 + k * 1024); } while (0)
#define PG8_MMA(ai, bj, At, Bt) do { __builtin_amdgcn_s_setprio(1); _Pragma("unroll") for (int m = 0; m < 4; ++m) _Pragma("unroll") for (int n = 0; n < 2; ++n) _Pragma("unroll") for (int k = 0; k < 2; ++k) \
        acc[ai][bj][m][n] = __builtin_amdgcn_mfma_f32_16x16x32_bf16(Bt[n][k], At[m][k], acc[ai][bj][m][n], 0, 0, 0); __builtin_amdgcn_s_setprio(0); } while (0)
#define PG8_WAIT_V(n) asm volatile("s_waitcnt vmcnt(" #n ")" ::: "memory")
#define PG8_WAIT_L(n) asm volatile("s_waitcnt lgkmcnt(" #n ")" ::: "memory")
#define PG8_BAR __builtin_amdgcn_s_barrier()
#define PG8_SCHED __builtin_amdgcn_sched_barrier(0)
    Unit cur, nxt; int ui = 0;
    if (!S.next(0, cur)) return;
    f32x4 acc[2][2][4][2];
#pragma unroll
    for (int a = 0; a < 2; ++a)
#pragma unroll
        for (int b = 0; b < 2; ++b)
#pragma unroll
            for (int m = 0; m < 4; ++m)
#pragma unroll
                for (int n = 0; n < 2; ++n) acc[a][b][m][n] = (f32x4){0.f, 0.f, 0.f, 0.f};
    bf16x8 At[4][2], B0[2][2], B1[2][2];
    const char* cA = GATHER ? (const char*)g.A : (const char*)g.A + (size_t)cur.pm * tstep; const char* cB = (const char*)g.Bt + (size_t)cur.pn * tstep;
    if constexpr (GATHER) { PG8_GOFFS(gc, cur); }
    S.a_ready(cur);
    if constexpr (SP2) {
        PG8_STAGE(PG8_SB(0, 0), cB, voffB); PG8_STAGE(PG8_SB(0, 1), cB + hstep, voffB); PG8_STAGE_A(PG8_SA(0, 0), cA, 0, false); PG8_STAGE_A(PG8_SA(0, 1), cA, 1, false);
        if (wr == 1) PG8_BAR;
        PG8_WAIT_V(2); PG8_BAR;
        PG8_STAGE(PG8_SB(1, 0), cB + kstep, voffB); PG8_STAGE_A(PG8_SA(1, 0), cA + kstep, 0, false); PG8_STAGE(PG8_SB(1, 1), cB + hstep + kstep, voffB);
        PG8_WAIT_V(6); PG8_BAR;
    } else {
        PG8_STAGE(PG8_SB(0, 0), cB, voffB); PG8_STAGE_A(PG8_SA(0, 0), cA, 0, false); PG8_STAGE(PG8_SB(0, 1), cB + hstep, voffB); PG8_STAGE_A(PG8_SA(0, 1), cA, 1, false);
        if (wr == 1) PG8_BAR;
        PG8_WAIT_V(4); PG8_BAR;
        PG8_STAGE(PG8_SB(1, 0), cB + kstep, voffB); PG8_STAGE_A(PG8_SA(1, 0), cA + kstep, 0, false); PG8_STAGE(PG8_SB(1, 1), cB + hstep + kstep, voffB);
        PG8_WAIT_V(6); PG8_BAR;
    }
    for (;;) {
        const bool has_next = S.next(ui + 1, nxt);
        if constexpr (GATHER) { if (has_next) { PG8_GOFFS(gn, nxt); } else {
#pragma unroll
            for (int h_ = 0; h_ < 2; ++h_) { gn[h_][0] = gc[h_][0]; gn[h_][1] = gc[h_][1]; } } }
        const char* nA = GATHER ? (const char*)g.A : has_next ? (const char*)g.A + (size_t)nxt.pm * tstep : cA; const char* nB = has_next ? (const char*)g.Bt + (size_t)nxt.pn * tstep : cB;
        for (int t = 0; t < nt; t += 2) {
            const bool last = (t == nt - 2);
            const char* a1 = cA + (size_t)(t + 1) * kstep;
            const char* a2 = last ? nA : cA + (size_t)(t + 2) * kstep; const char* b2 = last ? nB : cB + (size_t)(t + 2) * kstep;
            const char* a3 = a2 + kstep; const char* b3 = b2 + kstep;
            if (last && has_next) S.a_ready(nxt);
            if constexpr (SP2) {
            PG8_LDB(B0, 0, 0); PG8_LDB(B1, 0, 1); PG8_SCHED; PG8_LDA(At, 0, 0); PG8_STAGE_A(PG8_SA(1, 1), a1, 1, false);
            PG8_WAIT_V(8); PG8_WAIT_L(0); PG8_BAR; PG8_MMA(0, 0, At, B0); PG8_MMA(0, 1, At, B1); PG8_BAR; PG8_SCHED;
            PG8_LDA(At, 0, 1); PG8_STAGE(PG8_SB(0, 0), b2, voffB); PG8_STAGE(PG8_SB(0, 1), b2 + hstep, voffB); PG8_STAGE_A(PG8_SA(0, 0), a2, 0, last);
            PG8_WAIT_V(8); PG8_WAIT_L(0); PG8_BAR; PG8_MMA(1, 0, At, B0); PG8_MMA(1, 1, At, B1); PG8_BAR; PG8_SCHED;
            PG8_LDB(B0, 1, 0); PG8_LDB(B1, 1, 1); PG8_SCHED; PG8_LDA(At, 1, 0); PG8_STAGE_A(PG8_SA(0, 1), a2, 1, last);
            PG8_WAIT_V(8); PG8_WAIT_L(0); PG8_BAR; PG8_MMA(0, 0, At, B0); PG8_MMA(0, 1, At, B1); PG8_BAR; PG8_SCHED;
            PG8_LDA(At, 1, 1); PG8_STAGE(PG8_SB(1, 0), b3, voffB); PG8_STAGE(PG8_SB(1, 1), b3 + hstep, voffB); PG8_STAGE_A(PG8_SA(1, 0), a3, 0, last);
            PG8_WAIT_V(8); PG8_WAIT_L(0); PG8_BAR; PG8_MMA(1, 0, At, B0); PG8_MMA(1, 1, At, B1); PG8_BAR; PG8_SCHED;
            } else {
            PG8_LDB(B0, 0, 0); PG8_SCHED; PG8_LDA(At, 0, 0); PG8_STAGE_A(PG8_SA(1, 1), a1, 1, false);
            PG8_WAIT_L(8); PG8_BAR; PG8_WAIT_L(0); PG8_MMA(0, 0, At, B0); PG8_BAR; PG8_SCHED;
            PG8_LDB(B1, 0, 1); PG8_STAGE(PG8_SB(0, 0), b2, voffB);
            PG8_BAR; PG8_WAIT_L(0); PG8_MMA(0, 1, At, B1); PG8_BAR;
            PG8_LDA(At, 0, 1); PG8_STAGE_A(PG8_SA(0, 0), a2, 0, last);
            PG8_BAR; PG8_WAIT_L(0); PG8_MMA(1, 0, At, B0); PG8_BAR; PG8_SCHED;
            PG8_STAGE(PG8_SB(0, 1), b2 + hstep, voffB);
            PG8_WAIT_V(6); PG8_BAR; PG8_MMA(1, 1, At, B1); PG8_BAR;
            PG8_LDB(B0, 1, 0); PG8_SCHED; PG8_LDA(At, 1, 0); PG8_STAGE_A(PG8_SA(0, 1), a2, 1, last);
            PG8_WAIT_L(8); PG8_BAR; PG8_WAIT_L(0); PG8_MMA(0, 0, At, B0); PG8_BAR; PG8_SCHED;
            PG8_LDB(B1, 1, 1); PG8_STAGE(PG8_SB(1, 0), b3, voffB);
            PG8_BAR; PG8_WAIT_L(0); PG8_MMA(0, 1, At, B1); PG8_BAR;
            PG8_LDA(At, 1, 1); PG8_STAGE_A(PG8_SA(1, 0), a3, 0, last);
            PG8_BAR; PG8_WAIT_L(0); PG8_MMA(1, 0, At, B0); PG8_BAR; PG8_SCHED;
            PG8_STAGE(PG8_SB(1, 1), b3 + hstep, voffB);
            PG8_WAIT_V(6); PG8_BAR; PG8_MMA(1, 1, At, B1); PG8_BAR;
            }
        }
        if constexpr (ALIGN_EPI) { if (wr == 0) PG8_BAR; }
        if constexpr (!Epi::AFTER_DRAIN) { E(acc, cur, wr, wc, fr, fq); S.done(cur); }
        if (!has_next) break;
#pragma unroll
        for (int a = 0; a < 2; ++a)
#pragma unroll
            for (int b = 0; b < 2; ++b)
#pragma unroll
                for (int m = 0; m < 4; ++m)
#pragma unroll
                    for (int n = 0; n < 2; ++n) acc[a][b][m][n] = (f32x4){0.f, 0.f, 0.f, 0.f};
        cur = nxt; cA = nA; cB = nB; ++ui;
        if constexpr (GATHER) {
#pragma unroll
            for (int h_ = 0; h_ < 2; ++h_) { gc[h_][0] = gn[h_][0]; gc[h_][1] = gn[h_][1]; } }
        if constexpr (ALIGN_EPI) { if (wr == 1) PG8_BAR; }
    }
    PG8_WAIT_V(0);
    if constexpr (!ALIGN_EPI) { if (wr == 0) PG8_BAR; }
    PG8_BAR;
    if constexpr (Epi::AFTER_DRAIN) { E.fused(acc, cur, wr, wc, fr, fq, lds, wid, lane); S.done(cur); }
#undef PG8_SA
#undef PG8_SB
#undef PG8_STAGE
#undef PG8_STAGE_A
#undef PG8_GOFFS
#undef PG8_LDA
#undef PG8_LDB
#undef PG8_MMA
#undef PG8_WAIT_V
#undef PG8_WAIT_L
#undef PG8_BAR
#undef PG8_SCHED
}
}

namespace att2 {
constexpr int KSLOT = 8192, VSLOT = 16384, LDS_K = 0, LDS_V = 3 * KSLOT, LDS_WS = LDS_V + 3 * VSLOT, LDS_BYTES = LDS_WS + NWAVES * 256;
constexpr float THR = 8.f;
typedef LAS const char* lds_cptr;
typedef short v4i16_t __attribute__((ext_vector_type(4)));
typedef __bf16 bf2_t __attribute__((ext_vector_type(2)));
#define SBAR() __builtin_amdgcn_sched_barrier(0)
#define PIN(x) asm volatile("" : "+v"(x))
__device__ __forceinline__ int crow(int r, int hi) { return (r & 3) + 8 * (r >> 2) + 4 * hi; }
__device__ __forceinline__ f32x16 zero16() { float z = 0.f; asm volatile("" : "+v"(z)); f32x16 v;
#pragma unroll
    for (int r = 0; r < 16; ++r) v[r] = z;
    return v; }
__device__ __forceinline__ void glds16(const void* gsrc, unsigned lds_dst) { unsigned keep;
    asm volatile("s_mov_b32 %0, m0\n\ts_mov_b32 m0, %2\n\ts_nop 0\n\tglobal_load_lds_dwordx4 %1, off\n\ts_mov_b32 m0, %0" : "=&s"(keep) : "v"(gsrc), "s"(lds_dst) : "memory"); }
__device__ __forceinline__ bf16x8 kfrag(lds_cptr p) { return *(const LAS bf16x8*)p; }
__device__ __forceinline__ s16x4 vtr(lds_cptr p) { return __builtin_bit_cast(s16x4, __builtin_amdgcn_ds_read_tr16_b64_v4i16((LAS v4i16_t*)p)); }
__device__ __forceinline__ unsigned cvtpk_s(float lo, float hi) { typedef float f2 __attribute__((ext_vector_type(2))); typedef __bf16 b2 __attribute__((ext_vector_type(2)));
    f2 v = {lo, hi}; b2 b = __builtin_convertvector(v, b2); return __builtin_bit_cast(unsigned, b); }
#define MX3(a, b, c) __builtin_fmaxf(__builtin_fmaxf((a), (b)), (c))
__device__ __forceinline__ float rowmax(const f32x16& p0, const f32x16& p1) {
    float a = MX3(p0[0], p0[1], p1[0]), b = MX3(p0[2], p0[3], p1[1]); a = MX3(a, p1[2], p1[3]);
#pragma unroll
    for (int r = 4; r < 16; r += 4) { a = MX3(a, p0[r], p0[r + 1]); b = MX3(b, p0[r + 2], p0[r + 3]); a = MX3(a, p1[r], p1[r + 1]); b = MX3(b, p1[r + 2], p1[r + 3]); }
    float m = __builtin_fmaxf(a, b); auto rr = __builtin_amdgcn_permlane32_swap(__float_as_uint(m), __float_as_uint(m), false, false);
    return __builtin_fmaxf(__uint_as_float(rr[0]), __uint_as_float(rr[1])); }
__device__ __forceinline__ void wmask(f32x16& p0, f32x16& p1, int dk, int hi) {
#pragma unroll
    for (int r = 0; r < 16; ++r) { const int d = dk + crow(r, hi);
        if (d > 128 || d < -128) p0[r] = -1e30f;
        if (d + 32 > 128 || d + 32 < -128) p1[r] = -1e30f; } }
#define MFMA32(a, b, c) __builtin_amdgcn_mfma_f32_32x32x16_bf16(a, b, c, 0, 0, 0)
#define WAIT_BAR(N) asm volatile("s_waitcnt vmcnt(" #N ") lgkmcnt(0)\n\ts_barrier" ::: "memory")

template <int MODE, int LDK, int LDV, bool SAFE>
__device__ __forceinline__ void attn_body(const bf16_t* Qw, const bf16_t* Kh, const bf16_t* Vh, const int nA, const int a0, const int b0, const int NT, const int qpos,
                                          char* lds, const int tid, f32x16 (&o)[4], float& m_out, float& l_out) {
    constexpr int ND = (MODE == 1) ? 2 : 4, NVP = ND / 2;
    const int lane = tid & 63, r32 = lane & 31, hi = lane >> 5; const int wid = __builtin_amdgcn_readfirstlane(tid >> 6);
    const unsigned lds0 = (unsigned)(uintptr_t)lds; float* wsf = (float*)(lds + LDS_WS) + wid * 64;
#define KROW(t) ((t) < nA ? a0 + 64 * (t) : b0 + 64 * ((t) - nA))
    const bf16_t* ksrc = Kh + (size_t)lane * LDK + wid * 8;
    const bf16_t* vsrc = Vh + (size_t)(16 * (wid & 3) + (lane >> 2)) * LDV + (wid >> 2) * 32 + (lane & 3) * 8;
    const unsigned kdst = lds0 + LDS_K + wid * 1024, vdst = lds0 + LDS_V + (wid >> 2) * 4096 + (wid & 3) * 1024;
#define DMA_K(t, slot) glds16(ksrc + (size_t)KROW(t) * LDK, (unsigned)__builtin_amdgcn_readfirstlane(kdst + (slot) * KSLOT))
#define DMA_V(t, slot) do { const bf16_t* vs_ = vsrc + (size_t)KROW(t) * LDV; glds16(vs_, (unsigned)__builtin_amdgcn_readfirstlane(vdst + (slot) * VSLOT)); \
        if constexpr (NVP == 2) glds16(vs_ + 64, (unsigned)__builtin_amdgcn_readfirstlane(vdst + (slot) * VSLOT + 8192)); } while (0)
    const lds_cptr shm3 = (lds_cptr)(LAS char*)lds;
    const lds_cptr kp0 = shm3 + LDS_K + hi * 1024 + r32 * 16;
    const lds_cptr vp0 = shm3 + LDS_V + ((lane >> 4) & 1) * 32 + (lane & 3) * 8 + (4 * hi + ((lane & 15) >> 2)) * 64;
    bf16x8 qr[4];
#pragma unroll
    for (int d0 = 0; d0 < 4; ++d0) qr[d0] = *reinterpret_cast<const bf16x8*>(Qw + d0 * 16 + hi * 8);
    __syncthreads();
    if (wid >= 4) __builtin_amdgcn_s_setprio(1);
    DMA_K(0, 0); DMA_K(1, 1); DMA_V(0, 0);
    float mhat = 0.f, l_reg = 0.f;
#pragma unroll
    for (int d = 0; d < 4; ++d) o[d] = zero16();
    f32x16 negm = zero16(); PIN(negm);
    bool resc = false;
    if constexpr (NVP == 2) { WAIT_BAR(3); } else { WAIT_BAR(2); }
    f32x16 pA0, pA1, pB0, pB1;
    DMA_K(2, 2); DMA_V(1, 1);
    { bf16x8 kf[8];
#pragma unroll
      for (int i = 0; i < 8; ++i) kf[i] = kfrag(kp0 + (i >> 1) * 2048 + (i & 1) * 512);
      pA0 = MFMA32(kf[0], qr[0], negm); pA1 = MFMA32(kf[1], qr[0], negm); pA0 = MFMA32(kf[2], qr[1], pA0); pA1 = MFMA32(kf[3], qr[1], pA1);
      pA0 = MFMA32(kf[4], qr[2], pA0); pA1 = MFMA32(kf[5], qr[2], pA1); pA0 = MFMA32(kf[6], qr[3], pA0); pA1 = MFMA32(kf[7], qr[3], pA1); }
    if constexpr (MODE == 1) { if (0 >= nA) wmask(pA0, pA1, KROW(0) - qpos, hi); }
    { const float rm = rowmax(pA0, pA1); mhat = rm;
#pragma unroll
      for (int r = 0; r < 16; ++r) { pA0[r] = __builtin_amdgcn_exp2f(pA0[r] - rm); pA1[r] = __builtin_amdgcn_exp2f(pA1[r] - rm); }
#pragma unroll
      for (int r = 0; r < 16; ++r) negm[r] = -mhat;
      PIN(negm);
      if constexpr (!SAFE) { float s0 = 0.f, s1 = 0.f;
#pragma unroll
        for (int r = 0; r < 16; ++r) { s0 += pA0[r]; s1 += pA1[r]; }
        l_reg = s0 + s1; } }
    if constexpr (NVP == 2) { WAIT_BAR(3); } else { WAIT_BAR(2); }
    int sl_prev = 0, sl_cur = 1, sl_next = 2;
#define ROT() do { const int s_ = sl_prev; sl_prev = sl_cur; sl_cur = sl_next; sl_next = s_; } while (0)
#define RESC() do { if (resc) { asm volatile("s_waitcnt lgkmcnt(0)" ::: "memory"); \
        _Pragma("unroll") for (int d_ = 0; d_ < ND; ++d_) _Pragma("unroll") for (int r = 0; r < 16; ++r) o[d_][r] *= wsf[crow(r, hi)]; } } while (0)
    u32x4 pw0, pw1, pw2, pw3; s16x4 vl[16], vh[16]; bf16x8 kf[8]; float dummy_ = 0.f;
#define PAF(k) __builtin_bit_cast(bf16x8, pw##k)
#define VFR(i) (bf16x8){vl[i][0], vl[i][1], vl[i][2], vl[i][3], vh[i][0], vh[i][1], vh[i][2], vh[i][3]}
#define VRD(q, ks) do { if constexpr ((q) < ND) { vl[(q) * 4 + (ks)] = vtr(vp_ + ((q) * 4096 + (ks) * 1024)); vh[(q) * 4 + (ks)] = vtr(vp_ + ((q) * 4096 + (ks) * 1024 + 512)); } } while (0)
#define KRD(i) do { kf[i] = kfrag(kp_ + ((i) >> 1) * 2048 + ((i) & 1) * 512); } while (0)
#define PKW(P, i) cvtpk_s(P[i], P[i + 1])
#ifndef PROBE_VALU
#define PROBE_VALU 0
#endif
#ifndef ROWSUM_DOT2
#define ROWSUM_DOT2 0
#endif
#define DOT2(w, acc) __builtin_amdgcn_fdot2_f32_bf16(__builtin_bit_cast(bf2_t, (unsigned)(w)), __builtin_bit_cast(bf2_t, 0x3f803f80u), acc, false)
#define GAPA(MF, a0_, a1_, a2_, a3_, W0, W1, PW, i0_) do { MF; if (SAFE && !ROWSUM_DOT2) { sacc += a0_; sacb += a1_; sacc += a2_; sacb += a3_; PIN(sacc); PIN(sacb); } W0; W1; PIN(PW); \
        if (ROWSUM_DOT2) { sacc = DOT2(PW[i0_], sacc); sacb = DOT2(PW[(i0_) + 1], sacb); PIN(sacc); PIN(sacb); } SBAR(); } while (0)
#define EX(v) __builtin_amdgcn_exp2f(v)
#define GAPB(q, ks, X, i) do { if constexpr ((q) < ND) { o[q] = MFMA32(PAF(ks), VFR((q) * 4 + (ks)), o[q]); } X[i] = EX(X[i]); X[(i) + 1] = EX(X[(i) + 1]); X[(i) + 2] = EX(X[(i) + 2]); X[(i) + 3] = EX(X[(i) + 3]); PIN(X); SBAR(); } while (0)
#define GAPG(q, ks, ...) do { if constexpr ((q) < ND) { o[q] = MFMA32(PAF(ks), VFR((q) * 4 + (ks)), o[q]); } __VA_ARGS__; SBAR(); } while (0)
#define STEP(C0, C1, P0, P1, t, GK, GV) do { SBAR(); \
    const lds_cptr vp_ = vp0 + sl_prev * VSLOT; const lds_cptr kp_ = kp0 + sl_cur * KSLOT; \
    KRD(0); KRD(1); KRD(2); SBAR(); float sacc = (ROWSUM_DOT2 || !SAFE) ? 0.f : P0[0], sacb = (ROWSUM_DOT2 || !SAFE) ? 0.f : P0[1]; \
    KRD(3); SBAR();            GAPA(C0 = MFMA32(kf[0], qr[0], negm), P0[2], P0[3], P0[4], P0[5],     pw0[0] = PKW(P0, 0),  pw0[1] = PKW(P0, 2),  pw0, 0); \
    KRD(4); SBAR();            GAPA(C1 = MFMA32(kf[1], qr[0], negm), P0[6], P0[7], P0[8], P0[9],     pw0[2] = PKW(P0, 4),  pw0[3] = PKW(P0, 6),  pw0, 2); \
    KRD(5); SBAR();            GAPA(C0 = MFMA32(kf[2], qr[1], C0),   P0[10], P0[11], P0[12], P0[13], pw1[0] = PKW(P0, 8),  pw1[1] = PKW(P0, 10), pw1, 0); \
    KRD(6); SBAR();            GAPA(C1 = MFMA32(kf[3], qr[1], C1),   P0[14], P0[15], P1[0], P1[1],   pw1[2] = PKW(P0, 12), pw1[3] = PKW(P0, 14), pw1, 2); \
    KRD(7); VRD(0, 0); SBAR(); GAPA(C0 = MFMA32(kf[4], qr[2], C0),   P1[2], P1[3], P1[4], P1[5],     pw2[0] = PKW(P1, 0),  pw2[1] = PKW(P1, 2),  pw2, 0); \
            VRD(1, 0); SBAR(); GAPA(C1 = MFMA32(kf[5], qr[2], C1),   P1[6], P1[7], P1[8], P1[9],     pw2[2] = PKW(P1, 4),  pw2[3] = PKW(P1, 6),  pw2, 2); \
            VRD(2, 0); SBAR(); GAPA(C0 = MFMA32(kf[6], qr[3], C0),   P1[10], P1[11], P1[12], P1[13], pw3[0] = PKW(P1, 8),  pw3[1] = PKW(P1, 10), pw3, 0); \
            VRD(3, 0); SBAR(); GAPA(C1 = MFMA32(kf[7], qr[3], C1),   P1[14], P1[15], 0.f, 0.f,       pw3[2] = PKW(P1, 12), pw3[3] = PKW(P1, 14), pw3, 2); \
    if constexpr (SAFE) l_reg += sacc + sacb; \
    if constexpr (MODE == 1) { if ((t) >= nA) wmask(C0, C1, KROW(t) - qpos, hi); } \
    SBAR(); \
      \
      \
    if constexpr (!SAFE) { \
      \
    VRD(0, 1); SBAR(); GAPG(0, 0, C0[0] = EX(C0[0]); C0[1] = EX(C0[1]); PIN(C0)); \
    VRD(1, 1); SBAR(); GAPG(1, 0, C0[2] = EX(C0[2]); C0[3] = EX(C0[3]); sacc += C0[0]; sacb += C0[1]; PIN(C0); PIN(sacc); PIN(sacb)); \
    VRD(2, 1); SBAR(); GAPG(2, 0, C0[4] = EX(C0[4]); C0[5] = EX(C0[5]); sacc += C0[2]; sacb += C0[3]; PIN(C0); PIN(sacc); PIN(sacb)); \
    VRD(3, 1); SBAR(); GAPG(3, 0, C0[6] = EX(C0[6]); C0[7] = EX(C0[7]); sacc += C0[4]; sacb += C0[5]; PIN(C0); PIN(sacc); PIN(sacb)); \
    VRD(0, 2); SBAR(); GAPG(0, 1, C0[8] = EX(C0[8]); C0[9] = EX(C0[9]); sacc += C0[6]; sacb += C0[7]; PIN(C0); PIN(sacc); PIN(sacb)); \
    VRD(1, 2); SBAR(); GAPG(1, 1, C0[10] = EX(C0[10]); C0[11] = EX(C0[11]); sacc += C0[8]; sacb += C0[9]; PIN(C0); PIN(sacc); PIN(sacb)); \
    VRD(2, 2); SBAR(); GAPG(2, 1, C0[12] = EX(C0[12]); C0[13] = EX(C0[13]); sacc += C0[10]; sacb += C0[11]; PIN(C0); PIN(sacc); PIN(sacb)); \
    VRD(3, 2); SBAR(); GAPG(3, 1, C0[14] = EX(C0[14]); C0[15] = EX(C0[15]); sacc += C0[12]; sacb += C0[13]; PIN(C0); PIN(sacc); PIN(sacb)); \
    VRD(0, 3); SBAR(); GAPG(0, 2, C1[0] = EX(C1[0]); C1[1] = EX(C1[1]); sacc += C0[14]; sacb += C0[15]; PIN(C1); PIN(sacc); PIN(sacb)); \
    VRD(1, 3); SBAR(); GAPG(1, 2, C1[2] = EX(C1[2]); C1[3] = EX(C1[3]); sacc += C1[0]; sacb += C1[1]; PIN(C1); PIN(sacc); PIN(sacb)); \
    VRD(2, 3); SBAR(); GAPG(2, 2, C1[4] = EX(C1[4]); C1[5] = EX(C1[5]); sacc += C1[2]; sacb += C1[3]; PIN(C1); PIN(sacc); PIN(sacb)); \
    VRD(3, 3); SBAR(); GAPG(3, 2, C1[6] = EX(C1[6]); C1[7] = EX(C1[7]); sacc += C1[4]; sacb += C1[5]; PIN(C1); PIN(sacc); PIN(sacb)); \
    if (GK) { DMA_K((t) + 2, sl_prev); } SBAR(); GAPG(0, 3, C1[8] = EX(C1[8]); C1[9] = EX(C1[9]); sacc += C1[6]; sacb += C1[7]; PIN(C1); PIN(sacc); PIN(sacb)); \
    if (GV) { DMA_V((t) + 1, sl_next); } SBAR(); GAPG(1, 3, C1[10] = EX(C1[10]); C1[11] = EX(C1[11]); sacc += C1[8]; sacb += C1[9]; PIN(C1); PIN(sacc); PIN(sacb)); \
    GAPG(2, 3, C1[12] = EX(C1[12]); C1[13] = EX(C1[13]); sacc += C1[10]; sacb += C1[11]; PIN(C1); PIN(sacc); PIN(sacb)); \
    GAPG(3, 3, C1[14] = EX(C1[14]); C1[15] = EX(C1[15]); sacc += C1[12]; sacb += C1[13]; PIN(C1); PIN(sacc); PIN(sacb)); \
    sacc += C1[14]; sacb += C1[15]; l_reg += sacc + sacb; \
    } else { \
    float mxa, mxb; \
    VRD(0, 1); SBAR(); GAPG(0, 0, mxa = MX3(C0[0], C0[1], C0[2]); mxb = MX3(C0[3], C0[4], C0[5]); mxa = MX3(mxa, C0[6], C0[7]); mxb = MX3(mxb, C0[8], C0[9]); PIN(mxa); PIN(mxb)); \
    VRD(1, 1); SBAR(); GAPG(1, 0, mxa = MX3(mxa, C0[10], C0[11]); mxb = MX3(mxb, C0[12], C0[13]); mxa = MX3(mxa, C0[14], C0[15]); mxb = MX3(mxb, C1[0], C1[1]); PIN(mxa); PIN(mxb)); \
    VRD(2, 1); SBAR(); GAPG(2, 0, mxa = MX3(mxa, C1[2], C1[3]); mxb = MX3(mxb, C1[4], C1[5]); mxa = MX3(mxa, C1[6], C1[7]); mxb = MX3(mxb, C1[8], C1[9]); PIN(mxa); PIN(mxb)); \
    VRD(3, 1); SBAR(); GAPG(3, 0, mxa = MX3(mxa, C1[10], C1[11]); mxb = MX3(mxb, C1[12], C1[13]); mxa = MX3(mxa, C1[14], C1[15]); PIN(mxa); PIN(mxb)); \
    { float rm = __builtin_fmaxf(mxa, mxb); { auto rr = __builtin_amdgcn_permlane32_swap(__float_as_uint(rm), __float_as_uint(rm), false, false); rm = __builtin_fmaxf(__uint_as_float(rr[0]), __uint_as_float(rr[1])); } \
      resc = false; \
      if (__builtin_expect(__any(rm > THR), 0)) { const float dl = __builtin_fmaxf(rm, 0.f); mhat += dl; \
          _Pragma("unroll") for (int r = 0; r < 16; ++r) { C0[r] -= dl; C1[r] -= dl; } \
          _Pragma("unroll") for (int r = 0; r < 16; ++r) negm[r] = -mhat; PIN(negm); \
          const float f = __builtin_amdgcn_exp2f(-dl); l_reg *= f; if (hi == 0) wsf[r32] = f; resc = true; } } \
    SBAR(); \
    VRD(0, 2); SBAR(); GAPG(0, 1, C0[0] = EX(C0[0]); C0[1] = EX(C0[1]); C0[2] = EX(C0[2]); PIN(C0)); \
    VRD(1, 2); SBAR(); GAPG(1, 1, C0[3] = EX(C0[3]); C0[4] = EX(C0[4]); C0[5] = EX(C0[5]); PIN(C0)); \
    VRD(2, 2); SBAR(); GAPG(2, 1, C0[6] = EX(C0[6]); C0[7] = EX(C0[7]); C0[8] = EX(C0[8]); PIN(C0)); \
    VRD(3, 2); SBAR(); GAPG(3, 1, C0[9] = EX(C0[9]); C0[10] = EX(C0[10]); C0[11] = EX(C0[11]); PIN(C0)); \
    VRD(0, 3); SBAR(); GAPG(0, 2, C0[12] = EX(C0[12]); C0[13] = EX(C0[13]); C0[14] = EX(C0[14]); PIN(C0)); \
    VRD(1, 3); SBAR(); GAPG(1, 2, C0[15] = EX(C0[15]); C1[0] = EX(C1[0]); C1[1] = EX(C1[1]); PIN(C0); PIN(C1)); \
    VRD(2, 3); SBAR(); GAPG(2, 2, C1[2] = EX(C1[2]); C1[3] = EX(C1[3]); C1[4] = EX(C1[4]); PIN(C1)); \
    VRD(3, 3); SBAR(); GAPG(3, 2, C1[5] = EX(C1[5]); C1[6] = EX(C1[6]); C1[7] = EX(C1[7]); PIN(C1)); \
    if (GK) { DMA_K((t) + 2, sl_prev); if (PROBE_DUPK) DMA_K((t) + 2, sl_prev); } SBAR(); GAPG(0, 3, C1[8] = EX(C1[8]); C1[9] = EX(C1[9]); PIN(C1)); \
    if (GV) { DMA_V((t) + 1, sl_next); if (PROBE_DUPV) DMA_V((t) + 1, sl_next); } SBAR(); GAPG(1, 3, C1[10] = EX(C1[10]); C1[11] = EX(C1[11]); PIN(C1)); \
    GAPG(2, 3, C1[12] = EX(C1[12]); C1[13] = EX(C1[13]); PIN(C1)); \
    GAPG(3, 3, C1[14] = EX(C1[14]); C1[15] = EX(C1[15]); PIN(C1)); \
    } \
    } while (0)
#ifndef PROBE_DUPK
#define PROBE_DUPK 0
#endif
#ifndef PROBE_DUPV
#define PROBE_DUPV 0
#endif
#define WAIT_N(n_) do { if ((n_) == 6) { WAIT_BAR(6); } else if ((n_) == 5) { WAIT_BAR(5); } else if ((n_) == 4) { WAIT_BAR(4); } else if ((n_) == 3) { WAIT_BAR(3); } else if ((n_) == 2) { WAIT_BAR(2); } else if ((n_) == 1) { WAIT_BAR(1); } else { WAIT_BAR(0); } } while (0)
#define ENDW(tt) do { const int nk_ = ((tt) + 2 < NT) ? 1 + PROBE_DUPK : 0, nv_ = ((tt) + 1 < NT) ? NVP * (1 + PROBE_DUPV) : 0; WAIT_N(nk_ + nv_); } while (0)
    int t = 1;
    for (; t + 3 < NT; t += 2) {
        STEP(pB0, pB1, pA0, pA1, t, true, true);     WAIT_N(1 + PROBE_DUPK + NVP * (1 + PROBE_DUPV)); RESC(); ROT();
        STEP(pA0, pA1, pB0, pB1, t + 1, true, true); WAIT_N(1 + PROBE_DUPK + NVP * (1 + PROBE_DUPV)); RESC(); ROT();
    }
    for (; t + 1 < NT; t += 2) {
        STEP(pB0, pB1, pA0, pA1, t, (t + 2 < NT), (t + 1 < NT));         ENDW(t);     RESC(); ROT();
        STEP(pA0, pA1, pB0, pB1, t + 1, (t + 3 < NT), (t + 2 < NT));     ENDW(t + 1); RESC(); ROT();
    }
    STEP(pB0, pB1, pA0, pA1, NT - 1, false, false); WAIT_BAR(0); RESC(); ROT();
    { if constexpr (SAFE) { float sacc = pB0[0] + pB0[1];
#pragma unroll
      for (int r = 2; r < 16; ++r) sacc += pB0[r];
#pragma unroll
      for (int r = 0; r < 16; ++r) sacc += pB1[r];
      l_reg += sacc; }
      pw0 = (u32x4){PKW(pB0, 0), PKW(pB0, 2), PKW(pB0, 4), PKW(pB0, 6)}; pw1 = (u32x4){PKW(pB0, 8), PKW(pB0, 10), PKW(pB0, 12), PKW(pB0, 14)};
      pw2 = (u32x4){PKW(pB1, 0), PKW(pB1, 2), PKW(pB1, 4), PKW(pB1, 6)}; pw3 = (u32x4){PKW(pB1, 8), PKW(pB1, 10), PKW(pB1, 12), PKW(pB1, 14)};
      const lds_cptr vp_ = vp0 + sl_prev * VSLOT;
#pragma unroll
      for (int q = 0; q < ND; ++q) {
          s16x4 l0 = vtr(vp_ + q * 4096), h0 = vtr(vp_ + q * 4096 + 512), l1 = vtr(vp_ + q * 4096 + 1024), h1 = vtr(vp_ + q * 4096 + 1024 + 512);
          s16x4 l2 = vtr(vp_ + q * 4096 + 2048), h2 = vtr(vp_ + q * 4096 + 2048 + 512), l3 = vtr(vp_ + q * 4096 + 3072), h3 = vtr(vp_ + q * 4096 + 3072 + 512);
#define PKV(L, H) (bf16x8){L[0], L[1], L[2], L[3], H[0], H[1], H[2], H[3]}
          o[q] = MFMA32(PAF(0), PKV(l0, h0), o[q]); o[q] = MFMA32(PAF(1), PKV(l1, h1), o[q]); o[q] = MFMA32(PAF(2), PKV(l2, h2), o[q]); o[q] = MFMA32(PAF(3), PKV(l3, h3), o[q]);
#undef PKV
      } }
    { auto rr = __builtin_amdgcn_permlane32_swap(__float_as_uint(l_reg), __float_as_uint(l_reg), false, false); l_reg = __uint_as_float(rr[0]) + __uint_as_float(rr[1]); }
    if (PROBE_VALU) asm volatile("" :: "v"(dummy_));
    __builtin_amdgcn_s_setprio(0);
    m_out = mhat; l_out = l_reg;
#undef KROW
#undef DMA_K
#undef DMA_V
#undef ROT
#undef RESC
#undef PAF
#undef VFR
#undef VRD
#undef KRD
#undef PKW
#undef GAPA
#undef DOT2
#undef GAPB
#undef GAPG
#undef EX
#undef STEP
#undef ENDW
#undef WAIT_N
}
#undef SBAR
#undef PIN
#undef MX3
#undef MFMA32
#undef WAIT_BAR
}

#define XB_TMO      128
#define XB_XCNT(j)  (256  + 64 * (j))
#define XB_XSUB(j)  (1280 + 64 * (j))
#define XB_XGEN(j)  (2304 + 64 * (j))
#define XB_TOP      3328
#define XB_TOPGEN   3392
#define XCD_BAR_WORDS 3456
#define XB_SPIN_CAP (1u << 18)

__device__ __forceinline__ unsigned xb_ld(unsigned* p)              { return __hip_atomic_load(p, __ATOMIC_RELAXED, __HIP_MEMORY_SCOPE_AGENT); }
__device__ __forceinline__ unsigned xb_add(unsigned* p, unsigned v) { return __hip_atomic_fetch_add(p, v, __ATOMIC_RELAXED, __HIP_MEMORY_SCOPE_AGENT); }
__device__ __forceinline__ unsigned xb_xcc_id() { return (unsigned)__builtin_amdgcn_s_getreg((3 << 11) | 20) & 0xFu; }
#define XB_SPIN(cond, bar) do { unsigned _sp = 0; while (cond) { __builtin_amdgcn_s_sleep(1); \
    if ((++_sp & 255u) == 0u) { if (xb_ld(&(bar)[XB_TMO])) break; if (_sp > XB_SPIN_CAP) { atomicAdd(&(bar)[XB_TMO], 1u); break; } } } } while (0)

struct XcdBarrier {
    unsigned* bar; unsigned x;
    volatile LAS unsigned* st;
};

__device__ __forceinline__ XcdBarrier xcd_barrier_post(unsigned* bar, volatile LAS unsigned* st) {
    XcdBarrier b; b.bar = bar; b.x = xb_xcc_id(); b.st = st;
    if (threadIdx.x == 0) (void)xb_add(&bar[XB_XCNT(b.x)], 1u);
    return b;
}
__device__ __forceinline__ void xcd_barrier_complete(unsigned* bar, unsigned x, unsigned& nloc, unsigned& nx) {
    const unsigned G = gridDim.x * gridDim.y * gridDim.z;
    unsigned sum, cnt, mine, sp = 0u;
    for (;;) {
        sum = 0u; cnt = 0u; mine = 0u;
#pragma unroll
        for (unsigned j = 0; j < 16; ++j) { const unsigned c = xb_ld(&bar[XB_XCNT(j)]); sum += c; cnt += (c > 0u) ? 1u : 0u; mine = (j == x) ? c : mine; }
        if (sum == G) break;
        __builtin_amdgcn_s_sleep(1);
        if ((++sp & 255u) == 0u) { if (xb_ld(&bar[XB_TMO])) break; if (sp > XB_SPIN_CAP) { atomicAdd(&bar[XB_TMO], 1u); break; } }
    }
    nloc = mine > 0u ? mine : 1u; nx = cnt > 0u ? cnt : 1u;
}

__device__ __forceinline__ void xcd_barrier(const XcdBarrier& b) {
    asm volatile("s_waitcnt vmcnt(0)" ::: "memory");
    __syncthreads();
    if (threadIdx.x == 0) {
        unsigned* bar = b.bar;
        __builtin_amdgcn_s_waitcnt(0);
        unsigned nloc = b.st[0], nx = b.st[1];
        if (nloc == 0u) { xcd_barrier_complete(bar, b.x, nloc, nx); b.st[0] = nloc; b.st[1] = nx; }
        const unsigned old = xb_add(&bar[XB_XSUB(b.x)], 1u);
        const unsigned gen = old / nloc;
        if (old + 1u == (gen + 1u) * nloc) {
            __builtin_amdgcn_fence(__ATOMIC_RELEASE, "agent");
            asm volatile("s_waitcnt vmcnt(0)" ::: "memory");
            const unsigned og = xb_add(&bar[XB_TOP], 1u);
            const unsigned tg = og / nx;
            if (og + 1u == (tg + 1u) * nx) xb_add(&bar[XB_TOPGEN], 1u);
            else XB_SPIN(xb_ld(&bar[XB_TOPGEN]) == tg, bar);
            __builtin_amdgcn_fence(__ATOMIC_ACQUIRE, "agent");
            xb_add(&bar[XB_XGEN(b.x)], 1u);
            asm volatile("s_waitcnt vmcnt(0)" ::: "memory");
        } else {
            XB_SPIN(xb_ld(&bar[XB_XGEN(b.x)]) == gen, bar);
            __builtin_amdgcn_fence(__ATOMIC_ACQUIRE, "agent");
            asm volatile("s_waitcnt vmcnt(0)" ::: "memory");
        }
    }
    __syncthreads();
}

struct Args { const float* in[23]; float* out; unsigned char* ws; int ph_lo, ph_hi; };
enum { I_X = 0, I_C, I_CTX, I_CCTX, I_WADA, I_BADA, I_GMIX, I_WIN, I_DLAM, I_DNG, I_SINK, I_CONVW, I_CONVB, I_LNG, I_LNB, I_WOUT, I_GFFN, I_RW, I_RB, I_W1, I_W3, I_W2, I_GFIN };
constexpr int N_PHASES = 18;
__device__ __constant__ const float LAMBDA_INIT[2] = {0.2f, 0.35550906759097f};

struct EpiInProj {
    static constexpr bool PERM = true, AFTER_DRAIN = false;
    unsigned char* ws; const float* ropeC; const float* ropeS;
    __device__ __forceinline__ void operator()(const f32x4 (&acc)[2][2][4][2], const pg8::Unit& u, int wr, int wc, int fr, int fq) const {
        const int pn = u.pn; const bool latent = u.pm < 64; const int rowb = u.pm * 256 + wr * 64 + fr;
        if (pn >= 8) {
            bf16_t* Z = (bf16_t*)(ws + RA_Z); const int ch0 = (pn - 8) * 128 + wc * 32 + 8 * fq;
#pragma unroll
            for (int ai = 0; ai < 2; ++ai)
#pragma unroll
                for (int m = 0; m < 4; ++m) { const int row = rowb + ai * 128 + m * 16;
                    const f32x4 a0 = acc[ai][0][m][0], a1 = acc[ai][0][m][1], g0 = acc[ai][1][m][0], g1 = acc[ai][1][m][1];
                    u32x4 w; w.x = cvt_pk_bf16(a0[0] * sigmoid_f(g0[0]), a0[1] * sigmoid_f(g0[1])); w.y = cvt_pk_bf16(a0[2] * sigmoid_f(g0[2]), a0[3] * sigmoid_f(g0[3]));
                    w.z = cvt_pk_bf16(a1[0] * sigmoid_f(g1[0]), a1[1] * sigmoid_f(g1[1])); w.w = cvt_pk_bf16(a1[2] * sigmoid_f(g1[2]), a1[3] * sigmoid_f(g1[3]));
                    *(u32x4*)(Z + (size_t)row * 256 + ch0) = w; }
            return;
        }
        const float sgn = (fq < 2) ? -1.f : 1.f;
        const bool anyrope = latent && (pn < 4 || pn >= 6);
#pragma unroll
        for (int ai = 0; ai < 2; ++ai)
#pragma unroll
            for (int m = 0; m < 4; ++m) { const int row = rowb + ai * 128 + m * 16;
                f32x4 c0, c1, s0, s1;
                if (anyrope) { const int pos = (wc & 1) ? (row & 63) : (row >> 6); const int fo = pos * 16 + 8 * (fq & 1);
                    c0 = *(const f32x4*)(ropeC + fo); c1 = *(const f32x4*)(ropeC + fo + 4); s0 = *(const f32x4*)(ropeS + fo) * sgn; s1 = *(const f32x4*)(ropeS + fo + 4) * sgn; }
#pragma unroll
                for (int bj = 0; bj < 2; ++bj) {
                    bf16_t* dst; int ld, dcol; bool rope; float sc = 1.f; bool isvb = false;
                    if (pn < 2)       { dst = (bf16_t*)(ws + RA_QA); ld = 512; dcol = pn * 256 + bj * 128 + wc * 32; rope = true; sc = QSCALE; }
                    else if (pn < 4)  { dst = (bf16_t*)(ws + RA_KA); ld = 512; dcol = (pn - 2) * 256 + bj * 128 + wc * 32; rope = true; }
                    else if (pn < 6)  { dst = (bf16_t*)(ws + RA_VA); ld = 512; dcol = (pn - 4) * 256 + bj * 128 + wc * 32; rope = false; }
                    else if (pn == 6) { dst = (bf16_t*)(ws + RA_QB); ld = 256; dcol = bj * 128 + wc * 32; rope = true; sc = QSCALE; }
                    else if (bj == 0) { dst = (bf16_t*)(ws + RA_KB); ld = 128; dcol = wc * 32; rope = true; }
                    else              { dst = (bf16_t*)(ws + RA_VB); ld = 256; dcol = (wc >> 1) * 128 + (wc & 1) * 32; rope = false; isvb = true; }
                    rope = rope && latent;
                    f32x4 x0 = acc[ai][bj][m][0], x1 = acc[ai][bj][m][1];
                    if (rope) { f32x4 p0, p1;
#pragma unroll
                        for (int j = 0; j < 4; ++j) {
                            auto s0_ = __builtin_amdgcn_permlane32_swap(__float_as_uint(x0[j]), __float_as_uint(x0[j]), false, false); p0[j] = __uint_as_float(fq < 2 ? s0_[1] : s0_[0]);
                            auto s1_ = __builtin_amdgcn_permlane32_swap(__float_as_uint(x1[j]), __float_as_uint(x1[j]), false, false); p1[j] = __uint_as_float(fq < 2 ? s1_[1] : s1_[0]); }
                        x0 = x0 * c0 + p0 * s0; x1 = x1 * c1 + p1 * s1; }
                    x0 = x0 * sc; x1 = x1 * sc;
                    bf16_t* p = dst + (size_t)row * ld + dcol + 8 * fq;
                    u32x4 w; w.x = cvt_pk_bf16(x0[0], x0[1]); w.y = cvt_pk_bf16(x0[2], x0[3]); w.z = cvt_pk_bf16(x1[0], x1[1]); w.w = cvt_pk_bf16(x1[2], x1[3]);
                    *(u32x4*)p = w;
                    if (isvb) { unsigned zz = 0u; asm volatile("" : "+v"(zz)); const u32x4 z = {zz, zz, zz, zz}; *(u32x4*)(p + 64) = z; } }
            }
    }
};
__device__ __forceinline__ void st16_wt(void* p, const u32x4 v) { asm volatile("global_store_dwordx4 %0, %1, off sc1\n\ts_nop 1" :: "v"(p), "v"(v) : "memory"); }
__device__ __forceinline__ void st4bf_wt(bf16_t* p, const f32x4 v) { u32x2 w; w.x = cvt_pk_bf16(v.x, v.y); w.y = cvt_pk_bf16(v.z, v.w); asm volatile("global_store_dwordx2 %0, %1, off sc1\n\ts_nop 0" :: "v"(p), "v"(w) : "memory"); }
struct OutOrder {
    pg8::StaticOrder in; gu32* cnt; gu32* ctxc;
    __device__ __forceinline__ bool next(int i, pg8::Unit& u) const {
        if (ctxc == nullptr) { if (i != 0) return false; return in.next(0, u); }
        const int c = blockIdx.x;
        if (c < 12) { if (i != 0) return false; u.pm = 61 + (c >> 2); u.pn = c & 3; u.aux = 0; return true; }
        if (i == 0) return in.next(0, u);
        if (i == 1 && c < 16) { u.pm = 64; u.pn = c - 12; u.aux = 0; return true; }
        return false; }
    __device__ __forceinline__ void a_ready(const pg8::Unit& u) const {
        if (ctxc != nullptr && u.pm >= 64) { for (unsigned s = 0; s < (1u << 20); ++s) { if ((unsigned)__builtin_amdgcn_readfirstlane((int)__hip_atomic_load(ctxc, __ATOMIC_RELAXED, __HIP_MEMORY_SCOPE_AGENT)) == 12u) break; __builtin_amdgcn_s_sleep(2); }
            __builtin_amdgcn_fence(__ATOMIC_ACQUIRE, "agent"); } }
    __device__ __forceinline__ void done(const pg8::Unit& u) const {
        asm volatile("s_waitcnt vmcnt(0)" ::: "memory");
        int ln; asm volatile("v_mbcnt_lo_u32_b32 %0, -1, 0\n\tv_mbcnt_hi_u32_b32 %0, -1, %0" : "=v"(ln));
        if (ln == 0) __hip_atomic_fetch_add(cnt + u.pm, 1u, __ATOMIC_RELAXED, __HIP_MEMORY_SCOPE_AGENT); }
};
struct EpiOutProj {
    static constexpr bool PERM = true, AFTER_DRAIN = false;
    const float* xin; const float* ctxin; bf16_t* XB; const float* gate_lat; const float* gate_ctx; int layer;
    __device__ __forceinline__ void operator()(const f32x4 (&acc)[2][2][4][2], const pg8::Unit& u, int wr, int wc, int fr, int fq) const {
        const bool isctx = u.pm >= 64; const float* gate = isctx ? gate_ctx : gate_lat; const int col8 = u.pn * 256 + wc * 32 + 8 * fq;
#pragma unroll
        for (int ai = 0; ai < 2; ++ai)
#pragma unroll
            for (int m = 0; m < 4; ++m) { const int row = u.pm * 256 + ai * 128 + wr * 64 + m * 16 + fr;
                const float* xo = isctx ? ctxin + (size_t)(row - SEQ) * DM : xin + (size_t)row * DM;
                bf16_t* xn = XB + (size_t)row * DM;
#pragma unroll
                for (int bj = 0; bj < 2; ++bj) { const int col = col8 + bj * 128;
                    f32x4 x0, x1;
                    if (layer == 0) { x0 = *(const f32x4*)(xo + col); x1 = *(const f32x4*)(xo + col + 4); }
                    else { const u32x4 w = *(const u32x4*)(xn + col);
                        x0 = (f32x4){__builtin_bit_cast(float, w.x << 16), __builtin_bit_cast(float, w.x & 0xffff0000u), __builtin_bit_cast(float, w.y << 16), __builtin_bit_cast(float, w.y & 0xffff0000u)};
                        x1 = (f32x4){__builtin_bit_cast(float, w.z << 16), __builtin_bit_cast(float, w.z & 0xffff0000u), __builtin_bit_cast(float, w.w << 16), __builtin_bit_cast(float, w.w & 0xffff0000u)}; }
                    const f32x4 g0 = *(const f32x4*)(gate + col), g1 = *(const f32x4*)(gate + col + 4);
                    const f32x4 y0 = x0 + g0 * acc[ai][bj][m][0], y1 = x1 + g1 * acc[ai][bj][m][1];
                    u32x4 o; o.x = cvt_pk_bf16(y0.x, y0.y); o.y = cvt_pk_bf16(y0.z, y0.w); o.z = cvt_pk_bf16(y1.x, y1.y); o.w = cvt_pk_bf16(y1.z, y1.w);
                    st16_wt(xn + col, o); } }
    }
};
struct EpiMoe1 {
    static constexpr bool PERM = true, AFTER_DRAIN = false;
    bf16_t* HS;
    __device__ __forceinline__ void operator()(const f32x4 (&acc)[2][2][4][2], const pg8::Unit& u, int wr, int wc, int fr, int fq) const {
        const int col8 = (u.pn & 3) * 128 + wc * 32 + 8 * fq;
#pragma unroll
        for (int ai = 0; ai < 2; ++ai)
#pragma unroll
            for (int m = 0; m < 4; ++m) { const int row = u.pm * 256 + ai * 128 + wr * 64 + m * 16 + fr;
                const f32x4 a0 = acc[ai][0][m][0], a1 = acc[ai][0][m][1], b0 = acc[ai][1][m][0], b1 = acc[ai][1][m][1];
                u32x4 w; w.x = cvt_pk_bf16(silu_f(a0[0]) * b0[0], silu_f(a0[1]) * b0[1]); w.y = cvt_pk_bf16(silu_f(a0[2]) * b0[2], silu_f(a0[3]) * b0[3]);
                w.z = cvt_pk_bf16(silu_f(a1[0]) * b1[0], silu_f(a1[1]) * b1[1]); w.w = cvt_pk_bf16(silu_f(a1[2]) * b1[2], silu_f(a1[3]) * b1[3]);
                st16_wt(HS + (size_t)row * FFE + col8, w); }
    }
};
constexpr float YS_SCALE = 16.f, YS_INV = 1.f / 16.f;
struct EpiMoe2 {
    static constexpr bool PERM = true, AFTER_DRAIN = false;
    unsigned char* YS;
    __device__ __forceinline__ void operator()(const f32x4 (&acc)[2][2][4][2], const pg8::Unit& u, int wr, int wc, int fr, int fq) const {
        const int col8 = (u.pn & 3) * 256 + wc * 32 + 8 * fq;
#pragma unroll
        for (int ai = 0; ai < 2; ++ai)
#pragma unroll
            for (int m = 0; m < 4; ++m) { const int row = u.pm * 256 + ai * 128 + wr * 64 + m * 16 + fr;
#pragma unroll
                for (int bj = 0; bj < 2; ++bj) { f32x4 v0 = acc[ai][bj][m][0] * YS_SCALE, v1 = acc[ai][bj][m][1] * YS_SCALE;
#pragma unroll
                    for (int j = 0; j < 4; ++j) { v0[j] = __builtin_amdgcn_fmed3f(v0[j], -448.f, 448.f); v1[j] = __builtin_amdgcn_fmed3f(v1[j], -448.f, 448.f); }
                    int w0 = __builtin_amdgcn_cvt_pk_fp8_f32(v0[0], v0[1], 0, false); w0 = __builtin_amdgcn_cvt_pk_fp8_f32(v0[2], v0[3], w0, true);
                    int w1 = __builtin_amdgcn_cvt_pk_fp8_f32(v1[0], v1[1], 0, false); w1 = __builtin_amdgcn_cvt_pk_fp8_f32(v1[2], v1[3], w1, true);
                    *(u32x2*)(YS + (size_t)row * DM + col8 + bj * 128) = (u32x2){(unsigned)w0, (unsigned)w1}; } }
    }
};
struct MoeOrder {
    int G, vcu, nunits; int ts[16]; const int* rowtok;
    __device__ __forceinline__ unsigned row_off(const pg8::Unit& u, int r) const { return (unsigned)min((unsigned)rowtok[u.aux + r], (unsigned)(NROW - 1)) * (unsigned)(DM * 2); }
    __device__ __forceinline__ bool next(int i, pg8::Unit& u) const {
        const int L = i * G + vcu; if (L >= nunits) return false;
        const int rt = L >> 2, ct = L & 3; int e = 0, tb = ts[0];
#pragma unroll
        for (int k = 1; k < 16; ++k) { const bool ge = rt >= ts[k]; e += ge ? 1 : 0; tb = ge ? ts[k] : tb; }
        u.pm = rt; u.pn = e * 4 + ct; u.aux = e * ROWCAP + (rt - tb) * 256; return true;
    }
    __device__ __forceinline__ int nloc() const { return vcu < nunits ? (nunits - vcu + G - 1) / G : 0; }
    __device__ __forceinline__ void a_ready(const pg8::Unit&) const {}
    __device__ __forceinline__ void done(const pg8::Unit&) const {}
};

struct MoeOrder2 {
    int vcu, nunits, part; int ts[16];
    __device__ __forceinline__ bool next(int i, pg8::Unit& u) const {
        const int U = nunits, q = U >> 8, r = U & 255; int L;
        if (part == 0) { if (vcu < r || i >= q) return false; L = i * 256 + vcu; }
        else { int b = vcu + i * 256; if (b >= (q + 1) * r) return false; int k = 0; while (b >= r) { b -= r; ++k; } L = k * 256 + b; }
        const int rt = L >> 2, ct = L & 3; int e = 0;
#pragma unroll
        for (int k = 1; k < 16; ++k) e += (rt >= ts[k]) ? 1 : 0;
        u.pm = rt; u.pn = e * 4 + ct; u.aux = 0; return true; }
    __device__ __forceinline__ void a_ready(const pg8::Unit&) const {}
    __device__ __forceinline__ void done(const pg8::Unit&) const {}
};
__device__ __forceinline__ void moe_wait(gu32* flag, int base, int n) {
    const int tid = otid();
    if (tid < 64) { for (unsigned s = 0; s < (1u << 20); ++s) { bool ok = true;
            for (int j = tid; j < n; j += 64) ok = ok && (__hip_atomic_load(flag + base + j, __ATOMIC_RELAXED, __HIP_MEMORY_SCOPE_AGENT) == 1u);
            if (__all(ok)) break; __builtin_amdgcn_s_sleep(2); }
        __builtin_amdgcn_fence(__ATOMIC_ACQUIRE, "agent"); asm volatile("s_waitcnt vmcnt(0)" ::: "memory"); }
    __syncthreads();
}

__device__ __forceinline__ void tr_item(const float* W, int ldw, int k0, int n0, bf16_t* WT, int K, int nd0, LAS float* scr, int lane) {
    f32x4 v[8];
#pragma unroll
    for (int i = 0; i < 8; ++i) v[i] = *(const f32x4*)(W + (size_t)(k0 + 8 * i + (lane >> 3)) * ldw + n0 + (lane & 7) * 4);
#pragma unroll
    for (int i = 0; i < 8; ++i) { LAS float* d = scr + (8 * i + (lane >> 3)) * 33 + (lane & 7) * 4; d[0] = v[i].x; d[1] = v[i].y; d[2] = v[i].z; d[3] = v[i].w; }
    LDS_WAIT(); asm volatile("" ::: "memory");
    const int c = lane & 7;
#pragma unroll
    for (int j = 0; j < 4; ++j) { const int n = (lane >> 3) + 8 * j; const LAS float* s = scr + (8 * c) * 33 + n;
        u32x4 o; o.x = pk2(s[0 * 33], s[1 * 33]); o.y = pk2(s[2 * 33], s[3 * 33]); o.z = pk2(s[4 * 33], s[5 * 33]); o.w = pk2(s[6 * 33], s[7 * 33]);
        *(u32x4*)(WT + (size_t)(nd0 + n) * K + k0 + 8 * c) = o; }
    LDS_WAIT(); asm volatile("" ::: "memory");
}
__device__ __forceinline__ void moe_convert(const Args& a, int L, LAS float* scr, int gw, int NGW, int lane, int it0 = 0, int it1 = 12288) {
    bf16_t* W13T = (bf16_t*)(a.ws + WS_W13) + (size_t)L * 16 * 1024 * 1024; bf16_t* W2T = (bf16_t*)(a.ws + WS_W2) + (size_t)L * 16 * 1024 * 512;
    for (int it = it0 + gw; it < it1; it += NGW) {
        if (it < 8192) { const int e = it >> 9, r2 = it & 511, kb = r2 >> 5, nb = r2 & 31, nd0 = 32 * nb, t = nd0 >> 8, bj = (nd0 >> 7) & 1, i0 = nd0 & 127;
            const float* src = (bj ? a.in[I_W3] : a.in[I_W1]) + (size_t)(L * 16 + e) * 1024 * 512;
            tr_item(src, 512, 64 * kb, t * 128 + i0, W13T + (size_t)e * 1024 * 1024, 1024, nd0, scr, lane); }
        else { const int r = it - 8192, e = r >> 8, r2 = r & 255, kb = r2 >> 5, nb = r2 & 31;
            tr_item(a.in[I_W2] + (size_t)(L * 16 + e) * 512 * 1024, 1024, 64 * kb, 32 * nb, W2T + (size_t)e * 1024 * 512, 512, 32 * nb, scr, lane); }
    }
}
__device__ __forceinline__ void prologue_phase(const Args& a, unsigned char* lds) {
    const int tid = otid(), lane = tid & 63, wave = tid >> 6, gw = blockIdx.x * NWAVES + wave, NGW = gridDim.x * NWAVES;
    LAS float* scr = (LAS float*)((LAS unsigned char*)lds + wave * 8704);
    bf16_t* WinT = (bf16_t*)(a.ws + WS_WIN); bf16_t* WoutT = (bf16_t*)(a.ws + WS_WOUT);
    for (int it = gw; it < 3584; it += NGW) {
        if (it < 2560) { const int L = it / 1280, r = it % 1280, kb = r / 80, nb = r % 80, nd0 = 32 * nb; int n0 = nd0;
            if (nd0 >= 2048) { const int q = nd0 - 2048, t = q >> 8, bj = (q >> 7) & 1, i0 = q & 127; n0 = 2048 + bj * 256 + t * 128 + i0; }
            tr_item(a.in[I_WIN] + (size_t)L * 1024 * INW, INW, 64 * kb, n0, WinT + (size_t)L * INW * 1024, 1024, nd0, scr, lane); }
        else { const int r0 = it - 2560, L = r0 >> 9, r = r0 & 511, kb = r >> 5, nb = r & 31;
            tr_item(a.in[I_WOUT] + (size_t)L * 1024 * 1024, 1024, 64 * kb, 32 * nb, WoutT + (size_t)L * 1024 * 1024, 1024, 32 * nb, scr, lane); }
    }
    moe_convert(a, 0, scr, gw, NGW, lane, 0, 8192);
    __syncthreads();
    float* sc = (float*)(lds + 71680); float* scc = sc + 1024; float* red = scc + 1024;
    float* MOD = (float*)(a.ws + WS_MOD);
    for (int u = blockIdx.x; u < 192; u += gridDim.x) {
        const int L = u / 96, col0 = (u % 96) * 64;
        for (int k = tid; k < 1024; k += NTHREADS) { const float c = a.in[I_C][k], cc = a.in[I_CCTX][k]; sc[k] = c / (1.f + expf(-c)); scc[k] = cc / (1.f + expf(-cc)); }
        __syncthreads();
        const int cg = tid & 15, ks = tid >> 4;
        const float* w = a.in[I_WADA] + ((size_t)L * 1024 + ks * 32) * 6144 + col0 + cg * 4;
        f32x4 s1 = {0.f, 0.f, 0.f, 0.f}, s2 = {0.f, 0.f, 0.f, 0.f};
#pragma unroll 8
        for (int k = 0; k < 32; ++k) { const f32x4 wv = *(const f32x4*)(w + (size_t)k * 6144); s1 = s1 + wv * sc[ks * 32 + k]; s2 = s2 + wv * scc[ks * 32 + k]; }
        *(f32x4*)(red + (ks * 16 + cg) * 8) = s1; *(f32x4*)(red + (ks * 16 + cg) * 8 + 4) = s2;
        __syncthreads();
        if (tid < 128) { const int which = tid >> 6, c = tid & 63; float s = 0.f;
            for (int k = 0; k < 32; ++k) s += red[(k * 16 + (c >> 2)) * 8 + which * 4 + (c & 3)];
            MOD[(L * 2 + which) * 6144 + col0 + c] = s + a.in[I_BADA][L * 6144 + col0 + c]; }
        __syncthreads();
    }
    if (blockIdx.x >= 192 && tid < 64) {
        float* rc = (float*)(a.ws + WS_ROPEC); float* rs = (float*)(a.ws + WS_ROPES);
        const int i = ((int)blockIdx.x - 192) * 64 + tid; const int pos = i >> 4, f = i & 15; const float inv = powf(10000.f, -(float)f / 16.f), ang = (float)pos * inv; rc[i] = cosf(ang); rs[i] = sinf(ang);
    }
    if (blockIdx.x == gridDim.x - 2 && wave < 2) {
        const float* dl = a.in[I_DLAM] + wave * 256;
        const float s01 = wave_sum(dl[lane] * dl[64 + lane]), s23 = wave_sum(dl[128 + lane] * dl[192 + lane]);
        if (lane == 0) ((float*)(a.ws + WS_LAM))[wave] = expf(s01) - expf(s23) + LAMBDA_INIT[wave];
    }
}

__device__ __forceinline__ void norm1_phase(const Args& a, int l) {
    constexpr int NR = 4;
    const int tid = otid(), lane = tid & 63, wave = tid >> 6;
    const int nrows = (l == 2) ? SEQ : NROW, rpw = (nrows + gridDim.x - 1) / gridDim.x, r0 = blockIdx.x * rpw, r1 = min(nrows, r0 + rpw);
    const int rw = (rpw + NWAVES - 1) / NWAVES, wr0 = r0 + wave * rw, wr1 = min(r1, wr0 + rw);
    bf16_t* XB = (bf16_t*)(a.ws + WS_XB); bf16_t* HB = (bf16_t*)(a.ws + WS_HB); const unsigned char* YS = a.ws + WS_RA;
    const float* MOD = (const float*)(a.ws + WS_MOD);
    const int2* TOKP = (const int2*)(a.ws + WS_TOKP); const float2* TOKW = (const float2*)(a.ws + WS_TOKW);
    for (int rb = wr0; rb < wr1; rb += NR) {
        f32x4 v[NR][4]; int rowk[NR];
#pragma unroll
        for (int k = 0; k < NR; ++k) rowk[k] = min(rb + k, wr1 - 1);
        if (l == 0) {
#pragma unroll
            for (int k = 0; k < NR; ++k) { const int row = rowk[k]; const bool isctx = row >= SEQ;
                const f32x4* src = (const f32x4*)(isctx ? a.in[I_CTX] + (size_t)(row - SEQ) * DM : a.in[I_X] + (size_t)row * DM) + lane;
#pragma unroll
                for (int j = 0; j < 4; ++j) v[k][j] = src[64 * j]; }
        } else {
            int2 pp[NR]; float2 ww[NR];
#pragma unroll
            for (int k = 0; k < NR; ++k) { pp[k] = TOKP[rowk[k]]; ww[k] = TOKW[rowk[k]]; }
            { const int* tsg = (const int*)(a.ws + WS_TSG) + (l - 1) * 32;
#pragma unroll
              for (int k = 0; k < NR; ++k) { pp[k].x = tsg[pp[k].x >> 15] * 256 + (pp[k].x & 32767); pp[k].y = tsg[pp[k].y >> 15] * 256 + (pp[k].y & 32767); } }
            unsigned y0[NR][4], y1[NR][4]; f32x4 gt[NR][4];
#pragma unroll
            for (int k = 0; k < NR; ++k) { const int row = rowk[k]; const bool isctx = row >= SEQ;
                const bf16_t* xb = XB + (size_t)row * DM + 4 * lane;
                const f32x4* gate = (const f32x4*)(MOD + ((l - 1) * 2 + (isctx ? 1 : 0)) * 6144 + 5 * 1024) + lane;
                const unsigned* q0 = (const unsigned*)(YS + (size_t)pp[k].x * DM) + lane; const unsigned* q1 = (const unsigned*)(YS + (size_t)pp[k].y * DM) + lane;
#pragma unroll
                for (int j = 0; j < 4; ++j) { v[k][j] = ld4bf(xb + 256 * j); gt[k][j] = gate[64 * j]; y0[k][j] = q0[64 * j]; y1[k][j] = q1[64 * j]; } }
#pragma unroll
            for (int k = 0; k < NR; ++k) { const bool st = (rb + k < wr1) && (l < 2); bf16_t* xb = XB + (size_t)rowk[k] * DM + 4 * lane;
#pragma unroll
                for (int j = 0; j < 4; ++j) { const int p0 = (int)y0[k][j], p1 = (int)y1[k][j];
                    const auto a01 = __builtin_amdgcn_cvt_pk_f32_fp8(p0, false), a23 = __builtin_amdgcn_cvt_pk_f32_fp8(p0, true), b01 = __builtin_amdgcn_cvt_pk_f32_fp8(p1, false), b23 = __builtin_amdgcn_cvt_pk_f32_fp8(p1, true);
                    const f32x4 ya = {a01[0], a01[1], a23[0], a23[1]}, yb = {b01[0], b01[1], b23[0], b23[1]};
                    v[k][j] = v[k][j] + gt[k][j] * (ya * (ww[k].x * YS_INV) + yb * (ww[k].y * YS_INV));
                    if (st) st4bf(xb + 256 * j, v[k][j]); } }
        }
#pragma unroll
        for (int k = 0; k < NR; ++k) { const int row = rowk[k]; const bool isctx = row >= SEQ, st = rb + k < wr1;
            float ss = 0.f;
#pragma unroll
            for (int j = 0; j < 4; ++j) ss += (v[k][j].x * v[k][j].x + v[k][j].y * v[k][j].y) + (v[k][j].z * v[k][j].z + v[k][j].w * v[k][j].w);
            const float rstd = 1.f / sqrtf(wave_sum(ss) * (1.f / DM) + EPS);
            if (l < 2) {
                const f32x4* g = (const f32x4*)(a.in[I_GMIX] + l * DM) + lane; const float* md = MOD + (l * 2 + (isctx ? 1 : 0)) * 6144;
                const f32x4* sh = (const f32x4*)(md) + lane; const f32x4* sl = (const f32x4*)(md + 1024) + lane;
                u32x2* o8 = (u32x2*)(HB + (size_t)row * DM) + lane;
#pragma unroll
                for (int j = 0; j < 4; ++j) { const f32x4 h = v[k][j] * rstd * g[64 * j] * (sl[64 * j] + 1.f) + sh[64 * j];
                    u32x2 w; w.x = cvt_pk_bf16(h.x, h.y); w.y = cvt_pk_bf16(h.z, h.w); if (st) o8[64 * j] = w; }
            } else {
                const f32x4* g = (const f32x4*)(a.in[I_GFIN]) + lane; f32x4* o = (f32x4*)(a.out + (size_t)row * DM) + lane;
#pragma unroll
                for (int j = 0; j < 4; ++j) { const f32x4 r = v[k][j] * rstd * g[64 * j]; if (st) o[64 * j] = r; }
            }
        }
    }
}
__device__ __forceinline__ void norm2_phase(const Args& a, int l, unsigned char* lds) {
    const int tid = otid(), lane = tid & 63, wave = tid >> 6;
    const int b_ = blockIdx.x;
    const int nlat = (l == 1) ? 64 : (b_ < 16 ? 1 : 65), lat0 = (l == 1) ? b_ * 64 : (b_ < 16 ? 240 * 65 + b_ : (b_ - 16) * 65);
    const int nlate = (l == 1) ? 0 : 4, late0 = 61 * 256 + 4 * b_, tl = 61 + (b_ >> 6), nloc = nlat + nlate;
#define N2_ROW(i) ((i) < nlat ? lat0 + (i) : late0 + ((i) - nlat))
    float* hrow = (float*)lds;
    float* logit = (float*)(lds + 65536);
    int* e01 = (int*)(lds + 65536 + 8192);
    for (int i = tid; i < 128; i += NTHREADS) e01[i] = -1;
    gu32* cnt = (gu32*)(a.ws + WS_CTL) + CW_OPC + l * 128;
#define N2_WAIT(ta_, tb_) do { if (tid < 64) { for (unsigned s = 0; s < (1u << 20); ++s) { const unsigned c = __hip_atomic_load(cnt + ((lane & 1) ? (tb_) : (ta_)), __ATOMIC_RELAXED, __HIP_MEMORY_SCOPE_AGENT); \
              if (__all(c == 32u)) break; __builtin_amdgcn_s_sleep(2); } \
          __builtin_amdgcn_fence(__ATOMIC_ACQUIRE, "agent"); asm volatile("s_waitcnt vmcnt(0)" ::: "memory"); } \
      __syncthreads(); } while (0)
    N2_WAIT(lat0 >> 8, (lat0 + nlat - 1) >> 8);
    const bf16_t* XB = (const bf16_t*)(a.ws + WS_XB); bf16_t* HB = (bf16_t*)(a.ws + WS_HB); const float* MOD = (const float*)(a.ws + WS_MOD);
    int2* TOKE = (int2*)(a.ws + WS_TOKE); float2* TOKW = (float2*)(a.ws + WS_TOKW);
    const int eg = wave & 3, rh = wave >> 2;
    f32x4 wk[4][4];
#pragma unroll
    for (int j = 0; j < 4; ++j)
#pragma unroll
        for (int c = 0; c < 4; ++c) wk[j][c] = *(const f32x4*)(a.in[I_RW] + (size_t)(256 * j + 4 * lane + c) * 16 + 4 * eg);
    const f32x4* g = (const f32x4*)(a.in[I_GFFN] + l * DM) + lane;
    u32x2 xr[2][4];
#define N2_LOADX(rb_) do { _Pragma("unroll") for (int k = 0; k < 2; ++k) { const bf16_t* xb = XB + (size_t)N2_ROW(min((rb_) + 2 * wave + k, nloc - 1)) * DM + 4 * lane; \
        _Pragma("unroll") for (int j = 0; j < 4; ++j) xr[k][j] = *(const u32x2*)(xb + 256 * j); } } while (0)
    const bool cfirst = (l != 1) && nlat < 16;
    if (cfirst) N2_WAIT(tl, tl);
    N2_LOADX(0);
    for (int rb = 0; rb < nloc; rb += 16) {
        if ((l != 1) && !cfirst && rb <= nlat && nlat < rb + 16) { N2_WAIT(tl, tl); N2_LOADX(rb); }
        f32x4 vv[2][4];
#pragma unroll
        for (int k = 0; k < 2; ++k)
#pragma unroll
            for (int j = 0; j < 4; ++j) { const u32x2 w = xr[k][j]; vv[k][j] = (f32x4){__builtin_bit_cast(float, w.x << 16), __builtin_bit_cast(float, w.x & 0xffff0000u), __builtin_bit_cast(float, w.y << 16), __builtin_bit_cast(float, w.y & 0xffff0000u)}; }
#pragma unroll
        for (int k = 0; k < 2; ++k) { const int row = N2_ROW(min(rb + 2 * wave + k, nloc - 1)); const bool isctx = row >= SEQ, st = rb + 2 * wave + k < nloc;
            float ss = 0.f;
#pragma unroll
            for (int j = 0; j < 4; ++j) ss += (vv[k][j].x * vv[k][j].x + vv[k][j].y * vv[k][j].y) + (vv[k][j].z * vv[k][j].z + vv[k][j].w * vv[k][j].w);
            const float rstd = 1.f / sqrtf(wave_sum(ss) * (1.f / DM) + EPS);
            const float* md = MOD + (l * 2 + (isctx ? 1 : 0)) * 6144;
            const f32x4* sh = (const f32x4*)(md + 3 * 1024) + lane; const f32x4* sl = (const f32x4*)(md + 4 * 1024) + lane;
            u32x2* o8 = (u32x2*)(HB + (size_t)row * DM) + lane; f32x4* hr = (f32x4*)(hrow + (2 * wave + k) * 1024) + lane;
#pragma unroll
            for (int j = 0; j < 4; ++j) { const f32x4 h = vv[k][j] * rstd * g[64 * j] * (sl[64 * j] + 1.f) + sh[64 * j];
                hr[64 * j] = h; u32x2 w; w.x = cvt_pk_bf16(h.x, h.y); w.y = cvt_pk_bf16(h.z, h.w); if (st) o8[64 * j] = w; } }
        __syncthreads();
        if (rb + 16 < nloc && !((l != 1) && rb + 16 <= nlat && nlat < rb + 32)) N2_LOADX(rb + 16);
        float v32[32];
#pragma unroll
        for (int q = 0; q < 8; ++q) { const f32x4* hr = (const f32x4*)(hrow + (rh * 8 + q) * 1024) + lane; f32x4 acc = {0.f, 0.f, 0.f, 0.f};
#pragma unroll
            for (int j = 0; j < 4; ++j) { const f32x4 h = hr[64 * j];
#pragma unroll
                for (int e = 0; e < 4; ++e) { acc[e] = __builtin_fmaf(h.x, wk[j][0][e], acc[e]); acc[e] = __builtin_fmaf(h.y, wk[j][1][e], acc[e]); acc[e] = __builtin_fmaf(h.z, wk[j][2][e], acc[e]); acc[e] = __builtin_fmaf(h.w, wk[j][3][e], acc[e]); } }
            v32[q * 4] = acc[0]; v32[q * 4 + 1] = acc[1]; v32[q * 4 + 2] = acc[2]; v32[q * 4 + 3] = acc[3]; }
        float v16[16], v8[8], v4[4], v2[2], v1;
#pragma unroll
        for (int i = 0; i < 16; ++i) { const bool up = (lane & 32) != 0; v16[i] = (up ? v32[16 + i] : v32[i]) + __shfl_xor(up ? v32[i] : v32[16 + i], 32); }
#pragma unroll
        for (int i = 0; i < 8; ++i) { const bool up = (lane & 16) != 0; v8[i] = (up ? v16[8 + i] : v16[i]) + __shfl_xor(up ? v16[i] : v16[8 + i], 16); }
#pragma unroll
        for (int i = 0; i < 4; ++i) { const bool up = (lane & 8) != 0; v4[i] = (up ? v8[4 + i] : v8[i]) + __shfl_xor(up ? v8[i] : v8[4 + i], 8); }
#pragma unroll
        for (int i = 0; i < 2; ++i) { const bool up = (lane & 4) != 0; v2[i] = (up ? v4[2 + i] : v4[i]) + __shfl_xor(up ? v4[i] : v4[2 + i], 4); }
        { const bool up = (lane & 2) != 0; v1 = (up ? v2[1] : v2[0]) + __shfl_xor(up ? v2[0] : v2[1], 2); }
        v1 += __shfl_xor(v1, 1);
        { const int I = (lane >> 1) & 31, q = I >> 2, e = I & 3; const int rl = rh * 8 + q;
          if ((lane & 1) == 0 && rb + rl < nloc) logit[(rb + rl) * 16 + 4 * eg + e] = v1; }
        __syncthreads();
    }
#undef N2_LOADX
#undef N2_WAIT
    if (wave < 2) { const int rowl = wave * 64 + lane, row = N2_ROW(rowl);
      if (rowl < nloc) {
        float lg[16];
#pragma unroll
        for (int q = 0; q < 4; ++q) { const f32x4 t = *(const f32x4*)(logit + rowl * 16 + 4 * q); lg[4 * q] = t.x; lg[4 * q + 1] = t.y; lg[4 * q + 2] = t.z; lg[4 * q + 3] = t.w; }
        float sg[16], bs[16];
#pragma unroll
        for (int e = 0; e < 16; ++e) { sg[e] = sigmoid_f(lg[e]); bs[e] = sg[e] + a.in[I_RB][e]; }
        int gsel = 0; float best = 0.f;
#pragma unroll
        for (int gi = 0; gi < 4; ++gi) { const float p_ = bs[4 * gi], q_ = bs[4 * gi + 1], r_ = bs[4 * gi + 2], s_ = bs[4 * gi + 3];
            const float h1 = fmaxf(p_, q_), l1 = fminf(p_, q_), h2 = fmaxf(r_, s_), l2 = fminf(r_, s_);
            const float gsc = fmaxf(h1, h2) + fmaxf(fminf(h1, h2), fmaxf(l1, l2));
            if (gi == 0 || gsc > best) { best = gsc; gsel = gi; } }
        float gb[4], gs4[4];
#pragma unroll
        for (int i = 0; i < 4; ++i) { gb[i] = gsel == 0 ? bs[i] : gsel == 1 ? bs[4 + i] : gsel == 2 ? bs[8 + i] : bs[12 + i];
            gs4[i] = gsel == 0 ? sg[i] : gsel == 1 ? sg[4 + i] : gsel == 2 ? sg[8 + i] : sg[12 + i]; }
        int i0 = 0; float b0 = gb[0];
#pragma unroll
        for (int i = 1; i < 4; ++i) if (gb[i] > b0) { b0 = gb[i]; i0 = i; }
        int i1 = -1; float b1 = 0.f;
#pragma unroll
        for (int i = 0; i < 4; ++i) if (i != i0 && (i1 < 0 || gb[i] > b1)) { b1 = gb[i]; i1 = i; }
        const float s0 = i0 == 0 ? gs4[0] : i0 == 1 ? gs4[1] : i0 == 2 ? gs4[2] : gs4[3];
        const float s1 = i1 == 0 ? gs4[0] : i1 == 1 ? gs4[1] : i1 == 2 ? gs4[2] : gs4[3];
        const int e0 = gsel * 4 + i0, e1 = gsel * 4 + i1; const float inv = 1.f / (s0 + s1);
        TOKE[row] = make_int2(e0, e1); TOKW[row] = make_float2(s0 * inv, s1 * inv); e01[rowl] = e0 | (e1 << 8);
      } }
    __syncthreads();
    if (wave == 0) {
        int cnt = 0;
        for (int p = 0; p < 2; ++p) { const int pk = e01[p * 64 + lane]; const int e0 = pk < 0 ? -1 : (pk & 255), e1 = pk < 0 ? -1 : (pk >> 8);
#pragma unroll
            for (int e = 0; e < 16; ++e) { const int c = __popcll(__ballot(e0 == e)) + __popcll(__ballot(e1 == e)); if (lane == e) cnt += c; } }
        int base = 0;
        if (lane < 16) base = (int)__hip_atomic_fetch_add((unsigned*)(a.ws + WS_CTL) + CW_TOT + l * 64 + lane, (unsigned)cnt, __ATOMIC_RELAXED, __HIP_MEMORY_SCOPE_AGENT);
        int run[16];
#pragma unroll
        for (int e = 0; e < 16; ++e) run[e] = __builtin_amdgcn_readlane(base, e);
        int2* TOKP = (int2*)(a.ws + WS_TOKP); int* ROWTOK2 = (int*)(a.ws + WS_ROWTOK2) + (size_t)l * 16 * ROWCAP;
        for (int p = 0; p < 2; ++p) { const int i = p * 64 + lane, row = N2_ROW(i); const int pk = e01[i]; const bool ok = pk >= 0;
            const int ex = ok ? (pk & 255) : -1, ey = ok ? (pk >> 8) : -1;
            int pos0 = 0, pos1 = 0; const unsigned long long lt = (1ull << lane) - 1ull;
#pragma unroll
            for (int e = 0; e < 16; ++e) { const unsigned long long m0 = __ballot(ex == e), m1 = __ballot(ey == e);
                if (ex == e) pos0 = run[e] + __popcll(m0 & lt);
                if (ey == e) pos1 = run[e] + __popcll(m0) + __popcll(m1 & lt);
                run[e] += __popcll(m0) + __popcll(m1); }
            if (ok) { TOKP[row] = make_int2(ex * 32768 + pos0, ey * 32768 + pos1); ROWTOK2[ex * ROWCAP + pos0] = row; ROWTOK2[ey * ROWCAP + pos1] = row; } }
    }
    __syncthreads();
#undef N2_ROW
}
#ifndef ATT
#define ATT att2
#endif
#ifndef REP_INPROJ
#define REP_INPROJ 1
#endif
#ifndef REP_ATTN
#define REP_ATTN 1
#endif
#ifndef REP_OUTPROJ
#define REP_OUTPROJ 1
#endif
#ifndef REP_N2SC
#define REP_N2SC 1
#endif
#ifndef REP_MOE
#define REP_MOE 1
#endif
template <class Inner> struct RepOrder { Inner in; int ntot;
    __device__ __forceinline__ bool next(int i, pg8::Unit& u) const { if (i >= ntot) return false; const int nl = in.nloc(); return in.next(i % nl, u); }
    __device__ __forceinline__ unsigned row_off(int r) const { return in.row_off(r); }
    __device__ __forceinline__ void a_ready(const pg8::Unit&) const {}
    __device__ __forceinline__ void done(const pg8::Unit&) const {} };

__device__ __forceinline__ bool wg_any(bool pred, int* ws, int wid, int lane) {
    const int w = __any(pred) ? 1 : 0;
    __syncthreads();
    if (lane == 0) ws[wid] = w;
    __syncthreads();
    int r = 0;
#pragma unroll
    for (int i = 0; i < NWAVES; ++i) r |= ws[i];
    __syncthreads();
    return r != 0;
}
__device__ __forceinline__ void diff_unit(const Args& a, int l, int qt, int head, char* lds) {
    int tid_ = otid();
    const int tid = tid_, wid = tid >> 6, lane = tid & 63;
    const bool isctx = qt >= 64; const int q0 = qt * 256, nA = isctx ? 4 : 260, a0 = isctx ? SEQ : 0;
    const bf16_t* QA = (const bf16_t*)(a.ws + RA_QA); const bf16_t* KA = (const bf16_t*)(a.ws + RA_KA); const bf16_t* VA = (const bf16_t*)(a.ws + RA_VA);
    bf16_t* MIX = (bf16_t*)(a.ws + WS_HB);
    float* stash0 = (float*)(a.ws + WS_RB) + (size_t)blockIdx.x * 256 * 128;
    float* wsf = (float*)(lds + ATT::LDS_WS) + wid * 64;
    const float lam = ((const float*)(a.ws + WS_LAM))[l], post = 1.f - LAMBDA_INIT[l];
    for (int map = 0; map < 2; ++map) {
        f32x16 o[4]; float m_, l_;
        const bf16_t* Qw_ = QA + (size_t)(q0 + wid * 32 + (lane & 31)) * 512 + head * 128 + map * 64;
        ATT::attn_body<0, 512, 512, false>(Qw_, KA + head * 128 + map * 64, VA + head * 128, nA, a0, 0, nA, 0, lds, tid, o, m_, l_);
        if (wg_any(!(l_ < 1.0e18f), (int*)(lds + ATT::LDS_WS) + 8 * 64, wid, lane)) {
            ATT::attn_body<0, 512, 512, true>(Qw_, KA + head * 128 + map * 64, VA + head * 128, nA, a0, 0, nA, 0, lds, tid, o, m_, l_); }
        int lo_ = lane; asm volatile("" : "+v"(lo_));
        const int r32 = lo_ & 31, hi = lo_ >> 5;
        float* stashv = stash0 + (size_t)((wid << 6) | lo_) * 4;
        if (hi == 0) wsf[r32] = l_;
        LDS_WAIT();
        float rli[16];
#pragma unroll
        for (int r = 0; r < 16; ++r) rli[r] = __builtin_amdgcn_rcpf(wsf[ATT::crow(r, hi)]);
        if (map == 0) {
#pragma unroll
            for (int d0 = 0; d0 < 4; ++d0)
#pragma unroll
                for (int rq = 0; rq < 4; ++rq) *(f32x4*)(stashv + (size_t)((d0 * 4 + rq) * NTHREADS) * 4) =
                    (f32x4){o[d0][4 * rq] * rli[4 * rq], o[d0][4 * rq + 1] * rli[4 * rq + 1], o[d0][4 * rq + 2] * rli[4 * rq + 2], o[d0][4 * rq + 3] * rli[4 * rq + 3]};
        } else {
            const float* gn = a.in[I_DNG] + l * 128;
            float g4[4];
#pragma unroll
            for (int d0 = 0; d0 < 4; ++d0) g4[d0] = gn[d0 * 32 + r32] * post;
            float ss[16];
#pragma unroll
            for (int r = 0; r < 16; ++r) ss[r] = 0.f;
#pragma unroll
            for (int d0 = 0; d0 < 4; ++d0)
#pragma unroll
                for (int rq = 0; rq < 4; ++rq) { const f32x4 sv = *(const f32x4*)(stashv + (size_t)((d0 * 4 + rq) * NTHREADS) * 4);
#pragma unroll
                    for (int j = 0; j < 4; ++j) { const int r = 4 * rq + j; const float oc = sv[j] - lam * (o[d0][r] * rli[r]); o[d0][r] = oc; ss[r] += oc * oc; } }
            float s8[8], s4[4], s2[2], s1;
#pragma unroll
            for (int i = 0; i < 8; ++i) { const bool up = (lo_ & 16) != 0; s8[i] = (up ? ss[8 + i] : ss[i]) + __shfl_xor(up ? ss[i] : ss[8 + i], 16); }
#pragma unroll
            for (int i = 0; i < 4; ++i) { const bool up = (lo_ & 8) != 0; s4[i] = (up ? s8[4 + i] : s8[i]) + __shfl_xor(up ? s8[i] : s8[4 + i], 8); }
#pragma unroll
            for (int i = 0; i < 2; ++i) { const bool up = (lo_ & 4) != 0; s2[i] = (up ? s4[2 + i] : s4[i]) + __shfl_xor(up ? s4[i] : s4[2 + i], 4); }
            { const bool up = (lo_ & 2) != 0; s1 = (up ? s2[1] : s2[0]) + __shfl_xor(up ? s2[0] : s2[1], 2); }
            s1 += __shfl_xor(s1, 1);
            LDS_WAIT();
            if ((lo_ & 1) == 0) wsf[hi * 16 + ((lo_ >> 1) & 15)] = s1;
            LDS_WAIT();
#pragma unroll
            for (int r = 0; r < 16; ++r) { const float sc = __builtin_amdgcn_rsqf(wsf[hi * 16 + r] * (1.f / 128.f) + EPS);
                bf16_t* orow = MIX + (size_t)(q0 + wid * 32 + ATT::crow(r, hi)) * DM + head * 128 + r32;
#pragma unroll
                for (int d0 = 0; d0 < 4; ++d0) orow[d0 * 32] = (bf16_t)f2bf(o[d0][r] * sc * g4[d0]); }
        }
    }
}
__device__ __forceinline__ void win_unit(const Args& a, int l, int n, int g, char* lds) {
    int tid_ = otid();
    const int tid = tid_, wid = tid >> 6, lane = tid & 63;
    const bool isctx = n >= 128; const int h = 2 * g + (wid >> 2);
    const int rowq = (isctx ? SEQ + (n - 128) * 128 : n * 128) + (wid & 3) * 32;
    const int nB = isctx ? 0 : (6 - (n == 0 ? 2 : 0) - (n == 127 ? 2 : 0)), b0 = (n == 0) ? 0 : (n - 1) * 128;
    const bf16_t* QB = (const bf16_t*)(a.ws + RA_QB); const bf16_t* KB = (const bf16_t*)(a.ws + RA_KB); const bf16_t* VB = (const bf16_t*)(a.ws + RA_VB);
    bf16_t* MIX = (bf16_t*)(a.ws + WS_HB);
    float* wsf = (float*)(lds + ATT::LDS_WS) + wid * 64;
    f32x16 o[4]; float m_, l_;
    const bf16_t* Qw_ = QB + (size_t)(rowq + (lane & 31)) * 256 + h * 64;
    ATT::attn_body<1, 128, 256, false>(Qw_, KB + g * 64, VB + g * 128, 4, SEQ, b0, 4 + nB, rowq + (lane & 31), lds, tid, o, m_, l_);
    if (wg_any(!(l_ < 1.0e18f), (int*)(lds + ATT::LDS_WS) + 8 * 64, wid, lane)) {
        ATT::attn_body<1, 128, 256, true>(Qw_, KB + g * 64, VB + g * 128, 4, SEQ, b0, 4 + nB, rowq + (lane & 31), lds, tid, o, m_, l_); }
    const float ltot = l_ + __builtin_amdgcn_exp2f(a.in[I_SINK][l * 4 + h] * LOG2E - m_);
    int lo_ = lane; asm volatile("" : "+v"(lo_));
    const int r32 = lo_ & 31, hi = lo_ >> 5;
    if (hi == 0) wsf[r32] = ltot;
    LDS_WAIT();
#pragma unroll
    for (int r = 0; r < 16; ++r) { const float rl = __builtin_amdgcn_rcpf(wsf[ATT::crow(r, hi)]);
        bf16_t* orow = MIX + (size_t)(rowq + ATT::crow(r, hi)) * DM + 512 + h * 64 + r32;
        orow[0] = (bf16_t)f2bf(o[0][r] * rl); orow[32] = (bf16_t)f2bf(o[1][r] * rl); }
}
__device__ __forceinline__ void conv_unit(const Args& a, int l, int u, char* lds) {
    int tid_ = otid();
    const int tid = tid_, wid = tid >> 6, lane = tid & 63;
    const bool isctx = u >= 256; const int r0 = isctx ? (u - 256) * 64 : u * 64, rbase = isctx ? SEQ : 0, slen = isctx ? CTX : SEQ;
    const bf16_t* Z = (const bf16_t*)(a.ws + RA_Z); bf16_t* MIX = (bf16_t*)(a.ws + WS_HB);
    bf16_t* zt = (bf16_t*)lds; float* co = (float*)(lds + 49152);
    __syncthreads();
    for (int c = tid; c < 94 * 32; c += NTHREADS) { const int i = c >> 5, ch = c & 31, p = r0 - 15 + i;
        u32x4 v = {0u, 0u, 0u, 0u}; if (p >= 0 && p < slen) v = *(const u32x4*)(Z + (size_t)(rbase + p) * 256 + ch * 8);
        *(u32x4*)(zt + i * 256 + ch * 8) = v; }
    __syncthreads();
    { const int c = tid & 255, t0 = (tid >> 8) * 32; float w[31];
#pragma unroll
      for (int j = 0; j < 31; ++j) w[j] = a.in[I_CONVW][(size_t)(l * 31 + j) * 256 + c];
      const float bias = a.in[I_CONVB][l * 256 + c];
#pragma unroll
      for (int tb = 0; tb < 32; tb += 8) {
          float zr[38];
#pragma unroll
          for (int i = 0; i < 38; ++i) zr[i] = bf2f(zt[(t0 + tb + i) * 256 + c]);
#pragma unroll
          for (int t = 0; t < 8; ++t) { float acc = bias;
#pragma unroll
              for (int j = 0; j < 31; ++j) acc += zr[t + j] * w[j];
              co[(t0 + tb + t) * 256 + c] = acc; } } }
    __syncthreads();
    const f32x4 lg = *(const f32x4*)(a.in[I_LNG] + l * 256 + 4 * lane), lb = *(const f32x4*)(a.in[I_LNB] + l * 256 + 4 * lane);
#pragma unroll
    for (int ti = 0; ti < 8; ++ti) { const int t = wid + ti * NWAVES; const f32x4 v = *(const f32x4*)(co + t * 256 + 4 * lane);
        const float mu = wave_sum((v.x + v.y) + (v.z + v.w)) * (1.f / 256.f); const f32x4 d = v - mu;
        const float var = wave_sum((d.x * d.x + d.y * d.y) + (d.z * d.z + d.w * d.w)) * (1.f / 256.f); const float rs = 1.f / sqrtf(var + EPS);
        const f32x4 zn = d * rs * lg + lb;
        u32x2 w; w.x = cvt_pk_bf16(silu_f(zn.x), silu_f(zn.y)); w.y = cvt_pk_bf16(silu_f(zn.z), silu_f(zn.w));
        *(u32x2*)(MIX + (size_t)(rbase + r0 + t) * DM + 768 + 4 * lane) = w; }
    __syncthreads();
}
__device__ __forceinline__ void attn_phase(const Args& a, int l, char* lds, int pass) {
    const int b = blockIdx.x, G = gridDim.x, BIG = 1 << 20;
#ifndef AT_MASK
#define AT_MASK 7
#endif
    const int dst = pass == 0 ? b : (b < 4) ? 256 + b : BIG, wst = pass == 0 ? b : (b >= 4 && b < 8) ? 256 + (b - 4) : BIG, cst = pass == 0 ? b : (b >= 8 && b < 12) ? 256 + (b - 8) : BIG;
    const int uend = pass == 0 ? 256 : 260;
    if (AT_MASK & 1) for (int u = dst; u < uend; u += G) { const int qt = u < 256 ? (u >> 2) : 64, hd = u < 256 ? (u & 3) : (u - 256); diff_unit(a, l, qt, hd, lds); }
    if (AT_MASK & 2) for (int v = wst; v < uend; v += G) { const int n = v < 256 ? (v & 127) : 128 + ((v - 256) & 1), g = v < 256 ? (v >> 7) : ((v - 256) >> 1); win_unit(a, l, n, g, lds); }
    if (AT_MASK & 4) for (int v = cst; v < uend; v += G) conv_unit(a, l, v, lds);
    if (pass == 1 && b < 12) {
        asm volatile("s_waitcnt vmcnt(0)" ::: "memory"); __syncthreads();
        const int tid = otid(); if (tid < 64) { __builtin_amdgcn_fence(__ATOMIC_RELEASE, "agent"); asm volatile("s_waitcnt vmcnt(0)" ::: "memory");
            if (tid == 0) __hip_atomic_fetch_add((gu32*)(a.ws + WS_CTL) + CW_CTXC, 1u, __ATOMIC_RELAXED, __HIP_MEMORY_SCOPE_AGENT); } }
}

#ifndef MK_PER_PHASE
#define MK_PER_PHASE 0
#endif
#if defined(__HIP_DEVICE_COMPILE__)
#define KARGS(A) Args A; { const __attribute__((address_space(4))) Args* kp_ = (const __attribute__((address_space(4))) Args*)__builtin_amdgcn_kernarg_segment_ptr(); asm volatile("" : "+s"(kp_)); A = *kp_; }
#else
#define KARGS(A) Args A = a_unused;
#endif
__global__ void __launch_bounds__(NTHREADS, 2) hybrid_fwd(Args a_unused) {
    unsigned char* lds = g_lds;
    volatile LAS unsigned* MISC = (volatile LAS unsigned*)((LAS unsigned char*)lds + MISC_OFF);
    { const int tid0 = threadIdx.x; if (tid0 < 64) MISC[tid0] = 0u;
      if ((tid0 & 63) == 0) MISC[64 + ((unsigned)__builtin_amdgcn_s_getreg((5 << 11) | 4) & 63u)] = (unsigned)(tid0 >> 6); }
    __syncthreads();
    XcdBarrier bar; int lo, hi;
    { KARGS(a); lo = a.ph_lo; hi = a.ph_hi; gu32* ctl = (gu32*)(a.ws + WS_CTL);
      bar.bar = (unsigned*)(ctl + CW_BAR); bar.x = 0; bar.st = nullptr;
      if (!MK_PER_PHASE) bar = xcd_barrier_post((unsigned*)(ctl + CW_BAR), MISC); }
#ifndef PHMASK
#define PHMASK 0x3ffff
#endif
#define PHK(k) ((k) == 0 ? 0 : (k) == 17 ? 9 : (((k) - 1) & 7) + 1)
#define IN(k) (((PHMASK >> PHK(k)) & 1) && lo <= (k) && (k) < hi)
#define SEAM(k) do { if (!MK_PER_PHASE && IN(k) && IN((k) + 1)) xcd_barrier(bar); } while (0)
    LAS unsigned char* ldsl = (LAS unsigned char*)lds;
    const int G = gridDim.x, vcu = (G % 8 == 0) ? ((int)blockIdx.x % 8) * (G / 8) + (int)blockIdx.x / 8 : (int)blockIdx.x;

#ifndef REP_N1
#define REP_N1 1
#endif
#ifndef REP_SC
#define REP_SC 1
#endif
#ifndef REP_PRO
#define REP_PRO 1
#endif
    if (IN(0)) { KARGS(a); int nrep_ = REP_PRO; asm volatile("" : "+s"(nrep_)); for (int rp_ = 0; rp_ < nrep_; ++rp_) prologue_phase(a, lds); SEAM(0); }
    for (int l = 0; l < DEPTH; ++l) {
        const int pb = 1 + 8 * l;
        if (IN(pb + 0)) {
            KARGS(a);
            { int nrep_ = (l == 0) ? REP_N1 : 1; asm volatile("" : "+s"(nrep_)); for (int rp_ = 0; rp_ < nrep_; ++rp_) norm1_phase(a, l); }
            SEAM(pb + 0);
        }
        if (IN(pb + 1)) {
            KARGS(a);
            pg8::Gemm g{(const bf16_t*)(a.ws + WS_HB), (const bf16_t*)(a.ws + WS_WIN) + (size_t)l * INW * 1024, NROW, INW, DM};
            pg8::StaticOrder S; S.init(NROW, INW, G, (int)blockIdx.x);
            EpiInProj E{a.ws, (const float*)(a.ws + WS_ROPEC), (const float*)(a.ws + WS_ROPES)};
            RepOrder<pg8::StaticOrder> SR{S, REP_INPROJ * S.nloc()}; pg8::gemm_phase<EpiInProj, RepOrder<pg8::StaticOrder>, true, true>(ldsl, g, SR, E);
            if ((int)blockIdx.x >= 650 - 2 * G) {
                const int tid = otid(), c0 = 650 - 2 * G; moe_convert(a, l, (LAS float*)(ldsl + (tid >> 6) * 8704), ((int)blockIdx.x - c0) * NWAVES + (tid >> 6), (G - c0) * NWAVES, tid & 63, 8192, 12288); }
            SEAM(pb + 1);
        }
        if (IN(pb + 2)) { KARGS(a); int npass_ = (l == 0) ? 2 : 1; asm volatile("" : "+s"(npass_)); for (int ps_ = 0; ps_ < npass_; ++ps_) { attn_phase(a, l, (char*)lds, ps_); if (ps_ == 0) SEAM(pb + 2); } }
        if (IN(pb + 3)) {
            KARGS(a);
            const float* MOD = (const float*)(a.ws + WS_MOD);
            const int M = (l == DEPTH - 1) ? SEQ : NROW;
            pg8::Gemm g{(const bf16_t*)(a.ws + WS_HB), (const bf16_t*)(a.ws + WS_WOUT) + (size_t)l * 1024 * 1024, M, DM, DM};
            pg8::StaticOrder S; if (l == 0) S.init(61 * 256, DM, G - 12, (int)blockIdx.x - 12); else S.init(SEQ, DM, G, (int)blockIdx.x);
            EpiOutProj E{a.in[I_X], a.in[I_CTX], (bf16_t*)(a.ws + WS_XB), MOD + (l * 2) * 6144 + 2 * 1024, MOD + (l * 2 + 1) * 6144 + 2 * 1024, l};
            OutOrder SO{S, (gu32*)(a.ws + WS_CTL) + CW_OPC + l * 128, (l == 0) ? (gu32*)(a.ws + WS_CTL) + CW_CTXC : nullptr}; pg8::gemm_phase<EpiOutProj, OutOrder, true, true>(ldsl, g, SO, E);
            if (l == 0 && (int)blockIdx.x >= 16) {
                const int tid = otid(), nidle = G - 16; moe_convert(a, 1, (LAS float*)(ldsl + (tid >> 6) * 8704), ((int)blockIdx.x - 16) * NWAVES + (tid >> 6), nidle * NWAVES, tid & 63, 0, 8192); }
            __syncthreads();
        }
        if (IN(pb + 4)) { KARGS(a); int nrep_ = REP_N2SC; asm volatile("" : "+s"(nrep_)); for (int rp_ = 0; rp_ < nrep_; ++rp_) norm2_phase(a, l, lds); SEAM(pb + 4); }
        if (IN(pb + 6)) {
            KARGS(a);
            MoeOrder S; S.G = G; S.vcu = vcu;
            { const int tid = otid(); const unsigned* tot = (const unsigned*)(a.ws + WS_CTL) + CW_TOT + l * 64;
              if (tid == 0) { int t = 0; int* tsg = (int*)(a.ws + WS_TSG) + l * 32;
                  for (int e = 0; e < 16; ++e) { MISC[16 + e] = (unsigned)t; if (blockIdx.x == 0) tsg[e] = t; t += ((int)tot[e] + 255) >> 8; }
                  MISC[32] = (unsigned)t; if (blockIdx.x == 0) tsg[16] = t; }
              __syncthreads();
#pragma unroll
              for (int k = 0; k < 16; ++k) S.ts[k] = __builtin_amdgcn_readfirstlane((int)MISC[16 + k]);
              S.nunits = 4 * __builtin_amdgcn_readfirstlane((int)MISC[16 + 16]); }
            S.rowtok = (const int*)(a.ws + WS_ROWTOK2) + (size_t)l * 16 * ROWCAP;
            pg8::Gemm g{(const bf16_t*)(a.ws + WS_HB), (const bf16_t*)(a.ws + WS_W13) + (size_t)l * 16 * 1024 * 1024, XS_ROWS, 1024, DM};
            EpiMoe1 E{(bf16_t*)(a.ws + WS_RB)};
            pg8::gemm_phase<EpiMoe1, MoeOrder, true, true, true>(ldsl, g, S, E);
            gu32* flag = (gu32*)(a.ws + WS_CTL) + CW_MOEF + l * 256;
            { const int tid = otid(); if (tid == 0) __hip_atomic_store(flag + vcu, 1u, __ATOMIC_RELAXED, __HIP_MEMORY_SCOPE_AGENT); }
            MoeOrder2 S2; S2.vcu = vcu; S2.nunits = S.nunits;
#pragma unroll
            for (int k2 = 0; k2 < 16; ++k2) S2.ts[k2] = S.ts[k2];
            pg8::Gemm g2{(const bf16_t*)(a.ws + WS_RB), (const bf16_t*)(a.ws + WS_W2) + (size_t)l * 16 * 1024 * 512, XS_ROWS, 1024, FFE};
            EpiMoe2 E2{a.ws + WS_RA};
            const int r_ = S.nunits & 255;
            if (vcu >= r_ && S.nunits >= 256) { moe_wait(flag, vcu & ~3, 4); S2.part = 0; pg8::gemm_phase<EpiMoe2, MoeOrder2, true, true>(ldsl, g2, S2, E2); }
            if (r_ != 0) { moe_wait(flag, 0, r_); S2.part = 1; pg8::gemm_phase<EpiMoe2, MoeOrder2, true, true>(ldsl, g2, S2, E2); }
            SEAM(pb + 6);
        }
    }
    if (IN(17)) { KARGS(a); int nrep_ = REP_N1; asm volatile("" : "+s"(nrep_)); for (int rp_ = 0; rp_ < nrep_; ++rp_) norm1_phase(a, 2); }
#undef IN
#undef SEAM
}

extern "C" void kernel_launch(void* const* d_in, const int* in_sizes, int n_in, void* d_out, int out_size, void* d_ws, size_t ws_size, hipStream_t stream) {
    static int grid = 0;
    if (grid == 0) {
        if (n_in != 23 || in_sizes[0] != SEQ * DM || out_size != SEQ * DM || ws_size < WS_END) {
            fprintf(stderr, "kernel_launch: shape mismatch (n_in %d, in0 %d, out %d, ws %zu, need ws >= %zu); nothing launched\n", n_in, n_in > 0 ? in_sizes[0] : -1, out_size, ws_size, (size_t)WS_END); grid = -1; return; }
        int dev = 0, cus = 0, per_cu = 0;
        if (hipGetDevice(&dev) != hipSuccess || hipDeviceGetAttribute(&cus, hipDeviceAttributeMultiprocessorCount, dev) != hipSuccess) { fprintf(stderr, "kernel_launch: device query failed\n"); grid = -1; return; }
        if (hipFuncSetAttribute((const void*)hybrid_fwd, hipFuncAttributeMaxDynamicSharedMemorySize, LDS_BYTES) != hipSuccess) { fprintf(stderr, "kernel_launch: hipFuncSetAttribute failed\n"); grid = -1; return; }
        if (hipOccupancyMaxActiveBlocksPerMultiprocessor(&per_cu, (const void*)hybrid_fwd, NTHREADS, LDS_BYTES) != hipSuccess || per_cu < 1) { fprintf(stderr, "kernel_launch: occupancy query reports %d blocks per CU\n", per_cu); grid = -1; (void)hipGetLastError(); return; }
        if (cus != 256) { fprintf(stderr, "kernel_launch: built for 256 CUs, device has %d\n", cus); grid = -1; return; }
        grid = cus;
    }
    if (grid < 0) return;
    if (hipMemsetAsync((char*)d_ws + WS_CTL, 0, CTL_ZERO_BYTES, stream) != hipSuccess) { fprintf(stderr, "kernel_launch: memset failed\n"); return; }
    Args a{};
    for (int i = 0; i < 23; ++i) a.in[i] = (const float*)d_in[i];
    a.out = (float*)d_out; a.ws = (unsigned char*)d_ws;
#if MK_PER_PHASE
    for (int p = 0; p < N_PHASES; ++p) { a.ph_lo = p; a.ph_hi = p + 1; hipLaunchKernelGGL(hybrid_fwd, dim3(grid), dim3(NTHREADS), LDS_BYTES, stream, a); }
#else
    a.ph_lo = 0; a.ph_hi = N_PHASES;
    hipLaunchKernelGGL(hybrid_fwd, dim3(grid), dim3(NTHREADS), LDS_BYTES, stream, a);
#endif
    const hipError_t le = hipPeekAtLastError();
    if (le != hipSuccess) fprintf(stderr, "kernel_launch: launch failed: %s\n", hipGetErrorName(le));
}
```

```cpp
#define MK_PER_PHASE 0
#include <hip/hip_runtime.h>
#include <cstdio>
#include <cstdint>

#define GAS __attribute__((address_space(1)))
#define LAS __attribute__((address_space(3)))
typedef unsigned short bf16_t;
typedef short bf16x8 __attribute__((ext_vector_type(8)));
typedef short s16x4 __attribute__((ext_vector_type(4)));
typedef float f32x2 __attribute__((ext_vector_type(2)));
typedef float f32x4 __attribute__((ext_vector_type(4)));
typedef float f32x16 __attribute__((ext_vector_type(16)));
typedef unsigned u32x2 __attribute__((ext_vector_type(2)));
typedef unsigned u32x4 __attribute__((ext_vector_type(4)));
typedef GAS unsigned gu32;

constexpr int SEQ = 16384, CTX = 256, NROW = SEQ + CTX, DM = 1024, INW = 2560, NEXP = 16, FFE = 512, DEPTH = 2;
constexpr int XS_ROWS = 37376;
constexpr float EPS = 1e-6f, LOG2E = 1.4426950408889634f, QSCALE = 0.125f * 1.4426950408889634f;
constexpr int NWAVES = 8, NTHREADS = 512;

constexpr size_t MiB = 1u << 20;
constexpr size_t WS_CTL = 0, CTL_ZERO_BYTES = 128 * 1024;
constexpr size_t WS_MOD = 1 * MiB;
constexpr size_t WS_ROPEC = WS_MOD + 128 * 1024, WS_ROPES = WS_MOD + 192 * 1024;
constexpr size_t WS_LAM = WS_MOD + 256 * 1024;
constexpr size_t WS_CNT = WS_MOD + 320 * 1024;
constexpr size_t WS_TSG = WS_MOD + 384 * 1024;
constexpr size_t WS_TOKE = 2 * MiB, WS_TOKW = 2 * MiB + 256 * 1024, WS_TOKP = 2 * MiB + 512 * 1024;
constexpr size_t WS_ROWTOK = 3 * MiB;
constexpr size_t WS_WIN = 4 * MiB;
constexpr size_t WS_WOUT = 14 * MiB;
constexpr size_t WS_W13 = 18 * MiB;
constexpr size_t WS_W2 = 82 * MiB;
constexpr size_t WS_XB = 114 * MiB;
constexpr size_t WS_HB = 179 * MiB;
constexpr size_t WS_RA = 212 * MiB;
constexpr size_t RA_QA = WS_RA, RA_KA = RA_QA + (size_t)NROW * 512 * 2, RA_VA = RA_KA + (size_t)NROW * 512 * 2;
constexpr size_t RA_QB = RA_VA + (size_t)NROW * 512 * 2, RA_KB = RA_QB + (size_t)NROW * 256 * 2, RA_VB = RA_KB + (size_t)NROW * 128 * 2;
constexpr size_t RA_Z = RA_VB + (size_t)NROW * 256 * 2, RA_END = RA_Z + (size_t)NROW * 256 * 2;
constexpr size_t WS_RB = 290 * MiB;
constexpr size_t WS_ROWTOK2 = 327 * MiB;
constexpr size_t WS_END = 330 * MiB;
static_assert(RA_END <= WS_RB && WS_RA + (size_t)XS_ROWS * 2048 <= WS_RB && WS_RB + (size_t)XS_ROWS * 1024 <= WS_END && WS_RB + (size_t)256 * 256 * 128 * 4 <= WS_END, "ws map");
static_assert(WS_XB + (size_t)NROW * DM * 4 <= WS_HB && WS_HB + (size_t)NROW * DM * 2 <= WS_RA && WS_W13 + (size_t)2 * 16 * 1024 * 1024 * 2 <= WS_W2 && WS_W2 + (size_t)2 * 16 * 1024 * 512 * 2 <= WS_XB, "ws map 2");
constexpr int ROWCAP = 16640;
constexpr int CW_TOT = 24576;
constexpr int CW_MOEF = 28672;
constexpr int CW_OPC = 30720;
constexpr int CW_CTXC = 31232;
constexpr int CW_BAR = 4096;

constexpr int RING_BYTES = 131072;
constexpr int MISC_OFF = RING_BYTES;
constexpr int LDS_BYTES = 147456;

#define LDS_WAIT() asm volatile("s_waitcnt lgkmcnt(0)" ::: "memory")
#define VM_WAIT() asm volatile("s_waitcnt vmcnt(0)" ::: "memory")
__device__ __forceinline__ unsigned f2bf(float f) { unsigned u = __builtin_bit_cast(unsigned, f); return (u + 0x7fffu + ((u >> 16) & 1u)) >> 16; }
__device__ __forceinline__ unsigned pk2(float lo, float hi) { return f2bf(lo) | (f2bf(hi) << 16); }
__device__ __forceinline__ float bf2f(unsigned short b) { return __builtin_bit_cast(float, (unsigned)b << 16); }
__device__ __forceinline__ unsigned cvt_pk_bf16(float lo, float hi) { unsigned r; asm volatile("v_cvt_pk_bf16_f32 %0, %1, %2" : "=v"(r) : "v"(lo), "v"(hi)); return r; }
__device__ __forceinline__ float wave_sum(float v) {
#pragma unroll
    for (int o = 1; o < 64; o <<= 1) v += __shfl_xor(v, o);
    return v;
}
__device__ __forceinline__ f32x4 ld4bf(const bf16_t* p) { const u32x2 w = *(const u32x2*)p; return (f32x4){__builtin_bit_cast(float, w.x << 16), __builtin_bit_cast(float, w.x & 0xffff0000u), __builtin_bit_cast(float, w.y << 16), __builtin_bit_cast(float, w.y & 0xffff0000u)}; }
__device__ __forceinline__ void st4bf(bf16_t* p, const f32x4 v) { u32x2 w; w.x = cvt_pk_bf16(v.x, v.y); w.y = cvt_pk_bf16(v.z, v.w); *(u32x2*)p = w; }
__device__ __forceinline__ float silu_f(float a) { return a * __builtin_amdgcn_rcpf(1.f + __builtin_amdgcn_exp2f(-a * LOG2E)); }
__device__ __forceinline__ float sigmoid_f(float a) { return __builtin_amdgcn_rcpf(1.f + __builtin_amdgcn_exp2f(-a * LOG2E)); }
extern __shared__ __attribute__((aligned(16))) unsigned char g_lds[];
__device__ __forceinline__ int otid() {
    const unsigned slot = (unsigned)__builtin_amdgcn_s_getreg((5 << 11) | 4) & 63u;
    const int wave = ((const volatile LAS int*)((LAS unsigned char*)g_lds + MISC_OFF + 256))[slot];
    int ln; asm volatile("v_mbcnt_lo_u32_b32 %0, -1, 0\n\tv_mbcnt_hi_u32_b32 %0, -1, %0" : "=v"(ln));
    int t = (wave << 6) | ln;
    asm volatile("" : "+v"(t)); return t; }
namespace pg8 {
#define PG8_LAS __attribute__((address_space(3)))
constexpr int BM = 256, BK = 64, HALF = 128, HTB = HALF * BK * 2  , STAGE_BYTES = 8 * HTB, NXCD = 8, WGM = 8;

__host__ __device__ __forceinline__ int lds_byte(int r, int c) { const int st = (r >> 4) * 2 + (c >> 5), rr = r & 15, cc = c & 31, ob = rr * 64 + cc * 2; return st * 1024 + (ob ^ (((ob >> 9) & 1) << 5)); }
__host__ __device__ __forceinline__ void stage_rc(int b, int& R, int& C) { const int st = b / 1024, sb = b % 1024, swz = sb ^ (((sb >> 9) & 1) << 5); R = (st >> 1) * 16 + swz / 64; C = (st & 1) * 32 + (swz % 64) / 2; }
__host__ __device__ __forceinline__ int perm32(int rho) { const int n = rho >> 4, i = rho & 15; return 8 * (i >> 2) + 4 * n + (i & 3); }

struct Unit { int pm, pn, aux; };
struct Gemm { const bf16_t* A; const bf16_t* Bt; int M, N, K; };

struct StaticOrder {
    int nM, nN, nwg, G, c;
    __host__ __device__ void init(int M, int N, int G_, int c_) { nM = M / BM; nN = N / BM; nwg = nM * nN; G = G_; c = c_; }
    __host__ __device__ bool next(int i, Unit& u) const {
        const long L = (long)i * G + c; if (L >= nwg) return false;
        int wgid = (int)L; { const int q = nwg / NXCD, r = nwg % NXCD, xcd = wgid % NXCD, off = wgid / NXCD; wgid = (xcd < r ? xcd * (q + 1) : r * (q + 1) + (xcd - r) * q) + off; }
        const int nig = WGM * nN, gid = wgid / nig, fm = gid * WGM, gsz = (nM - fm) < WGM ? (nM - fm) : WGM;
        u.pm = fm + ((wgid % nig) % gsz); u.pn = (wgid % nig) / gsz; return true;
    }
    __host__ __device__ __forceinline__ int nloc() const { return c < nwg ? (nwg - c + G - 1) / G : 0; }
    __device__ __forceinline__ void a_ready(const Unit&) const {}
    __device__ __forceinline__ void done(const Unit&) const {}
};
template <class Epi, class Sched, bool ALIGN_EPI = false, bool SP2 = false, bool GATHER = false>
__device__ __forceinline__ void gemm_phase(PG8_LAS unsigned char* lds, const Gemm g, const Sched& S, const Epi& E) {
    const int tid = otid(), wid = __builtin_amdgcn_readfirstlane(tid >> 6), lane = tid & 63, wr = wid >> 2, wc = wid & 3, fr = lane & 15, fq = lane >> 4;
    const int K = g.K, nt = K / BK;
    unsigned voffA[2], voffB[2]; int rowA[2]; unsigned colA[2];
#pragma unroll
    for (int i = 0; i < 2; ++i) { int R, C; stage_rc(tid * 16 + i * 8192, R, C); const int Rb = Epi::PERM ? ((R & ~31) + perm32(R & 31)) : R;
        voffA[i] = (unsigned)(R * K + C) * 2u; voffB[i] = (unsigned)(Rb * K + C) * 2u; rowA[i] = R; colA[i] = (unsigned)C * 2u; }
    unsigned gc[2][2], gn[2][2];
#define PG8_GOFFS(dst, u) do { _Pragma("unroll") for (int h_ = 0; h_ < 2; ++h_) _Pragma("unroll") for (int i_ = 0; i_ < 2; ++i_) dst[h_][i_] = S.row_off((u), h_ * HALF + rowA[i_]) + colA[i_]; } while (0)
    const size_t kstep = (size_t)(BK * 2);
    const size_t hstep = (size_t)HALF * K * 2;
    const size_t tstep = 2 * hstep;
    const unsigned ldsw = (unsigned)wid * 1024u;
    const int aoff = lds_byte(wr * 64 + fr, fq * 8), boff = lds_byte(wc * 32 + fr, fq * 8);
#define PG8_SA(b, h) (((b) * 2 + (h)) * HTB)
#define PG8_SB(b, h) ((4 + (b) * 2 + (h)) * HTB)
#define PG8_STAGE(bufoff, gbase, voff) do { _Pragma("unroll") for (int _i = 0; _i < 2; ++_i) \
        __builtin_amdgcn_global_load_lds((const unsigned*)((const char*)(gbase) + (voff)[_i]), (PG8_LAS unsigned*)(lds + (bufoff) + ldsw + _i * 8192), 16, 0, 0); } while (0)
#define PG8_STAGE_A(bufoff, gbase, h, NX) do { _Pragma("unroll") for (int _i = 0; _i < 2; ++_i) { \
        const char* p_; if constexpr (GATHER) p_ = (const char*)(gbase) + ((NX) ? gn[h][_i] : gc[h][_i]); else p_ = (const char*)(gbase) + (h) * hstep + voffA[_i]; \
        __builtin_amdgcn_global_load_lds((const unsigned*)p_, (PG8_LAS unsigned*)(lds + (bufoff) + ldsw + _i * 8192), 16, 0, 0); } } while (0)
#define PG8_LDA(dst, b, h) do { _Pragma("unroll") for (int m = 0; m < 4; ++m) _Pragma("unroll") for (int k = 0; k < 2; ++k) dst[m][k] = *(const PG8_LAS bf16x8*)(lds + PG8_SA(b, h) + aoff + m * 2048 + k * 1024); } while (0)
#define PG8_LDB(dst, b, h) do { _Pragma("unroll") for (int n = 0; n < 2; ++n) _Pragma("unroll") for (int k = 0; k < 2; ++k) dst[n][k] = *(const PG8_LAS bf16x8*)(lds + PG8_SB(b, h) + boff + n * 2048 + k * 1024); } while (0)
#define PG8_MMA(ai, bj, At, Bt) do { __builtin_amdgcn_s_setprio(1); _Pragma("unroll") for (int m = 0; m < 4; ++m) _Pragma("unroll") for (int n = 0; n < 2; ++n) _Pragma("unroll") for (int k = 0; k < 2; ++k) \
        acc[ai][bj][m][n] = __builtin_amdgcn_mfma_f32_16x16x32_bf16(Bt[n][k], At[m][k], acc[ai][bj][m][n], 0, 0, 0); __builtin_amdgcn_s_setprio(0); } while (0)
#define PG8_WAIT_V(n) asm volatile("s_waitcnt vmcnt(" #n ")" ::: "memory")
#define PG8_WAIT_L(n) asm volatile("s_waitcnt lgkmcnt(" #n ")" ::: "memory")
#define PG8_BAR __builtin_amdgcn_s_barrier()
#define PG8_SCHED __builtin_amdgcn_sched_barrier(0)
    Unit cur, nxt; int ui = 0;
    if (!S.next(0, cur)) return;
    f32x4 acc[2][2][4][2];
#pragma unroll
    for (int a = 0; a < 2; ++a)
#pragma unroll
        for (int b = 0; b < 2; ++b)
#pragma unroll
            for (int m = 0; m < 4; ++m)
#pragma unroll
                for (int n = 0; n < 2; ++n) acc[a][b][m][n] = (f32x4){0.f, 0.f, 0.f, 0.f};
    bf16x8 At[4][2], B0[2][2], B1[2][2];
    const char* cA = GATHER ? (const char*)g.A : (const char*)g.A + (size_t)cur.pm * tstep; const char* cB = (const char*)g.Bt + (size_t)cur.pn * tstep;
    if constexpr (GATHER) { PG8_GOFFS(gc, cur); }
    S.a_ready(cur);
    if constexpr (SP2) {
        PG8_STAGE(PG8_SB(0, 0), cB, voffB); PG8_STAGE(PG8_SB(0, 1), cB + hstep, voffB); PG8_STAGE_A(PG8_SA(0, 0), cA, 0, false); PG8_STAGE_A(PG8_SA(0, 1), cA, 1, false);
        if (wr == 1) PG8_BAR;
        PG8_WAIT_V(2); PG8_BAR;
        PG8_STAGE(PG8_SB(1, 0), cB + kstep, voffB); PG8_STAGE_A(PG8_SA(1, 0), cA + kstep, 0, false); PG8_STAGE(PG8_SB(1, 1), cB + hstep + kstep, voffB);
        PG8_WAIT_V(6); PG8_BAR;
    } else {
        PG8_STAGE(PG8_SB(0, 0), cB, voffB); PG8_STAGE_A(PG8_SA(0, 0), cA, 0, false); PG8_STAGE(PG8_SB(0, 1), cB + hstep, voffB); PG8_STAGE_A(PG8_SA(0, 1), cA, 1, false);
        if (wr == 1) PG8_BAR;
        PG8_WAIT_V(4); PG8_BAR;
        PG8_STAGE(PG8_SB(1, 0), cB + kstep, voffB); PG8_STAGE_A(PG8_SA(1, 0), cA + kstep, 0, false); PG8_STAGE(PG8_SB(1, 1), cB + hstep + kstep, voffB);
        PG8_WAIT_V(6); PG8_BAR;
    }
    for (;;) {
        const bool has_next = S.next(ui + 1, nxt);
        if constexpr (GATHER) { if (has_next) { PG8_GOFFS(gn, nxt); } else {
#pragma unroll
            for (int h_ = 0; h_ < 2; ++h_) { gn[h_][0] = gc[h_][0]; gn[h_][1] = gc[h_][1]; } } }
        const char* nA = GATHER ? (const char*)g.A : has_next ? (const char*)g.A + (size_t)nxt.pm * tstep : cA; const char* nB = has_next ? (const char*)g.Bt + (size_t)nxt.pn * tstep : cB;
        for (int t = 0; t < nt; t += 2) {
            const bool last = (t == nt - 2);
            const char* a1 = cA + (size_t)(t + 1) * kstep;
            const char* a2 = last ? nA : cA + (size_t)(t + 2) * kstep; const char* b2 = last ? nB : cB + (size_t)(t + 2) * kstep;
            const char* a3 = a2 + kstep; const char* b3 = b2 + kstep;
            if (last && has_next) S.a_ready(nxt);
            if constexpr (SP2) {
            PG8_LDB(B0, 0, 0); PG8_LDB(B1, 0, 1); PG8_SCHED; PG8_LDA(At, 0, 0); PG8_STAGE_A(PG8_SA(1, 1), a1, 1, false);
            PG8_WAIT_V(8); PG8_WAIT_L(0); PG8_BAR; PG8_MMA(0, 0, At, B0); PG8_MMA(0, 1, At, B1); PG8_BAR; PG8_SCHED;
            PG8_LDA(At, 0, 1); PG8_STAGE(PG8_SB(0, 0), b2, voffB); PG8_STAGE(PG8_SB(0, 1), b2 + hstep, voffB); PG8_STAGE_A(PG8_SA(0, 0), a2, 0, last);
            PG8_WAIT_V(8); PG8_WAIT_L(0); PG8_BAR; PG8_MMA(1, 0, At, B0); PG8_MMA(1, 1, At, B1); PG8_BAR; PG8_SCHED;
            PG8_LDB(B0, 1, 0); PG8_LDB(B1, 1, 1); PG8_SCHED; PG8_LDA(At, 1, 0); PG8_STAGE_A(PG8_SA(0, 1), a2, 1, last);
            PG8_WAIT_V(8); PG8_WAIT_L(0); PG8_BAR; PG8_MMA(0, 0, At, B0); PG8_MMA(0, 1, At, B1); PG8_BAR; PG8_SCHED;
            PG8_LDA(At, 1, 1); PG8_STAGE(PG8_SB(1, 0), b3, voffB); PG8_STAGE(PG8_SB(1, 1), b3 + hstep, voffB); PG8_STAGE_A(PG8_SA(1, 0), a3, 0, last);
            PG8_WAIT_V(8); PG8_WAIT_L(0); PG8_BAR; PG8_MMA(1, 0, At, B0); PG8_MMA(1, 1, At, B1); PG8_BAR; PG8_SCHED;
            } else {
            PG8_LDB(B0, 0, 0); PG8_SCHED; PG8_LDA(At, 0, 0); PG8_STAGE_A(PG8_SA(1, 1), a1, 1, false);
            PG8_WAIT_L(8); PG8_BAR; PG8_WAIT_L(0); PG8_MMA(0, 0, At, B0); PG8_BAR; PG8_SCHED;
            PG8_LDB(B1, 0, 1); PG8_STAGE(PG8_SB(0, 0), b2, voffB);
            PG8_BAR; PG8_WAIT_L(0); PG8_MMA(0, 1, At, B1); PG8_BAR;
            PG8_LDA(At, 0, 1); PG8_STAGE_A(PG8_SA(0, 0), a2, 0, last);
            PG8_BAR; PG8_WAIT_L(0); PG8_MMA(1, 0, At, B0); PG8_BAR; PG8_SCHED;
            PG8_STAGE(PG8_SB(0, 1), b2 + hstep, voffB);
            PG8_WAIT_V(6); PG8_BAR; PG8_MMA(1, 1, At, B1); PG8_BAR;
            PG8_LDB(B0, 1, 0); PG8_SCHED; PG8_LDA(At, 1, 0); PG8_STAGE_A(PG8_SA(0, 1), a2, 1, last);
            PG8_WAIT_L(8); PG8_BAR; PG8_WAIT_L(0); PG8_MMA(0, 0, At, B0); PG8_BAR; PG8_SCHED;
            PG8_LDB(B1, 1, 1); PG8_STAGE(PG8_SB(1, 0), b3, voffB);
            PG8_BAR; PG8_WAIT_L(0); PG8_MMA(0, 1, At, B1); PG8_BAR;
            PG8_LDA(At, 1, 1); PG8_STAGE_A(PG8_SA(1, 0), a3, 0, last);
            PG8_BAR; PG8_WAIT_L(0); PG8_MMA(1, 0, At, B0); PG8_BAR; PG8_SCHED;
            PG8_STAGE(PG8_SB(1, 1), b3 + hstep, voffB);
            PG8_WAIT_V(6); PG8_BAR; PG8_MMA(1, 1, At, B1); PG8_BAR;
            }
        }
        if constexpr (ALIGN_EPI) { if (wr == 0) PG8_BAR; }
        if constexpr (!Epi::AFTER_DRAIN) { E(acc, cur, wr, wc, fr, fq); S.done(cur); }
        if (!has_next) break;
#pragma unroll
        for (int a = 0; a < 2; ++a)
#pragma unroll
            for (int b = 0; b < 2; ++b)
#pragma unroll
                for (int m = 0; m < 4; ++m)
#pragma unroll
                    for (int n = 0; n < 2; ++n) acc[a][b][m][n] = (f32x4){0.f, 0.f, 0.f, 0.f};
        cur = nxt; cA = nA; cB = nB; ++ui;
        if constexpr (GATHER) {
#pragma unroll
            for (int h_ = 0; h_ < 2; ++h_) { gc[h_][0] = gn[h_][0]; gc[h_][1] = gn[h_][1]; } }
        if constexpr (ALIGN_EPI) { if (wr == 1) PG8_BAR; }
    }
    PG8_WAIT_V(0);
    if constexpr (!ALIGN_EPI) { if (wr == 0) PG8_BAR; }
    PG8_BAR;
    if constexpr (Epi::AFTER_DRAIN) { E.fused(acc, cur, wr, wc, fr, fq, lds, wid, lane); S.done(cur); }
#undef PG8_SA
#undef PG8_SB
#undef PG8_STAGE
#undef PG8_STAGE_A
#undef PG8_GOFFS
#undef PG8_LDA
#undef PG8_LDB
#undef PG8_MMA
#undef PG8_WAIT_V
#undef PG8_WAIT_L
#undef PG8_BAR
#undef PG8_SCHED
}
}

namespace att2 {
constexpr int KSLOT = 8192, VSLOT = 16384, LDS_K = 0, LDS_V = 3 * KSLOT, LDS_WS = LDS_V + 3 * VSLOT, LDS_BYTES = LDS_WS + NWAVES * 256;
constexpr float THR = 8.f;
typedef LAS const char* lds_cptr;
typedef short v4i16_t __attribute__((ext_vector_type(4)));
typedef __bf16 bf2_t __attribute__((ext_vector_type(2)));
#define SBAR() __builtin_amdgcn_sched_barrier(0)
#define PIN(x) asm volatile("" : "+v"(x))
__device__ __forceinline__ int crow(int r, int hi) { return (r & 3) + 8 * (r >> 2) + 4 * hi; }
__device__ __forceinline__ f32x16 zero16() { float z = 0.f; asm volatile("" : "+v"(z)); f32x16 v;
#pragma unroll
    for (int r = 0; r < 16; ++r) v[r] = z;
    return v; }
__device__ __forceinline__ void glds16(const void* gsrc, unsigned lds_dst) { unsigned keep;
    asm volatile("s_mov_b32 %0, m0\n\ts_mov_b32 m0, %2\n\ts_nop 0\n\tglobal_load_lds_dwordx4 %1, off\n\ts_mov_b32 m0, %0" : "=&s"(keep) : "v"(gsrc), "s"(lds_dst) : "memory"); }
__device__ __forceinline__ bf16x8 kfrag(lds_cptr p) { return *(const LAS bf16x8*)p; }
__device__ __forceinline__ s16x4 vtr(lds_cptr p) { return __builtin_bit_cast(s16x4, __builtin_amdgcn_ds_read_tr16_b64_v4i16((LAS v4i16_t*)p)); }
__device__ __forceinline__ unsigned cvtpk_s(float lo, float hi) { typedef float f2 __attribute__((ext_vector_type(2))); typedef __bf16 b2 __attribute__((ext_vector_type(2)));
    f2 v = {lo, hi}; b2 b = __builtin_convertvector(v, b2); return __builtin_bit_cast(unsigned, b); }
#define MX3(a, b, c) __builtin_fmaxf(__builtin_fmaxf((a), (b)), (c))
__device__ __forceinline__ float rowmax(const f32x16& p0, const f32x16& p1) {
    float a = MX3(p0[0], p0[1], p1[0]), b = MX3(p0[2], p0[3], p1[1]); a = MX3(a, p1[2], p1[3]);
#pragma unroll
    for (int r = 4; r < 16; r += 4) { a = MX3(a, p0[r], p0[r + 1]); b = MX3(b, p0[r + 2], p0[r + 3]); a = MX3(a, p1[r], p1[r + 1]); b = MX3(b, p1[r + 2], p1[r + 3]); }
    float m = __builtin_fmaxf(a, b); auto rr = __builtin_amdgcn_permlane32_swap(__float_as_uint(m), __float_as_uint(m), false, false);
    return __builtin_fmaxf(__uint_as_float(rr[0]), __uint_as_float(rr[1])); }
__device__ __forceinline__ void wmask(f32x16& p0, f32x16& p1, int dk, int hi) {
#pragma unroll
    for (int r = 0; r < 16; ++r) { const int d = dk + crow(r, hi);
        if (d > 128 || d < -128) p0[r] = -1e30f;
        if (d + 32 > 128 || d + 32 < -128) p1[r] = -1e30f; } }
#define MFMA32(a, b, c) __builtin_amdgcn_mfma_f32_32x32x16_bf16(a, b, c, 0, 0, 0)
#define WAIT_BAR(N) asm volatile("s_waitcnt vmcnt(" #N ") lgkmcnt(0)\n\ts_barrier" ::: "memory")

template <int MODE, int LDK, int LDV, bool SAFE>
__device__ __forceinline__ void attn_body(const bf16_t* Qw, const bf16_t* Kh, const bf16_t* Vh, const int nA, const int a0, const int b0, const int NT, const int qpos,
                                          char* lds, const int tid, f32x16 (&o)[4], float& m_out, float& l_out) {
    constexpr int ND = (MODE == 1) ? 2 : 4, NVP = ND / 2;
    const int lane = tid & 63, r32 = lane & 31, hi = lane >> 5; const int wid = __builtin_amdgcn_readfirstlane(tid >> 6);
    const unsigned lds0 = (unsigned)(uintptr_t)lds; float* wsf = (float*)(lds + LDS_WS) + wid * 64;
#define KROW(t) ((t) < nA ? a0 + 64 * (t) : b0 + 64 * ((t) - nA))
    const bf16_t* ksrc = Kh + (size_t)lane * LDK + wid * 8;
    const bf16_t* vsrc = Vh + (size_t)(16 * (wid & 3) + (lane >> 2)) * LDV + (wid >> 2) * 32 + (lane & 3) * 8;
    const unsigned kdst = lds0 + LDS_K + wid * 1024, vdst = lds0 + LDS_V + (wid >> 2) * 4096 + (wid & 3) * 1024;
#define DMA_K(t, slot) glds16(ksrc + (size_t)KROW(t) * LDK, (unsigned)__builtin_amdgcn_readfirstlane(kdst + (slot) * KSLOT))
#define DMA_V(t, slot) do { const bf16_t* vs_ = vsrc + (size_t)KROW(t) * LDV; glds16(vs_, (unsigned)__builtin_amdgcn_readfirstlane(vdst + (slot) * VSLOT)); \
        if constexpr (NVP == 2) glds16(vs_ + 64, (unsigned)__builtin_amdgcn_readfirstlane(vdst + (slot) * VSLOT + 8192)); } while (0)
    const lds_cptr shm3 = (lds_cptr)(LAS char*)lds;
    const lds_cptr kp0 = shm3 + LDS_K + hi * 1024 + r32 * 16;
    const lds_cptr vp0 = shm3 + LDS_V + ((lane >> 4) & 1) * 32 + (lane & 3) * 8 + (4 * hi + ((lane & 15) >> 2)) * 64;
    bf16x8 qr[4];
#pragma unroll
    for (int d0 = 0; d0 < 4; ++d0) qr[d0] = *reinterpret_cast<const bf16x8*>(Qw + d0 * 16 + hi * 8);
    __syncthreads();
    if (wid >= 4) __builtin_amdgcn_s_setprio(1);
    DMA_K(0, 0); DMA_K(1, 1); DMA_V(0, 0);
    float mhat = 0.f, l_reg = 0.f;
#pragma unroll
    for (int d = 0; d < 4; ++d) o[d] = zero16();
    f32x16 negm = zero16(); PIN(negm);
    bool resc = false;
    if constexpr (NVP == 2) { WAIT_BAR(3); } else { WAIT_BAR(2); }
    f32x16 pA0, pA1, pB0, pB1;
    DMA_K(2, 2); DMA_V(1, 1);
    { bf16x8 kf[8];
#pragma unroll
      for (int i = 0; i < 8; ++i) kf[i] = kfrag(kp0 + (i >> 1) * 2048 + (i & 1) * 512);
      pA0 = MFMA32(kf[0], qr[0], negm); pA1 = MFMA32(kf[1], qr[0], negm); pA0 = MFMA32(kf[2], qr[1], pA0); pA1 = MFMA32(kf[3], qr[1], pA1);
      pA0 = MFMA32(kf[4], qr[2], pA0); pA1 = MFMA32(kf[5], qr[2], pA1); pA0 = MFMA32(kf[6], qr[3], pA0); pA1 = MFMA32(kf[7], qr[3], pA1); }
    if constexpr (MODE == 1) { if (0 >= nA) wmask(pA0, pA1, KROW(0) - qpos, hi); }
    { const float rm = rowmax(pA0, pA1); mhat = rm;
#pragma unroll
      for (int r = 0; r < 16; ++r) { pA0[r] = __builtin_amdgcn_exp2f(pA0[r] - rm); pA1[r] = __builtin_amdgcn_exp2f(pA1[r] - rm); }
#pragma unroll
      for (int r = 0; r < 16; ++r) negm[r] = -mhat;
      PIN(negm);
      if constexpr (!SAFE) { float s0 = 0.f, s1 = 0.f;
#pragma unroll
        for (int r = 0; r < 16; ++r) { s0 += pA0[r]; s1 += pA1[r]; }
        l_reg = s0 + s1; } }
    if constexpr (NVP == 2) { WAIT_BAR(3); } else { WAIT_BAR(2); }
    int sl_prev = 0, sl_cur = 1, sl_next = 2;
#define ROT() do { const int s_ = sl_prev; sl_prev = sl_cur; sl_cur = sl_next; sl_next = s_; } while (0)
#define RESC() do { if (resc) { asm volatile("s_waitcnt lgkmcnt(0)" ::: "memory"); \
        _Pragma("unroll") for (int d_ = 0; d_ < ND; ++d_) _Pragma("unroll") for (int r = 0; r < 16; ++r) o[d_][r] *= wsf[crow(r, hi)]; } } while (0)
    u32x4 pw0, pw1, pw2, pw3; s16x4 vl[16], vh[16]; bf16x8 kf[8]; float dummy_ = 0.f;
#define PAF(k) __builtin_bit_cast(bf16x8, pw##k)
#define VFR(i) (bf16x8){vl[i][0], vl[i][1], vl[i][2], vl[i][3], vh[i][0], vh[i][1], vh[i][2], vh[i][3]}
#define VRD(q, ks) do { if constexpr ((q) < ND) { vl[(q) * 4 + (ks)] = vtr(vp_ + ((q) * 4096 + (ks) * 1024)); vh[(q) * 4 + (ks)] = vtr(vp_ + ((q) * 4096 + (ks) * 1024 + 512)); } } while (0)
#define KRD(i) do { kf[i] = kfrag(kp_ + ((i) >> 1) * 2048 + ((i) & 1) * 512); } while (0)
#define PKW(P, i) cvtpk_s(P[i], P[i + 1])
#ifndef PROBE_VALU
#define PROBE_VALU 0
#endif
#ifndef ROWSUM_DOT2
#define ROWSUM_DOT2 0
#endif
#define DOT2(w, acc) __builtin_amdgcn_fdot2_f32_bf16(__builtin_bit_cast(bf2_t, (unsigned)(w)), __builtin_bit_cast(bf2_t, 0x3f803f80u), acc, false)
#define GAPA(MF, a0_, a1_, a2_, a3_, W0, W1, PW, i0_) do { MF; if (SAFE && !ROWSUM_DOT2) { sacc += a0_; sacb += a1_; sacc += a2_; sacb += a3_; PIN(sacc); PIN(sacb); } W0; W1; PIN(PW); \
        if (ROWSUM_DOT2) { sacc = DOT2(PW[i0_], sacc); sacb = DOT2(PW[(i0_) + 1], sacb); PIN(sacc); PIN(sacb); } SBAR(); } while (0)
#define EX(v) __builtin_amdgcn_exp2f(v)
#define GAPB(q, ks, X, i) do { if constexpr ((q) < ND) { o[q] = MFMA32(PAF(ks), VFR((q) * 4 + (ks)), o[q]); } X[i] = EX(X[i]); X[(i) + 1] = EX(X[(i) + 1]); X[(i) + 2] = EX(X[(i) + 2]); X[(i) + 3] = EX(X[(i) + 3]); PIN(X); SBAR(); } while (0)
#define GAPG(q, ks, ...) do { if constexpr ((q) < ND) { o[q] = MFMA32(PAF(ks), VFR((q) * 4 + (ks)), o[q]); } __VA_ARGS__; SBAR(); } while (0)
#define STEP(C0, C1, P0, P1, t, GK, GV) do { SBAR(); \
    const lds_cptr vp_ = vp0 + sl_prev * VSLOT; const lds_cptr kp_ = kp0 + sl_cur * KSLOT; \
    KRD(0); KRD(1); KRD(2); SBAR(); float sacc = (ROWSUM_DOT2 || !SAFE) ? 0.f : P0[0], sacb = (ROWSUM_DOT2 || !SAFE) ? 0.f : P0[1]; \
    KRD(3); SBAR();            GAPA(C0 = MFMA32(kf[0], qr[0], negm), P0[2], P0[3], P0[4], P0[5],     pw0[0] = PKW(P0, 0),  pw0[1] = PKW(P0, 2),  pw0, 0); \
    KRD(4); SBAR();            GAPA(C1 = MFMA32(kf[1], qr[0], negm), P0[6], P0[7], P0[8], P0[9],     pw0[2] = PKW(P0, 4),  pw0[3] = PKW(P0, 6),  pw0, 2); \
    KRD(5); SBAR();            GAPA(C0 = MFMA32(kf[2], qr[1], C0),   P0[10], P0[11], P0[12], P0[13], pw1[0] = PKW(P0, 8),  pw1[1] = PKW(P0, 10), pw1, 0); \
    KRD(6); SBAR();            GAPA(C1 = MFMA32(kf[3], qr[1], C1),   P0[14], P0[15], P1[0], P1[1],   pw1[2] = PKW(P0, 12), pw1[3] = PKW(P0, 14), pw1, 2); \
    KRD(7); VRD(0, 0); SBAR(); GAPA(C0 = MFMA32(kf[4], qr[2], C0),   P1[2], P1[3], P1[4], P1[5],     pw2[0] = PKW(P1, 0),  pw2[1] = PKW(P1, 2),  pw2, 0); \
            VRD(1, 0); SBAR(); GAPA(C1 = MFMA32(kf[5], qr[2], C1),   P1[6], P1[7], P1[8], P1[9],     pw2[2] = PKW(P1, 4),  pw2[3] = PKW(P1, 6),  pw2, 2); \
            VRD(2, 0); SBAR(); GAPA(C0 = MFMA32(kf[6], qr[3], C0),   P1[10], P1[11], P1[12], P1[13], pw3[0] = PKW(P1, 8),  pw3[1] = PKW(P1, 10), pw3, 0); \
            VRD(3, 0); SBAR(); GAPA(C1 = MFMA32(kf[7], qr[3], C1),   P1[14], P1[15], 0.f, 0.f,       pw3[2] = PKW(P1, 12), pw3[3] = PKW(P1, 14), pw3, 2); \
    if constexpr (SAFE) l_reg += sacc + sacb; \
    if constexpr (MODE == 1) { if ((t) >= nA) wmask(C0, C1, KROW(t) - qpos, hi); } \
    SBAR(); \
      \
      \
    if constexpr (!SAFE) { \
      \
    VRD(0, 1); SBAR(); GAPG(0, 0, C0[0] = EX(C0[0]); C0[1] = EX(C0[1]); PIN(C0)); \
    VRD(1, 1); SBAR(); GAPG(1, 0, C0[2] = EX(C0[2]); C0[3] = EX(C0[3]); sacc += C0[0]; sacb += C0[1]; PIN(C0); PIN(sacc); PIN(sacb)); \
    VRD(2, 1); SBAR(); GAPG(2, 0, C0[4] = EX(C0[4]); C0[5] = EX(C0[5]); sacc += C0[2]; sacb += C0[3]; PIN(C0); PIN(sacc); PIN(sacb)); \
    VRD(3, 1); SBAR(); GAPG(3, 0, C0[6] = EX(C0[6]); C0[7] = EX(C0[7]); sacc += C0[4]; sacb += C0[5]; PIN(C0); PIN(sacc); PIN(sacb)); \
    VRD(0, 2); SBAR(); GAPG(0, 1, C0[8] = EX(C0[8]); C0[9] = EX(C0[9]); sacc += C0[6]; sacb += C0[7]; PIN(C0); PIN(sacc); PIN(sacb)); \
    VRD(1, 2); SBAR(); GAPG(1, 1, C0[10] = EX(C0[10]); C0[11] = EX(C0[11]); sacc += C0[8]; sacb += C0[9]; PIN(C0); PIN(sacc); PIN(sacb)); \
    VRD(2, 2); SBAR(); GAPG(2, 1, C0[12] = EX(C0[12]); C0[13] = EX(C0[13]); sacc += C0[10]; sacb += C0[11]; PIN(C0); PIN(sacc); PIN(sacb)); \
    VRD(3, 2); SBAR(); GAPG(3, 1, C0[14] = EX(C0[14]); C0[15] = EX(C0[15]); sacc += C0[12]; sacb += C0[13]; PIN(C0); PIN(sacc); PIN(sacb)); \
    VRD(0, 3); SBAR(); GAPG(0, 2, C1[0] = EX(C1[0]); C1[1] = EX(C1[1]); sacc += C0[14]; sacb += C0[15]; PIN(C1); PIN(sacc); PIN(sacb)); \
    VRD(1, 3); SBAR(); GAPG(1, 2, C1[2] = EX(C1[2]); C1[3] = EX(C1[3]); sacc += C1[0]; sacb += C1[1]; PIN(C1); PIN(sacc); PIN(sacb)); \
    VRD(2, 3); SBAR(); GAPG(2, 2, C1[4] = EX(C1[4]); C1[5] = EX(C1[5]); sacc += C1[2]; sacb += C1[3]; PIN(C1); PIN(sacc); PIN(sacb)); \
    VRD(3, 3); SBAR(); GAPG(3, 2, C1[6] = EX(C1[6]); C1[7] = EX(C1[7]); sacc += C1[4]; sacb += C1[5]; PIN(C1); PIN(sacc); PIN(sacb)); \
    if (GK) { DMA_K((t) + 2, sl_prev); } SBAR(); GAPG(0, 3, C1[8] = EX(C1[8]); C1[9] = EX(C1[9]); sacc += C1[6]; sacb += C1[7]; PIN(C1); PIN(sacc); PIN(sacb)); \
    if (GV) { DMA_V((t) + 1, sl_next); } SBAR(); GAPG(1, 3, C1[10] = EX(C1[10]); C1[11] = EX(C1[11]); sacc += C1[8]; sacb += C1[9]; PIN(C1); PIN(sacc); PIN(sacb)); \
    GAPG(2, 3, C1[12] = EX(C1[12]); C1[13] = EX(C1[13]); sacc += C1[10]; sacb += C1[11]; PIN(C1); PIN(sacc); PIN(sacb)); \
    GAPG(3, 3, C1[14] = EX(C1[14]); C1[15] = EX(C1[15]); sacc += C1[12]; sacb += C1[13]; PIN(C1); PIN(sacc); PIN(sacb)); \
    sacc += C1[14]; sacb += C1[15]; l_reg += sacc + sacb; \
    } else { \
    float mxa, mxb; \
    VRD(0, 1); SBAR(); GAPG(0, 0, mxa = MX3(C0[0], C0[1], C0[2]); mxb = MX3(C0[3], C0[4], C0[5]); mxa = MX3(mxa, C0[6], C0[7]); mxb = MX3(mxb, C0[8], C0[9]); PIN(mxa); PIN(mxb)); \
    VRD(1, 1); SBAR(); GAPG(1, 0, mxa = MX3(mxa, C0[10], C0[11]); mxb = MX3(mxb, C0[12], C0[13]); mxa = MX3(mxa, C0[14], C0[15]); mxb = MX3(mxb, C1[0], C1[1]); PIN(mxa); PIN(mxb)); \
    VRD(2, 1); SBAR(); GAPG(2, 0, mxa = MX3(mxa, C1[2], C1[3]); mxb = MX3(mxb, C1[4], C1[5]); mxa = MX3(mxa, C1[6], C1[7]); mxb = MX3(mxb, C1[8], C1[9]); PIN(mxa); PIN(mxb)); \
    VRD(3, 1); SBAR(); GAPG(3, 0, mxa = MX3(mxa, C1[10], C1[11]); mxb = MX3(mxb, C1[12], C1[13]); mxa = MX3(mxa, C1[14], C1[15]); PIN(mxa); PIN(mxb)); \
    { float rm = __builtin_fmaxf(mxa, mxb); { auto rr = __builtin_amdgcn_permlane32_swap(__float_as_uint(rm), __float_as_uint(rm), false, false); rm = __builtin_fmaxf(__uint_as_float(rr[0]), __uint_as_float(rr[1])); } \
      resc = false; \
      if (__builtin_expect(__any(rm > THR), 0)) { const float dl = __builtin_fmaxf(rm, 0.f); mhat += dl; \
          _Pragma("unroll") for (int r = 0; r < 16; ++r) { C0[r] -= dl; C1[r] -= dl; } \
          _Pragma("unroll") for (int r = 0; r < 16; ++r) negm[r] = -mhat; PIN(negm); \
          const float f = __builtin_amdgcn_exp2f(-dl); l_reg *= f; if (hi == 0) wsf[r32] = f; resc = true; } } \
    SBAR(); \
    VRD(0, 2); SBAR(); GAPG(0, 1, C0[0] = EX(C0[0]); C0[1] = EX(C0[1]); C0[2] = EX(C0[2]); PIN(C0)); \
    VRD(1, 2); SBAR(); GAPG(1, 1, C0[3] = EX(C0[3]); C0[4] = EX(C0[4]); C0[5] = EX(C0[5]); PIN(C0)); \
    VRD(2, 2); SBAR(); GAPG(2, 1, C0[6] = EX(C0[6]); C0[7] = EX(C0[7]); C0[8] = EX(C0[8]); PIN(C0)); \
    VRD(3, 2); SBAR(); GAPG(3, 1, C0[9] = EX(C0[9]); C0[10] = EX(C0[10]); C0[11] = EX(C0[11]); PIN(C0)); \
    VRD(0, 3); SBAR(); GAPG(0, 2, C0[12] = EX(C0[12]); C0[13] = EX(C0[13]); C0[14] = EX(C0[14]); PIN(C0)); \
    VRD(1, 3); SBAR(); GAPG(1, 2, C0[15] = EX(C0[15]); C1[0] = EX(C1[0]); C1[1] = EX(C1[1]); PIN(C0); PIN(C1)); \
    VRD(2, 3); SBAR(); GAPG(2, 2, C1[2] = EX(C1[2]); C1[3] = EX(C1[3]); C1[4] = EX(C1[4]); PIN(C1)); \
    VRD(3, 3); SBAR(); GAPG(3, 2, C1[5] = EX(C1[5]); C1[6] = EX(C1[6]); C1[7] = EX(C1[7]); PIN(C1)); \
    if (GK) { DMA_K((t) + 2, sl_prev); if (PROBE_DUPK) DMA_K((t) + 2, sl_prev); } SBAR(); GAPG(0, 3, C1[8] = EX(C1[8]); C1[9] = EX(C1[9]); PIN(C1)); \
    if (GV) { DMA_V((t) + 1, sl_next); if (PROBE_DUPV) DMA_V((t) + 1, sl_next); } SBAR(); GAPG(1, 3, C1[10] = EX(C1[10]); C1[11] = EX(C1[11]); PIN(C1)); \
    GAPG(2, 3, C1[12] = EX(C1[12]); C1[13] = EX(C1[13]); PIN(C1)); \
    GAPG(3, 3, C1[14] = EX(C1[14]); C1[15] = EX(C1[15]); PIN(C1)); \
    } \
    } while (0)
#ifndef PROBE_DUPK
#define PROBE_DUPK 0
#endif
#ifndef PROBE_DUPV
#define PROBE_DUPV 0
#endif
#define WAIT_N(n_) do { if ((n_) == 6) { WAIT_BAR(6); } else if ((n_) == 5) { WAIT_BAR(5); } else if ((n_) == 4) { WAIT_BAR(4); } else if ((n_) == 3) { WAIT_BAR(3); } else if ((n_) == 2) { WAIT_BAR(2); } else if ((n_) == 1) { WAIT_BAR(1); } else { WAIT_BAR(0); } } while (0)
#define ENDW(tt) do { const int nk_ = ((tt) + 2 < NT) ? 1 + PROBE_DUPK : 0, nv_ = ((tt) + 1 < NT) ? NVP * (1 + PROBE_DUPV) : 0; WAIT_N(nk_ + nv_); } while (0)
    int t = 1;
    for (; t + 3 < NT; t += 2) {
        STEP(pB0, pB1, pA0, pA1, t, true, true);     WAIT_N(1 + PROBE_DUPK + NVP * (1 + PROBE_DUPV)); RESC(); ROT();
        STEP(pA0, pA1, pB0, pB1, t + 1, true, true); WAIT_N(1 + PROBE_DUPK + NVP * (1 + PROBE_DUPV)); RESC(); ROT();
    }
    for (; t + 1 < NT; t += 2) {
        STEP(pB0, pB1, pA0, pA1, t, (t + 2 < NT), (t + 1 < NT));         ENDW(t);     RESC(); ROT();
        STEP(pA0, pA1, pB0, pB1, t + 1, (t + 3 < NT), (t + 2 < NT));     ENDW(t + 1); RESC(); ROT();
    }
    STEP(pB0, pB1, pA0, pA1, NT - 1, false, false); WAIT_BAR(0); RESC(); ROT();
    { if constexpr (SAFE) { float sacc = pB0[0] + pB0[1];
#pragma unroll
      for (int r = 2; r < 16; ++r) sacc += pB0[r];
#pragma unroll
      for (int r = 0; r < 16; ++r) sacc += pB1[r];
      l_reg += sacc; }
      pw0 = (u32x4){PKW(pB0, 0), PKW(pB0, 2), PKW(pB0, 4), PKW(pB0, 6)}; pw1 = (u32x4){PKW(pB0, 8), PKW(pB0, 10), PKW(pB0, 12), PKW(pB0, 14)};
      pw2 = (u32x4){PKW(pB1, 0), PKW(pB1, 2), PKW(pB1, 4), PKW(pB1, 6)}; pw3 = (u32x4){PKW(pB1, 8), PKW(pB1, 10), PKW(pB1, 12), PKW(pB1, 14)};
      const lds_cptr vp_ = vp0 + sl_prev * VSLOT;
#pragma unroll
      for (int q = 0; q < ND; ++q) {
          s16x4 l0 = vtr(vp_ + q * 4096), h0 = vtr(vp_ + q * 4096 + 512), l1 = vtr(vp_ + q * 4096 + 1024), h1 = vtr(vp_ + q * 4096 + 1024 + 512);
          s16x4 l2 = vtr(vp_ + q * 4096 + 2048), h2 = vtr(vp_ + q * 4096 + 2048 + 512), l3 = vtr(vp_ + q * 4096 + 3072), h3 = vtr(vp_ + q * 4096 + 3072 + 512);
#define PKV(L, H) (bf16x8){L[0], L[1], L[2], L[3], H[0], H[1], H[2], H[3]}
          o[q] = MFMA32(PAF(0), PKV(l0, h0), o[q]); o[q] = MFMA32(PAF(1), PKV(l1, h1), o[q]); o[q] = MFMA32(PAF(2), PKV(l2, h2), o[q]); o[q] = MFMA32(PAF(3), PKV(l3, h3), o[q]);
#undef PKV
      } }
    { auto rr = __builtin_amdgcn_permlane32_swap(__float_as_uint(l_reg), __float_as_uint(l_reg), false, false); l_reg = __uint_as_float(rr[0]) + __uint_as_float(rr[1]); }
    if (PROBE_VALU) asm volatile("" :: "v"(dummy_));
    __builtin_amdgcn_s_setprio(0);
    m_out = mhat; l_out = l_reg;
#undef KROW
#undef DMA_K
#undef DMA_V
#undef ROT
#undef RESC
#undef PAF
#undef VFR
#undef VRD
#undef KRD
#undef PKW
#undef GAPA
#undef DOT2
#undef GAPB
#undef GAPG
#undef EX
#undef STEP
#undef ENDW
#undef WAIT_N
}
#undef SBAR
#undef PIN
#undef MX3
#undef MFMA32
#undef WAIT_BAR
}

#define XB_TMO      128
#define XB_XCNT(j)  (256  + 64 * (j))
#define XB_XSUB(j)  (1280 + 64 * (j))
#define XB_XGEN(j)  (2304 + 64 * (j))
#define XB_TOP      3328
#define XB_TOPGEN   3392
#define XCD_BAR_WORDS 3456
#define XB_SPIN_CAP (1u << 18)

__device__ __forceinline__ unsigned xb_ld(unsigned* p)              { return __hip_atomic_load(p, __ATOMIC_RELAXED, __HIP_MEMORY_SCOPE_AGENT); }
__device__ __forceinline__ unsigned xb_add(unsigned* p, unsigned v) { return __hip_atomic_fetch_add(p, v, __ATOMIC_RELAXED, __HIP_MEMORY_SCOPE_AGENT); }
__device__ __forceinline__ unsigned xb_xcc_id() { return (unsigned)__builtin_amdgcn_s_getreg((3 << 11) | 20) & 0xFu; }
#define XB_SPIN(cond, bar) do { unsigned _sp = 0; while (cond) { __builtin_amdgcn_s_sleep(1); \
    if ((++_sp & 255u) == 0u) { if (xb_ld(&(bar)[XB_TMO])) break; if (_sp > XB_SPIN_CAP) { atomicAdd(&(bar)[XB_TMO], 1u); break; } } } } while (0)

struct XcdBarrier {
    unsigned* bar; unsigned x;
    volatile LAS unsigned* st;
};

__device__ __forceinline__ XcdBarrier xcd_barrier_post(unsigned* bar, volatile LAS unsigned* st) {
    XcdBarrier b; b.bar = bar; b.x = xb_xcc_id(); b.st = st;
    if (threadIdx.x == 0) (void)xb_add(&bar[XB_XCNT(b.x)], 1u);
    return b;
}
__device__ __forceinline__ void xcd_barrier_complete(unsigned* bar, unsigned x, unsigned& nloc, unsigned& nx) {
    const unsigned G = gridDim.x * gridDim.y * gridDim.z;
    unsigned sum, cnt, mine, sp = 0u;
    for (;;) {
        sum = 0u; cnt = 0u; mine = 0u;
#pragma unroll
        for (unsigned j = 0; j < 16; ++j) { const unsigned c = xb_ld(&bar[XB_XCNT(j)]); sum += c; cnt += (c > 0u) ? 1u : 0u; mine = (j == x) ? c : mine; }
        if (sum == G) break;
        __builtin_amdgcn_s_sleep(1);
        if ((++sp & 255u) == 0u) { if (xb_ld(&bar[XB_TMO])) break; if (sp > XB_SPIN_CAP) { atomicAdd(&bar[XB_TMO], 1u); break; } }
    }
    nloc = mine > 0u ? mine : 1u; nx = cnt > 0u ? cnt : 1u;
}

__device__ __forceinline__ void xcd_barrier(const XcdBarrier& b) {
    asm volatile("s_waitcnt vmcnt(0)" ::: "memory");
    __syncthreads();
    if (threadIdx.x == 0) {
        unsigned* bar = b.bar;
        __builtin_amdgcn_s_waitcnt(0);
        unsigned nloc = b.st[0], nx = b.st[1];
        if (nloc == 0u) { xcd_barrier_complete(bar, b.x, nloc, nx); b.st[0] = nloc; b.st[1] = nx; }
        const unsigned old = xb_add(&bar[XB_XSUB(b.x)], 1u);
        const unsigned gen = old / nloc;
        if (old + 1u == (gen + 1u) * nloc) {
            __builtin_amdgcn_fence(__ATOMIC_RELEASE, "agent");
            asm volatile("s_waitcnt vmcnt(0)" ::: "memory");
            const unsigned og = xb_add(&bar[XB_TOP], 1u);
            const unsigned tg = og / nx;
            if (og + 1u == (tg + 1u) * nx) xb_add(&bar[XB_TOPGEN], 1u);
            else XB_SPIN(xb_ld(&bar[XB_TOPGEN]) == tg, bar);
            __builtin_amdgcn_fence(__ATOMIC_ACQUIRE, "agent");
            xb_add(&bar[XB_XGEN(b.x)], 1u);
            asm volatile("s_waitcnt vmcnt(0)" ::: "memory");
        } else {
            XB_SPIN(xb_ld(&bar[XB_XGEN(b.x)]) == gen, bar);
            __builtin_amdgcn_fence(__ATOMIC_ACQUIRE, "agent");
            asm volatile("s_waitcnt vmcnt(0)" ::: "memory");
        }
    }
    __syncthreads();
}

struct Args { const float* in[23]; float* out; unsigned char* ws; int ph_lo, ph_hi; };
enum { I_X = 0, I_C, I_CTX, I_CCTX, I_WADA, I_BADA, I_GMIX, I_WIN, I_DLAM, I_DNG, I_SINK, I_CONVW, I_CONVB, I_LNG, I_LNB, I_WOUT, I_GFFN, I_RW, I_RB, I_W1, I_W3, I_W2, I_GFIN };
constexpr int N_PHASES = 18;
__device__ __constant__ const float LAMBDA_INIT[2] = {0.2f, 0.35550906759097f};

struct EpiInProj {
    static constexpr bool PERM = true, AFTER_DRAIN = false;
    unsigned char* ws; const float* ropeC; const float* ropeS;
    __device__ __forceinline__ void operator()(const f32x4 (&acc)[2][2][4][2], const pg8::Unit& u, int wr, int wc, int fr, int fq) const {
        const int pn = u.pn; const bool latent = u.pm < 64; const int rowb = u.pm * 256 + wr * 64 + fr;
        if (pn >= 8) {
            bf16_t* Z = (bf16_t*)(ws + RA_Z); const int ch0 = (pn - 8) * 128 + wc * 32 + 8 * fq;
#pragma unroll
            for (int ai = 0; ai < 2; ++ai)
#pragma unroll
                for (int m = 0; m < 4; ++m) { const int row = rowb + ai * 128 + m * 16;
                    const f32x4 a0 = acc[ai][0][m][0], a1 = acc[ai][0][m][1], g0 = acc[ai][1][m][0], g1 = acc[ai][1][m][1];
                    u32x4 w; w.x = cvt_pk_bf16(a0[0] * sigmoid_f(g0[0]), a0[1] * sigmoid_f(g0[1])); w.y = cvt_pk_bf16(a0[2] * sigmoid_f(g0[2]), a0[3] * sigmoid_f(g0[3]));
                    w.z = cvt_pk_bf16(a1[0] * sigmoid_f(g1[0]), a1[1] * sigmoid_f(g1[1])); w.w = cvt_pk_bf16(a1[2] * sigmoid_f(g1[2]), a1[3] * sigmoid_f(g1[3]));
                    *(u32x4*)(Z + (size_t)row * 256 + ch0) = w; }
            return;
        }
        const float sgn = (fq < 2) ? -1.f : 1.f;
        const bool anyrope = latent && (pn < 4 || pn >= 6);
#pragma unroll
        for (int ai = 0; ai < 2; ++ai)
#pragma unroll
            for (int m = 0; m < 4; ++m) { const int row = rowb + ai * 128 + m * 16;
                f32x4 c0, c1, s0, s1;
                if (anyrope) { const int pos = (wc & 1) ? (row & 63) : (row >> 6); const int fo = pos * 16 + 8 * (fq & 1);
                    c0 = *(const f32x4*)(ropeC + fo); c1 = *(const f32x4*)(ropeC + fo + 4); s0 = *(const f32x4*)(ropeS + fo) * sgn; s1 = *(const f32x4*)(ropeS + fo + 4) * sgn; }
#pragma unroll
                for (int bj = 0; bj < 2; ++bj) {
                    bf16_t* dst; int ld, dcol; bool rope; float sc = 1.f; bool isvb = false;
                    if (pn < 2)       { dst = (bf16_t*)(ws + RA_QA); ld = 512; dcol = pn * 256 + bj * 128 + wc * 32; rope = true; sc = QSCALE; }
                    else if (pn < 4)  { dst = (bf16_t*)(ws + RA_KA); ld = 512; dcol = (pn - 2) * 256 + bj * 128 + wc * 32; rope = true; }
                    else if (pn < 6)  { dst = (bf16_t*)(ws + RA_VA); ld = 512; dcol = (pn - 4) * 256 + bj * 128 + wc * 32; rope = false; }
                    else if (pn == 6) { dst = (bf16_t*)(ws + RA_QB); ld = 256; dcol = bj * 128 + wc * 32; rope = true; sc = QSCALE; }
                    else if (bj == 0) { dst = (bf16_t*)(ws + RA_KB); ld = 128; dcol = wc * 32; rope = true; }
                    else              { dst = (bf16_t*)(ws + RA_VB); ld = 256; dcol = (wc >> 1) * 128 + (wc & 1) * 32; rope = false; isvb = true; }
                    rope = rope && latent;
                    f32x4 x0 = acc[ai][bj][m][0], x1 = acc[ai][bj][m][1];
                    if (rope) { f32x4 p0, p1;
#pragma unroll
                        for (int j = 0; j < 4; ++j) {
                            auto s0_ = __builtin_amdgcn_permlane32_swap(__float_as_uint(x0[j]), __float_as_uint(x0[j]), false, false); p0[j] = __uint_as_float(fq < 2 ? s0_[1] : s0_[0]);
                            auto s1_ = __builtin_amdgcn_permlane32_swap(__float_as_uint(x1[j]), __float_as_uint(x1[j]), false, false); p1[j] = __uint_as_float(fq < 2 ? s1_[1] : s1_[0]); }
                        x0 = x0 * c0 + p0 * s0; x1 = x1 * c1 + p1 * s1; }
                    x0 = x0 * sc; x1 = x1 * sc;
                    bf16_t* p = dst + (size_t)row * ld + dcol + 8 * fq;
                    u32x4 w; w.x = cvt_pk_bf16(x0[0], x0[1]); w.y = cvt_pk_bf16(x0[2], x0[3]); w.z = cvt_pk_bf16(x1[0], x1[1]); w.w = cvt_pk_bf16(x1[2], x1[3]);
                    *(u32x4*)p = w;
                    if (isvb) { unsigned zz = 0u; asm volatile("" : "+v"(zz)); const u32x4 z = {zz, zz, zz, zz}; *(u32x4*)(p + 64) = z; } }
            }
    }
};
__device__ __forceinline__ void st16_wt(void* p, const u32x4 v) { asm volatile("global_store_dwordx4 %0, %1, off sc1\n\ts_nop 1" :: "v"(p), "v"(v) : "memory"); }
__device__ __forceinline__ void st4bf_wt(bf16_t* p, const f32x4 v) { u32x2 w; w.x = cvt_pk_bf16(v.x, v.y); w.y = cvt_pk_bf16(v.z, v.w); asm volatile("global_store_dwordx2 %0, %1, off sc1\n\ts_nop 0" :: "v"(p), "v"(w) : "memory"); }
struct OutOrder {
    pg8::StaticOrder in; gu32* cnt; gu32* ctxc;
    __device__ __forceinline__ bool next(int i, pg8::Unit& u) const {
        if (ctxc == nullptr) { if (i != 0) return false; return in.next(0, u); }
        const int c = blockIdx.x;
        if (c < 12) { if (i != 0) return false; u.pm = 61 + (c >> 2); u.pn = c & 3; u.aux = 0; return true; }
        if (i == 0) return in.next(0, u);
        if (i == 1 && c < 16) { u.pm = 64; u.pn = c - 12; u.aux = 0; return true; }
        return false; }
    __device__ __forceinline__ void a_ready(const pg8::Unit& u) const {
        if (ctxc != nullptr && u.pm >= 64) { for (unsigned s = 0; s < (1u << 20); ++s) { if ((unsigned)__builtin_amdgcn_readfirstlane((int)__hip_atomic_load(ctxc, __ATOMIC_RELAXED, __HIP_MEMORY_SCOPE_AGENT)) == 12u) break; __builtin_amdgcn_s_sleep(2); }
            __builtin_amdgcn_fence(__ATOMIC_ACQUIRE, "agent"); } }
    __device__ __forceinline__ void done(const pg8::Unit& u) const {
        asm volatile("s_waitcnt vmcnt(0)" ::: "memory");
        int ln; asm volatile("v_mbcnt_lo_u32_b32 %0, -1, 0\n\tv_mbcnt_hi_u32_b32 %0, -1, %0" : "=v"(ln));
        if (ln == 0) __hip_atomic_fetch_add(cnt + u.pm, 1u, __ATOMIC_RELAXED, __HIP_MEMORY_SCOPE_AGENT); }
};
struct EpiOutProj {
    static constexpr bool PERM = true, AFTER_DRAIN = false;
    const float* xin; const float* ctxin; bf16_t* XB; const float* gate_lat; const float* gate_ctx; int layer;
    __device__ __forceinline__ void operator()(const f32x4 (&acc)[2][2][4][2], const pg8::Unit& u, int wr, int wc, int fr, int fq) const {
        const bool isctx = u.pm >= 64; const float* gate = isctx ? gate_ctx : gate_lat; const int col8 = u.pn * 256 + wc * 32 + 8 * fq;
        f32x4 g[2][2];
#pragma unroll
        for (int bj = 0; bj < 2; ++bj) { g[bj][0] = *(const f32x4*)(gate + col8 + bj * 128); g[bj][1] = *(const f32x4*)(gate + col8 + bj * 128 + 4); }
        if (layer == 0) {
#pragma unroll
            for (int am = 0; am < 4; ++am) { const int ai = am >> 1, m0 = (am & 1) * 2; f32x4 x[2][2][2];
#pragma unroll
                for (int mm = 0; mm < 2; ++mm) { const int row = u.pm * 256 + ai * 128 + wr * 64 + (m0 + mm) * 16 + fr;
                    const float* xo = (isctx ? ctxin + (size_t)(row - SEQ) * DM : xin + (size_t)row * DM) + col8;
#pragma unroll
                    for (int bj = 0; bj < 2; ++bj) { x[mm][bj][0] = *(const f32x4*)(xo + bj * 128); x[mm][bj][1] = *(const f32x4*)(xo + bj * 128 + 4); } }
#pragma unroll
                for (int mm = 0; mm < 2; ++mm) { const int m = m0 + mm; const int row = u.pm * 256 + ai * 128 + wr * 64 + m * 16 + fr; bf16_t* xn = XB + (size_t)row * DM + col8;
#pragma unroll
                    for (int bj = 0; bj < 2; ++bj) { const f32x4 y0 = x[mm][bj][0] + g[bj][0] * acc[ai][bj][m][0], y1 = x[mm][bj][1] + g[bj][1] * acc[ai][bj][m][1];
                        u32x4 o; o.x = cvt_pk_bf16(y0.x, y0.y); o.y = cvt_pk_bf16(y0.z, y0.w); o.z = cvt_pk_bf16(y1.x, y1.y); o.w = cvt_pk_bf16(y1.z, y1.w);
                        st16_wt(xn + bj * 128, o); } } }
        } else {
#pragma unroll
            for (int ai = 0; ai < 2; ++ai) { u32x4 xw[4][2];
#pragma unroll
                for (int m = 0; m < 4; ++m) { const int row = u.pm * 256 + ai * 128 + wr * 64 + m * 16 + fr; const bf16_t* xn = XB + (size_t)row * DM + col8;
#pragma unroll
                    for (int bj = 0; bj < 2; ++bj) xw[m][bj] = *(const u32x4*)(xn + bj * 128); }
#pragma unroll
                for (int m = 0; m < 4; ++m) { const int row = u.pm * 256 + ai * 128 + wr * 64 + m * 16 + fr; bf16_t* xn = XB + (size_t)row * DM + col8;
#pragma unroll
                    for (int bj = 0; bj < 2; ++bj) { const u32x4 w = xw[m][bj];
                        const f32x4 x0 = {__builtin_bit_cast(float, w.x << 16), __builtin_bit_cast(float, w.x & 0xffff0000u), __builtin_bit_cast(float, w.y << 16), __builtin_bit_cast(float, w.y & 0xffff0000u)};
                        const f32x4 x1 = {__builtin_bit_cast(float, w.z << 16), __builtin_bit_cast(float, w.z & 0xffff0000u), __builtin_bit_cast(float, w.w << 16), __builtin_bit_cast(float, w.w & 0xffff0000u)};
                        const f32x4 y0 = x0 + g[bj][0] * acc[ai][bj][m][0], y1 = x1 + g[bj][1] * acc[ai][bj][m][1];
                        u32x4 o; o.x = cvt_pk_bf16(y0.x, y0.y); o.y = cvt_pk_bf16(y0.z, y0.w); o.z = cvt_pk_bf16(y1.x, y1.y); o.w = cvt_pk_bf16(y1.z, y1.w);
                        st16_wt(xn + bj * 128, o); } } }
        }
    }
};
struct EpiMoe1 {
    static constexpr bool PERM = true, AFTER_DRAIN = false;
    bf16_t* HS;
    __device__ __forceinline__ void operator()(const f32x4 (&acc)[2][2][4][2], const pg8::Unit& u, int wr, int wc, int fr, int fq) const {
        const int col8 = (u.pn & 3) * 128 + wc * 32 + 8 * fq;
#pragma unroll
        for (int ai = 0; ai < 2; ++ai)
#pragma unroll
            for (int m = 0; m < 4; ++m) { const int row = u.pm * 256 + ai * 128 + wr * 64 + m * 16 + fr;
                const f32x4 a0 = acc[ai][0][m][0], a1 = acc[ai][0][m][1], b0 = acc[ai][1][m][0], b1 = acc[ai][1][m][1];
                u32x4 w; w.x = cvt_pk_bf16(silu_f(a0[0]) * b0[0], silu_f(a0[1]) * b0[1]); w.y = cvt_pk_bf16(silu_f(a0[2]) * b0[2], silu_f(a0[3]) * b0[3]);
                w.z = cvt_pk_bf16(silu_f(a1[0]) * b1[0], silu_f(a1[1]) * b1[1]); w.w = cvt_pk_bf16(silu_f(a1[2]) * b1[2], silu_f(a1[3]) * b1[3]);
                st16_wt(HS + (size_t)row * FFE + col8, w); }
    }
};
constexpr float YS_SCALE = 16.f, YS_INV = 1.f / 16.f;
struct EpiMoe2 {
    static constexpr bool PERM = true, AFTER_DRAIN = false;
    unsigned char* YS;
    __device__ __forceinline__ void operator()(const f32x4 (&acc)[2][2][4][2], const pg8::Unit& u, int wr, int wc, int fr, int fq) const {
        const int col8 = (u.pn & 3) * 256 + wc * 32 + 8 * fq;
#pragma unroll
        for (int ai = 0; ai < 2; ++ai)
#pragma unroll
            for (int m = 0; m < 4; ++m) { const int row = u.pm * 256 + ai * 128 + wr * 64 + m * 16 + fr;
#pragma unroll
                for (int bj = 0; bj < 2; ++bj) { f32x4 v0 = acc[ai][bj][m][0] * YS_SCALE, v1 = acc[ai][bj][m][1] * YS_SCALE;
#pragma unroll
                    for (int j = 0; j < 4; ++j) { v0[j] = __builtin_amdgcn_fmed3f(v0[j], -448.f, 448.f); v1[j] = __builtin_amdgcn_fmed3f(v1[j], -448.f, 448.f); }
                    int w0 = __builtin_amdgcn_cvt_pk_fp8_f32(v0[0], v0[1], 0, false); w0 = __builtin_amdgcn_cvt_pk_fp8_f32(v0[2], v0[3], w0, true);
                    int w1 = __builtin_amdgcn_cvt_pk_fp8_f32(v1[0], v1[1], 0, false); w1 = __builtin_amdgcn_cvt_pk_fp8_f32(v1[2], v1[3], w1, true);
                    *(u32x2*)(YS + (size_t)row * DM + col8 + bj * 128) = (u32x2){(unsigned)w0, (unsigned)w1}; } }
    }
};
struct MoeOrder {
    int G, vcu, nunits; int ts[16]; const int* rowtok;
    __device__ __forceinline__ unsigned row_off(const pg8::Unit& u, int r) const { return (unsigned)min((unsigned)rowtok[u.aux + r], (unsigned)(NROW - 1)) * (unsigned)(DM * 2); }
    __device__ __forceinline__ bool next(int i, pg8::Unit& u) const {
        const int L = i * G + vcu; if (L >= nunits) return false;
        const int rt = L >> 2, ct = L & 3; int e = 0, tb = ts[0];
#pragma unroll
        for (int k = 1; k < 16; ++k) { const bool ge = rt >= ts[k]; e += ge ? 1 : 0; tb = ge ? ts[k] : tb; }
        u.pm = rt; u.pn = e * 4 + ct; u.aux = e * ROWCAP + (rt - tb) * 256; return true;
    }
    __device__ __forceinline__ int nloc() const { return vcu < nunits ? (nunits - vcu + G - 1) / G : 0; }
    __device__ __forceinline__ void a_ready(const pg8::Unit&) const {}
    __device__ __forceinline__ void done(const pg8::Unit&) const {}
};

struct MoeOrder2 {
    int vcu, nunits, part; int ts[16];
    __device__ __forceinline__ bool next(int i, pg8::Unit& u) const {
        const int U = nunits, q = U >> 8, r = U & 255; int L;
        if (part == 0) { if (vcu < r || i >= q) return false; L = i * 256 + vcu; }
        else { int b = vcu + i * 256; if (b >= (q + 1) * r) return false; int k = 0; while (b >= r) { b -= r; ++k; } L = k * 256 + b; }
        const int rt = L >> 2, ct = L & 3; int e = 0;
#pragma unroll
        for (int k = 1; k < 16; ++k) e += (rt >= ts[k]) ? 1 : 0;
        u.pm = rt; u.pn = e * 4 + ct; u.aux = 0; return true; }
    __device__ __forceinline__ void a_ready(const pg8::Unit&) const {}
    __device__ __forceinline__ void done(const pg8::Unit&) const {}
};
__device__ __forceinline__ void moe_wait(gu32* flag, int base, int n) {
    const int tid = otid();
    if (tid < 64) { for (unsigned s = 0; s < (1u << 20); ++s) { bool ok = true;
            for (int j = tid; j < n; j += 64) ok = ok && (__hip_atomic_load(flag + base + j, __ATOMIC_RELAXED, __HIP_MEMORY_SCOPE_AGENT) == 1u);
            if (__all(ok)) break; __builtin_amdgcn_s_sleep(2); }
        __builtin_amdgcn_fence(__ATOMIC_ACQUIRE, "agent"); asm volatile("s_waitcnt vmcnt(0)" ::: "memory"); }
    __syncthreads();
}

__device__ __forceinline__ void tr_item(const float* W, int ldw, int k0, int n0, bf16_t* WT, int K, int nd0, LAS float* scr, int lane) {
    f32x4 v[8];
#pragma unroll
    for (int i = 0; i < 8; ++i) v[i] = *(const f32x4*)(W + (size_t)(k0 + 8 * i + (lane >> 3)) * ldw + n0 + (lane & 7) * 4);
#pragma unroll
    for (int i = 0; i < 8; ++i) { LAS float* d = scr + (8 * i + (lane >> 3)) * 33 + (lane & 7) * 4; d[0] = v[i].x; d[1] = v[i].y; d[2] = v[i].z; d[3] = v[i].w; }
    LDS_WAIT(); asm volatile("" ::: "memory");
    const int c = lane & 7;
#pragma unroll
    for (int j = 0; j < 4; ++j) { const int n = (lane >> 3) + 8 * j; const LAS float* s = scr + (8 * c) * 33 + n;
        u32x4 o; o.x = pk2(s[0 * 33], s[1 * 33]); o.y = pk2(s[2 * 33], s[3 * 33]); o.z = pk2(s[4 * 33], s[5 * 33]); o.w = pk2(s[6 * 33], s[7 * 33]);
        *(u32x4*)(WT + (size_t)(nd0 + n) * K + k0 + 8 * c) = o; }
    LDS_WAIT(); asm volatile("" ::: "memory");
}
__device__ __forceinline__ void moe_convert(const Args& a, int L, LAS float* scr, int gw, int NGW, int lane, int it0 = 0, int it1 = 12288) {
    bf16_t* W13T = (bf16_t*)(a.ws + WS_W13) + (size_t)L * 16 * 1024 * 1024; bf16_t* W2T = (bf16_t*)(a.ws + WS_W2) + (size_t)L * 16 * 1024 * 512;
    for (int it = it0 + gw; it < it1; it += NGW) {
        if (it < 8192) { const int e = it >> 9, r2 = it & 511, kb = r2 >> 5, nb = r2 & 31, nd0 = 32 * nb, t = nd0 >> 8, bj = (nd0 >> 7) & 1, i0 = nd0 & 127;
            const float* src = (bj ? a.in[I_W3] : a.in[I_W1]) + (size_t)(L * 16 + e) * 1024 * 512;
            tr_item(src, 512, 64 * kb, t * 128 + i0, W13T + (size_t)e * 1024 * 1024, 1024, nd0, scr, lane); }
        else { const int r = it - 8192, e = r >> 8, r2 = r & 255, kb = r2 >> 5, nb = r2 & 31;
            tr_item(a.in[I_W2] + (size_t)(L * 16 + e) * 512 * 1024, 1024, 64 * kb, 32 * nb, W2T + (size_t)e * 1024 * 512, 512, 32 * nb, scr, lane); }
    }
}
__device__ __forceinline__ void prologue_phase(const Args& a, unsigned char* lds) {
    const int tid = otid(), lane = tid & 63, wave = tid >> 6, gw = blockIdx.x * NWAVES + wave, NGW = gridDim.x * NWAVES;
    LAS float* scr = (LAS float*)((LAS unsigned char*)lds + wave * 8704);
    bf16_t* WinT = (bf16_t*)(a.ws + WS_WIN); bf16_t* WoutT = (bf16_t*)(a.ws + WS_WOUT);
    for (int it = gw; it < 3584; it += NGW) {
        if (it < 2560) { const int L = it / 1280, r = it % 1280, kb = r / 80, nb = r % 80, nd0 = 32 * nb; int n0 = nd0;
            if (nd0 >= 2048) { const int q = nd0 - 2048, t = q >> 8, bj = (q >> 7) & 1, i0 = q & 127; n0 = 2048 + bj * 256 + t * 128 + i0; }
            tr_item(a.in[I_WIN] + (size_t)L * 1024 * INW, INW, 64 * kb, n0, WinT + (size_t)L * INW * 1024, 1024, nd0, scr, lane); }
        else { const int r0 = it - 2560, L = r0 >> 9, r = r0 & 511, kb = r >> 5, nb = r & 31;
            tr_item(a.in[I_WOUT] + (size_t)L * 1024 * 1024, 1024, 64 * kb, 32 * nb, WoutT + (size_t)L * 1024 * 1024, 1024, 32 * nb, scr, lane); }
    }
    moe_convert(a, 0, scr, gw, NGW, lane, 0, 8192);
    __syncthreads();
    float* sc = (float*)(lds + 71680); float* scc = sc + 1024; float* red = scc + 1024;
    float* MOD = (float*)(a.ws + WS_MOD);
    for (int u = blockIdx.x; u < 192; u += gridDim.x) {
        const int L = u / 96, col0 = (u % 96) * 64;
        for (int k = tid; k < 1024; k += NTHREADS) { const float c = a.in[I_C][k], cc = a.in[I_CCTX][k]; sc[k] = c / (1.f + expf(-c)); scc[k] = cc / (1.f + expf(-cc)); }
        __syncthreads();
        const int cg = tid & 15, ks = tid >> 4;
        const float* w = a.in[I_WADA] + ((size_t)L * 1024 + ks * 32) * 6144 + col0 + cg * 4;
        f32x4 s1 = {0.f, 0.f, 0.f, 0.f}, s2 = {0.f, 0.f, 0.f, 0.f};
#pragma unroll 8
        for (int k = 0; k < 32; ++k) { const f32x4 wv = *(const f32x4*)(w + (size_t)k * 6144); s1 = s1 + wv * sc[ks * 32 + k]; s2 = s2 + wv * scc[ks * 32 + k]; }
        *(f32x4*)(red + (ks * 16 + cg) * 8) = s1; *(f32x4*)(red + (ks * 16 + cg) * 8 + 4) = s2;
        __syncthreads();
        if (tid < 128) { const int which = tid >> 6, c = tid & 63; float s = 0.f;
            for (int k = 0; k < 32; ++k) s += red[(k * 16 + (c >> 2)) * 8 + which * 4 + (c & 3)];
            MOD[(L * 2 + which) * 6144 + col0 + c] = s + a.in[I_BADA][L * 6144 + col0 + c]; }
        __syncthreads();
    }
    if (blockIdx.x >= 192 && tid < 64) {
        float* rc = (float*)(a.ws + WS_ROPEC); float* rs = (float*)(a.ws + WS_ROPES);
        const int i = ((int)blockIdx.x - 192) * 64 + tid; const int pos = i >> 4, f = i & 15; const float inv = powf(10000.f, -(float)f / 16.f), ang = (float)pos * inv; rc[i] = cosf(ang); rs[i] = sinf(ang);
    }
    if (blockIdx.x == gridDim.x - 2 && wave < 2) {
        const float* dl = a.in[I_DLAM] + wave * 256;
        const float s01 = wave_sum(dl[lane] * dl[64 + lane]), s23 = wave_sum(dl[128 + lane] * dl[192 + lane]);
        if (lane == 0) ((float*)(a.ws + WS_LAM))[wave] = expf(s01) - expf(s23) + LAMBDA_INIT[wave];
    }
}

__device__ __forceinline__ void norm1_phase(const Args& a, int l) {
    constexpr int NR = 4;
    const int tid = otid(), lane = tid & 63, wave = tid >> 6;
    const int nrows = (l == 2) ? SEQ : NROW, rpw = (nrows + gridDim.x - 1) / gridDim.x, r0 = blockIdx.x * rpw, r1 = min(nrows, r0 + rpw);
    const int rw = (rpw + NWAVES - 1) / NWAVES, wr0 = r0 + wave * rw, wr1 = min(r1, wr0 + rw);
    bf16_t* XB = (bf16_t*)(a.ws + WS_XB); bf16_t* HB = (bf16_t*)(a.ws + WS_HB); const unsigned char* YS = a.ws + WS_RA;
    const float* MOD = (const float*)(a.ws + WS_MOD);
    const int2* TOKP = (const int2*)(a.ws + WS_TOKP); const float2* TOKW = (const float2*)(a.ws + WS_TOKW);
    for (int rb = wr0; rb < wr1; rb += NR) {
        f32x4 v[NR][4]; int rowk[NR];
#pragma unroll
        for (int k = 0; k < NR; ++k) rowk[k] = min(rb + k, wr1 - 1);
        if (l == 0) {
#pragma unroll
            for (int k = 0; k < NR; ++k) { const int row = rowk[k]; const bool isctx = row >= SEQ;
                const f32x4* src = (const f32x4*)(isctx ? a.in[I_CTX] + (size_t)(row - SEQ) * DM : a.in[I_X] + (size_t)row * DM) + lane;
#pragma unroll
                for (int j = 0; j < 4; ++j) v[k][j] = src[64 * j]; }
        } else {
            int2 pp[NR]; float2 ww[NR];
#pragma unroll
            for (int k = 0; k < NR; ++k) { pp[k] = TOKP[rowk[k]]; ww[k] = TOKW[rowk[k]]; }
            { const int* tsg = (const int*)(a.ws + WS_TSG) + (l - 1) * 32;
#pragma unroll
              for (int k = 0; k < NR; ++k) { pp[k].x = tsg[pp[k].x >> 15] * 256 + (pp[k].x & 32767); pp[k].y = tsg[pp[k].y >> 15] * 256 + (pp[k].y & 32767); } }
            unsigned y0[NR][4], y1[NR][4]; f32x4 gt[NR][4];
#pragma unroll
            for (int k = 0; k < NR; ++k) { const int row = rowk[k]; const bool isctx = row >= SEQ;
                const bf16_t* xb = XB + (size_t)row * DM + 4 * lane;
                const f32x4* gate = (const f32x4*)(MOD + ((l - 1) * 2 + (isctx ? 1 : 0)) * 6144 + 5 * 1024) + lane;
                const unsigned* q0 = (const unsigned*)(YS + (size_t)pp[k].x * DM) + lane; const unsigned* q1 = (const unsigned*)(YS + (size_t)pp[k].y * DM) + lane;
#pragma unroll
                for (int j = 0; j < 4; ++j) { v[k][j] = ld4bf(xb + 256 * j); gt[k][j] = gate[64 * j]; y0[k][j] = q0[64 * j]; y1[k][j] = q1[64 * j]; } }
#pragma unroll
            for (int k = 0; k < NR; ++k) { const bool st = (rb + k < wr1) && (l < 2); bf16_t* xb = XB + (size_t)rowk[k] * DM + 4 * lane;
#pragma unroll
                for (int j = 0; j < 4; ++j) { const int p0 = (int)y0[k][j], p1 = (int)y1[k][j];
                    const auto a01 = __builtin_amdgcn_cvt_pk_f32_fp8(p0, false), a23 = __builtin_amdgcn_cvt_pk_f32_fp8(p0, true), b01 = __builtin_amdgcn_cvt_pk_f32_fp8(p1, false), b23 = __builtin_amdgcn_cvt_pk_f32_fp8(p1, true);
                    const f32x4 ya = {a01[0], a01[1], a23[0], a23[1]}, yb = {b01[0], b01[1], b23[0], b23[1]};
                    v[k][j] = v[k][j] + gt[k][j] * (ya * (ww[k].x * YS_INV) + yb * (ww[k].y * YS_INV));
                    if (st) st4bf(xb + 256 * j, v[k][j]); } }
        }
#pragma unroll
        for (int k = 0; k < NR; ++k) { const int row = rowk[k]; const bool isctx = row >= SEQ, st = rb + k < wr1;
            float ss = 0.f;
#pragma unroll
            for (int j = 0; j < 4; ++j) ss += (v[k][j].x * v[k][j].x + v[k][j].y * v[k][j].y) + (v[k][j].z * v[k][j].z + v[k][j].w * v[k][j].w);
            const float rstd = 1.f / sqrtf(wave_sum(ss) * (1.f / DM) + EPS);
            if (l < 2) {
                const f32x4* g = (const f32x4*)(a.in[I_GMIX] + l * DM) + lane; const float* md = MOD + (l * 2 + (isctx ? 1 : 0)) * 6144;
                const f32x4* sh = (const f32x4*)(md) + lane; const f32x4* sl = (const f32x4*)(md + 1024) + lane;
                u32x2* o8 = (u32x2*)(HB + (size_t)row * DM) + lane;
#pragma unroll
                for (int j = 0; j < 4; ++j) { const f32x4 h = v[k][j] * rstd * g[64 * j] * (sl[64 * j] + 1.f) + sh[64 * j];
                    u32x2 w; w.x = cvt_pk_bf16(h.x, h.y); w.y = cvt_pk_bf16(h.z, h.w); if (st) o8[64 * j] = w; }
            } else {
                const f32x4* g = (const f32x4*)(a.in[I_GFIN]) + lane; f32x4* o = (f32x4*)(a.out + (size_t)row * DM) + lane;
#pragma unroll
                for (int j = 0; j < 4; ++j) { const f32x4 r = v[k][j] * rstd * g[64 * j]; if (st) o[64 * j] = r; }
            }
        }
    }
}
__device__ __forceinline__ void norm2_phase(const Args& a, int l, unsigned char* lds) {
    const int tid = otid(), lane = tid & 63, wave = tid >> 6;
    const int b_ = blockIdx.x;
    const int nlat = (l == 1) ? 64 : (b_ < 16 ? 1 : 65), lat0 = (l == 1) ? b_ * 64 : (b_ < 16 ? 240 * 65 + b_ : (b_ - 16) * 65);
    const int nlate = (l == 1) ? 0 : 4, late0 = 61 * 256 + 4 * b_, tl = 61 + (b_ >> 6), nloc = nlat + nlate;
#define N2_ROW(i) ((i) < nlat ? lat0 + (i) : late0 + ((i) - nlat))
    float* hrow = (float*)lds;
    float* logit = (float*)(lds + 65536);
    int* e01 = (int*)(lds + 65536 + 8192);
    for (int i = tid; i < 128; i += NTHREADS) e01[i] = -1;
    gu32* cnt = (gu32*)(a.ws + WS_CTL) + CW_OPC + l * 128;
#define N2_WAIT(ta_, tb_) do { if (tid < 64) { for (unsigned s = 0; s < (1u << 20); ++s) { const unsigned c = __hip_atomic_load(cnt + ((lane & 1) ? (tb_) : (ta_)), __ATOMIC_RELAXED, __HIP_MEMORY_SCOPE_AGENT); \
              if (__all(c == 32u)) break; __builtin_amdgcn_s_sleep(2); } \
          __builtin_amdgcn_fence(__ATOMIC_ACQUIRE, "agent"); asm volatile("s_waitcnt vmcnt(0)" ::: "memory"); } \
      __syncthreads(); } while (0)
    N2_WAIT(lat0 >> 8, (lat0 + nlat - 1) >> 8);
    const bf16_t* XB = (const bf16_t*)(a.ws + WS_XB); bf16_t* HB = (bf16_t*)(a.ws + WS_HB); const float* MOD = (const float*)(a.ws + WS_MOD);
    int2* TOKE = (int2*)(a.ws + WS_TOKE); float2* TOKW = (float2*)(a.ws + WS_TOKW);
    const int eg = wave & 3, rh = wave >> 2;
    f32x4 wk[4][4];
#pragma unroll
    for (int j = 0; j < 4; ++j)
#pragma unroll
        for (int c = 0; c < 4; ++c) wk[j][c] = *(const f32x4*)(a.in[I_RW] + (size_t)(256 * j + 4 * lane + c) * 16 + 4 * eg);
    const f32x4* g = (const f32x4*)(a.in[I_GFFN] + l * DM) + lane;
    u32x2 xr[2][4];
#define N2_LOADX(rb_) do { _Pragma("unroll") for (int k = 0; k < 2; ++k) { const bf16_t* xb = XB + (size_t)N2_ROW(min((rb_) + 2 * wave + k, nloc - 1)) * DM + 4 * lane; \
        _Pragma("unroll") for (int j = 0; j < 4; ++j) xr[k][j] = *(const u32x2*)(xb + 256 * j); } } while (0)
    const bool cfirst = (l != 1) && nlat < 16;
    if (cfirst) N2_WAIT(tl, tl);
    N2_LOADX(0);
    for (int rb = 0; rb < nloc; rb += 16) {
        if ((l != 1) && !cfirst && rb <= nlat && nlat < rb + 16) { N2_WAIT(tl, tl); N2_LOADX(rb); }
        f32x4 vv[2][4];
#pragma unroll
        for (int k = 0; k < 2; ++k)
#pragma unroll
            for (int j = 0; j < 4; ++j) { const u32x2 w = xr[k][j]; vv[k][j] = (f32x4){__builtin_bit_cast(float, w.x << 16), __builtin_bit_cast(float, w.x & 0xffff0000u), __builtin_bit_cast(float, w.y << 16), __builtin_bit_cast(float, w.y & 0xffff0000u)}; }
#pragma unroll
        for (int k = 0; k < 2; ++k) { const int row = N2_ROW(min(rb + 2 * wave + k, nloc - 1)); const bool isctx = row >= SEQ, st = rb + 2 * wave + k < nloc;
            float ss = 0.f;
#pragma unroll
            for (int j = 0; j < 4; ++j) ss += (vv[k][j].x * vv[k][j].x + vv[k][j].y * vv[k][j].y) + (vv[k][j].z * vv[k][j].z + vv[k][j].w * vv[k][j].w);
            const float rstd = 1.f / sqrtf(wave_sum(ss) * (1.f / DM) + EPS);
            const float* md = MOD + (l * 2 + (isctx ? 1 : 0)) * 6144;
            const f32x4* sh = (const f32x4*)(md + 3 * 1024) + lane; const f32x4* sl = (const f32x4*)(md + 4 * 1024) + lane;
            u32x2* o8 = (u32x2*)(HB + (size_t)row * DM) + lane; f32x4* hr = (f32x4*)(hrow + (2 * wave + k) * 1024) + lane;
#pragma unroll
            for (int j = 0; j < 4; ++j) { const f32x4 h = vv[k][j] * rstd * g[64 * j] * (sl[64 * j] + 1.f) + sh[64 * j];
                hr[64 * j] = h; u32x2 w; w.x = cvt_pk_bf16(h.x, h.y); w.y = cvt_pk_bf16(h.z, h.w); if (st) o8[64 * j] = w; } }
        __syncthreads();
        if (rb + 16 < nloc && !((l != 1) && rb + 16 <= nlat && nlat < rb + 32)) N2_LOADX(rb + 16);
        float v32[32];
#pragma unroll
        for (int q = 0; q < 8; ++q) { const f32x4* hr = (const f32x4*)(hrow + (rh * 8 + q) * 1024) + lane; f32x4 acc = {0.f, 0.f, 0.f, 0.f};
#pragma unroll
            for (int j = 0; j < 4; ++j) { const f32x4 h = hr[64 * j];
#pragma unroll
                for (int e = 0; e < 4; ++e) { acc[e] = __builtin_fmaf(h.x, wk[j][0][e], acc[e]); acc[e] = __builtin_fmaf(h.y, wk[j][1][e], acc[e]); acc[e] = __builtin_fmaf(h.z, wk[j][2][e], acc[e]); acc[e] = __builtin_fmaf(h.w, wk[j][3][e], acc[e]); } }
            v32[q * 4] = acc[0]; v32[q * 4 + 1] = acc[1]; v32[q * 4 + 2] = acc[2]; v32[q * 4 + 3] = acc[3]; }
        float v16[16], v8[8], v4[4], v2[2], v1;
#pragma unroll
        for (int i = 0; i < 16; ++i) { const bool up = (lane & 32) != 0; v16[i] = (up ? v32[16 + i] : v32[i]) + __shfl_xor(up ? v32[i] : v32[16 + i], 32); }
#pragma unroll
        for (int i = 0; i < 8; ++i) { const bool up = (lane & 16) != 0; v8[i] = (up ? v16[8 + i] : v16[i]) + __shfl_xor(up ? v16[i] : v16[8 + i], 16); }
#pragma unroll
        for (int i = 0; i < 4; ++i) { const bool up = (lane & 8) != 0; v4[i] = (up ? v8[4 + i] : v8[i]) + __shfl_xor(up ? v8[i] : v8[4 + i], 8); }
#pragma unroll
        for (int i = 0; i < 2; ++i) { const bool up = (lane & 4) != 0; v2[i] = (up ? v4[2 + i] : v4[i]) + __shfl_xor(up ? v4[i] : v4[2 + i], 4); }
        { const bool up = (lane & 2) != 0; v1 = (up ? v2[1] : v2[0]) + __shfl_xor(up ? v2[0] : v2[1], 2); }
        v1 += __shfl_xor(v1, 1);
        { const int I = (lane >> 1) & 31, q = I >> 2, e = I & 3; const int rl = rh * 8 + q;
          if ((lane & 1) == 0 && rb + rl < nloc) logit[(rb + rl) * 16 + 4 * eg + e] = v1; }
        __syncthreads();
    }
#undef N2_LOADX
#undef N2_WAIT
    if (wave < 2) { const int rowl = wave * 64 + lane, row = N2_ROW(rowl);
      if (rowl < nloc) {
        float lg[16];
#pragma unroll
        for (int q = 0; q < 4; ++q) { const f32x4 t = *(const f32x4*)(logit + rowl * 16 + 4 * q); lg[4 * q] = t.x; lg[4 * q + 1] = t.y; lg[4 * q + 2] = t.z; lg[4 * q + 3] = t.w; }
        float sg[16], bs[16];
#pragma unroll
        for (int e = 0; e < 16; ++e) { sg[e] = sigmoid_f(lg[e]); bs[e] = sg[e] + a.in[I_RB][e]; }
        int gsel = 0; float best = 0.f;
#pragma unroll
        for (int gi = 0; gi < 4; ++gi) { const float p_ = bs[4 * gi], q_ = bs[4 * gi + 1], r_ = bs[4 * gi + 2], s_ = bs[4 * gi + 3];
            const float h1 = fmaxf(p_, q_), l1 = fminf(p_, q_), h2 = fmaxf(r_, s_), l2 = fminf(r_, s_);
            const float gsc = fmaxf(h1, h2) + fmaxf(fminf(h1, h2), fmaxf(l1, l2));
            if (gi == 0 || gsc > best) { best = gsc; gsel = gi; } }
        float gb[4], gs4[4];
#pragma unroll
        for (int i = 0; i < 4; ++i) { gb[i] = gsel == 0 ? bs[i] : gsel == 1 ? bs[4 + i] : gsel == 2 ? bs[8 + i] : bs[12 + i];
            gs4[i] = gsel == 0 ? sg[i] : gsel == 1 ? sg[4 + i] : gsel == 2 ? sg[8 + i] : sg[12 + i]; }
        int i0 = 0; float b0 = gb[0];
#pragma unroll
        for (int i = 1; i < 4; ++i) if (gb[i] > b0) { b0 = gb[i]; i0 = i; }
        int i1 = -1; float b1 = 0.f;
#pragma unroll
        for (int i = 0; i < 4; ++i) if (i != i0 && (i1 < 0 || gb[i] > b1)) { b1 = gb[i]; i1 = i; }
        const float s0 = i0 == 0 ? gs4[0] : i0 == 1 ? gs4[1] : i0 == 2 ? gs4[2] : gs4[3];
        const float s1 = i1 == 0 ? gs4[0] : i1 == 1 ? gs4[1] : i1 == 2 ? gs4[2] : gs4[3];
        const int e0 = gsel * 4 + i0, e1 = gsel * 4 + i1; const float inv = 1.f / (s0 + s1);
        TOKE[row] = make_int2(e0, e1); TOKW[row] = make_float2(s0 * inv, s1 * inv); e01[rowl] = e0 | (e1 << 8);
      } }
    __syncthreads();
    if (wave == 0) {
        int cnt = 0;
        for (int p = 0; p < 2; ++p) { const int pk = e01[p * 64 + lane]; const int e0 = pk < 0 ? -1 : (pk & 255), e1 = pk < 0 ? -1 : (pk >> 8);
#pragma unroll
            for (int e = 0; e < 16; ++e) { const int c = __popcll(__ballot(e0 == e)) + __popcll(__ballot(e1 == e)); if (lane == e) cnt += c; } }
        int base = 0;
        if (lane < 16) base = (int)__hip_atomic_fetch_add((unsigned*)(a.ws + WS_CTL) + CW_TOT + l * 64 + lane, (unsigned)cnt, __ATOMIC_RELAXED, __HIP_MEMORY_SCOPE_AGENT);
        int run[16];
#pragma unroll
        for (int e = 0; e < 16; ++e) run[e] = __builtin_amdgcn_readlane(base, e);
        int2* TOKP = (int2*)(a.ws + WS_TOKP); int* ROWTOK2 = (int*)(a.ws + WS_ROWTOK2) + (size_t)l * 16 * ROWCAP;
        for (int p = 0; p < 2; ++p) { const int i = p * 64 + lane, row = N2_ROW(i); const int pk = e01[i]; const bool ok = pk >= 0;
            const int ex = ok ? (pk & 255) : -1, ey = ok ? (pk >> 8) : -1;
            int pos0 = 0, pos1 = 0; const unsigned long long lt = (1ull << lane) - 1ull;
#pragma unroll
            for (int e = 0; e < 16; ++e) { const unsigned long long m0 = __ballot(ex == e), m1 = __ballot(ey == e);
                if (ex == e) pos0 = run[e] + __popcll(m0 & lt);
                if (ey == e) pos1 = run[e] + __popcll(m0) + __popcll(m1 & lt);
                run[e] += __popcll(m0) + __popcll(m1); }
            if (ok) { TOKP[row] = make_int2(ex * 32768 + pos0, ey * 32768 + pos1); ROWTOK2[ex * ROWCAP + pos0] = row; ROWTOK2[ey * ROWCAP + pos1] = row; } }
    }
    __syncthreads();
#undef N2_ROW
}
#ifndef ATT
#define ATT att2
#endif
#ifndef REP_INPROJ
#define REP_INPROJ 1
#endif
#ifndef REP_ATTN
#define REP_ATTN 1
#endif
#ifndef REP_OUTPROJ
#define REP_OUTPROJ 1
#endif
#ifndef REP_N2SC
#define REP_N2SC 1
#endif
#ifndef REP_MOE
#define REP_MOE 1
#endif
template <class Inner> struct RepOrder { Inner in; int ntot;
    __device__ __forceinline__ bool next(int i, pg8::Unit& u) const { if (i >= ntot) return false; const int nl = in.nloc(); return in.next(i % nl, u); }
    __device__ __forceinline__ unsigned row_off(int r) const { return in.row_off(r); }
    __device__ __forceinline__ void a_ready(const pg8::Unit&) const {}
    __device__ __forceinline__ void done(const pg8::Unit&) const {} };

__device__ __forceinline__ bool wg_any(bool pred, int* ws, int wid, int lane) {
    const int w = __any(pred) ? 1 : 0;
    __syncthreads();
    if (lane == 0) ws[wid] = w;
    __syncthreads();
    int r = 0;
#pragma unroll
    for (int i = 0; i < NWAVES; ++i) r |= ws[i];
    __syncthreads();
    return r != 0;
}
__device__ __forceinline__ void diff_unit(const Args& a, int l, int qt, int head, char* lds) {
    int tid_ = otid();
    const int tid = tid_, wid = tid >> 6, lane = tid & 63;
    const bool isctx = qt >= 64; const int q0 = qt * 256, nA = isctx ? 4 : 260, a0 = isctx ? SEQ : 0;
    const bf16_t* QA = (const bf16_t*)(a.ws + RA_QA); const bf16_t* KA = (const bf16_t*)(a.ws + RA_KA); const bf16_t* VA = (const bf16_t*)(a.ws + RA_VA);
    bf16_t* MIX = (bf16_t*)(a.ws + WS_HB);
    float* stash0 = (float*)(a.ws + WS_RB) + (size_t)blockIdx.x * 256 * 128;
    float* wsf = (float*)(lds + ATT::LDS_WS) + wid * 64;
    const float lam = ((const float*)(a.ws + WS_LAM))[l], post = 1.f - LAMBDA_INIT[l];
    for (int map = 0; map < 2; ++map) {
        f32x16 o[4]; float m_, l_;
        const bf16_t* Qw_ = QA + (size_t)(q0 + wid * 32 + (lane & 31)) * 512 + head * 128 + map * 64;
        ATT::attn_body<0, 512, 512, false>(Qw_, KA + head * 128 + map * 64, VA + head * 128, nA, a0, 0, nA, 0, lds, tid, o, m_, l_);
        if (wg_any(!(l_ < 1.0e18f), (int*)(lds + ATT::LDS_WS) + 8 * 64, wid, lane)) {
            ATT::attn_body<0, 512, 512, true>(Qw_, KA + head * 128 + map * 64, VA + head * 128, nA, a0, 0, nA, 0, lds, tid, o, m_, l_); }
        int lo_ = lane; asm volatile("" : "+v"(lo_));
        const int r32 = lo_ & 31, hi = lo_ >> 5;
        float* stashv = stash0 + (size_t)((wid << 6) | lo_) * 4;
        if (hi == 0) wsf[r32] = l_;
        LDS_WAIT();
        float rli[16];
#pragma unroll
        for (int r = 0; r < 16; ++r) rli[r] = __builtin_amdgcn_rcpf(wsf[ATT::crow(r, hi)]);
        if (map == 0) {
#pragma unroll
            for (int d0 = 0; d0 < 4; ++d0)
#pragma unroll
                for (int rq = 0; rq < 4; ++rq) *(f32x4*)(stashv + (size_t)((d0 * 4 + rq) * NTHREADS) * 4) =
                    (f32x4){o[d0][4 * rq] * rli[4 * rq], o[d0][4 * rq + 1] * rli[4 * rq + 1], o[d0][4 * rq + 2] * rli[4 * rq + 2], o[d0][4 * rq + 3] * rli[4 * rq + 3]};
        } else {
            const float* gn = a.in[I_DNG] + l * 128;
            float g4[4];
#pragma unroll
            for (int d0 = 0; d0 < 4; ++d0) g4[d0] = gn[d0 * 32 + r32] * post;
            float ss[16];
#pragma unroll
            for (int r = 0; r < 16; ++r) ss[r] = 0.f;
#pragma unroll
            for (int d0 = 0; d0 < 4; ++d0)
#pragma unroll
                for (int rq = 0; rq < 4; ++rq) { const f32x4 sv = *(const f32x4*)(stashv + (size_t)((d0 * 4 + rq) * NTHREADS) * 4);
#pragma unroll
                    for (int j = 0; j < 4; ++j) { const int r = 4 * rq + j; const float oc = sv[j] - lam * (o[d0][r] * rli[r]); o[d0][r] = oc; ss[r] += oc * oc; } }
            float s8[8], s4[4], s2[2], s1;
#pragma unroll
            for (int i = 0; i < 8; ++i) { const bool up = (lo_ & 16) != 0; s8[i] = (up ? ss[8 + i] : ss[i]) + __shfl_xor(up ? ss[i] : ss[8 + i], 16); }
#pragma unroll
            for (int i = 0; i < 4; ++i) { const bool up = (lo_ & 8) != 0; s4[i] = (up ? s8[4 + i] : s8[i]) + __shfl_xor(up ? s8[i] : s8[4 + i], 8); }
#pragma unroll
            for (int i = 0; i < 2; ++i) { const bool up = (lo_ & 4) != 0; s2[i] = (up ? s4[2 + i] : s4[i]) + __shfl_xor(up ? s4[i] : s4[2 + i], 4); }
            { const bool up = (lo_ & 2) != 0; s1 = (up ? s2[1] : s2[0]) + __shfl_xor(up ? s2[0] : s2[1], 2); }
            s1 += __shfl_xor(s1, 1);
            LDS_WAIT();
            if ((lo_ & 1) == 0) wsf[hi * 16 + ((lo_ >> 1) & 15)] = s1;
            LDS_WAIT();
#pragma unroll
            for (int r = 0; r < 16; ++r) { const float sc = __builtin_amdgcn_rsqf(wsf[hi * 16 + r] * (1.f / 128.f) + EPS);
                bf16_t* orow = MIX + (size_t)(q0 + wid * 32 + ATT::crow(r, hi)) * DM + head * 128 + r32;
#pragma unroll
                for (int d0 = 0; d0 < 4; ++d0) orow[d0 * 32] = (bf16_t)f2bf(o[d0][r] * sc * g4[d0]); }
        }
    }
}
__device__ __forceinline__ void win_unit(const Args& a, int l, int n, int g, char* lds) {
    int tid_ = otid();
    const int tid = tid_, wid = tid >> 6, lane = tid & 63;
    const bool isctx = n >= 128; const int h = 2 * g + (wid >> 2);
    const int rowq = (isctx ? SEQ + (n - 128) * 128 : n * 128) + (wid & 3) * 32;
    const int nB = isctx ? 0 : (6 - (n == 0 ? 2 : 0) - (n == 127 ? 2 : 0)), b0 = (n == 0) ? 0 : (n - 1) * 128;
    const bf16_t* QB = (const bf16_t*)(a.ws + RA_QB); const bf16_t* KB = (const bf16_t*)(a.ws + RA_KB); const bf16_t* VB = (const bf16_t*)(a.ws + RA_VB);
    bf16_t* MIX = (bf16_t*)(a.ws + WS_HB);
    float* wsf = (float*)(lds + ATT::LDS_WS) + wid * 64;
    f32x16 o[4]; float m_, l_;
    const bf16_t* Qw_ = QB + (size_t)(rowq + (lane & 31)) * 256 + h * 64;
    ATT::attn_body<1, 128, 256, false>(Qw_, KB + g * 64, VB + g * 128, 4, SEQ, b0, 4 + nB, rowq + (lane & 31), lds, tid, o, m_, l_);
    if (wg_any(!(l_ < 1.0e18f), (int*)(lds + ATT::LDS_WS) + 8 * 64, wid, lane)) {
        ATT::attn_body<1, 128, 256, true>(Qw_, KB + g * 64, VB + g * 128, 4, SEQ, b0, 4 + nB, rowq + (lane & 31), lds, tid, o, m_, l_); }
    const float ltot = l_ + __builtin_amdgcn_exp2f(a.in[I_SINK][l * 4 + h] * LOG2E - m_);
    int lo_ = lane; asm volatile("" : "+v"(lo_));
    const int r32 = lo_ & 31, hi = lo_ >> 5;
    if (hi == 0) wsf[r32] = ltot;
    LDS_WAIT();
#pragma unroll
    for (int r = 0; r < 16; ++r) { const float rl = __builtin_amdgcn_rcpf(wsf[ATT::crow(r, hi)]);
        bf16_t* orow = MIX + (size_t)(rowq + ATT::crow(r, hi)) * DM + 512 + h * 64 + r32;
        orow[0] = (bf16_t)f2bf(o[0][r] * rl); orow[32] = (bf16_t)f2bf(o[1][r] * rl); }
}
__device__ __forceinline__ void conv_unit(const Args& a, int l, int u, char* lds) {
    int tid_ = otid();
    const int tid = tid_, wid = tid >> 6, lane = tid & 63;
    const bool isctx = u >= 256; const int r0 = isctx ? (u - 256) * 64 : u * 64, rbase = isctx ? SEQ : 0, slen = isctx ? CTX : SEQ;
    const bf16_t* Z = (const bf16_t*)(a.ws + RA_Z); bf16_t* MIX = (bf16_t*)(a.ws + WS_HB);
    bf16_t* zt = (bf16_t*)lds; float* co = (float*)(lds + 49152);
    __syncthreads();
    for (int c = tid; c < 94 * 32; c += NTHREADS) { const int i = c >> 5, ch = c & 31, p = r0 - 15 + i;
        u32x4 v = {0u, 0u, 0u, 0u}; if (p >= 0 && p < slen) v = *(const u32x4*)(Z + (size_t)(rbase + p) * 256 + ch * 8);
        *(u32x4*)(zt + i * 256 + ch * 8) = v; }
    __syncthreads();
    { const int c = tid & 255, t0 = (tid >> 8) * 32; float w[31];
#pragma unroll
      for (int j = 0; j < 31; ++j) w[j] = a.in[I_CONVW][(size_t)(l * 31 + j) * 256 + c];
      const float bias = a.in[I_CONVB][l * 256 + c];
#pragma unroll
      for (int tb = 0; tb < 32; tb += 8) {
          float zr[38];
#pragma unroll
          for (int i = 0; i < 38; ++i) zr[i] = bf2f(zt[(t0 + tb + i) * 256 + c]);
#pragma unroll
          for (int t = 0; t < 8; ++t) { float acc = bias;
#pragma unroll
              for (int j = 0; j < 31; ++j) acc += zr[t + j] * w[j];
              co[(t0 + tb + t) * 256 + c] = acc; } } }
    __syncthreads();
    const f32x4 lg = *(const f32x4*)(a.in[I_LNG] + l * 256 + 4 * lane), lb = *(const f32x4*)(a.in[I_LNB] + l * 256 + 4 * lane);
#pragma unroll
    for (int ti = 0; ti < 8; ++ti) { const int t = wid + ti * NWAVES; const f32x4 v = *(const f32x4*)(co + t * 256 + 4 * lane);
        const float mu = wave_sum((v.x + v.y) + (v.z + v.w)) * (1.f / 256.f); const f32x4 d = v - mu;
        const float var = wave_sum((d.x * d.x + d.y * d.y) + (d.z * d.z + d.w * d.w)) * (1.f / 256.f); const float rs = 1.f / sqrtf(var + EPS);
        const f32x4 zn = d * rs * lg + lb;
        u32x2 w; w.x = cvt_pk_bf16(silu_f(zn.x), silu_f(zn.y)); w.y = cvt_pk_bf16(silu_f(zn.z), silu_f(zn.w));
        *(u32x2*)(MIX + (size_t)(rbase + r0 + t) * DM + 768 + 4 * lane) = w; }
    __syncthreads();
}
__device__ __forceinline__ void attn_phase(const Args& a, int l, char* lds, int pass) {
    const int b = blockIdx.x, G = gridDim.x, BIG = 1 << 20;
#ifndef AT_MASK
#define AT_MASK 7
#endif
    const int dst = pass == 0 ? b : (b < 4) ? 256 + b : BIG, wst = pass == 0 ? b : (b >= 4 && b < 8) ? 256 + (b - 4) : BIG, cst = pass == 0 ? b : (b >= 8 && b < 12) ? 256 + (b - 8) : BIG;
    const int uend = pass == 0 ? 256 : 260;
    if (AT_MASK & 1) for (int u = dst; u < uend; u += G) { const int qt = u < 256 ? (u >> 2) : 64, hd = u < 256 ? (u & 3) : (u - 256); diff_unit(a, l, qt, hd, lds); }
    if (AT_MASK & 2) for (int v = wst; v < uend; v += G) { const int n = v < 256 ? (v & 127) : 128 + ((v - 256) & 1), g = v < 256 ? (v >> 7) : ((v - 256) >> 1); win_unit(a, l, n, g, lds); }
    if (AT_MASK & 4) for (int v = cst; v < uend; v += G) conv_unit(a, l, v, lds);
    if (pass == 1 && b < 12) {
        asm volatile("s_waitcnt vmcnt(0)" ::: "memory"); __syncthreads();
        const int tid = otid(); if (tid < 64) { __builtin_amdgcn_fence(__ATOMIC_RELEASE, "agent"); asm volatile("s_waitcnt vmcnt(0)" ::: "memory");
            if (tid == 0) __hip_atomic_fetch_add((gu32*)(a.ws + WS_CTL) + CW_CTXC, 1u, __ATOMIC_RELAXED, __HIP_MEMORY_SCOPE_AGENT); } }
}

#ifndef MK_PER_PHASE
#define MK_PER_PHASE 0
#endif
#if defined(__HIP_DEVICE_COMPILE__)
#define KARGS(A) Args A; { const __attribute__((address_space(4))) Args* kp_ = (const __attribute__((address_space(4))) Args*)__builtin_amdgcn_kernarg_segment_ptr(); asm volatile("" : "+s"(kp_)); A = *kp_; }
#else
#define KARGS(A) Args A = a_unused;
#endif
__global__ void __launch_bounds__(NTHREADS, 2) hybrid_fwd(Args a_unused) {
    unsigned char* lds = g_lds;
    volatile LAS unsigned* MISC = (volatile LAS unsigned*)((LAS unsigned char*)lds + MISC_OFF);
    { const int tid0 = threadIdx.x; if (tid0 < 64) MISC[tid0] = 0u;
      if ((tid0 & 63) == 0) MISC[64 + ((unsigned)__builtin_amdgcn_s_getreg((5 << 11) | 4) & 63u)] = (unsigned)(tid0 >> 6); }
    __syncthreads();
    XcdBarrier bar; int lo, hi;
    { KARGS(a); lo = a.ph_lo; hi = a.ph_hi; gu32* ctl = (gu32*)(a.ws + WS_CTL);
      bar.bar = (unsigned*)(ctl + CW_BAR); bar.x = 0; bar.st = nullptr;
      if (!MK_PER_PHASE) bar = xcd_barrier_post((unsigned*)(ctl + CW_BAR), MISC); }
#ifndef PHMASK
#define PHMASK 0x3ffff
#endif
#define PHK(k) ((k) == 0 ? 0 : (k) == 17 ? 9 : (((k) - 1) & 7) + 1)
#define IN(k) (((PHMASK >> PHK(k)) & 1) && lo <= (k) && (k) < hi)
#define SEAM(k) do { if (!MK_PER_PHASE && IN(k) && IN((k) + 1)) xcd_barrier(bar); } while (0)
    LAS unsigned char* ldsl = (LAS unsigned char*)lds;
    const int G = gridDim.x, vcu = (G % 8 == 0) ? ((int)blockIdx.x % 8) * (G / 8) + (int)blockIdx.x / 8 : (int)blockIdx.x;

#ifndef REP_N1
#define REP_N1 1
#endif
#ifndef REP_SC
#define REP_SC 1
#endif
#ifndef REP_PRO
#define REP_PRO 1
#endif
    if (IN(0)) { KARGS(a); int nrep_ = REP_PRO; asm volatile("" : "+s"(nrep_)); for (int rp_ = 0; rp_ < nrep_; ++rp_) prologue_phase(a, lds); SEAM(0); }
    for (int l = 0; l < DEPTH; ++l) {
        const int pb = 1 + 8 * l;
        if (IN(pb + 0)) {
            KARGS(a);
            { int nrep_ = (l == 0) ? REP_N1 : 1; asm volatile("" : "+s"(nrep_)); for (int rp_ = 0; rp_ < nrep_; ++rp_) norm1_phase(a, l); }
            SEAM(pb + 0);
        }
        if (IN(pb + 1)) {
            KARGS(a);
            pg8::Gemm g{(const bf16_t*)(a.ws + WS_HB), (const bf16_t*)(a.ws + WS_WIN) + (size_t)l * INW * 1024, NROW, INW, DM};
            pg8::StaticOrder S; S.init(NROW, INW, G, (int)blockIdx.x);
            EpiInProj E{a.ws, (const float*)(a.ws + WS_ROPEC), (const float*)(a.ws + WS_ROPES)};
            RepOrder<pg8::StaticOrder> SR{S, REP_INPROJ * S.nloc()}; pg8::gemm_phase<EpiInProj, RepOrder<pg8::StaticOrder>, true, true>(ldsl, g, SR, E);
            if ((int)blockIdx.x >= 650 - 2 * G) {
                const int tid = otid(), c0 = 650 - 2 * G; moe_convert(a, l, (LAS float*)(ldsl + (tid >> 6) * 8704), ((int)blockIdx.x - c0) * NWAVES + (tid >> 6), (G - c0) * NWAVES, tid & 63, 8192, 12288); }
            SEAM(pb + 1);
        }
        if (IN(pb + 2)) { KARGS(a); int npass_ = (l == 0) ? 2 : 1; asm volatile("" : "+s"(npass_)); for (int ps_ = 0; ps_ < npass_; ++ps_) { attn_phase(a, l, (char*)lds, ps_); if (ps_ == 0) SEAM(pb + 2); } }
        if (IN(pb + 3)) {
            KARGS(a);
            const float* MOD = (const float*)(a.ws + WS_MOD);
            const int M = (l == DEPTH - 1) ? SEQ : NROW;
            pg8::Gemm g{(const bf16_t*)(a.ws + WS_HB), (const bf16_t*)(a.ws + WS_WOUT) + (size_t)l * 1024 * 1024, M, DM, DM};
            pg8::StaticOrder S; if (l == 0) S.init(61 * 256, DM, G - 12, (int)blockIdx.x - 12); else S.init(SEQ, DM, G, (int)blockIdx.x);
            EpiOutProj E{a.in[I_X], a.in[I_CTX], (bf16_t*)(a.ws + WS_XB), MOD + (l * 2) * 6144 + 2 * 1024, MOD + (l * 2 + 1) * 6144 + 2 * 1024, l};
            OutOrder SO{S, (gu32*)(a.ws + WS_CTL) + CW_OPC + l * 128, (l == 0) ? (gu32*)(a.ws + WS_CTL) + CW_CTXC : nullptr}; pg8::gemm_phase<EpiOutProj, OutOrder, true, true>(ldsl, g, SO, E);
            if (l == 0 && (int)blockIdx.x >= 16) {
                const int tid = otid(), nidle = G - 16; moe_convert(a, 1, (LAS float*)(ldsl + (tid >> 6) * 8704), ((int)blockIdx.x - 16) * NWAVES + (tid >> 6), nidle * NWAVES, tid & 63, 0, 8192); }
            __syncthreads();
        }
        if (IN(pb + 4)) { KARGS(a); int nrep_ = REP_N2SC; asm volatile("" : "+s"(nrep_)); for (int rp_ = 0; rp_ < nrep_; ++rp_) norm2_phase(a, l, lds); SEAM(pb + 4); }
        if (IN(pb + 6)) {
            KARGS(a);
            MoeOrder S; S.G = G; S.vcu = vcu;
            { const int tid = otid(); const unsigned* tot = (const unsigned*)(a.ws + WS_CTL) + CW_TOT + l * 64;
              if (tid == 0) { int t = 0; int* tsg = (int*)(a.ws + WS_TSG) + l * 32;
                  for (int e = 0; e < 16; ++e) { MISC[16 + e] = (unsigned)t; if (blockIdx.x == 0) tsg[e] = t; t += ((int)tot[e] + 255) >> 8; }
                  MISC[32] = (unsigned)t; if (blockIdx.x == 0) tsg[16] = t; }
              __syncthreads();
#pragma unroll
              for (int k = 0; k < 16; ++k) S.ts[k] = __builtin_amdgcn_readfirstlane((int)MISC[16 + k]);
              S.nunits = 4 * __builtin_amdgcn_readfirstlane((int)MISC[16 + 16]); }
            S.rowtok = (const int*)(a.ws + WS_ROWTOK2) + (size_t)l * 16 * ROWCAP;
            pg8::Gemm g{(const bf16_t*)(a.ws + WS_HB), (const bf16_t*)(a.ws + WS_W13) + (size_t)l * 16 * 1024 * 1024, XS_ROWS, 1024, DM};
            EpiMoe1 E{(bf16_t*)(a.ws + WS_RB)};
            pg8::gemm_phase<EpiMoe1, MoeOrder, true, true, true>(ldsl, g, S, E);
            gu32* flag = (gu32*)(a.ws + WS_CTL) + CW_MOEF + l * 256;
            { const int tid = otid(); if (tid == 0) __hip_atomic_store(flag + vcu, 1u, __ATOMIC_RELAXED, __HIP_MEMORY_SCOPE_AGENT); }
            MoeOrder2 S2; S2.vcu = vcu; S2.nunits = S.nunits;
#pragma unroll
            for (int k2 = 0; k2 < 16; ++k2) S2.ts[k2] = S.ts[k2];
            pg8::Gemm g2{(const bf16_t*)(a.ws + WS_RB), (const bf16_t*)(a.ws + WS_W2) + (size_t)l * 16 * 1024 * 512, XS_ROWS, 1024, FFE};
            EpiMoe2 E2{a.ws + WS_RA};
            const int r_ = S.nunits & 255;
            if (vcu >= r_ && S.nunits >= 256) { moe_wait(flag, vcu & ~3, 4); S2.part = 0; pg8::gemm_phase<EpiMoe2, MoeOrder2, true, true>(ldsl, g2, S2, E2); }
            if (r_ != 0) { moe_wait(flag, 0, r_); S2.part = 1; pg8::gemm_phase<EpiMoe2, MoeOrder2, true, true>(ldsl, g2, S2, E2); }
            SEAM(pb + 6);
        }
    }
    if (IN(17)) { KARGS(a); int nrep_ = REP_N1; asm volatile("" : "+s"(nrep_)); for (int rp_ = 0; rp_ < nrep_; ++rp_) norm1_phase(a, 2); }
#undef IN
#undef SEAM
}

extern "C" void kernel_launch(void* const* d_in, const int* in_sizes, int n_in, void* d_out, int out_size, void* d_ws, size_t ws_size, hipStream_t stream) {
    static int grid = 0;
    if (grid == 0) {
        if (n_in != 23 || in_sizes[0] != SEQ * DM || out_size != SEQ * DM || ws_size < WS_END) {
            fprintf(stderr, "kernel_launch: shape mismatch (n_in %d, in0 %d, out %d, ws %zu, need ws >= %zu); nothing launched\n", n_in, n_in > 0 ? in_sizes[0] : -1, out_size, ws_size, (size_t)WS_END); grid = -1; return; }
        int dev = 0, cus = 0, per_cu = 0;
        if (hipGetDevice(&dev) != hipSuccess || hipDeviceGetAttribute(&cus, hipDeviceAttributeMultiprocessorCount, dev) != hipSuccess) { fprintf(stderr, "kernel_launch: device query failed\n"); grid = -1; return; }
        if (hipFuncSetAttribute((const void*)hybrid_fwd, hipFuncAttributeMaxDynamicSharedMemorySize, LDS_BYTES) != hipSuccess) { fprintf(stderr, "kernel_launch: hipFuncSetAttribute failed\n"); grid = -1; return; }
        if (hipOccupancyMaxActiveBlocksPerMultiprocessor(&per_cu, (const void*)hybrid_fwd, NTHREADS, LDS_BYTES) != hipSuccess || per_cu < 1) { fprintf(stderr, "kernel_launch: occupancy query reports %d blocks per CU\n", per_cu); grid = -1; (void)hipGetLastError(); return; }
        if (cus != 256) { fprintf(stderr, "kernel_launch: built for 256 CUs, device has %d\n", cus); grid = -1; return; }
        grid = cus;
    }
    if (grid < 0) return;
    if (hipMemsetAsync((char*)d_ws + WS_CTL, 0, CTL_ZERO_BYTES, stream) != hipSuccess) { fprintf(stderr, "kernel_launch: memset failed\n"); return; }
    Args a{};
    for (int i = 0; i < 23; ++i) a.in[i] = (const float*)d_in[i];
    a.out = (float*)d_out; a.ws = (unsigned char*)d_ws;
#if MK_PER_PHASE
    for (int p = 0; p < N_PHASES; ++p) { a.ph_lo = p; a.ph_hi = p + 1; hipLaunchKernelGGL(hybrid_fwd, dim3(grid), dim3(NTHREADS), LDS_BYTES, stream, a); }
#else
    a.ph_lo = 0; a.ph_hi = N_PHASES;
    hipLaunchKernelGGL(hybrid_fwd, dim3(grid), dim3(NTHREADS), LDS_BYTES, stream, a);
#endif
    const hipError_t le = hipPeekAtLastError();
    if (le != hipSuccess) fprintf(stderr, "kernel_launch: launch failed: %s\n", hipGetErrorName(le));
}
```

```cpp
#define MK_PER_PHASE 0
#include <hip/hip_runtime.h>
#include <cstdio>
#include <cstdint>

#define GAS __attribute__((address_space(1)))
#define LAS __attribute__((address_space(3)))
typedef unsigned short bf16_t;
typedef short bf16x8 __attribute__((ext_vector_type(8)));
typedef short s16x4 __attribute__((ext_vector_type(4)));
typedef float f32x2 __attribute__((ext_vector_type(2)));
typedef float f32x4 __attribute__((ext_vector_type(4)));
typedef float f32x16 __attribute__((ext_vector_type(16)));
typedef unsigned u32x2 __attribute__((ext_vector_type(2)));
typedef unsigned u32x4 __attribute__((ext_vector_type(4)));
typedef GAS unsigned gu32;

constexpr int SEQ = 16384, CTX = 256, NROW = SEQ + CTX, DM = 1024, INW = 2560, NEXP = 16, FFE = 512, DEPTH = 2;
constexpr int XS_ROWS = 37376;
constexpr float EPS = 1e-6f, LOG2E = 1.4426950408889634f, QSCALE = 0.125f * 1.4426950408889634f;
constexpr int NWAVES = 8, NTHREADS = 512;

constexpr size_t MiB = 1u << 20;
constexpr size_t WS_CTL = 0, CTL_ZERO_BYTES = 128 * 1024;
constexpr size_t WS_MOD = 1 * MiB;
constexpr size_t WS_ROPEC = WS_MOD + 128 * 1024, WS_ROPES = WS_MOD + 192 * 1024;
constexpr size_t WS_LAM = WS_MOD + 256 * 1024;
constexpr size_t WS_CNT = WS_MOD + 320 * 1024;
constexpr size_t WS_TSG = WS_MOD + 384 * 1024;
constexpr size_t WS_TOKE = 2 * MiB, WS_TOKW = 2 * MiB + 256 * 1024, WS_TOKP = 2 * MiB + 512 * 1024;
constexpr size_t WS_ROWTOK = 3 * MiB;
constexpr size_t WS_WIN = 4 * MiB;
constexpr size_t WS_WOUT = 14 * MiB;
constexpr size_t WS_W13 = 18 * MiB;
constexpr size_t WS_W2 = 82 * MiB;
constexpr size_t WS_XB = 114 * MiB;
constexpr size_t WS_HB = 179 * MiB;
constexpr size_t WS_RA = 212 * MiB;
constexpr size_t RA_QA = WS_RA, RA_KA = RA_QA + (size_t)NROW * 512 * 2, RA_VA = RA_KA + (size_t)NROW * 512 * 2;
constexpr size_t RA_QB = RA_VA + (size_t)NROW * 512 * 2, RA_KB = RA_QB + (size_t)NROW * 256 * 2, RA_VB = RA_KB + (size_t)NROW * 128 * 2;
constexpr size_t RA_Z = RA_VB + (size_t)NROW * 256 * 2, RA_END = RA_Z + (size_t)NROW * 256 * 2;
constexpr size_t WS_RB = 290 * MiB;
constexpr size_t WS_ROWTOK2 = 327 * MiB;
constexpr size_t WS_END = 330 * MiB;
static_assert(RA_END <= WS_RB && WS_RA + (size_t)XS_ROWS * 2048 <= WS_RB && WS_RB + (size_t)XS_ROWS * 1024 <= WS_END && WS_RB + (size_t)256 * 256 * 128 * 4 <= WS_END, "ws map");
static_assert(WS_XB + (size_t)NROW * DM * 4 <= WS_HB && WS_HB + (size_t)NROW * DM * 2 <= WS_RA && WS_W13 + (size_t)2 * 16 * 1024 * 1024 * 2 <= WS_W2 && WS_W2 + (size_t)2 * 16 * 1024 * 512 * 2 <= WS_XB, "ws map 2");
constexpr int ROWCAP = 16640;
constexpr int CW_TOT = 24576;
constexpr int CW_MOEF = 28672;
constexpr int CW_OPC = 30720;
constexpr int CW_CTXC = 31232;
constexpr int CW_BAR = 4096;

constexpr int RING_BYTES = 131072;
constexpr int MISC_OFF = RING_BYTES;
constexpr int LDS_BYTES = 147456;

#define LDS_WAIT() asm volatile("s_waitcnt lgkmcnt(0)" ::: "memory")
#define VM_WAIT() asm volatile("s_waitcnt vmcnt(0)" ::: "memory")
__device__ __forceinline__ unsigned f2bf(float f) { unsigned u = __builtin_bit_cast(unsigned, f); return (u + 0x7fffu + ((u >> 16) & 1u)) >> 16; }
__device__ __forceinline__ unsigned pk2(float lo, float hi) { return f2bf(lo) | (f2bf(hi) << 16); }
__device__ __forceinline__ float bf2f(unsigned short b) { return __builtin_bit_cast(float, (unsigned)b << 16); }
__device__ __forceinline__ unsigned cvt_pk_bf16(float lo, float hi) { unsigned r; asm volatile("v_cvt_pk_bf16_f32 %0, %1, %2" : "=v"(r) : "v"(lo), "v"(hi)); return r; }
__device__ __forceinline__ float wave_sum(float v) {
#pragma unroll
    for (int o = 1; o < 64; o <<= 1) v += __shfl_xor(v, o);
    return v;
}
__device__ __forceinline__ f32x4 ld4bf(const bf16_t* p) { const u32x2 w = *(const u32x2*)p; return (f32x4){__builtin_bit_cast(float, w.x << 16), __builtin_bit_cast(float, w.x & 0xffff0000u), __builtin_bit_cast(float, w.y << 16), __builtin_bit_cast(float, w.y & 0xffff0000u)}; }
__device__ __forceinline__ void st4bf(bf16_t* p, const f32x4 v) { u32x2 w; w.x = cvt_pk_bf16(v.x, v.y); w.y = cvt_pk_bf16(v.z, v.w); *(u32x2*)p = w; }
__device__ __forceinline__ float silu_f(float a) { return a * __builtin_amdgcn_rcpf(1.f + __builtin_amdgcn_exp2f(-a * LOG2E)); }
__device__ __forceinline__ float sigmoid_f(float a) { return __builtin_amdgcn_rcpf(1.f + __builtin_amdgcn_exp2f(-a * LOG2E)); }
extern __shared__ __attribute__((aligned(16))) unsigned char g_lds[];
__device__ __forceinline__ int otid() {
    const unsigned slot = (unsigned)__builtin_amdgcn_s_getreg((5 << 11) | 4) & 63u;
    const int wave = ((const volatile LAS int*)((LAS unsigned char*)g_lds + MISC_OFF + 256))[slot];
    int ln; asm volatile("v_mbcnt_lo_u32_b32 %0, -1, 0\n\tv_mbcnt_hi_u32_b32 %0, -1, %0" : "=v"(ln));
    int t = (wave << 6) | ln;
    asm volatile("" : "+v"(t)); return t; }
namespace pg8 {
#define PG8_LAS __attribute__((address_space(3)))
constexpr int BM = 256, BK = 64, HALF = 128, HTB = HALF * BK * 2  , STAGE_BYTES = 8 * HTB, NXCD = 8, WGM = 8;

__host__ __device__ __forceinline__ int lds_byte(int r, int c) { const int st = (r >> 4) * 2 + (c >> 5), rr = r & 15, cc = c & 31, ob = rr * 64 + cc * 2; return st * 1024 + (ob ^ (((ob >> 9) & 1) << 5)); }
__host__ __device__ __forceinline__ void stage_rc(int b, int& R, int& C) { const int st = b / 1024, sb = b % 1024, swz = sb ^ (((sb >> 9) & 1) << 5); R = (st >> 1) * 16 + swz / 64; C = (st & 1) * 32 + (swz % 64) / 2; }
__host__ __device__ __forceinline__ int perm32(int rho) { const int n = rho >> 4, i = rho & 15; return 8 * (i >> 2) + 4 * n + (i & 3); }

struct Unit { int pm, pn, aux; };
struct Gemm { const bf16_t* A; const bf16_t* Bt; int M, N, K; };

struct StaticOrder {
    int nM, nN, nwg, G, c;
    __host__ __device__ void init(int M, int N, int G_, int c_) { nM = M / BM; nN = N / BM; nwg = nM * nN; G = G_; c = c_; }
    __host__ __device__ bool next(int i, Unit& u) const {
        const long L = (long)i * G + c; if (L >= nwg) return false;
        int wgid = (int)L; { const int q = nwg / NXCD, r = nwg % NXCD, xcd = wgid % NXCD, off = wgid / NXCD; wgid = (xcd < r ? xcd * (q + 1) : r * (q + 1) + (xcd - r) * q) + off; }
        const int nig = WGM * nN, gid = wgid / nig, fm = gid * WGM, gsz = (nM - fm) < WGM ? (nM - fm) : WGM;
        u.pm = fm + ((wgid % nig) % gsz); u.pn = (wgid % nig) / gsz; return true;
    }
    __host__ __device__ __forceinline__ int nloc() const { return c < nwg ? (nwg - c + G - 1) / G : 0; }
    __device__ __forceinline__ void a_ready(const Unit&) const {}
    __device__ __forceinline__ void done(const Unit&) const {}
};
template <class Epi, class Sched, bool ALIGN_EPI = false, bool SP2 = false, bool GATHER = false>
__device__ __forceinline__ void gemm_phase(PG8_LAS unsigned char* lds, const Gemm g, const Sched& S, const Epi& E) {
    const int tid = otid(), wid = __builtin_amdgcn_readfirstlane(tid >> 6), lane = tid & 63, wr = wid >> 2, wc = wid & 3, fr = lane & 15, fq = lane >> 4;
    const int K = g.K, nt = K / BK;
    unsigned voffA[2], voffB[2]; int rowA[2]; unsigned colA[2];
#pragma unroll
    for (int i = 0; i < 2; ++i) { int R, C; stage_rc(tid * 16 + i * 8192, R, C); const int Rb = Epi::PERM ? ((R & ~31) + perm32(R & 31)) : R;
        voffA[i] = (unsigned)(R * K + C) * 2u; voffB[i] = (unsigned)(Rb * K + C) * 2u; rowA[i] = R; colA[i] = (unsigned)C * 2u; }
    unsigned gc[2][2], gn[2][2];
#define PG8_GOFFS(dst, u) do { _Pragma("unroll") for (int h_ = 0; h_ < 2; ++h_) _Pragma("unroll") for (int i_ = 0; i_ < 2; ++i_) dst[h_][i_] = S.row_off((u), h_ * HALF + rowA[i_]) + colA[i_]; } while (0)
    const size_t kstep = (size_t)(BK * 2);
    const size_t hstep = (size_t)HALF * K * 2;
    const size_t tstep = 2 * hstep;
    const unsigned ldsw = (unsigned)wid * 1024u;
    const int aoff = lds_byte(wr * 64 + fr, fq * 8), boff = lds_byte(wc * 32 + fr, fq * 8);
#define PG8_SA(b, h) (((b) * 2 + (h)) * HTB)
#define PG8_SB(b, h) ((4 + (b) * 2 + (h)) * HTB)
#define PG8_STAGE(bufoff, gbase, voff) do { _Pragma("unroll") for (int _i = 0; _i < 2; ++_i) \
        __builtin_amdgcn_global_load_lds((const unsigned*)((const char*)(gbase) + (voff)[_i]), (PG8_LAS unsigned*)(lds + (bufoff) + ldsw + _i * 8192), 16, 0, 0); } while (0)
#define PG8_STAGE_A(bufoff, gbase, h, NX) do { _Pragma("unroll") for (int _i = 0; _i < 2; ++_i) { \
        const char* p_; if constexpr (GATHER) p_ = (const char*)(gbase) + ((NX) ? gn[h][_i] : gc[h][_i]); else p_ = (const char*)(gbase) + (h) * hstep + voffA[_i]; \
        __builtin_amdgcn_global_load_lds((const unsigned*)p_, (PG8_LAS unsigned*)(lds + (bufoff) + ldsw + _i * 8192), 16, 0, 0); } } while (0)
#define PG8_LDA(dst, b, h) do { _Pragma("unroll") for (int m = 0; m < 4; ++m) _Pragma("unroll") for (int k = 0; k < 2; ++k) dst[m][k] = *(const PG8_LAS bf16x8*)(lds + PG8_SA(b, h) + aoff + m * 2048 + k * 1024); } while (0)
#define PG8_LDB(dst, b, h) do { _Pragma("unroll") for (int n = 0; n < 2; ++n) _Pragma("unroll") for (int k = 0; k < 2; ++k) dst[n][k] = *(const PG8_LAS bf16x8*)(lds + PG8_SB(b, h) + boff + n * 2048 + k * 1024); } while (0)
#define PG8_MMA(ai, bj, At, Bt) do { __builtin_amdgcn_s_setprio(1); _Pragma("unroll") for (int m = 0; m < 4; ++m) _Pragma("unroll") for (int n = 0; n < 2; ++n) _Pragma("unroll") for (int k = 0; k < 2; ++k) \
        acc[ai][bj][m][n] = __builtin_amdgcn_mfma_f32_16x16x32_bf16(Bt[n][k], At[m][k], acc[ai][bj][m][n], 0, 0, 0); __builtin_amdgcn_s_setprio(0); } while (0)
#define PG8_WAIT_V(n) asm volatile("s_waitcnt vmcnt(" #n ")" ::: "memory")
#define PG8_WAIT_L(n) asm volatile("s_waitcnt lgkmcnt(" #n ")" ::: "memory")
#define PG8_BAR __builtin_amdgcn_s_barrier()
#define PG8_SCHED __builtin_amdgcn_sched_barrier(0)
    Unit cur, nxt; int ui = 0;
    if (!S.next(0, cur)) return;
    f32x4 acc[2][2][4][2];
#pragma unroll
    for (int a = 0; a < 2; ++a)
#pragma unroll
        for (int b = 0; b < 2; ++b)
#pragma unroll
            for (int m = 0; m < 4; ++m)
#pragma unroll
                for (int n = 0; n < 2; ++n) acc[a][b][m][n] = (f32x4){0.f, 0.f, 0.f, 0.f};
    bf16x8 At[4][2], B0[2][2], B1[2][2];
    const char* cA = GATHER ? (const char*)g.A : (const char*)g.A + (size_t)cur.pm * tstep; const char* cB = (const char*)g.Bt + (size_t)cur.pn * tstep;
    if constexpr (GATHER) { PG8_GOFFS(gc, cur); }
    S.a_ready(cur);
    if constexpr (SP2) {
        PG8_STAGE(PG8_SB(0, 0), cB, voffB); PG8_STAGE(PG8_SB(0, 1), cB + hstep, voffB); PG8_STAGE_A(PG8_SA(0, 0), cA, 0, false); PG8_STAGE_A(PG8_SA(0, 1), cA, 1, false);
        if (wr == 1) PG8_BAR;
        PG8_WAIT_V(2); PG8_BAR;
        PG8_STAGE(PG8_SB(1, 0), cB + kstep, voffB); PG8_STAGE_A(PG8_SA(1, 0), cA + kstep, 0, false); PG8_STAGE(PG8_SB(1, 1), cB + hstep + kstep, voffB);
        PG8_WAIT_V(6); PG8_BAR;
    } else {
        PG8_STAGE(PG8_SB(0, 0), cB, voffB); PG8_STAGE_A(PG8_SA(0, 0), cA, 0, false); PG8_STAGE(PG8_SB(0, 1), cB + hstep, voffB); PG8_STAGE_A(PG8_SA(0, 1), cA, 1, false);
        if (wr == 1) PG8_BAR;
        PG8_WAIT_V(4); PG8_BAR;
        PG8_STAGE(PG8_SB(1, 0), cB + kstep, voffB); PG8_STAGE_A(PG8_SA(1, 0), cA + kstep, 0, false); PG8_STAGE(PG8_SB(1, 1), cB + hstep + kstep, voffB);
        PG8_WAIT_V(6); PG8_BAR;
    }
    for (;;) {
        const bool has_next = S.next(ui + 1, nxt);
        if constexpr (GATHER) { if (has_next) { PG8_GOFFS(gn, nxt); } else {
#pragma unroll
            for (int h_ = 0; h_ < 2; ++h_) { gn[h_][0] = gc[h_][0]; gn[h_][1] = gc[h_][1]; } } }
        const char* nA = GATHER ? (const char*)g.A : has_next ? (const char*)g.A + (size_t)nxt.pm * tstep : cA; const char* nB = has_next ? (const char*)g.Bt + (size_t)nxt.pn * tstep : cB;
        for (int t = 0; t < nt; t += 2) {
            const bool last = (t == nt - 2);
            const char* a1 = cA + (size_t)(t + 1) * kstep;
            const char* a2 = last ? nA : cA + (size_t)(t + 2) * kstep; const char* b2 = last ? nB : cB + (size_t)(t + 2) * kstep;
            const char* a3 = a2 + kstep; const char* b3 = b2 + kstep;
            if (last && has_next) S.a_ready(nxt);
            if constexpr (SP2) {
            PG8_LDB(B0, 0, 0); PG8_LDB(B1, 0, 1); PG8_SCHED; PG8_LDA(At, 0, 0); PG8_STAGE_A(PG8_SA(1, 1), a1, 1, false);
            PG8_WAIT_V(8); PG8_WAIT_L(0); PG8_BAR; PG8_MMA(0, 0, At, B0); PG8_MMA(0, 1, At, B1); PG8_BAR; PG8_SCHED;
            PG8_LDA(At, 0, 1); PG8_STAGE(PG8_SB(0, 0), b2, voffB); PG8_STAGE(PG8_SB(0, 1), b2 + hstep, voffB); PG8_STAGE_A(PG8_SA(0, 0), a2, 0, last);
            PG8_WAIT_V(8); PG8_WAIT_L(0); PG8_BAR; PG8_MMA(1, 0, At, B0); PG8_MMA(1, 1, At, B1); PG8_BAR; PG8_SCHED;
            PG8_LDB(B0, 1, 0); PG8_LDB(B1, 1, 1); PG8_SCHED; PG8_LDA(At, 1, 0); PG8_STAGE_A(PG8_SA(0, 1), a2, 1, last);
            PG8_WAIT_V(8); PG8_WAIT_L(0); PG8_BAR; PG8_MMA(0, 0, At, B0); PG8_MMA(0, 1, At, B1); PG8_BAR; PG8_SCHED;
            PG8_LDA(At, 1, 1); PG8_STAGE(PG8_SB(1, 0), b3, voffB); PG8_STAGE(PG8_SB(1, 1), b3 + hstep, voffB); PG8_STAGE_A(PG8_SA(1, 0), a3, 0, last);
            PG8_WAIT_V(8); PG8_WAIT_L(0); PG8_BAR; PG8_MMA(1, 0, At, B0); PG8_MMA(1, 1, At, B1); PG8_BAR; PG8_SCHED;
            } else {
            PG8_LDB(B0, 0, 0); PG8_SCHED; PG8_LDA(At, 0, 0); PG8_STAGE_A(PG8_SA(1, 1), a1, 1, false);
            PG8_WAIT_L(8); PG8_BAR; PG8_WAIT_L(0); PG8_MMA(0, 0, At, B0); PG8_BAR; PG8_SCHED;
            PG8_LDB(B1, 0, 1); PG8_STAGE(PG8_SB(0, 0), b2, voffB);
            PG8_BAR; PG8_WAIT_L(0); PG8_MMA(0, 1, At, B1); PG8_BAR;
            PG8_LDA(At, 0, 1); PG8_STAGE_A(PG8_SA(0, 0), a2, 0, last);
            PG8_BAR; PG8_WAIT_L(0); PG8_MMA(1, 0, At, B0); PG8_BAR; PG8_SCHED;
            PG8_STAGE(PG8_SB(0, 1), b2 + hstep, voffB);
            PG8_WAIT_V(6); PG8_BAR; PG8_MMA(1, 1, At, B1); PG8_BAR;
            PG8_LDB(B0, 1, 0); PG8_SCHED; PG8_LDA(At, 1, 0); PG8_STAGE_A(PG8_SA(0, 1), a2, 1, last);
            PG8_WAIT_L(8); PG8_BAR; PG8_WAIT_L(0); PG8_MMA(0, 0, At, B0); PG8_BAR; PG8_SCHED;
            PG8_LDB(B1, 1, 1); PG8_STAGE(PG8_SB(1, 0), b3, voffB);
            PG8_BAR; PG8_WAIT_L(0); PG8_MMA(0, 1, At, B1); PG8_BAR;
            PG8_LDA(At, 1, 1); PG8_STAGE_A(PG8_SA(1, 0), a3, 0, last);
            PG8_BAR; PG8_WAIT_L(0); PG8_MMA(1, 0, At, B0); PG8_BAR; PG8_SCHED;
            PG8_STAGE(PG8_SB(1, 1), b3 + hstep, voffB);
            PG8_WAIT_V(6); PG8_BAR; PG8_MMA(1, 1, At, B1); PG8_BAR;
            }
        }
        if constexpr (ALIGN_EPI) { if (wr == 0) PG8_BAR; }
        if constexpr (!Epi::AFTER_DRAIN) { E(acc, cur, wr, wc, fr, fq); S.done(cur); }
        if (!has_next) break;
#pragma unroll
        for (int a = 0; a < 2; ++a)
#pragma unroll
            for (int b = 0; b < 2; ++b)
#pragma unroll
                for (int m = 0; m < 4; ++m)
#pragma unroll
                    for (int n = 0; n < 2; ++n) acc[a][b][m][n] = (f32x4){0.f, 0.f, 0.f, 0.f};
        cur = nxt; cA = nA; cB = nB; ++ui;
        if constexpr (GATHER) {
#pragma unroll
            for (int h_ = 0; h_ < 2; ++h_) { gc[h_][0] = gn[h_][0]; gc[h_][1] = gn[h_][1]; } }
        if constexpr (ALIGN_EPI) { if (wr == 1) PG8_BAR; }
    }
    PG8_WAIT_V(0);
    if constexpr (!ALIGN_EPI) { if (wr == 0) PG8_BAR; }
    PG8_BAR;
    if constexpr (Epi::AFTER_DRAIN) { E.fused(acc, cur, wr, wc, fr, fq, lds, wid, lane); S.done(cur); }
#undef PG8_SA
#undef PG8_SB
#undef PG8_STAGE
#undef PG8_STAGE_A
#undef PG8_GOFFS
#undef PG8_LDA
#undef PG8_LDB
#undef PG8_MMA
#undef PG8_WAIT_V
#undef PG8_WAIT_L
#undef PG8_BAR
#undef PG8_SCHED
}
}

namespace att2 {
constexpr int KSLOT = 8192, VSLOT = 16384, LDS_K = 0, LDS_V = 3 * KSLOT, LDS_WS = LDS_V + 3 * VSLOT, LDS_BYTES = LDS_WS + NWAVES * 256;
constexpr float THR = 8.f;
typedef LAS const char* lds_cptr;
typedef short v4i16_t __attribute__((ext_vector_type(4)));
typedef __bf16 bf2_t __attribute__((ext_vector_type(2)));
#define SBAR() __builtin_amdgcn_sched_barrier(0)
#define PIN(x) asm volatile("" : "+v"(x))
__device__ __forceinline__ int crow(int r, int hi) { return (r & 3) + 8 * (r >> 2) + 4 * hi; }
__device__ __forceinline__ f32x16 zero16() { float z = 0.f; asm volatile("" : "+v"(z)); f32x16 v;
#pragma unroll
    for (int r = 0; r < 16; ++r) v[r] = z;
    return v; }
__device__ __forceinline__ void glds16(const void* gsrc, unsigned lds_dst) { unsigned keep;
    asm volatile("s_mov_b32 %0, m0\n\ts_mov_b32 m0, %2\n\ts_nop 0\n\tglobal_load_lds_dwordx4 %1, off\n\ts_mov_b32 m0, %0" : "=&s"(keep) : "v"(gsrc), "s"(lds_dst) : "memory"); }
__device__ __forceinline__ bf16x8 kfrag(lds_cptr p) { return *(const LAS bf16x8*)p; }
__device__ __forceinline__ s16x4 vtr(lds_cptr p) { return __builtin_bit_cast(s16x4, __builtin_amdgcn_ds_read_tr16_b64_v4i16((LAS v4i16_t*)p)); }
__device__ __forceinline__ unsigned cvtpk_s(float lo, float hi) { typedef float f2 __attribute__((ext_vector_type(2))); typedef __bf16 b2 __attribute__((ext_vector_type(2)));
    f2 v = {lo, hi}; b2 b = __builtin_convertvector(v, b2); return __builtin_bit_cast(unsigned, b); }
#define MX3(a, b, c) __builtin_fmaxf(__builtin_fmaxf((a), (b)), (c))
__device__ __forceinline__ float rowmax(const f32x16& p0, const f32x16& p1) {
    float a = MX3(p0[0], p0[1], p1[0]), b = MX3(p0[2], p0[3], p1[1]); a = MX3(a, p1[2], p1[3]);
#pragma unroll
    for (int r = 4; r < 16; r += 4) { a = MX3(a, p0[r], p0[r + 1]); b = MX3(b, p0[r + 2], p0[r + 3]); a = MX3(a, p1[r], p1[r + 1]); b = MX3(b, p1[r + 2], p1[r + 3]); }
    float m = __builtin_fmaxf(a, b); auto rr = __builtin_amdgcn_permlane32_swap(__float_as_uint(m), __float_as_uint(m), false, false);
    return __builtin_fmaxf(__uint_as_float(rr[0]), __uint_as_float(rr[1])); }
__device__ __forceinline__ void wmask(f32x16& p0, f32x16& p1, int dk, int hi) {
#pragma unroll
    for (int r = 0; r < 16; ++r) { const int d = dk + crow(r, hi);
        if (d > 128 || d < -128) p0[r] = -1e30f;
        if (d + 32 > 128 || d + 32 < -128) p1[r] = -1e30f; } }
#define MFMA32(a, b, c) __builtin_amdgcn_mfma_f32_32x32x16_bf16(a, b, c, 0, 0, 0)
#define WAIT_BAR(N) asm volatile("s_waitcnt vmcnt(" #N ") lgkmcnt(0)\n\ts_barrier" ::: "memory")

template <int MODE, int LDK, int LDV, bool SAFE>
__device__ __forceinline__ void attn_body(const bf16_t* Qw, const bf16_t* Kh, const bf16_t* Vh, const int nA, const int a0, const int b0, const int NT, const int qpos,
                                          char* lds, const int tid, f32x16 (&o)[4], float& m_out, float& l_out) {
    constexpr int ND = (MODE == 1) ? 2 : 4, NVP = ND / 2;
    const int lane = tid & 63, r32 = lane & 31, hi = lane >> 5; const int wid = __builtin_amdgcn_readfirstlane(tid >> 6);
    const unsigned lds0 = (unsigned)(uintptr_t)lds; float* wsf = (float*)(lds + LDS_WS) + wid * 64;
#define KROW(t) ((t) < nA ? a0 + 64 * (t) : b0 + 64 * ((t) - nA))
    const bf16_t* ksrc = Kh + (size_t)lane * LDK + wid * 8;
    const bf16_t* vsrc = Vh + (size_t)(16 * (wid & 3) + (lane >> 2)) * LDV + (wid >> 2) * 32 + (lane & 3) * 8;
    const unsigned kdst = lds0 + LDS_K + wid * 1024, vdst = lds0 + LDS_V + (wid >> 2) * 4096 + (wid & 3) * 1024;
#define DMA_K(t, slot) glds16(ksrc + (size_t)KROW(t) * LDK, (unsigned)__builtin_amdgcn_readfirstlane(kdst + (slot) * KSLOT))
#define DMA_V(t, slot) do { const bf16_t* vs_ = vsrc + (size_t)KROW(t) * LDV; glds16(vs_, (unsigned)__builtin_amdgcn_readfirstlane(vdst + (slot) * VSLOT)); \
        if constexpr (NVP == 2) glds16(vs_ + 64, (unsigned)__builtin_amdgcn_readfirstlane(vdst + (slot) * VSLOT + 8192)); } while (0)
    const lds_cptr shm3 = (lds_cptr)(LAS char*)lds;
    const lds_cptr kp0 = shm3 + LDS_K + hi * 1024 + r32 * 16;
    const lds_cptr vp0 = shm3 + LDS_V + ((lane >> 4) & 1) * 32 + (lane & 3) * 8 + (4 * hi + ((lane & 15) >> 2)) * 64;
    bf16x8 qr[4];
#pragma unroll
    for (int d0 = 0; d0 < 4; ++d0) qr[d0] = *reinterpret_cast<const bf16x8*>(Qw + d0 * 16 + hi * 8);
    __syncthreads();
    if (wid >= 4) __builtin_amdgcn_s_setprio(1);
    DMA_K(0, 0); DMA_K(1, 1); DMA_V(0, 0);
    float mhat = 0.f, l_reg = 0.f;
#pragma unroll
    for (int d = 0; d < 4; ++d) o[d] = zero16();
    f32x16 negm = zero16(); PIN(negm);
    bool resc = false;
    if constexpr (NVP == 2) { WAIT_BAR(3); } else { WAIT_BAR(2); }
    f32x16 pA0, pA1, pB0, pB1;
    DMA_K(2, 2); DMA_V(1, 1);
    { bf16x8 kf[8];
#pragma unroll
      for (int i = 0; i < 8; ++i) kf[i] = kfrag(kp0 + (i >> 1) * 2048 + (i & 1) * 512);
      pA0 = MFMA32(kf[0], qr[0], negm); pA1 = MFMA32(kf[1], qr[0], negm); pA0 = MFMA32(kf[2], qr[1], pA0); pA1 = MFMA32(kf[3], qr[1], pA1);
      pA0 = MFMA32(kf[4], qr[2], pA0); pA1 = MFMA32(kf[5], qr[2], pA1); pA0 = MFMA32(kf[6], qr[3], pA0); pA1 = MFMA32(kf[7], qr[3], pA1); }
    if constexpr (MODE == 1) { if (0 >= nA) wmask(pA0, pA1, KROW(0) - qpos, hi); }
    { const float rm = rowmax(pA0, pA1); mhat = rm;
#pragma unroll
      for (int r = 0; r < 16; ++r) { pA0[r] = __builtin_amdgcn_exp2f(pA0[r] - rm); pA1[r] = __builtin_amdgcn_exp2f(pA1[r] - rm); }
#pragma unroll
      for (int r = 0; r < 16; ++r) negm[r] = -mhat;
      PIN(negm);
      if constexpr (!SAFE) { float s0 = 0.f, s1 = 0.f;
#pragma unroll
        for (int r = 0; r < 16; ++r) { s0 += pA0[r]; s1 += pA1[r]; }
        l_reg = s0 + s1; } }
    if constexpr (NVP == 2) { WAIT_BAR(3); } else { WAIT_BAR(2); }
    int sl_prev = 0, sl_cur = 1, sl_next = 2;
#define ROT() do { const int s_ = sl_prev; sl_prev = sl_cur; sl_cur = sl_next; sl_next = s_; } while (0)
#define RESC() do { if (resc) { asm volatile("s_waitcnt lgkmcnt(0)" ::: "memory"); \
        _Pragma("unroll") for (int d_ = 0; d_ < ND; ++d_) _Pragma("unroll") for (int r = 0; r < 16; ++r) o[d_][r] *= wsf[crow(r, hi)]; } } while (0)
    u32x4 pw0, pw1, pw2, pw3; s16x4 vl[16], vh[16]; bf16x8 kf[8]; float dummy_ = 0.f;
#define PAF(k) __builtin_bit_cast(bf16x8, pw##k)
#define VFR(i) (bf16x8){vl[i][0], vl[i][1], vl[i][2], vl[i][3], vh[i][0], vh[i][1], vh[i][2], vh[i][3]}
#define VRD(q, ks) do { if constexpr ((q) < ND) { vl[(q) * 4 + (ks)] = vtr(vp_ + ((q) * 4096 + (ks) * 1024)); vh[(q) * 4 + (ks)] = vtr(vp_ + ((q) * 4096 + (ks) * 1024 + 512)); } } while (0)
#define KRD(i) do { kf[i] = kfrag(kp_ + ((i) >> 1) * 2048 + ((i) & 1) * 512); } while (0)
#define PKW(P, i) cvtpk_s(P[i], P[i + 1])
#ifndef PROBE_VALU
#define PROBE_VALU 0
#endif
#ifndef ROWSUM_DOT2
#define ROWSUM_DOT2 0
#endif
#define DOT2(w, acc) __builtin_amdgcn_fdot2_f32_bf16(__builtin_bit_cast(bf2_t, (unsigned)(w)), __builtin_bit_cast(bf2_t, 0x3f803f80u), acc, false)
#define GAPA(MF, a0_, a1_, a2_, a3_, W0, W1, PW, i0_) do { MF; if (SAFE && !ROWSUM_DOT2) { sacc += a0_; sacb += a1_; sacc += a2_; sacb += a3_; PIN(sacc); PIN(sacb); } W0; W1; PIN(PW); \
        if (ROWSUM_DOT2) { sacc = DOT2(PW[i0_], sacc); sacb = DOT2(PW[(i0_) + 1], sacb); PIN(sacc); PIN(sacb); } SBAR(); } while (0)
#define EX(v) __builtin_amdgcn_exp2f(v)
#define GAPB(q, ks, X, i) do { if constexpr ((q) < ND) { o[q] = MFMA32(PAF(ks), VFR((q) * 4 + (ks)), o[q]); } X[i] = EX(X[i]); X[(i) + 1] = EX(X[(i) + 1]); X[(i) + 2] = EX(X[(i) + 2]); X[(i) + 3] = EX(X[(i) + 3]); PIN(X); SBAR(); } while (0)
#define GAPG(q, ks, ...) do { if constexpr ((q) < ND) { o[q] = MFMA32(PAF(ks), VFR((q) * 4 + (ks)), o[q]); } __VA_ARGS__; SBAR(); } while (0)
#define STEP(C0, C1, P0, P1, t, GK, GV) do { SBAR(); \
    const lds_cptr vp_ = vp0 + sl_prev * VSLOT; const lds_cptr kp_ = kp0 + sl_cur * KSLOT; \
    KRD(0); KRD(1); KRD(2); SBAR(); float sacc = (ROWSUM_DOT2 || !SAFE) ? 0.f : P0[0], sacb = (ROWSUM_DOT2 || !SAFE) ? 0.f : P0[1]; \
    KRD(3); SBAR();            GAPA(C0 = MFMA32(kf[0], qr[0], negm), P0[2], P0[3], P0[4], P0[5],     pw0[0] = PKW(P0, 0),  pw0[1] = PKW(P0, 2),  pw0, 0); \
    KRD(4); SBAR();            GAPA(C1 = MFMA32(kf[1], qr[0], negm), P0[6], P0[7], P0[8], P0[9],     pw0[2] = PKW(P0, 4),  pw0[3] = PKW(P0, 6),  pw0, 2); \
    KRD(5); SBAR();            GAPA(C0 = MFMA32(kf[2], qr[1], C0),   P0[10], P0[11], P0[12], P0[13], pw1[0] = PKW(P0, 8),  pw1[1] = PKW(P0, 10), pw1, 0); \
    KRD(6); SBAR();            GAPA(C1 = MFMA32(kf[3], qr[1], C1),   P0[14], P0[15], P1[0], P1[1],   pw1[2] = PKW(P0, 12), pw1[3] = PKW(P0, 14), pw1, 2); \
    KRD(7); VRD(0, 0); SBAR(); GAPA(C0 = MFMA32(kf[4], qr[2], C0),   P1[2], P1[3], P1[4], P1[5],     pw2[0] = PKW(P1, 0),  pw2[1] = PKW(P1, 2),  pw2, 0); \
            VRD(1, 0); SBAR(); GAPA(C1 = MFMA32(kf[5], qr[2], C1),   P1[6], P1[7], P1[8], P1[9],     pw2[2] = PKW(P1, 4),  pw2[3] = PKW(P1, 6),  pw2, 2); \
            VRD(2, 0); SBAR(); GAPA(C0 = MFMA32(kf[6], qr[3], C0),   P1[10], P1[11], P1[12], P1[13], pw3[0] = PKW(P1, 8),  pw3[1] = PKW(P1, 10), pw3, 0); \
            VRD(3, 0); SBAR(); GAPA(C1 = MFMA32(kf[7], qr[3], C1),   P1[14], P1[15], 0.f, 0.f,       pw3[2] = PKW(P1, 12), pw3[3] = PKW(P1, 14), pw3, 2); \
    if constexpr (SAFE) l_reg += sacc + sacb; \
    if constexpr (MODE == 1) { if ((t) >= nA) wmask(C0, C1, KROW(t) - qpos, hi); } \
    SBAR(); \
      \
      \
    if constexpr (!SAFE) { \
      \
    VRD(0, 1); SBAR(); GAPG(0, 0, C0[0] = EX(C0[0]); C0[1] = EX(C0[1]); PIN(C0)); \
    VRD(1, 1); SBAR(); GAPG(1, 0, C0[2] = EX(C0[2]); C0[3] = EX(C0[3]); sacc += C0[0]; sacb += C0[1]; PIN(C0); PIN(sacc); PIN(sacb)); \
    VRD(2, 1); SBAR(); GAPG(2, 0, C0[4] = EX(C0[4]); C0[5] = EX(C0[5]); sacc += C0[2]; sacb += C0[3]; PIN(C0); PIN(sacc); PIN(sacb)); \
    VRD(3, 1); SBAR(); GAPG(3, 0, C0[6] = EX(C0[6]); C0[7] = EX(C0[7]); sacc += C0[4]; sacb += C0[5]; PIN(C0); PIN(sacc); PIN(sacb)); \
    VRD(0, 2); SBAR(); GAPG(0, 1, C0[8] = EX(C0[8]); C0[9] = EX(C0[9]); sacc += C0[6]; sacb += C0[7]; PIN(C0); PIN(sacc); PIN(sacb)); \
    VRD(1, 2); SBAR(); GAPG(1, 1, C0[10] = EX(C0[10]); C0[11] = EX(C0[11]); sacc += C0[8]; sacb += C0[9]; PIN(C0); PIN(sacc); PIN(sacb)); \
    VRD(2, 2); SBAR(); GAPG(2, 1, C0[12] = EX(C0[12]); C0[13] = EX(C0[13]); sacc += C0[10]; sacb += C0[11]; PIN(C0); PIN(sacc); PIN(sacb)); \
    VRD(3, 2); SBAR(); GAPG(3, 1, C0[14] = EX(C0[14]); C0[15] = EX(C0[15]); sacc += C0[12]; sacb += C0[13]; PIN(C0); PIN(sacc); PIN(sacb)); \
    VRD(0, 3); SBAR(); GAPG(0, 2, C1[0] = EX(C1[0]); C1[1] = EX(C1[1]); sacc += C0[14]; sacb += C0[15]; PIN(C1); PIN(sacc); PIN(sacb)); \
    VRD(1, 3); SBAR(); GAPG(1, 2, C1[2] = EX(C1[2]); C1[3] = EX(C1[3]); sacc += C1[0]; sacb += C1[1]; PIN(C1); PIN(sacc); PIN(sacb)); \
    VRD(2, 3); SBAR(); GAPG(2, 2, C1[4] = EX(C1[4]); C1[5] = EX(C1[5]); sacc += C1[2]; sacb += C1[3]; PIN(C1); PIN(sacc); PIN(sacb)); \
    VRD(3, 3); SBAR(); GAPG(3, 2, C1[6] = EX(C1[6]); C1[7] = EX(C1[7]); sacc += C1[4]; sacb += C1[5]; PIN(C1); PIN(sacc); PIN(sacb)); \
    if (GK) { DMA_K((t) + 2, sl_prev); } SBAR(); GAPG(0, 3, C1[8] = EX(C1[8]); C1[9] = EX(C1[9]); sacc += C1[6]; sacb += C1[7]; PIN(C1); PIN(sacc); PIN(sacb)); \
    if (GV) { DMA_V((t) + 1, sl_next); } SBAR(); GAPG(1, 3, C1[10] = EX(C1[10]); C1[11] = EX(C1[11]); sacc += C1[8]; sacb += C1[9]; PIN(C1); PIN(sacc); PIN(sacb)); \
    GAPG(2, 3, C1[12] = EX(C1[12]); C1[13] = EX(C1[13]); sacc += C1[10]; sacb += C1[11]; PIN(C1); PIN(sacc); PIN(sacb)); \
    GAPG(3, 3, C1[14] = EX(C1[14]); C1[15] = EX(C1[15]); sacc += C1[12]; sacb += C1[13]; PIN(C1); PIN(sacc); PIN(sacb)); \
    sacc += C1[14]; sacb += C1[15]; l_reg += sacc + sacb; \
    } else { \
    float mxa, mxb; \
    VRD(0, 1); SBAR(); GAPG(0, 0, mxa = MX3(C0[0], C0[1], C0[2]); mxb = MX3(C0[3], C0[4], C0[5]); mxa = MX3(mxa, C0[6], C0[7]); mxb = MX3(mxb, C0[8], C0[9]); PIN(mxa); PIN(mxb)); \
    VRD(1, 1); SBAR(); GAPG(1, 0, mxa = MX3(mxa, C0[10], C0[11]); mxb = MX3(mxb, C0[12], C0[13]); mxa = MX3(mxa, C0[14], C0[15]); mxb = MX3(mxb, C1[0], C1[1]); PIN(mxa); PIN(mxb)); \
    VRD(2, 1); SBAR(); GAPG(2, 0, mxa = MX3(mxa, C1[2], C1[3]); mxb = MX3(mxb, C1[4], C1[5]); mxa = MX3(mxa, C1[6], C1[7]); mxb = MX3(mxb, C1[8], C1[9]); PIN(mxa); PIN(mxb)); \
    VRD(3, 1); SBAR(); GAPG(3, 0, mxa = MX3(mxa, C1[10], C1[11]); mxb = MX3(mxb, C1[12], C1[13]); mxa = MX3(mxa, C1[14], C1[15]); PIN(mxa); PIN(mxb)); \
    { float rm = __builtin_fmaxf(mxa, mxb); { auto rr = __builtin_amdgcn_permlane32_swap(__float_as_uint(rm), __float_as_uint(rm), false, false); rm = __builtin_fmaxf(__uint_as_float(rr[0]), __uint_as_float(rr[1])); } \
      resc = false; \
      if (__builtin_expect(__any(rm > THR), 0)) { const float dl = __builtin_fmaxf(rm, 0.f); mhat += dl; \
          _Pragma("unroll") for (int r = 0; r < 16; ++r) { C0[r] -= dl; C1[r] -= dl; } \
          _Pragma("unroll") for (int r = 0; r < 16; ++r) negm[r] = -mhat; PIN(negm); \
          const float f = __builtin_amdgcn_exp2f(-dl); l_reg *= f; if (hi == 0) wsf[r32] = f; resc = true; } } \
    SBAR(); \
    VRD(0, 2); SBAR(); GAPG(0, 1, C0[0] = EX(C0[0]); C0[1] = EX(C0[1]); C0[2] = EX(C0[2]); PIN(C0)); \
    VRD(1, 2); SBAR(); GAPG(1, 1, C0[3] = EX(C0[3]); C0[4] = EX(C0[4]); C0[5] = EX(C0[5]); PIN(C0)); \
    VRD(2, 2); SBAR(); GAPG(2, 1, C0[6] = EX(C0[6]); C0[7] = EX(C0[7]); C0[8] = EX(C0[8]); PIN(C0)); \
    VRD(3, 2); SBAR(); GAPG(3, 1, C0[9] = EX(C0[9]); C0[10] = EX(C0[10]); C0[11] = EX(C0[11]); PIN(C0)); \
    VRD(0, 3); SBAR(); GAPG(0, 2, C0[12] = EX(C0[12]); C0[13] = EX(C0[13]); C0[14] = EX(C0[14]); PIN(C0)); \
    VRD(1, 3); SBAR(); GAPG(1, 2, C0[15] = EX(C0[15]); C1[0] = EX(C1[0]); C1[1] = EX(C1[1]); PIN(C0); PIN(C1)); \
    VRD(2, 3); SBAR(); GAPG(2, 2, C1[2] = EX(C1[2]); C1[3] = EX(C1[3]); C1[4] = EX(C1[4]); PIN(C1)); \
    VRD(3, 3); SBAR(); GAPG(3, 2, C1[5] = EX(C1[5]); C1[6] = EX(C1[6]); C1[7] = EX(C1[7]); PIN(C1)); \
    if (GK) { DMA_K((t) + 2, sl_prev); if (PROBE_DUPK) DMA_K((t) + 2, sl_prev); } SBAR(); GAPG(0, 3, C1[8] = EX(C1[8]); C1[9] = EX(C1[9]); PIN(C1)); \
    if (GV) { DMA_V((t) + 1, sl_next); if (PROBE_DUPV) DMA_V((t) + 1, sl_next); } SBAR(); GAPG(1, 3, C1[10] = EX(C1[10]); C1[11] = EX(C1[11]); PIN(C1)); \
    GAPG(2, 3, C1[12] = EX(C1[12]); C1[13] = EX(C1[13]); PIN(C1)); \
    GAPG(3, 3, C1[14] = EX(C1[14]); C1[15] = EX(C1[15]); PIN(C1)); \
    } \
    } while (0)
#ifndef PROBE_DUPK
#define PROBE_DUPK 0
#endif
#ifndef PROBE_DUPV
#define PROBE_DUPV 0
#endif
#define WAIT_N(n_) do { if ((n_) == 6) { WAIT_BAR(6); } else if ((n_) == 5) { WAIT_BAR(5); } else if ((n_) == 4) { WAIT_BAR(4); } else if ((n_) == 3) { WAIT_BAR(3); } else if ((n_) == 2) { WAIT_BAR(2); } else if ((n_) == 1) { WAIT_BAR(1); } else { WAIT_BAR(0); } } while (0)
#define ENDW(tt) do { const int nk_ = ((tt) + 2 < NT) ? 1 + PROBE_DUPK : 0, nv_ = ((tt) + 1 < NT) ? NVP * (1 + PROBE_DUPV) : 0; WAIT_N(nk_ + nv_); } while (0)
    int t = 1;
    for (; t + 3 < NT; t += 2) {
        STEP(pB0, pB1, pA0, pA1, t, true, true);     WAIT_N(1 + PROBE_DUPK + NVP * (1 + PROBE_DUPV)); RESC(); ROT();
        STEP(pA0, pA1, pB0, pB1, t + 1, true, true); WAIT_N(1 + PROBE_DUPK + NVP * (1 + PROBE_DUPV)); RESC(); ROT();
    }
    for (; t + 1 < NT; t += 2) {
        STEP(pB0, pB1, pA0, pA1, t, (t + 2 < NT), (t + 1 < NT));         ENDW(t);     RESC(); ROT();
        STEP(pA0, pA1, pB0, pB1, t + 1, (t + 3 < NT), (t + 2 < NT));     ENDW(t + 1); RESC(); ROT();
    }
    STEP(pB0, pB1, pA0, pA1, NT - 1, false, false); WAIT_BAR(0); RESC(); ROT();
    { if constexpr (SAFE) { float sacc = pB0[0] + pB0[1];
#pragma unroll
      for (int r = 2; r < 16; ++r) sacc += pB0[r];
#pragma unroll
      for (int r = 0; r < 16; ++r) sacc += pB1[r];
      l_reg += sacc; }
      pw0 = (u32x4){PKW(pB0, 0), PKW(pB0, 2), PKW(pB0, 4), PKW(pB0, 6)}; pw1 = (u32x4){PKW(pB0, 8), PKW(pB0, 10), PKW(pB0, 12), PKW(pB0, 14)};
      pw2 = (u32x4){PKW(pB1, 0), PKW(pB1, 2), PKW(pB1, 4), PKW(pB1, 6)}; pw3 = (u32x4){PKW(pB1, 8), PKW(pB1, 10), PKW(pB1, 12), PKW(pB1, 14)};
      const lds_cptr vp_ = vp0 + sl_prev * VSLOT;
#pragma unroll
      for (int q = 0; q < ND; ++q) {
          s16x4 l0 = vtr(vp_ + q * 4096), h0 = vtr(vp_ + q * 4096 + 512), l1 = vtr(vp_ + q * 4096 + 1024), h1 = vtr(vp_ + q * 4096 + 1024 + 512);
          s16x4 l2 = vtr(vp_ + q * 4096 + 2048), h2 = vtr(vp_ + q * 4096 + 2048 + 512), l3 = vtr(vp_ + q * 4096 + 3072), h3 = vtr(vp_ + q * 4096 + 3072 + 512);
#define PKV(L, H) (bf16x8){L[0], L[1], L[2], L[3], H[0], H[1], H[2], H[3]}
          o[q] = MFMA32(PAF(0), PKV(l0, h0), o[q]); o[q] = MFMA32(PAF(1), PKV(l1, h1), o[q]); o[q] = MFMA32(PAF(2), PKV(l2, h2), o[q]); o[q] = MFMA32(PAF(3), PKV(l3, h3), o[q]);
#undef PKV
      } }
    { auto rr = __builtin_amdgcn_permlane32_swap(__float_as_uint(l_reg), __float_as_uint(l_reg), false, false); l_reg = __uint_as_float(rr[0]) + __uint_as_float(rr[1]); }
    if (PROBE_VALU) asm volatile("" :: "v"(dummy_));
    __builtin_amdgcn_s_setprio(0);
    m_out = mhat; l_out = l_reg;
#undef KROW
#undef DMA_K
#undef DMA_V
#undef ROT
#undef RESC
#undef PAF
#undef VFR
#undef VRD
#undef KRD
#undef PKW
#undef GAPA
#undef DOT2
#undef GAPB
#undef GAPG
#undef EX
#undef STEP
#undef ENDW
#undef WAIT_N
}
#undef SBAR
#undef PIN
#undef MX3
#undef MFMA32
#undef WAIT_BAR
}

#define XB_TMO      128
#define XB_XCNT(j)  (256  + 64 * (j))
#define XB_XSUB(j)  (1280 + 64 * (j))
#define XB_XGEN(j)  (2304 + 64 * (j))
#define XB_TOP      3328
#define XB_TOPGEN   3392
#define XCD_BAR_WORDS 3456
#define XB_SPIN_CAP (1u << 18)

__device__ __forceinline__ unsigned xb_ld(unsigned* p)              { return __hip_atomic_load(p, __ATOMIC_RELAXED, __HIP_MEMORY_SCOPE_AGENT); }
__device__ __forceinline__ unsigned xb_add(unsigned* p, unsigned v) { return __hip_atomic_fetch_add(p, v, __ATOMIC_RELAXED, __HIP_MEMORY_SCOPE_AGENT); }
__device__ __forceinline__ unsigned xb_xcc_id() { return (unsigned)__builtin_amdgcn_s_getreg((3 << 11) | 20) & 0xFu; }
#define XB_SPIN(cond, bar) do { unsigned _sp = 0; while (cond) { __builtin_amdgcn_s_sleep(1); \
    if ((++_sp & 255u) == 0u) { if (xb_ld(&(bar)[XB_TMO])) break; if (_sp > XB_SPIN_CAP) { atomicAdd(&(bar)[XB_TMO], 1u); break; } } } } while (0)

struct XcdBarrier {
    unsigned* bar; unsigned x;
    volatile LAS unsigned* st;
};

__device__ __forceinline__ XcdBarrier xcd_barrier_post(unsigned* bar, volatile LAS unsigned* st) {
    XcdBarrier b; b.bar = bar; b.x = xb_xcc_id(); b.st = st;
    if (threadIdx.x == 0) (void)xb_add(&bar[XB_XCNT(b.x)], 1u);
    return b;
}
__device__ __forceinline__ void xcd_barrier_complete(unsigned* bar, unsigned x, unsigned& nloc, unsigned& nx) {
    const unsigned G = gridDim.x * gridDim.y * gridDim.z;
    unsigned sum, cnt, mine, sp = 0u;
    for (;;) {
        sum = 0u; cnt = 0u; mine = 0u;
#pragma unroll
        for (unsigned j = 0; j < 16; ++j) { const unsigned c = xb_ld(&bar[XB_XCNT(j)]); sum += c; cnt += (c > 0u) ? 1u : 0u; mine = (j == x) ? c : mine; }
        if (sum == G) break;
        __builtin_amdgcn_s_sleep(1);
        if ((++sp & 255u) == 0u) { if (xb_ld(&bar[XB_TMO])) break; if (sp > XB_SPIN_CAP) { atomicAdd(&bar[XB_TMO], 1u); break; } }
    }
    nloc = mine > 0u ? mine : 1u; nx = cnt > 0u ? cnt : 1u;
}

__device__ __forceinline__ void xcd_barrier(const XcdBarrier& b) {
    asm volatile("s_waitcnt vmcnt(0)" ::: "memory");
    __syncthreads();
    if (threadIdx.x == 0) {
        unsigned* bar = b.bar;
        __builtin_amdgcn_s_waitcnt(0);
        unsigned nloc = b.st[0], nx = b.st[1];
        if (nloc == 0u) { xcd_barrier_complete(bar, b.x, nloc, nx); b.st[0] = nloc; b.st[1] = nx; }
        const unsigned old = xb_add(&bar[XB_XSUB(b.x)], 1u);
        const unsigned gen = old / nloc;
        if (old + 1u == (gen + 1u) * nloc) {
            __builtin_amdgcn_fence(__ATOMIC_RELEASE, "agent");
            asm volatile("s_waitcnt vmcnt(0)" ::: "memory");
            const unsigned og = xb_add(&bar[XB_TOP], 1u);
            const unsigned tg = og / nx;
            if (og + 1u == (tg + 1u) * nx) xb_add(&bar[XB_TOPGEN], 1u);
            else XB_SPIN(xb_ld(&bar[XB_TOPGEN]) == tg, bar);
            __builtin_amdgcn_fence(__ATOMIC_ACQUIRE, "agent");
            xb_add(&bar[XB_XGEN(b.x)], 1u);
            asm volatile("s_waitcnt vmcnt(0)" ::: "memory");
        } else {
            XB_SPIN(xb_ld(&bar[XB_XGEN(b.x)]) == gen, bar);
            __builtin_amdgcn_fence(__ATOMIC_ACQUIRE, "agent");
            asm volatile("s_waitcnt vmcnt(0)" ::: "memory");
        }
    }
    __syncthreads();
}

struct Args { const float* in[23]; float* out; unsigned char* ws; int ph_lo, ph_hi; };
enum { I_X = 0, I_C, I_CTX, I_CCTX, I_WADA, I_BADA, I_GMIX, I_WIN, I_DLAM, I_DNG, I_SINK, I_CONVW, I_CONVB, I_LNG, I_LNB, I_WOUT, I_GFFN, I_RW, I_RB, I_W1, I_W3, I_W2, I_GFIN };
constexpr int N_PHASES = 18;
__device__ __constant__ const float LAMBDA_INIT[2] = {0.2f, 0.35550906759097f};

struct EpiInProj {
    static constexpr bool PERM = true, AFTER_DRAIN = false;
    unsigned char* ws; const float* ropeC; const float* ropeS;
    __device__ __forceinline__ void operator()(const f32x4 (&acc)[2][2][4][2], const pg8::Unit& u, int wr, int wc, int fr, int fq) const {
        const int pn = u.pn; const bool latent = u.pm < 64; const int rowb = u.pm * 256 + wr * 64 + fr;
        if (pn >= 8) {
            bf16_t* Z = (bf16_t*)(ws + RA_Z); const int ch0 = (pn - 8) * 128 + wc * 32 + 8 * fq;
#pragma unroll
            for (int ai = 0; ai < 2; ++ai)
#pragma unroll
                for (int m = 0; m < 4; ++m) { const int row = rowb + ai * 128 + m * 16;
                    const f32x4 a0 = acc[ai][0][m][0], a1 = acc[ai][0][m][1], g0 = acc[ai][1][m][0], g1 = acc[ai][1][m][1];
                    u32x4 w; w.x = cvt_pk_bf16(a0[0] * sigmoid_f(g0[0]), a0[1] * sigmoid_f(g0[1])); w.y = cvt_pk_bf16(a0[2] * sigmoid_f(g0[2]), a0[3] * sigmoid_f(g0[3]));
                    w.z = cvt_pk_bf16(a1[0] * sigmoid_f(g1[0]), a1[1] * sigmoid_f(g1[1])); w.w = cvt_pk_bf16(a1[2] * sigmoid_f(g1[2]), a1[3] * sigmoid_f(g1[3]));
                    *(u32x4*)(Z + (size_t)row * 256 + ch0) = w; }
            return;
        }
        const float sgn = (fq < 2) ? -1.f : 1.f;
        const bool anyrope = latent && (pn < 4 || pn >= 6);
#pragma unroll
        for (int ai = 0; ai < 2; ++ai)
#pragma unroll
            for (int m = 0; m < 4; ++m) { const int row = rowb + ai * 128 + m * 16;
                f32x4 c0, c1, s0, s1;
                if (anyrope) { const int pos = (wc & 1) ? (row & 63) : (row >> 6); const int fo = pos * 16 + 8 * (fq & 1);
                    c0 = *(const f32x4*)(ropeC + fo); c1 = *(const f32x4*)(ropeC + fo + 4); s0 = *(const f32x4*)(ropeS + fo) * sgn; s1 = *(const f32x4*)(ropeS + fo + 4) * sgn; }
#pragma unroll
                for (int bj = 0; bj < 2; ++bj) {
                    bf16_t* dst; int ld, dcol; bool rope; float sc = 1.f; bool isvb = false;
                    if (pn < 2)       { dst = (bf16_t*)(ws + RA_QA); ld = 512; dcol = pn * 256 + bj * 128 + wc * 32; rope = true; sc = QSCALE; }
                    else if (pn < 4)  { dst = (bf16_t*)(ws + RA_KA); ld = 512; dcol = (pn - 2) * 256 + bj * 128 + wc * 32; rope = true; }
                    else if (pn < 6)  { dst = (bf16_t*)(ws + RA_VA); ld = 512; dcol = (pn - 4) * 256 + bj * 128 + wc * 32; rope = false; }
                    else if (pn == 6) { dst = (bf16_t*)(ws + RA_QB); ld = 256; dcol = bj * 128 + wc * 32; rope = true; sc = QSCALE; }
                    else if (bj == 0) { dst = (bf16_t*)(ws + RA_KB); ld = 128; dcol = wc * 32; rope = true; }
                    else              { dst = (bf16_t*)(ws + RA_VB); ld = 256; dcol = (wc >> 1) * 128 + (wc & 1) * 32; rope = false; isvb = true; }
                    rope = rope && latent;
                    f32x4 x0 = acc[ai][bj][m][0], x1 = acc[ai][bj][m][1];
                    if (rope) { f32x4 p0, p1;
#pragma unroll
                        for (int j = 0; j < 4; ++j) {
                            auto s0_ = __builtin_amdgcn_permlane32_swap(__float_as_uint(x0[j]), __float_as_uint(x0[j]), false, false); p0[j] = __uint_as_float(fq < 2 ? s0_[1] : s0_[0]);
                            auto s1_ = __builtin_amdgcn_permlane32_swap(__float_as_uint(x1[j]), __float_as_uint(x1[j]), false, false); p1[j] = __uint_as_float(fq < 2 ? s1_[1] : s1_[0]); }
                        x0 = x0 * c0 + p0 * s0; x1 = x1 * c1 + p1 * s1; }
                    x0 = x0 * sc; x1 = x1 * sc;
                    bf16_t* p = dst + (size_t)row * ld + dcol + 8 * fq;
                    u32x4 w; w.x = cvt_pk_bf16(x0[0], x0[1]); w.y = cvt_pk_bf16(x0[2], x0[3]); w.z = cvt_pk_bf16(x1[0], x1[1]); w.w = cvt_pk_bf16(x1[2], x1[3]);
                    *(u32x4*)p = w;
                    if (isvb) { unsigned zz = 0u; asm volatile("" : "+v"(zz)); const u32x4 z = {zz, zz, zz, zz}; *(u32x4*)(p + 64) = z; } }
            }
    }
};
__device__ __forceinline__ void st16_wt(void* p, const u32x4 v) { asm volatile("global_store_dwordx4 %0, %1, off sc1\n\ts_nop 1" :: "v"(p), "v"(v) : "memory"); }
__device__ __forceinline__ void st4bf_wt(bf16_t* p, const f32x4 v) { u32x2 w; w.x = cvt_pk_bf16(v.x, v.y); w.y = cvt_pk_bf16(v.z, v.w); asm volatile("global_store_dwordx2 %0, %1, off sc1\n\ts_nop 0" :: "v"(p), "v"(w) : "memory"); }
struct OutOrder {
    pg8::StaticOrder in; gu32* cnt; gu32* ctxc;
    __device__ __forceinline__ bool next(int i, pg8::Unit& u) const {
        if (ctxc == nullptr) { if (i != 0) return false; return in.next(0, u); }
        const int c = blockIdx.x;
        if (c < 12) { if (i != 0) return false; u.pm = 61 + (c >> 2); u.pn = c & 3; u.aux = 0; return true; }
        if (i == 0) return in.next(0, u);
        if (i == 1 && c < 16) { u.pm = 64; u.pn = c - 12; u.aux = 0; return true; }
        return false; }
    __device__ __forceinline__ void a_ready(const pg8::Unit& u) const {
        if (ctxc != nullptr && u.pm >= 64) { for (unsigned s = 0; s < (1u << 20); ++s) { if ((unsigned)__builtin_amdgcn_readfirstlane((int)__hip_atomic_load(ctxc, __ATOMIC_RELAXED, __HIP_MEMORY_SCOPE_AGENT)) == 12u) break; __builtin_amdgcn_s_sleep(2); }
            __builtin_amdgcn_fence(__ATOMIC_ACQUIRE, "agent"); } }
    __device__ __forceinline__ void done(const pg8::Unit& u) const {
        asm volatile("s_waitcnt vmcnt(0)" ::: "memory");
        int ln; asm volatile("v_mbcnt_lo_u32_b32 %0, -1, 0\n\tv_mbcnt_hi_u32_b32 %0, -1, %0" : "=v"(ln));
        if (ln == 0) __hip_atomic_fetch_add(cnt + u.pm, 1u, __ATOMIC_RELAXED, __HIP_MEMORY_SCOPE_AGENT); }
};
struct EpiOutProj {
    static constexpr bool PERM = true, AFTER_DRAIN = false;
    const float* xin; const float* ctxin; bf16_t* XB; const float* gate_lat; const float* gate_ctx; int layer;
    __device__ __forceinline__ void operator()(const f32x4 (&acc)[2][2][4][2], const pg8::Unit& u, int wr, int wc, int fr, int fq) const {
        const bool isctx = u.pm >= 64; const float* gate = isctx ? gate_ctx : gate_lat; const int col8 = u.pn * 256 + wc * 32 + 8 * fq;
        f32x4 g[2][2];
#pragma unroll
        for (int bj = 0; bj < 2; ++bj) { g[bj][0] = *(const f32x4*)(gate + col8 + bj * 128); g[bj][1] = *(const f32x4*)(gate + col8 + bj * 128 + 4); }
        if (layer == 0) {
#pragma unroll
            for (int am = 0; am < 4; ++am) { const int ai = am >> 1, m0 = (am & 1) * 2; f32x4 x[2][2][2];
#pragma unroll
                for (int mm = 0; mm < 2; ++mm) { const int row = u.pm * 256 + ai * 128 + wr * 64 + (m0 + mm) * 16 + fr;
                    const float* xo = (isctx ? ctxin + (size_t)(row - SEQ) * DM : xin + (size_t)row * DM) + col8;
#pragma unroll
                    for (int bj = 0; bj < 2; ++bj) { x[mm][bj][0] = *(const f32x4*)(xo + bj * 128); x[mm][bj][1] = *(const f32x4*)(xo + bj * 128 + 4); } }
#pragma unroll
                for (int mm = 0; mm < 2; ++mm) { const int m = m0 + mm; const int row = u.pm * 256 + ai * 128 + wr * 64 + m * 16 + fr; bf16_t* xn = XB + (size_t)row * DM + col8;
#pragma unroll
                    for (int bj = 0; bj < 2; ++bj) { const f32x4 y0 = x[mm][bj][0] + g[bj][0] * acc[ai][bj][m][0], y1 = x[mm][bj][1] + g[bj][1] * acc[ai][bj][m][1];
                        u32x4 o; o.x = cvt_pk_bf16(y0.x, y0.y); o.y = cvt_pk_bf16(y0.z, y0.w); o.z = cvt_pk_bf16(y1.x, y1.y); o.w = cvt_pk_bf16(y1.z, y1.w);
                        st16_wt(xn + bj * 128, o); } } }
        } else {
#pragma unroll
            for (int ai = 0; ai < 2; ++ai) { u32x4 xw[4][2];
#pragma unroll
                for (int m = 0; m < 4; ++m) { const int row = u.pm * 256 + ai * 128 + wr * 64 + m * 16 + fr; const bf16_t* xn = XB + (size_t)row * DM + col8;
#pragma unroll
                    for (int bj = 0; bj < 2; ++bj) xw[m][bj] = *(const u32x4*)(xn + bj * 128); }
#pragma unroll
                for (int m = 0; m < 4; ++m) { const int row = u.pm * 256 + ai * 128 + wr * 64 + m * 16 + fr; bf16_t* xn = XB + (size_t)row * DM + col8;
#pragma unroll
                    for (int bj = 0; bj < 2; ++bj) { const u32x4 w = xw[m][bj];
                        const f32x4 x0 = {__builtin_bit_cast(float, w.x << 16), __builtin_bit_cast(float, w.x & 0xffff0000u), __builtin_bit_cast(float, w.y << 16), __builtin_bit_cast(float, w.y & 0xffff0000u)};
                        const f32x4 x1 = {__builtin_bit_cast(float, w.z << 16), __builtin_bit_cast(float, w.z & 0xffff0000u), __builtin_bit_cast(float, w.w << 16), __builtin_bit_cast(float, w.w & 0xffff0000u)};
                        const f32x4 y0 = x0 + g[bj][0] * acc[ai][bj][m][0], y1 = x1 + g[bj][1] * acc[ai][bj][m][1];
                        u32x4 o; o.x = cvt_pk_bf16(y0.x, y0.y); o.y = cvt_pk_bf16(y0.z, y0.w); o.z = cvt_pk_bf16(y1.x, y1.y); o.w = cvt_pk_bf16(y1.z, y1.w);
                        st16_wt(xn + bj * 128, o); } } }
        }
    }
};
struct EpiMoe1 {
    static constexpr bool PERM = true, AFTER_DRAIN = false;
    bf16_t* HS;
    __device__ __forceinline__ void operator()(const f32x4 (&acc)[2][2][4][2], const pg8::Unit& u, int wr, int wc, int fr, int fq) const {
        const int col8 = (u.pn & 3) * 128 + wc * 32 + 8 * fq;
#pragma unroll
        for (int ai = 0; ai < 2; ++ai)
#pragma unroll
            for (int m = 0; m < 4; ++m) { const int row = u.pm * 256 + ai * 128 + wr * 64 + m * 16 + fr;
                const f32x4 a0 = acc[ai][0][m][0], a1 = acc[ai][0][m][1], b0 = acc[ai][1][m][0], b1 = acc[ai][1][m][1];
                u32x4 w; w.x = cvt_pk_bf16(silu_f(a0[0]) * b0[0], silu_f(a0[1]) * b0[1]); w.y = cvt_pk_bf16(silu_f(a0[2]) * b0[2], silu_f(a0[3]) * b0[3]);
                w.z = cvt_pk_bf16(silu_f(a1[0]) * b1[0], silu_f(a1[1]) * b1[1]); w.w = cvt_pk_bf16(silu_f(a1[2]) * b1[2], silu_f(a1[3]) * b1[3]);
                st16_wt(HS + (size_t)row * FFE + col8, w); }
    }
};
constexpr float YS_SCALE = 16.f, YS_INV = 1.f / 16.f;
struct EpiMoe2 {
    static constexpr bool PERM = true, AFTER_DRAIN = false;
    unsigned char* YS;
    __device__ __forceinline__ void operator()(const f32x4 (&acc)[2][2][4][2], const pg8::Unit& u, int wr, int wc, int fr, int fq) const {
        const int col8 = (u.pn & 3) * 256 + wc * 32 + 8 * fq;
#pragma unroll
        for (int ai = 0; ai < 2; ++ai)
#pragma unroll
            for (int m = 0; m < 4; ++m) { const int row = u.pm * 256 + ai * 128 + wr * 64 + m * 16 + fr;
#pragma unroll
                for (int bj = 0; bj < 2; ++bj) { f32x4 v0 = acc[ai][bj][m][0] * YS_SCALE, v1 = acc[ai][bj][m][1] * YS_SCALE;
#pragma unroll
                    for (int j = 0; j < 4; ++j) { v0[j] = __builtin_amdgcn_fmed3f(v0[j], -448.f, 448.f); v1[j] = __builtin_amdgcn_fmed3f(v1[j], -448.f, 448.f); }
                    int w0 = __builtin_amdgcn_cvt_pk_fp8_f32(v0[0], v0[1], 0, false); w0 = __builtin_amdgcn_cvt_pk_fp8_f32(v0[2], v0[3], w0, true);
                    int w1 = __builtin_amdgcn_cvt_pk_fp8_f32(v1[0], v1[1], 0, false); w1 = __builtin_amdgcn_cvt_pk_fp8_f32(v1[2], v1[3], w1, true);
                    *(u32x2*)(YS + (size_t)row * DM + col8 + bj * 128) = (u32x2){(unsigned)w0, (unsigned)w1}; } }
    }
};
struct MoeOrder {
    int G, vcu, nunits; int ts[16]; const int* rowtok;
    __device__ __forceinline__ unsigned row_off(const pg8::Unit& u, int r) const { return (unsigned)min((unsigned)rowtok[u.aux + r], (unsigned)(NROW - 1)) * (unsigned)(DM * 2); }
    __device__ __forceinline__ bool next(int i, pg8::Unit& u) const {
        const int L = i * G + vcu; if (L >= nunits) return false;
        const int rt = L >> 2, ct = L & 3; int e = 0, tb = ts[0];
#pragma unroll
        for (int k = 1; k < 16; ++k) { const bool ge = rt >= ts[k]; e += ge ? 1 : 0; tb = ge ? ts[k] : tb; }
        u.pm = rt; u.pn = e * 4 + ct; u.aux = e * ROWCAP + (rt - tb) * 256; return true;
    }
    __device__ __forceinline__ int nloc() const { return vcu < nunits ? (nunits - vcu + G - 1) / G : 0; }
    __device__ __forceinline__ void a_ready(const pg8::Unit&) const {}
    __device__ __forceinline__ void done(const pg8::Unit&) const {}
};

struct MoeOrder2 {
    int vcu, nunits, part; int ts[16];
    __device__ __forceinline__ bool next(int i, pg8::Unit& u) const {
        const int U = nunits, q = U >> 8, r = U & 255; int L;
        if (part == 0) { if (vcu < r || i >= q) return false; L = i * 256 + vcu; }
        else { int b = vcu + i * 256; if (b >= (q + 1) * r) return false; int k = 0; while (b >= r) { b -= r; ++k; } L = k * 256 + b; }
        const int rt = L >> 2, ct = L & 3; int e = 0;
#pragma unroll
        for (int k = 1; k < 16; ++k) e += (rt >= ts[k]) ? 1 : 0;
        u.pm = rt; u.pn = e * 4 + ct; u.aux = 0; return true; }
    __device__ __forceinline__ void a_ready(const pg8::Unit&) const {}
    __device__ __forceinline__ void done(const pg8::Unit&) const {}
};
__device__ __forceinline__ void moe_wait(gu32* flag, int base, int n) {
    const int tid = otid();
    if (tid < 64) { for (unsigned s = 0; s < (1u << 20); ++s) { bool ok = true;
            for (int j = tid; j < n; j += 64) ok = ok && (__hip_atomic_load(flag + base + j, __ATOMIC_RELAXED, __HIP_MEMORY_SCOPE_AGENT) == 1u);
            if (__all(ok)) break; __builtin_amdgcn_s_sleep(2); }
        __builtin_amdgcn_fence(__ATOMIC_ACQUIRE, "agent"); asm volatile("s_waitcnt vmcnt(0)" ::: "memory"); }
    __syncthreads();
}

__device__ __forceinline__ void tr_item(const float* W, int ldw, int k0, int n0, bf16_t* WT, int K, int nd0, LAS float* scr, int lane) {
    f32x4 v[8];
#pragma unroll
    for (int i = 0; i < 8; ++i) v[i] = *(const f32x4*)(W + (size_t)(k0 + 8 * i + (lane >> 3)) * ldw + n0 + (lane & 7) * 4);
#pragma unroll
    for (int i = 0; i < 8; ++i) { LAS float* d = scr + (8 * i + (lane >> 3)) * 33 + (lane & 7) * 4; d[0] = v[i].x; d[1] = v[i].y; d[2] = v[i].z; d[3] = v[i].w; }
    LDS_WAIT(); asm volatile("" ::: "memory");
    const int c = lane & 7;
#pragma unroll
    for (int j = 0; j < 4; ++j) { const int n = (lane >> 3) + 8 * j; const LAS float* s = scr + (8 * c) * 33 + n;
        u32x4 o; o.x = pk2(s[0 * 33], s[1 * 33]); o.y = pk2(s[2 * 33], s[3 * 33]); o.z = pk2(s[4 * 33], s[5 * 33]); o.w = pk2(s[6 * 33], s[7 * 33]);
        *(u32x4*)(WT + (size_t)(nd0 + n) * K + k0 + 8 * c) = o; }
    LDS_WAIT(); asm volatile("" ::: "memory");
}
__device__ __forceinline__ void moe_convert(const Args& a, int L, LAS float* scr, int gw, int NGW, int lane, int it0 = 0, int it1 = 12288) {
    bf16_t* W13T = (bf16_t*)(a.ws + WS_W13) + (size_t)L * 16 * 1024 * 1024; bf16_t* W2T = (bf16_t*)(a.ws + WS_W2) + (size_t)L * 16 * 1024 * 512;
    for (int it = it0 + gw; it < it1; it += NGW) {
        if (it < 8192) { const int e = it >> 9, r2 = it & 511, kb = r2 >> 5, nb = r2 & 31, nd0 = 32 * nb, t = nd0 >> 8, bj = (nd0 >> 7) & 1, i0 = nd0 & 127;
            const float* src = (bj ? a.in[I_W3] : a.in[I_W1]) + (size_t)(L * 16 + e) * 1024 * 512;
            tr_item(src, 512, 64 * kb, t * 128 + i0, W13T + (size_t)e * 1024 * 1024, 1024, nd0, scr, lane); }
        else { const int r = it - 8192, e = r >> 8, r2 = r & 255, kb = r2 >> 5, nb = r2 & 31;
            tr_item(a.in[I_W2] + (size_t)(L * 16 + e) * 512 * 1024, 1024, 64 * kb, 32 * nb, W2T + (size_t)e * 1024 * 512, 512, 32 * nb, scr, lane); }
    }
}
__device__ __forceinline__ void prologue_phase(const Args& a, unsigned char* lds) {
    const int tid = otid(), lane = tid & 63, wave = tid >> 6, gw = blockIdx.x * NWAVES + wave, NGW = gridDim.x * NWAVES;
    LAS float* scr = (LAS float*)((LAS unsigned char*)lds + wave * 8704);
    bf16_t* WinT = (bf16_t*)(a.ws + WS_WIN); bf16_t* WoutT = (bf16_t*)(a.ws + WS_WOUT);
    for (int it = gw; it < 3584; it += NGW) {
        if (it < 2560) { const int L = it / 1280, r = it % 1280, kb = r / 80, nb = r % 80, nd0 = 32 * nb; int n0 = nd0;
            if (nd0 >= 2048) { const int q = nd0 - 2048, t = q >> 8, bj = (q >> 7) & 1, i0 = q & 127; n0 = 2048 + bj * 256 + t * 128 + i0; }
            tr_item(a.in[I_WIN] + (size_t)L * 1024 * INW, INW, 64 * kb, n0, WinT + (size_t)L * INW * 1024, 1024, nd0, scr, lane); }
        else { const int r0 = it - 2560, L = r0 >> 9, r = r0 & 511, kb = r >> 5, nb = r & 31;
            tr_item(a.in[I_WOUT] + (size_t)L * 1024 * 1024, 1024, 64 * kb, 32 * nb, WoutT + (size_t)L * 1024 * 1024, 1024, 32 * nb, scr, lane); }
    }
    moe_convert(a, 0, scr, gw, NGW, lane, 0, 8192);
    __syncthreads();
    float* sc = (float*)(lds + 71680); float* scc = sc + 1024; float* red = scc + 1024;
    float* MOD = (float*)(a.ws + WS_MOD);
    for (int u = blockIdx.x; u < 192; u += gridDim.x) {
        const int L = u / 96, col0 = (u % 96) * 64;
        for (int k = tid; k < 1024; k += NTHREADS) { const float c = a.in[I_C][k], cc = a.in[I_CCTX][k]; sc[k] = c / (1.f + expf(-c)); scc[k] = cc / (1.f + expf(-cc)); }
        __syncthreads();
        const int cg = tid & 15, ks = tid >> 4;
        const float* w = a.in[I_WADA] + ((size_t)L * 1024 + ks * 32) * 6144 + col0 + cg * 4;
        f32x4 s1 = {0.f, 0.f, 0.f, 0.f}, s2 = {0.f, 0.f, 0.f, 0.f};
#pragma unroll 8
        for (int k = 0; k < 32; ++k) { const f32x4 wv = *(const f32x4*)(w + (size_t)k * 6144); s1 = s1 + wv * sc[ks * 32 + k]; s2 = s2 + wv * scc[ks * 32 + k]; }
        *(f32x4*)(red + (ks * 16 + cg) * 8) = s1; *(f32x4*)(red + (ks * 16 + cg) * 8 + 4) = s2;
        __syncthreads();
        if (tid < 128) { const int which = tid >> 6, c = tid & 63; float s = 0.f;
            for (int k = 0; k < 32; ++k) s += red[(k * 16 + (c >> 2)) * 8 + which * 4 + (c & 3)];
            MOD[(L * 2 + which) * 6144 + col0 + c] = s + a.in[I_BADA][L * 6144 + col0 + c]; }
        __syncthreads();
    }
    if (blockIdx.x >= 192 && tid < 64) {
        float* rc = (float*)(a.ws + WS_ROPEC); float* rs = (float*)(a.ws + WS_ROPES);
        const int i = ((int)blockIdx.x - 192) * 64 + tid; const int pos = i >> 4, f = i & 15; const float inv = powf(10000.f, -(float)f / 16.f), ang = (float)pos * inv; rc[i] = cosf(ang); rs[i] = sinf(ang);
    }
    if (blockIdx.x == gridDim.x - 2 && wave < 2) {
        const float* dl = a.in[I_DLAM] + wave * 256;
        const float s01 = wave_sum(dl[lane] * dl[64 + lane]), s23 = wave_sum(dl[128 + lane] * dl[192 + lane]);
        if (lane == 0) ((float*)(a.ws + WS_LAM))[wave] = expf(s01) - expf(s23) + LAMBDA_INIT[wave];
    }
}

__device__ __forceinline__ void norm1_phase(const Args& a, int l) {
    constexpr int NR = 4;
    const int tid = otid(), lane = tid & 63, wave = tid >> 6;
    const int nrows = (l == 2) ? SEQ : NROW, rpw = (nrows + gridDim.x - 1) / gridDim.x, r0 = blockIdx.x * rpw, r1 = min(nrows, r0 + rpw);
    const int rw = (rpw + NWAVES - 1) / NWAVES, wr0 = r0 + wave * rw, wr1 = min(r1, wr0 + rw);
    bf16_t* XB = (bf16_t*)(a.ws + WS_XB); bf16_t* HB = (bf16_t*)(a.ws + WS_HB); const unsigned char* YS = a.ws + WS_RA;
    const float* MOD = (const float*)(a.ws + WS_MOD);
    const int2* TOKP = (const int2*)(a.ws + WS_TOKP); const float2* TOKW = (const float2*)(a.ws + WS_TOKW);
    f32x4 ga[4], gb[4], gq[4]; int cur_ctx = -1;
#define N1_PARAMS(isctx_) do { if ((int)(isctx_) != cur_ctx) { cur_ctx = (int)(isctx_); \
        if (l < 2) { const f32x4* g_ = (const f32x4*)(a.in[I_GMIX] + l * DM) + lane; const float* md_ = MOD + (l * 2 + cur_ctx) * 6144; \
            _Pragma("unroll") for (int j = 0; j < 4; ++j) { ga[j] = g_[64 * j] * (((const f32x4*)(md_ + 1024) + lane)[64 * j] + 1.f); gb[j] = ((const f32x4*)(md_) + lane)[64 * j]; } } \
        else { const f32x4* g_ = (const f32x4*)(a.in[I_GFIN]) + lane; _Pragma("unroll") for (int j = 0; j < 4; ++j) { ga[j] = g_[64 * j]; gb[j] = ga[j]; } } \
        if (l != 0) { const f32x4* q_ = (const f32x4*)(MOD + ((l - 1) * 2 + cur_ctx) * 6144 + 5 * 1024) + lane; _Pragma("unroll") for (int j = 0; j < 4; ++j) gq[j] = q_[64 * j]; } \
        else { _Pragma("unroll") for (int j = 0; j < 4; ++j) gq[j] = ga[j]; } } } while (0)
    for (int rb = wr0; rb < wr1; rb += NR) {
        f32x4 v[NR][4]; int rowk[NR];
#pragma unroll
        for (int k = 0; k < NR; ++k) rowk[k] = min(rb + k, wr1 - 1);
        if (l == 0) {
#pragma unroll
            for (int k = 0; k < NR; ++k) { const int row = rowk[k]; const bool isctx = row >= SEQ;
                const f32x4* src = (const f32x4*)(isctx ? a.in[I_CTX] + (size_t)(row - SEQ) * DM : a.in[I_X] + (size_t)row * DM) + lane;
#pragma unroll
                for (int j = 0; j < 4; ++j) v[k][j] = src[64 * j]; }
        } else {
            int2 pp[NR]; float2 ww[NR];
#pragma unroll
            for (int k = 0; k < NR; ++k) { pp[k] = TOKP[rowk[k]]; ww[k] = TOKW[rowk[k]]; }
            { const int* tsg = (const int*)(a.ws + WS_TSG) + (l - 1) * 32;
#pragma unroll
              for (int k = 0; k < NR; ++k) { pp[k].x = tsg[pp[k].x >> 15] * 256 + (pp[k].x & 32767); pp[k].y = tsg[pp[k].y >> 15] * 256 + (pp[k].y & 32767); } }
            unsigned y0[NR][4], y1[NR][4];
#pragma unroll
            for (int k = 0; k < NR; ++k) { const int row = rowk[k]; const bool isctx = row >= SEQ;
                const bf16_t* xb = XB + (size_t)row * DM + 4 * lane; (void)isctx;
                const unsigned* q0 = (const unsigned*)(YS + (size_t)pp[k].x * DM) + lane; const unsigned* q1 = (const unsigned*)(YS + (size_t)pp[k].y * DM) + lane;
#pragma unroll
                for (int j = 0; j < 4; ++j) { v[k][j] = ld4bf(xb + 256 * j); y0[k][j] = q0[64 * j]; y1[k][j] = q1[64 * j]; } }
#pragma unroll
            for (int k = 0; k < NR; ++k) { const bool st = (rb + k < wr1) && (l < 2); bf16_t* xb = XB + (size_t)rowk[k] * DM + 4 * lane; N1_PARAMS(rowk[k] >= SEQ);
#pragma unroll
                for (int j = 0; j < 4; ++j) { const int p0 = (int)y0[k][j], p1 = (int)y1[k][j];
                    const auto a01 = __builtin_amdgcn_cvt_pk_f32_fp8(p0, false), a23 = __builtin_amdgcn_cvt_pk_f32_fp8(p0, true), b01 = __builtin_amdgcn_cvt_pk_f32_fp8(p1, false), b23 = __builtin_amdgcn_cvt_pk_f32_fp8(p1, true);
                    const f32x4 ya = {a01[0], a01[1], a23[0], a23[1]}, yb = {b01[0], b01[1], b23[0], b23[1]};
                    v[k][j] = v[k][j] + gq[j] * (ya * (ww[k].x * YS_INV) + yb * (ww[k].y * YS_INV));
                    if (st) st4bf(xb + 256 * j, v[k][j]); } }
        }
#pragma unroll
        for (int k = 0; k < NR; ++k) { const int row = rowk[k]; const bool isctx = row >= SEQ, st = rb + k < wr1;
            float ss = 0.f;
#pragma unroll
            for (int j = 0; j < 4; ++j) ss += (v[k][j].x * v[k][j].x + v[k][j].y * v[k][j].y) + (v[k][j].z * v[k][j].z + v[k][j].w * v[k][j].w);
            const float rstd = 1.f / sqrtf(wave_sum(ss) * (1.f / DM) + EPS);
            N1_PARAMS(isctx);
            if (l < 2) {
                u32x2* o8 = (u32x2*)(HB + (size_t)row * DM) + lane;
#pragma unroll
                for (int j = 0; j < 4; ++j) { const f32x4 h = v[k][j] * rstd * ga[j] + gb[j];
                    u32x2 w; w.x = cvt_pk_bf16(h.x, h.y); w.y = cvt_pk_bf16(h.z, h.w); if (st) o8[64 * j] = w; }
            } else {
                f32x4* o = (f32x4*)(a.out + (size_t)row * DM) + lane;
#pragma unroll
                for (int j = 0; j < 4; ++j) { const f32x4 r = v[k][j] * rstd * ga[j]; if (st) o[64 * j] = r; }
            }
        }
    }
}
#undef N1_PARAMS
__device__ __forceinline__ void norm2_phase(const Args& a, int l, unsigned char* lds) {
    const int tid = otid(), lane = tid & 63, wave = tid >> 6;
    const int b_ = blockIdx.x;
    const int nlat = (l == 1) ? 64 : (b_ < 16 ? 1 : 65), lat0 = (l == 1) ? b_ * 64 : (b_ < 16 ? 240 * 65 + b_ : (b_ - 16) * 65);
    const int nlate = (l == 1) ? 0 : 4, late0 = 61 * 256 + 4 * b_, tl = 61 + (b_ >> 6), nloc = nlat + nlate;
#define N2_ROW(i) ((i) < nlat ? lat0 + (i) : late0 + ((i) - nlat))
    float* hrow = (float*)lds;
    float* logit = (float*)(lds + 65536);
    int* e01 = (int*)(lds + 65536 + 8192);
    for (int i = tid; i < 128; i += NTHREADS) e01[i] = -1;
    gu32* cnt = (gu32*)(a.ws + WS_CTL) + CW_OPC + l * 128;
#define N2_WAIT(ta_, tb_) do { if (tid < 64) { for (unsigned s = 0; s < (1u << 20); ++s) { const unsigned c = __hip_atomic_load(cnt + ((lane & 1) ? (tb_) : (ta_)), __ATOMIC_RELAXED, __HIP_MEMORY_SCOPE_AGENT); \
              if (__all(c == 32u)) break; __builtin_amdgcn_s_sleep(2); } \
          __builtin_amdgcn_fence(__ATOMIC_ACQUIRE, "agent"); asm volatile("s_waitcnt vmcnt(0)" ::: "memory"); } \
      __syncthreads(); } while (0)
    N2_WAIT(lat0 >> 8, (lat0 + nlat - 1) >> 8);
    const bf16_t* XB = (const bf16_t*)(a.ws + WS_XB); bf16_t* HB = (bf16_t*)(a.ws + WS_HB); const float* MOD = (const float*)(a.ws + WS_MOD);
    int2* TOKE = (int2*)(a.ws + WS_TOKE); float2* TOKW = (float2*)(a.ws + WS_TOKW);
    const int eg = wave & 3, rh = wave >> 2;
    f32x4 wk[4][4];
#pragma unroll
    for (int j = 0; j < 4; ++j)
#pragma unroll
        for (int c = 0; c < 4; ++c) wk[j][c] = *(const f32x4*)(a.in[I_RW] + (size_t)(256 * j + 4 * lane + c) * 16 + 4 * eg);
    f32x4 ga[4], gb[4]; int cur_ctx = -1;
#define N2_PARAMS(isctx_) do { if ((int)(isctx_) != cur_ctx) { cur_ctx = (int)(isctx_); const f32x4* g_ = (const f32x4*)(a.in[I_GFFN] + l * DM) + lane; const float* md_ = MOD + (l * 2 + cur_ctx) * 6144; \
        _Pragma("unroll") for (int j = 0; j < 4; ++j) { ga[j] = g_[64 * j] * (((const f32x4*)(md_ + 4 * 1024) + lane)[64 * j] + 1.f); gb[j] = ((const f32x4*)(md_ + 3 * 1024) + lane)[64 * j]; } } } while (0)
    u32x2 xr[2][4];
#define N2_LOADX(rb_) do { _Pragma("unroll") for (int k = 0; k < 2; ++k) { const bf16_t* xb = XB + (size_t)N2_ROW(min((rb_) + 2 * wave + k, nloc - 1)) * DM + 4 * lane; \
        _Pragma("unroll") for (int j = 0; j < 4; ++j) xr[k][j] = *(const u32x2*)(xb + 256 * j); } } while (0)
    const bool cfirst = (l != 1) && nlat < 16;
    if (cfirst) N2_WAIT(tl, tl);
    N2_LOADX(0);
    for (int rb = 0; rb < nloc; rb += 16) {
        if ((l != 1) && !cfirst && rb <= nlat && nlat < rb + 16) { N2_WAIT(tl, tl); N2_LOADX(rb); }
        f32x4 vv[2][4];
#pragma unroll
        for (int k = 0; k < 2; ++k)
#pragma unroll
            for (int j = 0; j < 4; ++j) { const u32x2 w = xr[k][j]; vv[k][j] = (f32x4){__builtin_bit_cast(float, w.x << 16), __builtin_bit_cast(float, w.x & 0xffff0000u), __builtin_bit_cast(float, w.y << 16), __builtin_bit_cast(float, w.y & 0xffff0000u)}; }
#pragma unroll
        for (int k = 0; k < 2; ++k) { const int row = N2_ROW(min(rb + 2 * wave + k, nloc - 1)); const bool isctx = row >= SEQ, st = rb + 2 * wave + k < nloc;
            float ss = 0.f;
#pragma unroll
            for (int j = 0; j < 4; ++j) ss += (vv[k][j].x * vv[k][j].x + vv[k][j].y * vv[k][j].y) + (vv[k][j].z * vv[k][j].z + vv[k][j].w * vv[k][j].w);
            const float rstd = 1.f / sqrtf(wave_sum(ss) * (1.f / DM) + EPS);
            N2_PARAMS(isctx);
            u32x2* o8 = (u32x2*)(HB + (size_t)row * DM) + lane; f32x4* hr = (f32x4*)(hrow + (2 * wave + k) * 1024) + lane;
#pragma unroll
            for (int j = 0; j < 4; ++j) { const f32x4 h = vv[k][j] * rstd * ga[j] + gb[j];
                hr[64 * j] = h; u32x2 w; w.x = cvt_pk_bf16(h.x, h.y); w.y = cvt_pk_bf16(h.z, h.w); if (st) o8[64 * j] = w; } }
        __syncthreads();
        if (rb + 16 < nloc && !((l != 1) && rb + 16 <= nlat && nlat < rb + 32)) N2_LOADX(rb + 16);
        float v32[32];
#pragma unroll
        for (int q = 0; q < 8; ++q) { const f32x4* hr = (const f32x4*)(hrow + (rh * 8 + q) * 1024) + lane; f32x4 acc = {0.f, 0.f, 0.f, 0.f};
#pragma unroll
            for (int j = 0; j < 4; ++j) { const f32x4 h = hr[64 * j];
#pragma unroll
                for (int e = 0; e < 4; ++e) { acc[e] = __builtin_fmaf(h.x, wk[j][0][e], acc[e]); acc[e] = __builtin_fmaf(h.y, wk[j][1][e], acc[e]); acc[e] = __builtin_fmaf(h.z, wk[j][2][e], acc[e]); acc[e] = __builtin_fmaf(h.w, wk[j][3][e], acc[e]); } }
            v32[q * 4] = acc[0]; v32[q * 4 + 1] = acc[1]; v32[q * 4 + 2] = acc[2]; v32[q * 4 + 3] = acc[3]; }
        float v16[16], v8[8], v4[4], v2[2], v1;
#pragma unroll
        for (int i = 0; i < 16; ++i) { const bool up = (lane & 32) != 0; v16[i] = (up ? v32[16 + i] : v32[i]) + __shfl_xor(up ? v32[i] : v32[16 + i], 32); }
#pragma unroll
        for (int i = 0; i < 8; ++i) { const bool up = (lane & 16) != 0; v8[i] = (up ? v16[8 + i] : v16[i]) + __shfl_xor(up ? v16[i] : v16[8 + i], 16); }
#pragma unroll
        for (int i = 0; i < 4; ++i) { const bool up = (lane & 8) != 0; v4[i] = (up ? v8[4 + i] : v8[i]) + __shfl_xor(up ? v8[i] : v8[4 + i], 8); }
#pragma unroll
        for (int i = 0; i < 2; ++i) { const bool up = (lane & 4) != 0; v2[i] = (up ? v4[2 + i] : v4[i]) + __shfl_xor(up ? v4[i] : v4[2 + i], 4); }
        { const bool up = (lane & 2) != 0; v1 = (up ? v2[1] : v2[0]) + __shfl_xor(up ? v2[0] : v2[1], 2); }
        v1 += __shfl_xor(v1, 1);
        { const int I = (lane >> 1) & 31, q = I >> 2, e = I & 3; const int rl = rh * 8 + q;
          if ((lane & 1) == 0 && rb + rl < nloc) logit[(rb + rl) * 16 + 4 * eg + e] = v1; }
        __syncthreads();
    }
#undef N2_LOADX
#undef N2_WAIT
#undef N2_PARAMS
    if (wave < 2) { const int rowl = wave * 64 + lane, row = N2_ROW(rowl);
      if (rowl < nloc) {
        float lg[16];
#pragma unroll
        for (int q = 0; q < 4; ++q) { const f32x4 t = *(const f32x4*)(logit + rowl * 16 + 4 * q); lg[4 * q] = t.x; lg[4 * q + 1] = t.y; lg[4 * q + 2] = t.z; lg[4 * q + 3] = t.w; }
        float sg[16], bs[16];
#pragma unroll
        for (int e = 0; e < 16; ++e) { sg[e] = sigmoid_f(lg[e]); bs[e] = sg[e] + a.in[I_RB][e]; }
        int gsel = 0; float best = 0.f;
#pragma unroll
        for (int gi = 0; gi < 4; ++gi) { const float p_ = bs[4 * gi], q_ = bs[4 * gi + 1], r_ = bs[4 * gi + 2], s_ = bs[4 * gi + 3];
            const float h1 = fmaxf(p_, q_), l1 = fminf(p_, q_), h2 = fmaxf(r_, s_), l2 = fminf(r_, s_);
            const float gsc = fmaxf(h1, h2) + fmaxf(fminf(h1, h2), fmaxf(l1, l2));
            if (gi == 0 || gsc > best) { best = gsc; gsel = gi; } }
        float gb[4], gs4[4];
#pragma unroll
        for (int i = 0; i < 4; ++i) { gb[i] = gsel == 0 ? bs[i] : gsel == 1 ? bs[4 + i] : gsel == 2 ? bs[8 + i] : bs[12 + i];
            gs4[i] = gsel == 0 ? sg[i] : gsel == 1 ? sg[4 + i] : gsel == 2 ? sg[8 + i] : sg[12 + i]; }
        int i0 = 0; float b0 = gb[0];
#pragma unroll
        for (int i = 1; i < 4; ++i) if (gb[i] > b0) { b0 = gb[i]; i0 = i; }
        int i1 = -1; float b1 = 0.f;
#pragma unroll
        for (int i = 0; i < 4; ++i) if (i != i0 && (i1 < 0 || gb[i] > b1)) { b1 = gb[i]; i1 = i; }
        const float s0 = i0 == 0 ? gs4[0] : i0 == 1 ? gs4[1] : i0 == 2 ? gs4[2] : gs4[3];
        const float s1 = i1 == 0 ? gs4[0] : i1 == 1 ? gs4[1] : i1 == 2 ? gs4[2] : gs4[3];
        const int e0 = gsel * 4 + i0, e1 = gsel * 4 + i1; const float inv = 1.f / (s0 + s1);
        TOKE[row] = make_int2(e0, e1); TOKW[row] = make_float2(s0 * inv, s1 * inv); e01[rowl] = e0 | (e1 << 8);
      } }
    __syncthreads();
    if (wave == 0) {
        int cnt = 0;
        for (int p = 0; p < 2; ++p) { const int pk = e01[p * 64 + lane]; const int e0 = pk < 0 ? -1 : (pk & 255), e1 = pk < 0 ? -1 : (pk >> 8);
#pragma unroll
            for (int e = 0; e < 16; ++e) { const int c = __popcll(__ballot(e0 == e)) + __popcll(__ballot(e1 == e)); if (lane == e) cnt += c; } }
        int base = 0;
        if (lane < 16) base = (int)__hip_atomic_fetch_add((unsigned*)(a.ws + WS_CTL) + CW_TOT + l * 64 + lane, (unsigned)cnt, __ATOMIC_RELAXED, __HIP_MEMORY_SCOPE_AGENT);
        int run[16];
#pragma unroll
        for (int e = 0; e < 16; ++e) run[e] = __builtin_amdgcn_readlane(base, e);
        int2* TOKP = (int2*)(a.ws + WS_TOKP); int* ROWTOK2 = (int*)(a.ws + WS_ROWTOK2) + (size_t)l * 16 * ROWCAP;
        for (int p = 0; p < 2; ++p) { const int i = p * 64 + lane, row = N2_ROW(i); const int pk = e01[i]; const bool ok = pk >= 0;
            const int ex = ok ? (pk & 255) : -1, ey = ok ? (pk >> 8) : -1;
            int pos0 = 0, pos1 = 0; const unsigned long long lt = (1ull << lane) - 1ull;
#pragma unroll
            for (int e = 0; e < 16; ++e) { const unsigned long long m0 = __ballot(ex == e), m1 = __ballot(ey == e);
                if (ex == e) pos0 = run[e] + __popcll(m0 & lt);
                if (ey == e) pos1 = run[e] + __popcll(m0) + __popcll(m1 & lt);
                run[e] += __popcll(m0) + __popcll(m1); }
            if (ok) { TOKP[row] = make_int2(ex * 32768 + pos0, ey * 32768 + pos1); ROWTOK2[ex * ROWCAP + pos0] = row; ROWTOK2[ey * ROWCAP + pos1] = row; } }
    }
    __syncthreads();
#undef N2_ROW
}
#ifndef ATT
#define ATT att2
#endif
#ifndef REP_INPROJ
#define REP_INPROJ 1
#endif
#ifndef REP_ATTN
#define REP_ATTN 1
#endif
#ifndef REP_OUTPROJ
#define REP_OUTPROJ 1
#endif
#ifndef REP_N2SC
#define REP_N2SC 1
#endif
#ifndef REP_MOE
#define REP_MOE 1
#endif
template <class Inner> struct RepOrder { Inner in; int ntot;
    __device__ __forceinline__ bool next(int i, pg8::Unit& u) const { if (i >= ntot) return false; const int nl = in.nloc(); return in.next(i % nl, u); }
    __device__ __forceinline__ unsigned row_off(int r) const { return in.row_off(r); }
    __device__ __forceinline__ void a_ready(const pg8::Unit&) const {}
    __device__ __forceinline__ void done(const pg8::Unit&) const {} };

__device__ __forceinline__ bool wg_any(bool pred, int* ws, int wid, int lane) {
    const int w = __any(pred) ? 1 : 0;
    __syncthreads();
    if (lane == 0) ws[wid] = w;
    __syncthreads();
    int r = 0;
#pragma unroll
    for (int i = 0; i < NWAVES; ++i) r |= ws[i];
    __syncthreads();
    return r != 0;
}
__device__ __forceinline__ void diff_unit(const Args& a, int l, int qt, int head, char* lds) {
    int tid_ = otid();
    const int tid = tid_, wid = tid >> 6, lane = tid & 63;
    const bool isctx = qt >= 64; const int q0 = qt * 256, nA = isctx ? 4 : 260, a0 = isctx ? SEQ : 0;
    const bf16_t* QA = (const bf16_t*)(a.ws + RA_QA); const bf16_t* KA = (const bf16_t*)(a.ws + RA_KA); const bf16_t* VA = (const bf16_t*)(a.ws + RA_VA);
    bf16_t* MIX = (bf16_t*)(a.ws + WS_HB);
    float* stash0 = (float*)(a.ws + WS_RB) + (size_t)blockIdx.x * 256 * 128;
    float* wsf = (float*)(lds + ATT::LDS_WS) + wid * 64;
    const float lam = ((const float*)(a.ws + WS_LAM))[l], post = 1.f - LAMBDA_INIT[l];
    for (int map = 0; map < 2; ++map) {
        f32x16 o[4]; float m_, l_;
        const bf16_t* Qw_ = QA + (size_t)(q0 + wid * 32 + (lane & 31)) * 512 + head * 128 + map * 64;
        ATT::attn_body<0, 512, 512, false>(Qw_, KA + head * 128 + map * 64, VA + head * 128, nA, a0, 0, nA, 0, lds, tid, o, m_, l_);
        if (wg_any(!(l_ < 1.0e18f), (int*)(lds + ATT::LDS_WS) + 8 * 64, wid, lane)) {
            ATT::attn_body<0, 512, 512, true>(Qw_, KA + head * 128 + map * 64, VA + head * 128, nA, a0, 0, nA, 0, lds, tid, o, m_, l_); }
        int lo_ = lane; asm volatile("" : "+v"(lo_));
        const int r32 = lo_ & 31, hi = lo_ >> 5;
        float* stashv = stash0 + (size_t)((wid << 6) | lo_) * 4;
        if (hi == 0) wsf[r32] = l_;
        LDS_WAIT();
        float rli[16];
#pragma unroll
        for (int r = 0; r < 16; ++r) rli[r] = __builtin_amdgcn_rcpf(wsf[ATT::crow(r, hi)]);
        if (map == 0) {
#pragma unroll
            for (int d0 = 0; d0 < 4; ++d0)
#pragma unroll
                for (int rq = 0; rq < 4; ++rq) *(f32x4*)(stashv + (size_t)((d0 * 4 + rq) * NTHREADS) * 4) =
                    (f32x4){o[d0][4 * rq] * rli[4 * rq], o[d0][4 * rq + 1] * rli[4 * rq + 1], o[d0][4 * rq + 2] * rli[4 * rq + 2], o[d0][4 * rq + 3] * rli[4 * rq + 3]};
        } else {
            const float* gn = a.in[I_DNG] + l * 128;
            float g4[4];
#pragma unroll
            for (int d0 = 0; d0 < 4; ++d0) g4[d0] = gn[d0 * 32 + r32] * post;
            float ss[16];
#pragma unroll
            for (int r = 0; r < 16; ++r) { ss[r] = 0.f; const float f_ = lam * rli[r];
#pragma unroll
                for (int d0 = 0; d0 < 4; ++d0) o[d0][r] *= f_; }
#pragma unroll
            for (int d0 = 0; d0 < 4; ++d0) {
                f32x4 sv[4];
#pragma unroll
                for (int rq = 0; rq < 4; ++rq) sv[rq] = *(const f32x4*)(stashv + (size_t)((d0 * 4 + rq) * NTHREADS) * 4);
                asm volatile("" : "+v"(sv[0]), "+v"(sv[1]), "+v"(sv[2]), "+v"(sv[3]));
#pragma unroll
                for (int rq = 0; rq < 4; ++rq)
#pragma unroll
                    for (int j = 0; j < 4; ++j) { const int r = 4 * rq + j; const float oc = sv[rq][j] - o[d0][r]; o[d0][r] = oc; ss[r] += oc * oc; } }
            float s8[8], s4[4], s2[2], s1;
#pragma unroll
            for (int i = 0; i < 8; ++i) { const bool up = (lo_ & 16) != 0; s8[i] = (up ? ss[8 + i] : ss[i]) + __shfl_xor(up ? ss[i] : ss[8 + i], 16); }
#pragma unroll
            for (int i = 0; i < 4; ++i) { const bool up = (lo_ & 8) != 0; s4[i] = (up ? s8[4 + i] : s8[i]) + __shfl_xor(up ? s8[i] : s8[4 + i], 8); }
#pragma unroll
            for (int i = 0; i < 2; ++i) { const bool up = (lo_ & 4) != 0; s2[i] = (up ? s4[2 + i] : s4[i]) + __shfl_xor(up ? s4[i] : s4[2 + i], 4); }
            { const bool up = (lo_ & 2) != 0; s1 = (up ? s2[1] : s2[0]) + __shfl_xor(up ? s2[0] : s2[1], 2); }
            s1 += __shfl_xor(s1, 1);
            LDS_WAIT();
            if ((lo_ & 1) == 0) wsf[hi * 16 + ((lo_ >> 1) & 15)] = s1;
            LDS_WAIT();
#pragma unroll
            for (int r = 0; r < 16; ++r) { const float sc = __builtin_amdgcn_rsqf(wsf[hi * 16 + r] * (1.f / 128.f) + EPS);
                bf16_t* orow = MIX + (size_t)(q0 + wid * 32 + ATT::crow(r, hi)) * DM + head * 128 + r32;
#pragma unroll
                for (int d0 = 0; d0 < 4; ++d0) orow[d0 * 32] = (bf16_t)f2bf(o[d0][r] * sc * g4[d0]); }
        }
    }
}
__device__ __forceinline__ void win_unit(const Args& a, int l, int n, int g, char* lds) {
    int tid_ = otid();
    const int tid = tid_, wid = tid >> 6, lane = tid & 63;
    const bool isctx = n >= 128; const int h = 2 * g + (wid >> 2);
    const int rowq = (isctx ? SEQ + (n - 128) * 128 : n * 128) + (wid & 3) * 32;
    const int nB = isctx ? 0 : (6 - (n == 0 ? 2 : 0) - (n == 127 ? 2 : 0)), b0 = (n == 0) ? 0 : (n - 1) * 128;
    const bf16_t* QB = (const bf16_t*)(a.ws + RA_QB); const bf16_t* KB = (const bf16_t*)(a.ws + RA_KB); const bf16_t* VB = (const bf16_t*)(a.ws + RA_VB);
    bf16_t* MIX = (bf16_t*)(a.ws + WS_HB);
    float* wsf = (float*)(lds + ATT::LDS_WS) + wid * 64;
    f32x16 o[4]; float m_, l_;
    const bf16_t* Qw_ = QB + (size_t)(rowq + (lane & 31)) * 256 + h * 64;
    ATT::attn_body<1, 128, 256, false>(Qw_, KB + g * 64, VB + g * 128, 4, SEQ, b0, 4 + nB, rowq + (lane & 31), lds, tid, o, m_, l_);
    if (wg_any(!(l_ < 1.0e18f), (int*)(lds + ATT::LDS_WS) + 8 * 64, wid, lane)) {
        ATT::attn_body<1, 128, 256, true>(Qw_, KB + g * 64, VB + g * 128, 4, SEQ, b0, 4 + nB, rowq + (lane & 31), lds, tid, o, m_, l_); }
    const float ltot = l_ + __builtin_amdgcn_exp2f(a.in[I_SINK][l * 4 + h] * LOG2E - m_);
    int lo_ = lane; asm volatile("" : "+v"(lo_));
    const int r32 = lo_ & 31, hi = lo_ >> 5;
    if (hi == 0) wsf[r32] = ltot;
    LDS_WAIT();
#pragma unroll
    for (int r = 0; r < 16; ++r) { const float rl = __builtin_amdgcn_rcpf(wsf[ATT::crow(r, hi)]);
        bf16_t* orow = MIX + (size_t)(rowq + ATT::crow(r, hi)) * DM + 512 + h * 64 + r32;
        orow[0] = (bf16_t)f2bf(o[0][r] * rl); orow[32] = (bf16_t)f2bf(o[1][r] * rl); }
}
__device__ __forceinline__ void conv_unit(const Args& a, int l, int u, char* lds) {
    int tid_ = otid();
    const int tid = tid_, wid = tid >> 6, lane = tid & 63;
    const bool isctx = u >= 256; const int r0 = isctx ? (u - 256) * 64 : u * 64, rbase = isctx ? SEQ : 0, slen = isctx ? CTX : SEQ;
    const bf16_t* Z = (const bf16_t*)(a.ws + RA_Z); bf16_t* MIX = (bf16_t*)(a.ws + WS_HB);
    bf16_t* zt = (bf16_t*)lds; float* co = (float*)(lds + 49152);
    __syncthreads();
    for (int c = tid; c < 94 * 32; c += NTHREADS) { const int i = c >> 5, ch = c & 31, p = r0 - 15 + i;
        u32x4 v = {0u, 0u, 0u, 0u}; if (p >= 0 && p < slen) v = *(const u32x4*)(Z + (size_t)(rbase + p) * 256 + ch * 8);
        *(u32x4*)(zt + i * 256 + ch * 8) = v; }
    __syncthreads();
    { const int c = tid & 255, t0 = (tid >> 8) * 32; float w[31];
#pragma unroll
      for (int j = 0; j < 31; ++j) w[j] = a.in[I_CONVW][(size_t)(l * 31 + j) * 256 + c];
      const float bias = a.in[I_CONVB][l * 256 + c];
#pragma unroll
      for (int tb = 0; tb < 32; tb += 8) {
          float zr[38];
#pragma unroll
          for (int i = 0; i < 38; ++i) zr[i] = bf2f(zt[(t0 + tb + i) * 256 + c]);
#pragma unroll
          for (int t = 0; t < 8; ++t) { float acc = bias;
#pragma unroll
              for (int j = 0; j < 31; ++j) acc += zr[t + j] * w[j];
              co[(t0 + tb + t) * 256 + c] = acc; } } }
    __syncthreads();
    const f32x4 lg = *(const f32x4*)(a.in[I_LNG] + l * 256 + 4 * lane), lb = *(const f32x4*)(a.in[I_LNB] + l * 256 + 4 * lane);
#pragma unroll
    for (int ti = 0; ti < 8; ++ti) { const int t = wid + ti * NWAVES; const f32x4 v = *(const f32x4*)(co + t * 256 + 4 * lane);
        const float mu = wave_sum((v.x + v.y) + (v.z + v.w)) * (1.f / 256.f); const f32x4 d = v - mu;
        const float var = wave_sum((d.x * d.x + d.y * d.y) + (d.z * d.z + d.w * d.w)) * (1.f / 256.f); const float rs = 1.f / sqrtf(var + EPS);
        const f32x4 zn = d * rs * lg + lb;
        u32x2 w; w.x = cvt_pk_bf16(silu_f(zn.x), silu_f(zn.y)); w.y = cvt_pk_bf16(silu_f(zn.z), silu_f(zn.w));
        *(u32x2*)(MIX + (size_t)(rbase + r0 + t) * DM + 768 + 4 * lane) = w; }
    __syncthreads();
}
__device__ __forceinline__ void attn_phase(const Args& a, int l, char* lds, int pass) {
    const int b = blockIdx.x, G = gridDim.x, BIG = 1 << 20;
#ifndef AT_MASK
#define AT_MASK 7
#endif
    const int dst = pass == 0 ? b : (b < 4) ? 256 + b : BIG, wst = pass == 0 ? b : (b >= 4 && b < 8) ? 256 + (b - 4) : BIG, cst = pass == 0 ? b : (b >= 8 && b < 12) ? 256 + (b - 8) : BIG;
    const int uend = pass == 0 ? 256 : 260;
    if (AT_MASK & 1) for (int u = dst; u < uend; u += G) { const int qt = u < 256 ? (u >> 2) : 64, hd = u < 256 ? (u & 3) : (u - 256); diff_unit(a, l, qt, hd, lds); }
    if (AT_MASK & 2) for (int v = wst; v < uend; v += G) { const int n = v < 256 ? (v & 127) : 128 + ((v - 256) & 1), g = v < 256 ? (v >> 7) : ((v - 256) >> 1); win_unit(a, l, n, g, lds); }
    if (AT_MASK & 4) for (int v = cst; v < uend; v += G) conv_unit(a, l, v, lds);
    if (pass == 1 && b < 12) {
        asm volatile("s_waitcnt vmcnt(0)" ::: "memory"); __syncthreads();
        const int tid = otid(); if (tid < 64) { __builtin_amdgcn_fence(__ATOMIC_RELEASE, "agent"); asm volatile("s_waitcnt vmcnt(0)" ::: "memory");
            if (tid == 0) __hip_atomic_fetch_add((gu32*)(a.ws + WS_CTL) + CW_CTXC, 1u, __ATOMIC_RELAXED, __HIP_MEMORY_SCOPE_AGENT); } }
}

#ifndef MK_PER_PHASE
#define MK_PER_PHASE 0
#endif
#if defined(__HIP_DEVICE_COMPILE__)
#define KARGS(A) Args A; { const __attribute__((address_space(4))) Args* kp_ = (const __attribute__((address_space(4))) Args*)__builtin_amdgcn_kernarg_segment_ptr(); asm volatile("" : "+s"(kp_)); A = *kp_; }
#else
#define KARGS(A) Args A = a_unused;
#endif
__global__ void __launch_bounds__(NTHREADS, 2) hybrid_fwd(Args a_unused) {
    unsigned char* lds = g_lds;
    volatile LAS unsigned* MISC = (volatile LAS unsigned*)((LAS unsigned char*)lds + MISC_OFF);
    { const int tid0 = threadIdx.x; if (tid0 < 64) MISC[tid0] = 0u;
      if ((tid0 & 63) == 0) MISC[64 + ((unsigned)__builtin_amdgcn_s_getreg((5 << 11) | 4) & 63u)] = (unsigned)(tid0 >> 6); }
    __syncthreads();
    XcdBarrier bar; int lo, hi;
    { KARGS(a); lo = a.ph_lo; hi = a.ph_hi; gu32* ctl = (gu32*)(a.ws + WS_CTL);
      bar.bar = (unsigned*)(ctl + CW_BAR); bar.x = 0; bar.st = nullptr;
      if (!MK_PER_PHASE) bar = xcd_barrier_post((unsigned*)(ctl + CW_BAR), MISC); }
#ifndef PHMASK
#define PHMASK 0x3ffff
#endif
#define PHK(k) ((k) == 0 ? 0 : (k) == 17 ? 9 : (((k) - 1) & 7) + 1)
#define IN(k) (((PHMASK >> PHK(k)) & 1) && lo <= (k) && (k) < hi)
#define SEAM(k) do { if (!MK_PER_PHASE && IN(k) && IN((k) + 1)) xcd_barrier(bar); } while (0)
    LAS unsigned char* ldsl = (LAS unsigned char*)lds;
    const int G = gridDim.x, vcu = (G % 8 == 0) ? ((int)blockIdx.x % 8) * (G / 8) + (int)blockIdx.x / 8 : (int)blockIdx.x;

#ifndef REP_N1
#define REP_N1 1
#endif
#ifndef REP_SC
#define REP_SC 1
#endif
#ifndef REP_PRO
#define REP_PRO 1
#endif
    if (IN(0)) { KARGS(a); int nrep_ = REP_PRO; asm volatile("" : "+s"(nrep_)); for (int rp_ = 0; rp_ < nrep_; ++rp_) prologue_phase(a, lds); SEAM(0); }
    for (int l = 0; l < DEPTH; ++l) {
        const int pb = 1 + 8 * l;
        if (IN(pb + 0)) {
            KARGS(a);
            { int nrep_ = (l == 0) ? REP_N1 : 1; asm volatile("" : "+s"(nrep_)); for (int rp_ = 0; rp_ < nrep_; ++rp_) norm1_phase(a, l); }
            SEAM(pb + 0);
        }
        if (IN(pb + 1)) {
            KARGS(a);
            pg8::Gemm g{(const bf16_t*)(a.ws + WS_HB), (const bf16_t*)(a.ws + WS_WIN) + (size_t)l * INW * 1024, NROW, INW, DM};
            pg8::StaticOrder S; S.init(NROW, INW, G, (int)blockIdx.x);
            EpiInProj E{a.ws, (const float*)(a.ws + WS_ROPEC), (const float*)(a.ws + WS_ROPES)};
            RepOrder<pg8::StaticOrder> SR{S, REP_INPROJ * S.nloc()}; pg8::gemm_phase<EpiInProj, RepOrder<pg8::StaticOrder>, true, true>(ldsl, g, SR, E);
            if ((int)blockIdx.x >= 650 - 2 * G) {
                const int tid = otid(), c0 = 650 - 2 * G; moe_convert(a, l, (LAS float*)(ldsl + (tid >> 6) * 8704), ((int)blockIdx.x - c0) * NWAVES + (tid >> 6), (G - c0) * NWAVES, tid & 63, 8192, 12288); }
            SEAM(pb + 1);
        }
        if (IN(pb + 2)) { KARGS(a); int npass_ = (l == 0) ? 2 : 1; asm volatile("" : "+s"(npass_)); for (int ps_ = 0; ps_ < npass_; ++ps_) { attn_phase(a, l, (char*)lds, ps_); if (ps_ == 0) SEAM(pb + 2); } }
        if (IN(pb + 3)) {
            KARGS(a);
            const float* MOD = (const float*)(a.ws + WS_MOD);
            const int M = (l == DEPTH - 1) ? SEQ : NROW;
            pg8::Gemm g{(const bf16_t*)(a.ws + WS_HB), (const bf16_t*)(a.ws + WS_WOUT) + (size_t)l * 1024 * 1024, M, DM, DM};
            pg8::StaticOrder S; if (l == 0) S.init(61 * 256, DM, G - 12, (int)blockIdx.x - 12); else S.init(SEQ, DM, G, (int)blockIdx.x);
            EpiOutProj E{a.in[I_X], a.in[I_CTX], (bf16_t*)(a.ws + WS_XB), MOD + (l * 2) * 6144 + 2 * 1024, MOD + (l * 2 + 1) * 6144 + 2 * 1024, l};
            OutOrder SO{S, (gu32*)(a.ws + WS_CTL) + CW_OPC + l * 128, (l == 0) ? (gu32*)(a.ws + WS_CTL) + CW_CTXC : nullptr}; pg8::gemm_phase<EpiOutProj, OutOrder, true, true>(ldsl, g, SO, E);
            if (l == 0 && (int)blockIdx.x >= 16) {
                const int tid = otid(), nidle = G - 16; moe_convert(a, 1, (LAS float*)(ldsl + (tid >> 6) * 8704), ((int)blockIdx.x - 16) * NWAVES + (tid >> 6), nidle * NWAVES, tid & 63, 0, 8192); }
            __syncthreads();
        }
        if (IN(pb + 4)) { KARGS(a); int nrep_ = REP_N2SC; asm volatile("" : "+s"(nrep_)); for (int rp_ = 0; rp_ < nrep_; ++rp_) norm2_phase(a, l, lds); SEAM(pb + 4); }
        if (IN(pb + 6)) {
            KARGS(a);
            MoeOrder S; S.G = G; S.vcu = vcu;
            { const int tid = otid(); const unsigned* tot = (const unsigned*)(a.ws + WS_CTL) + CW_TOT + l * 64;
              if (tid == 0) { int t = 0; int* tsg = (int*)(a.ws + WS_TSG) + l * 32;
                  for (int e = 0; e < 16; ++e) { MISC[16 + e] = (unsigned)t; if (blockIdx.x == 0) tsg[e] = t; t += ((int)tot[e] + 255) >> 8; }
                  MISC[32] = (unsigned)t; if (blockIdx.x == 0) tsg[16] = t; }
              __syncthreads();
#pragma unroll
              for (int k = 0; k < 16; ++k) S.ts[k] = __builtin_amdgcn_readfirstlane((int)MISC[16 + k]);
              S.nunits = 4 * __builtin_amdgcn_readfirstlane((int)MISC[16 + 16]); }
            S.rowtok = (const int*)(a.ws + WS_ROWTOK2) + (size_t)l * 16 * ROWCAP;
            pg8::Gemm g{(const bf16_t*)(a.ws + WS_HB), (const bf16_t*)(a.ws + WS_W13) + (size_t)l * 16 * 1024 * 1024, XS_ROWS, 1024, DM};
            EpiMoe1 E{(bf16_t*)(a.ws + WS_RB)};
            pg8::gemm_phase<EpiMoe1, MoeOrder, true, true, true>(ldsl, g, S, E);
            gu32* flag = (gu32*)(a.ws + WS_CTL) + CW_MOEF + l * 256;
            { const int tid = otid(); if (tid == 0) __hip_atomic_store(flag + vcu, 1u, __ATOMIC_RELAXED, __HIP_MEMORY_SCOPE_AGENT); }
            MoeOrder2 S2; S2.vcu = vcu; S2.nunits = S.nunits;
#pragma unroll
            for (int k2 = 0; k2 < 16; ++k2) S2.ts[k2] = S.ts[k2];
            pg8::Gemm g2{(const bf16_t*)(a.ws + WS_RB), (const bf16_t*)(a.ws + WS_W2) + (size_t)l * 16 * 1024 * 512, XS_ROWS, 1024, FFE};
            EpiMoe2 E2{a.ws + WS_RA};
            const int r_ = S.nunits & 255;
            if (vcu >= r_ && S.nunits >= 256) { moe_wait(flag, vcu & ~3, 4); S2.part = 0; pg8::gemm_phase<EpiMoe2, MoeOrder2, true, true>(ldsl, g2, S2, E2); }
            if (r_ != 0) { moe_wait(flag, 0, r_); S2.part = 1; pg8::gemm_phase<EpiMoe2, MoeOrder2, true, true>(ldsl, g2, S2, E2); }
            SEAM(pb + 6);
        }
    }
    if (IN(17)) { KARGS(a); int nrep_ = REP_N1; asm volatile("" : "+s"(nrep_)); for (int rp_ = 0; rp_ < nrep_; ++rp_) norm1_phase(a, 2); }
#undef IN
#undef SEAM
}

extern "C" void kernel_launch(void* const* d_in, const int* in_sizes, int n_in, void* d_out, int out_size, void* d_ws, size_t ws_size, hipStream_t stream) {
    static int grid = 0;
    if (grid == 0) {
        if (n_in != 23 || in_sizes[0] != SEQ * DM || out_size != SEQ * DM || ws_size < WS_END) {
            fprintf(stderr, "kernel_launch: shape mismatch (n_in %d, in0 %d, out %d, ws %zu, need ws >= %zu); nothing launched\n", n_in, n_in > 0 ? in_sizes[0] : -1, out_size, ws_size, (size_t)WS_END); grid = -1; return; }
        int dev = 0, cus = 0, per_cu = 0;
        if (hipGetDevice(&dev) != hipSuccess || hipDeviceGetAttribute(&cus, hipDeviceAttributeMultiprocessorCount, dev) != hipSuccess) { fprintf(stderr, "kernel_launch: device query failed\n"); grid = -1; return; }
        if (hipFuncSetAttribute((const void*)hybrid_fwd, hipFuncAttributeMaxDynamicSharedMemorySize, LDS_BYTES) != hipSuccess) { fprintf(stderr, "kernel_launch: hipFuncSetAttribute failed\n"); grid = -1; return; }
        if (hipOccupancyMaxActiveBlocksPerMultiprocessor(&per_cu, (const void*)hybrid_fwd, NTHREADS, LDS_BYTES) != hipSuccess || per_cu < 1) { fprintf(stderr, "kernel_launch: occupancy query reports %d blocks per CU\n", per_cu); grid = -1; (void)hipGetLastError(); return; }
        if (cus != 256) { fprintf(stderr, "kernel_launch: built for 256 CUs, device has %d\n", cus); grid = -1; return; }
        grid = cus;
    }
    if (grid < 0) return;
    if (hipMemsetAsync((char*)d_ws + WS_CTL, 0, CTL_ZERO_BYTES, stream) != hipSuccess) { fprintf(stderr, "kernel_launch: memset failed\n"); return; }
    Args a{};
    for (int i = 0; i < 23; ++i) a.in[i] = (const float*)d_in[i];
    a.out = (float*)d_out; a.ws = (unsigned char*)d_ws;
#if MK_PER_PHASE
    for (int p = 0; p < N_PHASES; ++p) { a.ph_lo = p; a.ph_hi = p + 1; hipLaunchKernelGGL(hybrid_fwd, dim3(grid), dim3(NTHREADS), LDS_BYTES, stream, a); }
#else
    a.ph_lo = 0; a.ph_hi = N_PHASES;
    hipLaunchKernelGGL(hybrid_fwd, dim3(grid), dim3(NTHREADS), LDS_BYTES, stream, a);
#endif
    const hipError_t le = hipPeekAtLastError();
    if (le != hipSuccess) fprintf(stderr, "kernel_launch: launch failed: %s\n", hipGetErrorName(le));
}
```

```cpp
#define MK_PER_PHASE 0
#include <hip/hip_runtime.h>
#include <cstdio>
#include <cstdint>

#define GAS __attribute__((address_space(1)))
#define LAS __attribute__((address_space(3)))
typedef unsigned short bf16_t;
typedef short bf16x8 __attribute__((ext_vector_type(8)));
typedef short s16x4 __attribute__((ext_vector_type(4)));
typedef float f32x2 __attribute__((ext_vector_type(2)));
typedef float f32x4 __attribute__((ext_vector_type(4)));
typedef float f32x16 __attribute__((ext_vector_type(16)));
typedef unsigned u32x2 __attribute__((ext_vector_type(2)));
typedef unsigned u32x4 __attribute__((ext_vector_type(4)));
typedef GAS unsigned gu32;

constexpr int SEQ = 16384, CTX = 256, NROW = SEQ + CTX, DM = 1024, INW = 2560, NEXP = 16, FFE = 512, DEPTH = 2;
constexpr int XS_ROWS = 37376;
constexpr float EPS = 1e-6f, LOG2E = 1.4426950408889634f, QSCALE = 0.125f * 1.4426950408889634f;
constexpr int NWAVES = 8, NTHREADS = 512;

constexpr size_t MiB = 1u << 20;
constexpr size_t WS_CTL = 0, CTL_ZERO_BYTES = 128 * 1024;
constexpr size_t WS_MOD = 1 * MiB;
constexpr size_t WS_ROPEC = WS_MOD + 128 * 1024, WS_ROPES = WS_MOD + 192 * 1024;
constexpr size_t WS_LAM = WS_MOD + 256 * 1024;
constexpr size_t WS_CNT = WS_MOD + 320 * 1024;
constexpr size_t WS_TSG = WS_MOD + 384 * 1024;
constexpr size_t WS_TOKE = 2 * MiB, WS_TOKW = 2 * MiB + 256 * 1024, WS_TOKP = 2 * MiB + 512 * 1024;
constexpr size_t WS_ROWTOK = 3 * MiB;
constexpr size_t WS_WIN = 4 * MiB;
constexpr size_t WS_WOUT = 14 * MiB;
constexpr size_t WS_W13 = 18 * MiB;
constexpr size_t WS_W2 = 82 * MiB;
constexpr size_t WS_XB = 114 * MiB;
constexpr size_t WS_HB = 179 * MiB;
constexpr size_t WS_RA = 212 * MiB;
constexpr size_t RA_QA = WS_RA, RA_KA = RA_QA + (size_t)NROW * 512 * 2, RA_VA = RA_KA + (size_t)NROW * 512 * 2;
constexpr size_t RA_QB = RA_VA + (size_t)NROW * 512 * 2, RA_KB = RA_QB + (size_t)NROW * 256 * 2, RA_VB = RA_KB + (size_t)NROW * 128 * 2;
constexpr size_t RA_Z = RA_VB + (size_t)NROW * 256 * 2, RA_END = RA_Z + (size_t)NROW * 256 * 2;
constexpr size_t WS_RB = 290 * MiB;
constexpr size_t WS_ROWTOK2 = 327 * MiB;
constexpr size_t WS_END = 330 * MiB;
static_assert(RA_END <= WS_RB && WS_RA + (size_t)XS_ROWS * 2048 <= WS_RB && WS_RB + (size_t)XS_ROWS * 1024 <= WS_END && WS_RB + (size_t)256 * 256 * 128 * 4 <= WS_END, "ws map");
static_assert(WS_XB + (size_t)NROW * DM * 4 <= WS_HB && WS_HB + (size_t)NROW * DM * 2 <= WS_RA && WS_W13 + (size_t)2 * 16 * 1024 * 1024 * 2 <= WS_W2 && WS_W2 + (size_t)2 * 16 * 1024 * 512 * 2 <= WS_XB, "ws map 2");
constexpr int ROWCAP = 16640;
constexpr int CW_TOT = 24576;
constexpr int CW_MOEF = 28672;
constexpr int CW_OPC = 30720;
constexpr int CW_CTXC = 31232;
constexpr int CW_BAR = 4096;

constexpr int RING_BYTES = 131072;
constexpr int MISC_OFF = RING_BYTES;
constexpr int LDS_BYTES = 147456;

#define LDS_WAIT() asm volatile("s_waitcnt lgkmcnt(0)" ::: "memory")
#define VM_WAIT() asm volatile("s_waitcnt vmcnt(0)" ::: "memory")
__device__ __forceinline__ unsigned f2bf(float f) { unsigned u = __builtin_bit_cast(unsigned, f); return (u + 0x7fffu + ((u >> 16) & 1u)) >> 16; }
__device__ __forceinline__ unsigned pk2(float lo, float hi) { return f2bf(lo) | (f2bf(hi) << 16); }
__device__ __forceinline__ float bf2f(unsigned short b) { return __builtin_bit_cast(float, (unsigned)b << 16); }
__device__ __forceinline__ unsigned cvt_pk_bf16(float lo, float hi) { unsigned r; asm volatile("v_cvt_pk_bf16_f32 %0, %1, %2" : "=v"(r) : "v"(lo), "v"(hi)); return r; }
__device__ __forceinline__ float wave_sum(float v) {
#pragma unroll
    for (int o = 1; o < 64; o <<= 1) v += __shfl_xor(v, o);
    return v;
}
__device__ __forceinline__ f32x4 ld4bf(const bf16_t* p) { const u32x2 w = *(const u32x2*)p; return (f32x4){__builtin_bit_cast(float, w.x << 16), __builtin_bit_cast(float, w.x & 0xffff0000u), __builtin_bit_cast(float, w.y << 16), __builtin_bit_cast(float, w.y & 0xffff0000u)}; }
__device__ __forceinline__ void st4bf(bf16_t* p, const f32x4 v) { u32x2 w; w.x = cvt_pk_bf16(v.x, v.y); w.y = cvt_pk_bf16(v.z, v.w); *(u32x2*)p = w; }
__device__ __forceinline__ float silu_f(float a) { return a * __builtin_amdgcn_rcpf(1.f + __builtin_amdgcn_exp2f(-a * LOG2E)); }
__device__ __forceinline__ float sigmoid_f(float a) { return __builtin_amdgcn_rcpf(1.f + __builtin_amdgcn_exp2f(-a * LOG2E)); }
extern __shared__ __attribute__((aligned(16))) unsigned char g_lds[];
__device__ __forceinline__ int otid() {
    const unsigned slot = (unsigned)__builtin_amdgcn_s_getreg((5 << 11) | 4) & 63u;
    const int wave = ((const volatile LAS int*)((LAS unsigned char*)g_lds + MISC_OFF + 256))[slot];
    int ln; asm volatile("v_mbcnt_lo_u32_b32 %0, -1, 0\n\tv_mbcnt_hi_u32_b32 %0, -1, %0" : "=v"(ln));
    int t = (wave << 6) | ln;
    asm volatile("" : "+v"(t)); return t; }
namespace pg8 {
#define PG8_LAS __attribute__((address_space(3)))
constexpr int BM = 256, BK = 64, HALF = 128, HTB = HALF * BK * 2  , STAGE_BYTES = 8 * HTB, NXCD = 8, WGM = 8;

__host__ __device__ __forceinline__ int lds_byte(int r, int c) { const int st = (r >> 4) * 2 + (c >> 5), rr = r & 15, cc = c & 31, ob = rr * 64 + cc * 2; return st * 1024 + (ob ^ (((ob >> 9) & 1) << 5)); }
__host__ __device__ __forceinline__ void stage_rc(int b, int& R, int& C) { const int st = b / 1024, sb = b % 1024, swz = sb ^ (((sb >> 9) & 1) << 5); R = (st >> 1) * 16 + swz / 64; C = (st & 1) * 32 + (swz % 64) / 2; }
__host__ __device__ __forceinline__ int perm32(int rho) { const int n = rho >> 4, i = rho & 15; return 8 * (i >> 2) + 4 * n + (i & 3); }

struct Unit { int pm, pn, aux; };
struct Gemm { const bf16_t* A; const bf16_t* Bt; int M, N, K; };

struct StaticOrder {
    int nM, nN, nwg, G, c;
    __host__ __device__ void init(int M, int N, int G_, int c_) { nM = M / BM; nN = N / BM; nwg = nM * nN; G = G_; c = c_; }
    __host__ __device__ bool next(int i, Unit& u) const {
        const long L = (long)i * G + c; if (L >= nwg) return false;
        int wgid = (int)L; { const int q = nwg / NXCD, r = nwg % NXCD, xcd = wgid % NXCD, off = wgid / NXCD; wgid = (xcd < r ? xcd * (q + 1) : r * (q + 1) + (xcd - r) * q) + off; }
        const int nig = WGM * nN, gid = wgid / nig, fm = gid * WGM, gsz = (nM - fm) < WGM ? (nM - fm) : WGM;
        u.pm = fm + ((wgid % nig) % gsz); u.pn = (wgid % nig) / gsz; return true;
    }
    __host__ __device__ __forceinline__ int nloc() const { return c < nwg ? (nwg - c + G - 1) / G : 0; }
    __device__ __forceinline__ void a_ready(const Unit&) const {}
    __device__ __forceinline__ void done(const Unit&) const {}
};
template <class Epi, class Sched, bool ALIGN_EPI = false, bool SP2 = false, bool GATHER = false>
__device__ __forceinline__ void gemm_phase(PG8_LAS unsigned char* lds, const Gemm g, const Sched& S, const Epi& E) {
    const int tid = otid(), wid = __builtin_amdgcn_readfirstlane(tid >> 6), lane = tid & 63, wr = wid >> 2, wc = wid & 3, fr = lane & 15, fq = lane >> 4;
    const int K = g.K, nt = K / BK;
    unsigned voffA[2], voffB[2]; int rowA[2]; unsigned colA[2];
#pragma unroll
    for (int i = 0; i < 2; ++i) { int R, C; stage_rc(tid * 16 + i * 8192, R, C); const int Rb = Epi::PERM ? ((R & ~31) + perm32(R & 31)) : R;
        voffA[i] = (unsigned)(R * K + C) * 2u; voffB[i] = (unsigned)(Rb * K + C) * 2u; rowA[i] = R; colA[i] = (unsigned)C * 2u; }
    unsigned gc[2][2], gn[2][2];
#define PG8_GOFFS(dst, u) do { _Pragma("unroll") for (int h_ = 0; h_ < 2; ++h_) _Pragma("unroll") for (int i_ = 0; i_ < 2; ++i_) dst[h_][i_] = S.row_off((u), h_ * HALF + rowA[i_]) + colA[i_]; } while (0)
    const size_t kstep = (size_t)(BK * 2);
    const size_t hstep = (size_t)HALF * K * 2;
    const size_t tstep = 2 * hstep;
    const unsigned ldsw = (unsigned)wid * 1024u;
    const int aoff = lds_byte(wr * 64 + fr, fq * 8), boff = lds_byte(wc * 32 + fr, fq * 8);
#define PG8_SA(b, h) (((b) * 2 + (h)) * HTB)
#define PG8_SB(b, h) ((4 + (b) * 2 + (h)) * HTB)
#define PG8_STAGE(bufoff, gbase, voff) do { _Pragma("unroll") for (int _i = 0; _i < 2; ++_i) \
        __builtin_amdgcn_global_load_lds((const unsigned*)((const char*)(gbase) + (voff)[_i]), (PG8_LAS unsigned*)(lds + (bufoff) + ldsw + _i * 8192), 16, 0, 0); } while (0)
#define PG8_STAGE_A(bufoff, gbase, h, NX) do { _Pragma("unroll") for (int _i = 0; _i < 2; ++_i) { \
        const char* p_; if constexpr (GATHER) p_ = (const char*)(gbase) + ((NX) ? gn[h][_i] : gc[h][_i]); else p_ = (const char*)(gbase) + (h) * hstep + voffA[_i]; \
        __builtin_amdgcn_global_load_lds((const unsigned*)p_, (PG8_LAS unsigned*)(lds + (bufoff) + ldsw + _i * 8192), 16, 0, 0); } } while (0)
#define PG8_LDA(dst, b, h) do { _Pragma("unroll") for (int m = 0; m < 4; ++m) _Pragma("unroll") for (int k = 0; k < 2; ++k) dst[m][k] = *(const PG8_LAS bf16x8*)(lds + PG8_SA(b, h) + aoff + m * 2048 + k * 1024); } while (0)
#define PG8_LDB(dst, b, h) do { _Pragma("unroll") for (int n = 0; n < 2; ++n) _Pragma("unroll") for (int k = 0; k < 2; ++k) dst[n][k] = *(const PG8_LAS bf16x8*)(lds + PG8_SB(b, h) + boff + n * 2048 + k * 1024); } while (0)
#define PG8_MMA(ai, bj, At, Bt) do { __builtin_amdgcn_s_setprio(1); _Pragma("unroll") for (int m = 0; m < 4; ++m) _Pragma("unroll") for (int n = 0; n < 2; ++n) _Pragma("unroll") for (int k = 0; k < 2; ++k) \
        acc[ai][bj][m][n] = __builtin_amdgcn_mfma_f32_16x16x32_bf16(Bt[n][k], At[m][k], acc[ai][bj][m][n], 0, 0, 0); __builtin_amdgcn_s_setprio(0); } while (0)
#define PG8_WAIT_V(n) asm volatile("s_waitcnt vmcnt(" #n ")" ::: "memory")
#define PG8_WAIT_L(n) asm volatile("s_waitcnt lgkmcnt(" #n ")" ::: "memory")
#define PG8_BAR __builtin_amdgcn_s_barrier()
#define PG8_SCHED __builtin_amdgcn_sched_barrier(0)
    Unit cur, nxt; int ui = 0;
    if (!S.next(0, cur)) return;
    f32x4 acc[2][2][4][2];
#pragma unroll
    for (int a = 0; a < 2; ++a)
#pragma unroll
        for (int b = 0; b < 2; ++b)
#pragma unroll
            for (int m = 0; m < 4; ++m)
#pragma unroll
                for (int n = 0; n < 2; ++n) acc[a][b][m][n] = (f32x4){0.f, 0.f, 0.f, 0.f};
    bf16x8 At[4][2], B0[2][2], B1[2][2];
    const char* cA = GATHER ? (const char*)g.A : (const char*)g.A + (size_t)cur.pm * tstep; const char* cB = (const char*)g.Bt + (size_t)cur.pn * tstep;
    if constexpr (GATHER) { PG8_GOFFS(gc, cur); }
    S.a_ready(cur);
    if constexpr (SP2) {
        PG8_STAGE(PG8_SB(0, 0), cB, voffB); PG8_STAGE(PG8_SB(0, 1), cB + hstep, voffB); PG8_STAGE_A(PG8_SA(0, 0), cA, 0, false); PG8_STAGE_A(PG8_SA(0, 1), cA, 1, false);
        if (wr == 1) PG8_BAR;
        PG8_WAIT_V(2); PG8_BAR;
        PG8_STAGE(PG8_SB(1, 0), cB + kstep, voffB); PG8_STAGE_A(PG8_SA(1, 0), cA + kstep, 0, false); PG8_STAGE(PG8_SB(1, 1), cB + hstep + kstep, voffB);
        PG8_WAIT_V(6); PG8_BAR;
    } else {
        PG8_STAGE(PG8_SB(0, 0), cB, voffB); PG8_STAGE_A(PG8_SA(0, 0), cA, 0, false); PG8_STAGE(PG8_SB(0, 1), cB + hstep, voffB); PG8_STAGE_A(PG8_SA(0, 1), cA, 1, false);
        if (wr == 1) PG8_BAR;
        PG8_WAIT_V(4); PG8_BAR;
        PG8_STAGE(PG8_SB(1, 0), cB + kstep, voffB); PG8_STAGE_A(PG8_SA(1, 0), cA + kstep, 0, false); PG8_STAGE(PG8_SB(1, 1), cB + hstep + kstep, voffB);
        PG8_WAIT_V(6); PG8_BAR;
    }
    for (;;) {
        const bool has_next = S.next(ui + 1, nxt);
        if constexpr (GATHER) { if (has_next) { PG8_GOFFS(gn, nxt); } else {
#pragma unroll
            for (int h_ = 0; h_ < 2; ++h_) { gn[h_][0] = gc[h_][0]; gn[h_][1] = gc[h_][1]; } } }
        const char* nA = GATHER ? (const char*)g.A : has_next ? (const char*)g.A + (size_t)nxt.pm * tstep : cA; const char* nB = has_next ? (const char*)g.Bt + (size_t)nxt.pn * tstep : cB;
        for (int t = 0; t < nt; t += 2) {
            const bool last = (t == nt - 2);
            const char* a1 = cA + (size_t)(t + 1) * kstep;
            const char* a2 = last ? nA : cA + (size_t)(t + 2) * kstep; const char* b2 = last ? nB : cB + (size_t)(t + 2) * kstep;
            const char* a3 = a2 + kstep; const char* b3 = b2 + kstep;
            if (last && has_next) S.a_ready(nxt);
            if constexpr (SP2) {
            PG8_LDB(B0, 0, 0); PG8_LDB(B1, 0, 1); PG8_SCHED; PG8_LDA(At, 0, 0); PG8_STAGE_A(PG8_SA(1, 1), a1, 1, false);
            PG8_WAIT_V(8); PG8_WAIT_L(0); PG8_BAR; PG8_MMA(0, 0, At, B0); PG8_MMA(0, 1, At, B1); PG8_BAR; PG8_SCHED;
            PG8_LDA(At, 0, 1); PG8_STAGE(PG8_SB(0, 0), b2, voffB); PG8_STAGE(PG8_SB(0, 1), b2 + hstep, voffB); PG8_STAGE_A(PG8_SA(0, 0), a2, 0, last);
            PG8_WAIT_V(8); PG8_WAIT_L(0); PG8_BAR; PG8_MMA(1, 0, At, B0); PG8_MMA(1, 1, At, B1); PG8_BAR; PG8_SCHED;
            PG8_LDB(B0, 1, 0); PG8_LDB(B1, 1, 1); PG8_SCHED; PG8_LDA(At, 1, 0); PG8_STAGE_A(PG8_SA(0, 1), a2, 1, last);
            PG8_WAIT_V(8); PG8_WAIT_L(0); PG8_BAR; PG8_MMA(0, 0, At, B0); PG8_MMA(0, 1, At, B1); PG8_BAR; PG8_SCHED;
            PG8_LDA(At, 1, 1); PG8_STAGE(PG8_SB(1, 0), b3, voffB); PG8_STAGE(PG8_SB(1, 1), b3 + hstep, voffB); PG8_STAGE_A(PG8_SA(1, 0), a3, 0, last);
            PG8_WAIT_V(8); PG8_WAIT_L(0); PG8_BAR; PG8_MMA(1, 0, At, B0); PG8_MMA(1, 1, At, B1); PG8_BAR; PG8_SCHED;
            } else {
            PG8_LDB(B0, 0, 0); PG8_SCHED; PG8_LDA(At, 0, 0); PG8_STAGE_A(PG8_SA(1, 1), a1, 1, false);
            PG8_WAIT_L(8); PG8_BAR; PG8_WAIT_L(0); PG8_MMA(0, 0, At, B0); PG8_BAR; PG8_SCHED;
            PG8_LDB(B1, 0, 1); PG8_STAGE(PG8_SB(0, 0), b2, voffB);
            PG8_BAR; PG8_WAIT_L(0); PG8_MMA(0, 1, At, B1); PG8_BAR;
            PG8_LDA(At, 0, 1); PG8_STAGE_A(PG8_SA(0, 0), a2, 0, last);
            PG8_BAR; PG8_WAIT_L(0); PG8_MMA(1, 0, At, B0); PG8_BAR; PG8_SCHED;
            PG8_STAGE(PG8_SB(0, 1), b2 + hstep, voffB);
            PG8_WAIT_V(6); PG8_BAR; PG8_MMA(1, 1, At, B1); PG8_BAR;
            PG8_LDB(B0, 1, 0); PG8_SCHED; PG8_LDA(At, 1, 0); PG8_STAGE_A(PG8_SA(0, 1), a2, 1, last);
            PG8_WAIT_L(8); PG8_BAR; PG8_WAIT_L(0); PG8_MMA(0, 0, At, B0); PG8_BAR; PG8_SCHED;
            PG8_LDB(B1, 1, 1); PG8_STAGE(PG8_SB(1, 0), b3, voffB);
            PG8_BAR; PG8_WAIT_L(0); PG8_MMA(0, 1, At, B1); PG8_BAR;
            PG8_LDA(At, 1, 1); PG8_STAGE_A(PG8_SA(1, 0), a3, 0, last);
            PG8_BAR; PG8_WAIT_L(0); PG8_MMA(1, 0, At, B0); PG8_BAR; PG8_SCHED;
            PG8_STAGE(PG8_SB(1, 1), b3 + hstep, voffB);
            PG8_WAIT_V(6); PG8_BAR; PG8_MMA(1, 1, At, B1); PG8_BAR;
            }
        }
        if constexpr (ALIGN_EPI) { if (wr == 0) PG8_BAR; }
        if constexpr (!Epi::AFTER_DRAIN) { E(acc, cur, wr, wc, fr, fq); S.done(cur); }
        if (!has_next) break;
#pragma unroll
        for (int a = 0; a < 2; ++a)
#pragma unroll
            for (int b = 0; b < 2; ++b)
#pragma unroll
                for (int m = 0; m < 4; ++m)
#pragma unroll
                    for (int n = 0; n < 2; ++n) acc[a][b][m][n] = (f32x4){0.f, 0.f, 0.f, 0.f};
        cur = nxt; cA = nA; cB = nB; ++ui;
        if constexpr (GATHER) {
#pragma unroll
            for (int h_ = 0; h_ < 2; ++h_) { gc[h_][0] = gn[h_][0]; gc[h_][1] = gn[h_][1]; } }
        if constexpr (ALIGN_EPI) { if (wr == 1) PG8_BAR; }
    }
    PG8_WAIT_V(0);
    if constexpr (!ALIGN_EPI) { if (wr == 0) PG8_BAR; }
    PG8_BAR;
    if constexpr (Epi::AFTER_DRAIN) { E.fused(acc, cur, wr, wc, fr, fq, lds, wid, lane); S.done(cur); }
#undef PG8_SA
#undef PG8_SB
#undef PG8_STAGE
#undef PG8_STAGE_A
#undef PG8_GOFFS
#undef PG8_LDA
#undef PG8_LDB
#undef PG8_MMA
#undef PG8_WAIT_V
#undef PG8_WAIT_L
#undef PG8_BAR
#undef PG8_SCHED
}
}

namespace att2 {
constexpr int KSLOT = 8192, VSLOT = 16384, LDS_K = 0, LDS_V = 3 * KSLOT, LDS_WS = LDS_V + 3 * VSLOT, LDS_BYTES = LDS_WS + NWAVES * 256;
constexpr float THR = 8.f;
typedef LAS const char* lds_cptr;
typedef short v4i16_t __attribute__((ext_vector_type(4)));
typedef __bf16 bf2_t __attribute__((ext_vector_type(2)));
#define SBAR() __builtin_amdgcn_sched_barrier(0)
#define PIN(x) asm volatile("" : "+v"(x))
__device__ __forceinline__ int crow(int r, int hi) { return (r & 3) + 8 * (r >> 2) + 4 * hi; }
__device__ __forceinline__ f32x16 zero16() { float z = 0.f; asm volatile("" : "+v"(z)); f32x16 v;
#pragma unroll
    for (int r = 0; r < 16; ++r) v[r] = z;
    return v; }
__device__ __forceinline__ void glds16(const void* gsrc, unsigned lds_dst) { unsigned keep;
    asm volatile("s_mov_b32 %0, m0\n\ts_mov_b32 m0, %2\n\ts_nop 0\n\tglobal_load_lds_dwordx4 %1, off\n\ts_mov_b32 m0, %0" : "=&s"(keep) : "v"(gsrc), "s"(lds_dst) : "memory"); }
__device__ __forceinline__ bf16x8 kfrag(lds_cptr p) { return *(const LAS bf16x8*)p; }
__device__ __forceinline__ s16x4 vtr(lds_cptr p) { return __builtin_bit_cast(s16x4, __builtin_amdgcn_ds_read_tr16_b64_v4i16((LAS v4i16_t*)p)); }
__device__ __forceinline__ unsigned cvtpk_s(float lo, float hi) { typedef float f2 __attribute__((ext_vector_type(2))); typedef __bf16 b2 __attribute__((ext_vector_type(2)));
    f2 v = {lo, hi}; b2 b = __builtin_convertvector(v, b2); return __builtin_bit_cast(unsigned, b); }
#define MX3(a, b, c) __builtin_fmaxf(__builtin_fmaxf((a), (b)), (c))
__device__ __forceinline__ float rowmax(const f32x16& p0, const f32x16& p1) {
    float a = MX3(p0[0], p0[1], p1[0]), b = MX3(p0[2], p0[3], p1[1]); a = MX3(a, p1[2], p1[3]);
#pragma unroll
    for (int r = 4; r < 16; r += 4) { a = MX3(a, p0[r], p0[r + 1]); b = MX3(b, p0[r + 2], p0[r + 3]); a = MX3(a, p1[r], p1[r + 1]); b = MX3(b, p1[r + 2], p1[r + 3]); }
    float m = __builtin_fmaxf(a, b); auto rr = __builtin_amdgcn_permlane32_swap(__float_as_uint(m), __float_as_uint(m), false, false);
    return __builtin_fmaxf(__uint_as_float(rr[0]), __uint_as_float(rr[1])); }
__device__ __forceinline__ void wmask(f32x16& p0, f32x16& p1, int dk, int hi) {
#pragma unroll
    for (int r = 0; r < 16; ++r) { const int d = dk + crow(r, hi);
        if (d > 128 || d < -128) p0[r] = -1e30f;
        if (d + 32 > 128 || d + 32 < -128) p1[r] = -1e30f; } }
#define MFMA32(a, b, c) __builtin_amdgcn_mfma_f32_32x32x16_bf16(a, b, c, 0, 0, 0)
#define WAIT_BAR(N) asm volatile("s_waitcnt vmcnt(" #N ") lgkmcnt(0)\n\ts_barrier" ::: "memory")

template <int MODE, int LDK, int LDV, bool SAFE>
__device__ __forceinline__ void attn_body(const bf16_t* Qw, const bf16_t* Kh, const bf16_t* Vh, const int nA, const int a0, const int b0, const int NT, const int qpos,
                                          char* lds, const int tid, f32x16 (&o)[4], float& m_out, float& l_out) {
    constexpr int ND = (MODE == 1) ? 2 : 4, NVP = ND / 2;
    const int lane = tid & 63, r32 = lane & 31, hi = lane >> 5; const int wid = __builtin_amdgcn_readfirstlane(tid >> 6);
    const unsigned lds0 = (unsigned)(uintptr_t)lds; float* wsf = (float*)(lds + LDS_WS) + wid * 64;
#define KROW(t) ((t) < nA ? a0 + 64 * (t) : b0 + 64 * ((t) - nA))
    const bf16_t* ksrc = Kh + (size_t)lane * LDK + wid * 8;
    const bf16_t* vsrc = Vh + (size_t)(16 * (wid & 3) + (lane >> 2)) * LDV + (wid >> 2) * 32 + (lane & 3) * 8;
    const unsigned kdst = lds0 + LDS_K + wid * 1024, vdst = lds0 + LDS_V + (wid >> 2) * 4096 + (wid & 3) * 1024;
#define DMA_K(t, slot) glds16(ksrc + (size_t)KROW(t) * LDK, (unsigned)__builtin_amdgcn_readfirstlane(kdst + (slot) * KSLOT))
#define DMA_V(t, slot) do { const bf16_t* vs_ = vsrc + (size_t)KROW(t) * LDV; glds16(vs_, (unsigned)__builtin_amdgcn_readfirstlane(vdst + (slot) * VSLOT)); \
        if constexpr (NVP == 2) glds16(vs_ + 64, (unsigned)__builtin_amdgcn_readfirstlane(vdst + (slot) * VSLOT + 8192)); } while (0)
    const lds_cptr shm3 = (lds_cptr)(LAS char*)lds;
    const lds_cptr kp0 = shm3 + LDS_K + hi * 1024 + r32 * 16;
    const lds_cptr vp0 = shm3 + LDS_V + ((lane >> 4) & 1) * 32 + (lane & 3) * 8 + (4 * hi + ((lane & 15) >> 2)) * 64;
    bf16x8 qr[4];
#pragma unroll
    for (int d0 = 0; d0 < 4; ++d0) qr[d0] = *reinterpret_cast<const bf16x8*>(Qw + d0 * 16 + hi * 8);
    __syncthreads();
    if (wid >= 4) __builtin_amdgcn_s_setprio(1);
    DMA_K(0, 0); DMA_K(1, 1); DMA_V(0, 0);
    float mhat = 0.f, l_reg = 0.f;
#pragma unroll
    for (int d = 0; d < 4; ++d) o[d] = zero16();
    f32x16 negm = zero16(); PIN(negm);
    bool resc = false;
    if constexpr (NVP == 2) { WAIT_BAR(3); } else { WAIT_BAR(2); }
    f32x16 pA0, pA1, pB0, pB1;
    DMA_K(2, 2); DMA_V(1, 1);
    { bf16x8 kf[8];
#pragma unroll
      for (int i = 0; i < 8; ++i) kf[i] = kfrag(kp0 + (i >> 1) * 2048 + (i & 1) * 512);
      pA0 = MFMA32(kf[0], qr[0], negm); pA1 = MFMA32(kf[1], qr[0], negm); pA0 = MFMA32(kf[2], qr[1], pA0); pA1 = MFMA32(kf[3], qr[1], pA1);
      pA0 = MFMA32(kf[4], qr[2], pA0); pA1 = MFMA32(kf[5], qr[2], pA1); pA0 = MFMA32(kf[6], qr[3], pA0); pA1 = MFMA32(kf[7], qr[3], pA1); }
    if constexpr (MODE == 1) { if (0 >= nA) wmask(pA0, pA1, KROW(0) - qpos, hi); }
    { const float rm = rowmax(pA0, pA1); mhat = rm;
#pragma unroll
      for (int r = 0; r < 16; ++r) { pA0[r] = __builtin_amdgcn_exp2f(pA0[r] - rm); pA1[r] = __builtin_amdgcn_exp2f(pA1[r] - rm); }
#pragma unroll
      for (int r = 0; r < 16; ++r) negm[r] = -mhat;
      PIN(negm);
      if constexpr (!SAFE) { float s0 = 0.f, s1 = 0.f;
#pragma unroll
        for (int r = 0; r < 16; ++r) { s0 += pA0[r]; s1 += pA1[r]; }
        l_reg = s0 + s1; } }
    if constexpr (NVP == 2) { WAIT_BAR(3); } else { WAIT_BAR(2); }
    int sl_prev = 0, sl_cur = 1, sl_next = 2;
#define ROT() do { const int s_ = sl_prev; sl_prev = sl_cur; sl_cur = sl_next; sl_next = s_; } while (0)
#define RESC() do { if (resc) { asm volatile("s_waitcnt lgkmcnt(0)" ::: "memory"); \
        _Pragma("unroll") for (int d_ = 0; d_ < ND; ++d_) _Pragma("unroll") for (int r = 0; r < 16; ++r) o[d_][r] *= wsf[crow(r, hi)]; } } while (0)
    u32x4 pw0, pw1, pw2, pw3; s16x4 vl[16], vh[16]; bf16x8 kf[8]; float dummy_ = 0.f;
#define PAF(k) __builtin_bit_cast(bf16x8, pw##k)
#define VFR(i) (bf16x8){vl[i][0], vl[i][1], vl[i][2], vl[i][3], vh[i][0], vh[i][1], vh[i][2], vh[i][3]}
#define VRD(q, ks) do { if constexpr ((q) < ND) { vl[(q) * 4 + (ks)] = vtr(vp_ + ((q) * 4096 + (ks) * 1024)); vh[(q) * 4 + (ks)] = vtr(vp_ + ((q) * 4096 + (ks) * 1024 + 512)); } } while (0)
#define KRD(i) do { kf[i] = kfrag(kp_ + ((i) >> 1) * 2048 + ((i) & 1) * 512); } while (0)
#define PKW(P, i) cvtpk_s(P[i], P[i + 1])
#ifndef PROBE_VALU
#define PROBE_VALU 0
#endif
#ifndef ROWSUM_DOT2
#define ROWSUM_DOT2 0
#endif
#define DOT2(w, acc) __builtin_amdgcn_fdot2_f32_bf16(__builtin_bit_cast(bf2_t, (unsigned)(w)), __builtin_bit_cast(bf2_t, 0x3f803f80u), acc, false)
#define GAPA(MF, a0_, a1_, a2_, a3_, W0, W1, PW, i0_) do { MF; if (SAFE && !ROWSUM_DOT2) { sacc += a0_; sacb += a1_; sacc += a2_; sacb += a3_; PIN(sacc); PIN(sacb); } W0; W1; PIN(PW); \
        if (ROWSUM_DOT2) { sacc = DOT2(PW[i0_], sacc); sacb = DOT2(PW[(i0_) + 1], sacb); PIN(sacc); PIN(sacb); } SBAR(); } while (0)
#define EX(v) __builtin_amdgcn_exp2f(v)
#define GAPB(q, ks, X, i) do { if constexpr ((q) < ND) { o[q] = MFMA32(PAF(ks), VFR((q) * 4 + (ks)), o[q]); } X[i] = EX(X[i]); X[(i) + 1] = EX(X[(i) + 1]); X[(i) + 2] = EX(X[(i) + 2]); X[(i) + 3] = EX(X[(i) + 3]); PIN(X); SBAR(); } while (0)
#define GAPG(q, ks, ...) do { if constexpr ((q) < ND) { o[q] = MFMA32(PAF(ks), VFR((q) * 4 + (ks)), o[q]); } __VA_ARGS__; SBAR(); } while (0)
#define STEP(C0, C1, P0, P1, t, GK, GV) do { SBAR(); \
    const lds_cptr vp_ = vp0 + sl_prev * VSLOT; const lds_cptr kp_ = kp0 + sl_cur * KSLOT; \
    KRD(0); KRD(1); KRD(2); SBAR(); float sacc = (ROWSUM_DOT2 || !SAFE) ? 0.f : P0[0], sacb = (ROWSUM_DOT2 || !SAFE) ? 0.f : P0[1]; \
    KRD(3); SBAR();            GAPA(C0 = MFMA32(kf[0], qr[0], negm), P0[2], P0[3], P0[4], P0[5],     pw0[0] = PKW(P0, 0),  pw0[1] = PKW(P0, 2),  pw0, 0); \
    KRD(4); SBAR();            GAPA(C1 = MFMA32(kf[1], qr[0], negm), P0[6], P0[7], P0[8], P0[9],     pw0[2] = PKW(P0, 4),  pw0[3] = PKW(P0, 6),  pw0, 2); \
    KRD(5); SBAR();            GAPA(C0 = MFMA32(kf[2], qr[1], C0),   P0[10], P0[11], P0[12], P0[13], pw1[0] = PKW(P0, 8),  pw1[1] = PKW(P0, 10), pw1, 0); \
    KRD(6); SBAR();            GAPA(C1 = MFMA32(kf[3], qr[1], C1),   P0[14], P0[15], P1[0], P1[1],   pw1[2] = PKW(P0, 12), pw1[3] = PKW(P0, 14), pw1, 2); \
    KRD(7); VRD(0, 0); SBAR(); GAPA(C0 = MFMA32(kf[4], qr[2], C0),   P1[2], P1[3], P1[4], P1[5],     pw2[0] = PKW(P1, 0),  pw2[1] = PKW(P1, 2),  pw2, 0); \
            VRD(1, 0); SBAR(); GAPA(C1 = MFMA32(kf[5], qr[2], C1),   P1[6], P1[7], P1[8], P1[9],     pw2[2] = PKW(P1, 4),  pw2[3] = PKW(P1, 6),  pw2, 2); \
            VRD(2, 0); SBAR(); GAPA(C0 = MFMA32(kf[6], qr[3], C0),   P1[10], P1[11], P1[12], P1[13], pw3[0] = PKW(P1, 8),  pw3[1] = PKW(P1, 10), pw3, 0); \
            VRD(3, 0); SBAR(); GAPA(C1 = MFMA32(kf[7], qr[3], C1),   P1[14], P1[15], 0.f, 0.f,       pw3[2] = PKW(P1, 12), pw3[3] = PKW(P1, 14), pw3, 2); \
    if constexpr (SAFE) l_reg += sacc + sacb; \
    if constexpr (MODE == 1) { if ((t) >= nA) wmask(C0, C1, KROW(t) - qpos, hi); } \
    SBAR(); \
      \
      \
    if constexpr (!SAFE) { \
      \
    VRD(0, 1); SBAR(); GAPG(0, 0, C0[0] = EX(C0[0]); C0[1] = EX(C0[1]); PIN(C0)); \
    VRD(1, 1); SBAR(); GAPG(1, 0, C0[2] = EX(C0[2]); C0[3] = EX(C0[3]); sacc += C0[0]; sacb += C0[1]; PIN(C0); PIN(sacc); PIN(sacb)); \
    VRD(2, 1); SBAR(); GAPG(2, 0, C0[4] = EX(C0[4]); C0[5] = EX(C0[5]); sacc += C0[2]; sacb += C0[3]; PIN(C0); PIN(sacc); PIN(sacb)); \
    VRD(3, 1); SBAR(); GAPG(3, 0, C0[6] = EX(C0[6]); C0[7] = EX(C0[7]); sacc += C0[4]; sacb += C0[5]; PIN(C0); PIN(sacc); PIN(sacb)); \
    VRD(0, 2); SBAR(); GAPG(0, 1, C0[8] = EX(C0[8]); C0[9] = EX(C0[9]); sacc += C0[6]; sacb += C0[7]; PIN(C0); PIN(sacc); PIN(sacb)); \
    VRD(1, 2); SBAR(); GAPG(1, 1, C0[10] = EX(C0[10]); C0[11] = EX(C0[11]); sacc += C0[8]; sacb += C0[9]; PIN(C0); PIN(sacc); PIN(sacb)); \
    VRD(2, 2); SBAR(); GAPG(2, 1, C0[12] = EX(C0[12]); C0[13] = EX(C0[13]); sacc += C0[10]; sacb += C0[11]; PIN(C0); PIN(sacc); PIN(sacb)); \
    VRD(3, 2); SBAR(); GAPG(3, 1, C0[14] = EX(C0[14]); C0[15] = EX(C0[15]); sacc += C0[12]; sacb += C0[13]; PIN(C0); PIN(sacc); PIN(sacb)); \
    VRD(0, 3); SBAR(); GAPG(0, 2, C1[0] = EX(C1[0]); C1[1] = EX(C1[1]); sacc += C0[14]; sacb += C0[15]; PIN(C1); PIN(sacc); PIN(sacb)); \
    VRD(1, 3); SBAR(); GAPG(1, 2, C1[2] = EX(C1[2]); C1[3] = EX(C1[3]); sacc += C1[0]; sacb += C1[1]; PIN(C1); PIN(sacc); PIN(sacb)); \
    VRD(2, 3); SBAR(); GAPG(2, 2, C1[4] = EX(C1[4]); C1[5] = EX(C1[5]); sacc += C1[2]; sacb += C1[3]; PIN(C1); PIN(sacc); PIN(sacb)); \
    VRD(3, 3); SBAR(); GAPG(3, 2, C1[6] = EX(C1[6]); C1[7] = EX(C1[7]); sacc += C1[4]; sacb += C1[5]; PIN(C1); PIN(sacc); PIN(sacb)); \
    if (GK) { DMA_K((t) + 2, sl_prev); } SBAR(); GAPG(0, 3, C1[8] = EX(C1[8]); C1[9] = EX(C1[9]); sacc += C1[6]; sacb += C1[7]; PIN(C1); PIN(sacc); PIN(sacb)); \
    if (GV) { DMA_V((t) + 1, sl_next); } SBAR(); GAPG(1, 3, C1[10] = EX(C1[10]); C1[11] = EX(C1[11]); sacc += C1[8]; sacb += C1[9]; PIN(C1); PIN(sacc); PIN(sacb)); \
    GAPG(2, 3, C1[12] = EX(C1[12]); C1[13] = EX(C1[13]); sacc += C1[10]; sacb += C1[11]; PIN(C1); PIN(sacc); PIN(sacb)); \
    GAPG(3, 3, C1[14] = EX(C1[14]); C1[15] = EX(C1[15]); sacc += C1[12]; sacb += C1[13]; PIN(C1); PIN(sacc); PIN(sacb)); \
    sacc += C1[14]; sacb += C1[15]; l_reg += sacc + sacb; \
    } else { \
    float mxa, mxb; \
    VRD(0, 1); SBAR(); GAPG(0, 0, mxa = MX3(C0[0], C0[1], C0[2]); mxb = MX3(C0[3], C0[4], C0[5]); mxa = MX3(mxa, C0[6], C0[7]); mxb = MX3(mxb, C0[8], C0[9]); PIN(mxa); PIN(mxb)); \
    VRD(1, 1); SBAR(); GAPG(1, 0, mxa = MX3(mxa, C0[10], C0[11]); mxb = MX3(mxb, C0[12], C0[13]); mxa = MX3(mxa, C0[14], C0[15]); mxb = MX3(mxb, C1[0], C1[1]); PIN(mxa); PIN(mxb)); \
    VRD(2, 1); SBAR(); GAPG(2, 0, mxa = MX3(mxa, C1[2], C1[3]); mxb = MX3(mxb, C1[4], C1[5]); mxa = MX3(mxa, C1[6], C1[7]); mxb = MX3(mxb, C1[8], C1[9]); PIN(mxa); PIN(mxb)); \
    VRD(3, 1); SBAR(); GAPG(3, 0, mxa = MX3(mxa, C1[10], C1[11]); mxb = MX3(mxb, C1[12], C1[13]); mxa = MX3(mxa, C1[14], C1[15]); PIN(mxa); PIN(mxb)); \
    { float rm = __builtin_fmaxf(mxa, mxb); { auto rr = __builtin_amdgcn_permlane32_swap(__float_as_uint(rm), __float_as_uint(rm), false, false); rm = __builtin_fmaxf(__uint_as_float(rr[0]), __uint_as_float(rr[1])); } \
      resc = false; \
      if (__builtin_expect(__any(rm > THR), 0)) { const float dl = __builtin_fmaxf(rm, 0.f); mhat += dl; \
          _Pragma("unroll") for (int r = 0; r < 16; ++r) { C0[r] -= dl; C1[r] -= dl; } \
          _Pragma("unroll") for (int r = 0; r < 16; ++r) negm[r] = -mhat; PIN(negm); \
          const float f = __builtin_amdgcn_exp2f(-dl); l_reg *= f; if (hi == 0) wsf[r32] = f; resc = true; } } \
    SBAR(); \
    VRD(0, 2); SBAR(); GAPG(0, 1, C0[0] = EX(C0[0]); C0[1] = EX(C0[1]); C0[2] = EX(C0[2]); PIN(C0)); \
    VRD(1, 2); SBAR(); GAPG(1, 1, C0[3] = EX(C0[3]); C0[4] = EX(C0[4]); C0[5] = EX(C0[5]); PIN(C0)); \
    VRD(2, 2); SBAR(); GAPG(2, 1, C0[6] = EX(C0[6]); C0[7] = EX(C0[7]); C0[8] = EX(C0[8]); PIN(C0)); \
    VRD(3, 2); SBAR(); GAPG(3, 1, C0[9] = EX(C0[9]); C0[10] = EX(C0[10]); C0[11] = EX(C0[11]); PIN(C0)); \
    VRD(0, 3); SBAR(); GAPG(0, 2, C0[12] = EX(C0[12]); C0[13] = EX(C0[13]); C0[14] = EX(C0[14]); PIN(C0)); \
    VRD(1, 3); SBAR(); GAPG(1, 2, C0[15] = EX(C0[15]); C1[0] = EX(C1[0]); C1[1] = EX(C1[1]); PIN(C0); PIN(C1)); \
    VRD(2, 3); SBAR(); GAPG(2, 2, C1[2] = EX(C1[2]); C1[3] = EX(C1[3]); C1[4] = EX(C1[4]); PIN(C1)); \
    VRD(3, 3); SBAR(); GAPG(3, 2, C1[5] = EX(C1[5]); C1[6] = EX(C1[6]); C1[7] = EX(C1[7]); PIN(C1)); \
    if (GK) { DMA_K((t) + 2, sl_prev); if (PROBE_DUPK) DMA_K((t) + 2, sl_prev); } SBAR(); GAPG(0, 3, C1[8] = EX(C1[8]); C1[9] = EX(C1[9]); PIN(C1)); \
    if (GV) { DMA_V((t) + 1, sl_next); if (PROBE_DUPV) DMA_V((t) + 1, sl_next); } SBAR(); GAPG(1, 3, C1[10] = EX(C1[10]); C1[11] = EX(C1[11]); PIN(C1)); \
    GAPG(2, 3, C1[12] = EX(C1[12]); C1[13] = EX(C1[13]); PIN(C1)); \
    GAPG(3, 3, C1[14] = EX(C1[14]); C1[15] = EX(C1[15]); PIN(C1)); \
    } \
    } while (0)
#ifndef PROBE_DUPK
#define PROBE_DUPK 0
#endif
#ifndef PROBE_DUPV
#define PROBE_DUPV 0
#endif
#define WAIT_N(n_) do { if ((n_) == 6) { WAIT_BAR(6); } else if ((n_) == 5) { WAIT_BAR(5); } else if ((n_) == 4) { WAIT_BAR(4); } else if ((n_) == 3) { WAIT_BAR(3); } else if ((n_) == 2) { WAIT_BAR(2); } else if ((n_) == 1) { WAIT_BAR(1); } else { WAIT_BAR(0); } } while (0)
#define ENDW(tt) do { const int nk_ = ((tt) + 2 < NT) ? 1 + PROBE_DUPK : 0, nv_ = ((tt) + 1 < NT) ? NVP * (1 + PROBE_DUPV) : 0; WAIT_N(nk_ + nv_); } while (0)
    int t = 1;
    for (; t + 3 < NT; t += 2) {
        STEP(pB0, pB1, pA0, pA1, t, true, true);     WAIT_N(1 + PROBE_DUPK + NVP * (1 + PROBE_DUPV)); RESC(); ROT();
        STEP(pA0, pA1, pB0, pB1, t + 1, true, true); WAIT_N(1 + PROBE_DUPK + NVP * (1 + PROBE_DUPV)); RESC(); ROT();
    }
    for (; t + 1 < NT; t += 2) {
        STEP(pB0, pB1, pA0, pA1, t, (t + 2 < NT), (t + 1 < NT));         ENDW(t);     RESC(); ROT();
        STEP(pA0, pA1, pB0, pB1, t + 1, (t + 3 < NT), (t + 2 < NT));     ENDW(t + 1); RESC(); ROT();
    }
    STEP(pB0, pB1, pA0, pA1, NT - 1, false, false); WAIT_BAR(0); RESC(); ROT();
    { if constexpr (SAFE) { float sacc = pB0[0] + pB0[1];
#pragma unroll
      for (int r = 2; r < 16; ++r) sacc += pB0[r];
#pragma unroll
      for (int r = 0; r < 16; ++r) sacc += pB1[r];
      l_reg += sacc; }
      pw0 = (u32x4){PKW(pB0, 0), PKW(pB0, 2), PKW(pB0, 4), PKW(pB0, 6)}; pw1 = (u32x4){PKW(pB0, 8), PKW(pB0, 10), PKW(pB0, 12), PKW(pB0, 14)};
      pw2 = (u32x4){PKW(pB1, 0), PKW(pB1, 2), PKW(pB1, 4), PKW(pB1, 6)}; pw3 = (u32x4){PKW(pB1, 8), PKW(pB1, 10), PKW(pB1, 12), PKW(pB1, 14)};
      const lds_cptr vp_ = vp0 + sl_prev * VSLOT;
#pragma unroll
      for (int q = 0; q < ND; ++q) {
          s16x4 l0 = vtr(vp_ + q * 4096), h0 = vtr(vp_ + q * 4096 + 512), l1 = vtr(vp_ + q * 4096 + 1024), h1 = vtr(vp_ + q * 4096 + 1024 + 512);
          s16x4 l2 = vtr(vp_ + q * 4096 + 2048), h2 = vtr(vp_ + q * 4096 + 2048 + 512), l3 = vtr(vp_ + q * 4096 + 3072), h3 = vtr(vp_ + q * 4096 + 3072 + 512);
#define PKV(L, H) (bf16x8){L[0], L[1], L[2], L[3], H[0], H[1], H[2], H[3]}
          o[q] = MFMA32(PAF(0), PKV(l0, h0), o[q]); o[q] = MFMA32(PAF(1), PKV(l1, h1), o[q]); o[q] = MFMA32(PAF(2), PKV(l2, h2), o[q]); o[q] = MFMA32(PAF(3), PKV(l3, h3), o[q]);
#undef PKV
      } }
    { auto rr = __builtin_amdgcn_permlane32_swap(__float_as_uint(l_reg), __float_as_uint(l_reg), false, false); l_reg = __uint_as_float(rr[0]) + __uint_as_float(rr[1]); }
    if (PROBE_VALU) asm volatile("" :: "v"(dummy_));
    __builtin_amdgcn_s_setprio(0);
    m_out = mhat; l_out = l_reg;
#undef KROW
#undef DMA_K
#undef DMA_V
#undef ROT
#undef RESC
#undef PAF
#undef VFR
#undef VRD
#undef KRD
#undef PKW
#undef GAPA
#undef DOT2
#undef GAPB
#undef GAPG
#undef EX
#undef STEP
#undef ENDW
#undef WAIT_N
}
#undef SBAR
#undef PIN
#undef MX3
#undef MFMA32
#undef WAIT_BAR
}

#define XB_TMO      128
#define XB_XCNT(j)  (256  + 64 * (j))
#define XB_XSUB(j)  (1280 + 64 * (j))
#define XB_XGEN(j)  (2304 + 64 * (j))
#define XB_TOP      3328
#define XB_TOPGEN   3392
#define XCD_BAR_WORDS 3456
#define XB_SPIN_CAP (1u << 18)

__device__ __forceinline__ unsigned xb_ld(unsigned* p)              { return __hip_atomic_load(p, __ATOMIC_RELAXED, __HIP_MEMORY_SCOPE_AGENT); }
__device__ __forceinline__ unsigned xb_add(unsigned* p, unsigned v) { return __hip_atomic_fetch_add(p, v, __ATOMIC_RELAXED, __HIP_MEMORY_SCOPE_AGENT); }
__device__ __forceinline__ unsigned xb_xcc_id() { return (unsigned)__builtin_amdgcn_s_getreg((3 << 11) | 20) & 0xFu; }
#define XB_SPIN(cond, bar) do { unsigned _sp = 0; while (cond) { __builtin_amdgcn_s_sleep(1); \
    if ((++_sp & 255u) == 0u) { if (xb_ld(&(bar)[XB_TMO])) break; if (_sp > XB_SPIN_CAP) { atomicAdd(&(bar)[XB_TMO], 1u); break; } } } } while (0)

struct XcdBarrier {
    unsigned* bar; unsigned x;
    volatile LAS unsigned* st;
};

__device__ __forceinline__ XcdBarrier xcd_barrier_post(unsigned* bar, volatile LAS unsigned* st) {
    XcdBarrier b; b.bar = bar; b.x = xb_xcc_id(); b.st = st;
    if (threadIdx.x == 0) (void)xb_add(&bar[XB_XCNT(b.x)], 1u);
    return b;
}
__device__ __forceinline__ void xcd_barrier_complete(unsigned* bar, unsigned x, unsigned& nloc, unsigned& nx) {
    const unsigned G = gridDim.x * gridDim.y * gridDim.z;
    unsigned sum, cnt, mine, sp = 0u;
    for (;;) {
        sum = 0u; cnt = 0u; mine = 0u;
#pragma unroll
        for (unsigned j = 0; j < 16; ++j) { const unsigned c = xb_ld(&bar[XB_XCNT(j)]); sum += c; cnt += (c > 0u) ? 1u : 0u; mine = (j == x) ? c : mine; }
        if (sum == G) break;
        __builtin_amdgcn_s_sleep(1);
        if ((++sp & 255u) == 0u) { if (xb_ld(&bar[XB_TMO])) break; if (sp > XB_SPIN_CAP) { atomicAdd(&bar[XB_TMO], 1u); break; } }
    }
    nloc = mine > 0u ? mine : 1u; nx = cnt > 0u ? cnt : 1u;
}

__device__ __forceinline__ void xcd_barrier(const XcdBarrier& b) {
    asm volatile("s_waitcnt vmcnt(0)" ::: "memory");
    __syncthreads();
    if (threadIdx.x == 0) {
        unsigned* bar = b.bar;
        __builtin_amdgcn_s_waitcnt(0);
        unsigned nloc = b.st[0], nx = b.st[1];
        if (nloc == 0u) { xcd_barrier_complete(bar, b.x, nloc, nx); b.st[0] = nloc; b.st[1] = nx; }
        const unsigned old = xb_add(&bar[XB_XSUB(b.x)], 1u);
        const unsigned gen = old / nloc;
        if (old + 1u == (gen + 1u) * nloc) {
            __builtin_amdgcn_fence(__ATOMIC_RELEASE, "agent");
            asm volatile("s_waitcnt vmcnt(0)" ::: "memory");
            const unsigned og = xb_add(&bar[XB_TOP], 1u);
            const unsigned tg = og / nx;
            if (og + 1u == (tg + 1u) * nx) xb_add(&bar[XB_TOPGEN], 1u);
            else XB_SPIN(xb_ld(&bar[XB_TOPGEN]) == tg, bar);
            __builtin_amdgcn_fence(__ATOMIC_ACQUIRE, "agent");
            xb_add(&bar[XB_XGEN(b.x)], 1u);
            asm volatile("s_waitcnt vmcnt(0)" ::: "memory");
        } else {
            XB_SPIN(xb_ld(&bar[XB_XGEN(b.x)]) == gen, bar);
            __builtin_amdgcn_fence(__ATOMIC_ACQUIRE, "agent");
            asm volatile("s_waitcnt vmcnt(0)" ::: "memory");
        }
    }
    __syncthreads();
}

struct Args { const float* in[23]; float* out; unsigned char* ws; int ph_lo, ph_hi; };
enum { I_X = 0, I_C, I_CTX, I_CCTX, I_WADA, I_BADA, I_GMIX, I_WIN, I_DLAM, I_DNG, I_SINK, I_CONVW, I_CONVB, I_LNG, I_LNB, I_WOUT, I_GFFN, I_RW, I_RB, I_W1, I_W3, I_W2, I_GFIN };
constexpr int N_PHASES = 18;
__device__ __constant__ const float LAMBDA_INIT[2] = {0.2f, 0.35550906759097f};

struct EpiInProj {
    static constexpr bool PERM = true, AFTER_DRAIN = false;
    unsigned char* ws; const float* ropeC; const float* ropeS;
    __device__ __forceinline__ void operator()(const f32x4 (&acc)[2][2][4][2], const pg8::Unit& u, int wr, int wc, int fr, int fq) const {
        const int pn = u.pn; const bool latent = u.pm < 64; const int rowb = u.pm * 256 + wr * 64 + fr;
        if (pn >= 8) {
            bf16_t* Z = (bf16_t*)(ws + RA_Z); const int ch0 = (pn - 8) * 128 + wc * 32 + 8 * fq;
#pragma unroll
            for (int ai = 0; ai < 2; ++ai)
#pragma unroll
                for (int m = 0; m < 4; ++m) { const int row = rowb + ai * 128 + m * 16;
                    const f32x4 a0 = acc[ai][0][m][0], a1 = acc[ai][0][m][1], g0 = acc[ai][1][m][0], g1 = acc[ai][1][m][1];
                    u32x4 w; w.x = cvt_pk_bf16(a0[0] * sigmoid_f(g0[0]), a0[1] * sigmoid_f(g0[1])); w.y = cvt_pk_bf16(a0[2] * sigmoid_f(g0[2]), a0[3] * sigmoid_f(g0[3]));
                    w.z = cvt_pk_bf16(a1[0] * sigmoid_f(g1[0]), a1[1] * sigmoid_f(g1[1])); w.w = cvt_pk_bf16(a1[2] * sigmoid_f(g1[2]), a1[3] * sigmoid_f(g1[3]));
                    *(u32x4*)(Z + (size_t)row * 256 + ch0) = w; }
            return;
        }
        const float sgn = (fq < 2) ? -1.f : 1.f;
        const bool anyrope = latent && (pn < 4 || pn >= 6);
#pragma unroll
        for (int ai = 0; ai < 2; ++ai)
#pragma unroll
            for (int m = 0; m < 4; ++m) { const int row = rowb + ai * 128 + m * 16;
                f32x4 c0, c1, s0, s1;
                if (anyrope) { const int pos = (wc & 1) ? (row & 63) : (row >> 6); const int fo = pos * 16 + 8 * (fq & 1);
                    c0 = *(const f32x4*)(ropeC + fo); c1 = *(const f32x4*)(ropeC + fo + 4); s0 = *(const f32x4*)(ropeS + fo) * sgn; s1 = *(const f32x4*)(ropeS + fo + 4) * sgn; }
#pragma unroll
                for (int bj = 0; bj < 2; ++bj) {
                    bf16_t* dst; int ld, dcol; bool rope; float sc = 1.f; bool isvb = false;
                    if (pn < 2)       { dst = (bf16_t*)(ws + RA_QA); ld = 512; dcol = pn * 256 + bj * 128 + wc * 32; rope = true; sc = QSCALE; }
                    else if (pn < 4)  { dst = (bf16_t*)(ws + RA_KA); ld = 512; dcol = (pn - 2) * 256 + bj * 128 + wc * 32; rope = true; }
                    else if (pn < 6)  { dst = (bf16_t*)(ws + RA_VA); ld = 512; dcol = (pn - 4) * 256 + bj * 128 + wc * 32; rope = false; }
                    else if (pn == 6) { dst = (bf16_t*)(ws + RA_QB); ld = 256; dcol = bj * 128 + wc * 32; rope = true; sc = QSCALE; }
                    else if (bj == 0) { dst = (bf16_t*)(ws + RA_KB); ld = 128; dcol = wc * 32; rope = true; }
                    else              { dst = (bf16_t*)(ws + RA_VB); ld = 256; dcol = (wc >> 1) * 128 + (wc & 1) * 32; rope = false; isvb = true; }
                    rope = rope && latent;
                    f32x4 x0 = acc[ai][bj][m][0], x1 = acc[ai][bj][m][1];
                    if (rope) { f32x4 p0, p1;
#pragma unroll
                        for (int j = 0; j < 4; ++j) {
                            auto s0_ = __builtin_amdgcn_permlane32_swap(__float_as_uint(x0[j]), __float_as_uint(x0[j]), false, false); p0[j] = __uint_as_float(fq < 2 ? s0_[1] : s0_[0]);
                            auto s1_ = __builtin_amdgcn_permlane32_swap(__float_as_uint(x1[j]), __float_as_uint(x1[j]), false, false); p1[j] = __uint_as_float(fq < 2 ? s1_[1] : s1_[0]); }
                        x0 = x0 * c0 + p0 * s0; x1 = x1 * c1 + p1 * s1; }
                    x0 = x0 * sc; x1 = x1 * sc;
                    bf16_t* p = dst + (size_t)row * ld + dcol + 8 * fq;
                    u32x4 w; w.x = cvt_pk_bf16(x0[0], x0[1]); w.y = cvt_pk_bf16(x0[2], x0[3]); w.z = cvt_pk_bf16(x1[0], x1[1]); w.w = cvt_pk_bf16(x1[2], x1[3]);
                    *(u32x4*)p = w;
                    if (isvb) { unsigned zz = 0u; asm volatile("" : "+v"(zz)); const u32x4 z = {zz, zz, zz, zz}; *(u32x4*)(p + 64) = z; } }
            }
    }
};
__device__ __forceinline__ void st16_wt(void* p, const u32x4 v) { asm volatile("global_store_dwordx4 %0, %1, off sc1\n\ts_nop 1" :: "v"(p), "v"(v) : "memory"); }
__device__ __forceinline__ void st4bf_wt(bf16_t* p, const f32x4 v) { u32x2 w; w.x = cvt_pk_bf16(v.x, v.y); w.y = cvt_pk_bf16(v.z, v.w); asm volatile("global_store_dwordx2 %0, %1, off sc1\n\ts_nop 0" :: "v"(p), "v"(w) : "memory"); }
struct OutOrder {
    pg8::StaticOrder in; gu32* cnt; gu32* ctxc;
    __device__ __forceinline__ bool next(int i, pg8::Unit& u) const {
        if (ctxc == nullptr) { if (i != 0) return false; return in.next(0, u); }
        const int c = blockIdx.x;
        if (c < 12) { if (i != 0) return false; u.pm = 61 + (c >> 2); u.pn = c & 3; u.aux = 0; return true; }
        if (i == 0) return in.next(0, u);
        if (i == 1 && c < 16) { u.pm = 64; u.pn = c - 12; u.aux = 0; return true; }
        return false; }
    __device__ __forceinline__ void a_ready(const pg8::Unit& u) const {
        if (ctxc != nullptr && u.pm >= 64) { for (unsigned s = 0; s < (1u << 20); ++s) { if ((unsigned)__builtin_amdgcn_readfirstlane((int)__hip_atomic_load(ctxc, __ATOMIC_RELAXED, __HIP_MEMORY_SCOPE_AGENT)) == 12u) break; __builtin_amdgcn_s_sleep(2); }
            __builtin_amdgcn_fence(__ATOMIC_ACQUIRE, "agent"); } }
    __device__ __forceinline__ void done(const pg8::Unit& u) const {
        asm volatile("s_waitcnt vmcnt(0)" ::: "memory");
        int ln; asm volatile("v_mbcnt_lo_u32_b32 %0, -1, 0\n\tv_mbcnt_hi_u32_b32 %0, -1, %0" : "=v"(ln));
        if (ln == 0) __hip_atomic_fetch_add(cnt + u.pm, 1u, __ATOMIC_RELAXED, __HIP_MEMORY_SCOPE_AGENT); }
};
struct EpiOutProj {
    static constexpr bool PERM = true, AFTER_DRAIN = false;
    const float* xin; const float* ctxin; bf16_t* XB; const float* gate_lat; const float* gate_ctx; int layer;
    __device__ __forceinline__ void operator()(const f32x4 (&acc)[2][2][4][2], const pg8::Unit& u, int wr, int wc, int fr, int fq) const {
        const bool isctx = u.pm >= 64; const float* gate = isctx ? gate_ctx : gate_lat; const int col8 = u.pn * 256 + wc * 32 + 8 * fq;
        f32x4 g[2][2];
#pragma unroll
        for (int bj = 0; bj < 2; ++bj) { g[bj][0] = *(const f32x4*)(gate + col8 + bj * 128); g[bj][1] = *(const f32x4*)(gate + col8 + bj * 128 + 4); }
        if (layer == 0) {
#pragma unroll
            for (int am = 0; am < 4; ++am) { const int ai = am >> 1, m0 = (am & 1) * 2; f32x4 x[2][2][2];
#pragma unroll
                for (int mm = 0; mm < 2; ++mm) { const int row = u.pm * 256 + ai * 128 + wr * 64 + (m0 + mm) * 16 + fr;
                    const float* xo = (isctx ? ctxin + (size_t)(row - SEQ) * DM : xin + (size_t)row * DM) + col8;
#pragma unroll
                    for (int bj = 0; bj < 2; ++bj) { x[mm][bj][0] = *(const f32x4*)(xo + bj * 128); x[mm][bj][1] = *(const f32x4*)(xo + bj * 128 + 4); } }
#pragma unroll
                for (int mm = 0; mm < 2; ++mm) { const int m = m0 + mm; const int row = u.pm * 256 + ai * 128 + wr * 64 + m * 16 + fr; bf16_t* xn = XB + (size_t)row * DM + col8;
#pragma unroll
                    for (int bj = 0; bj < 2; ++bj) { const f32x4 y0 = x[mm][bj][0] + g[bj][0] * acc[ai][bj][m][0], y1 = x[mm][bj][1] + g[bj][1] * acc[ai][bj][m][1];
                        u32x4 o; o.x = cvt_pk_bf16(y0.x, y0.y); o.y = cvt_pk_bf16(y0.z, y0.w); o.z = cvt_pk_bf16(y1.x, y1.y); o.w = cvt_pk_bf16(y1.z, y1.w);
                        st16_wt(xn + bj * 128, o); } } }
        } else {
#pragma unroll
            for (int ai = 0; ai < 2; ++ai) { u32x4 xw[4][2];
#pragma unroll
                for (int m = 0; m < 4; ++m) { const int row = u.pm * 256 + ai * 128 + wr * 64 + m * 16 + fr; const bf16_t* xn = XB + (size_t)row * DM + col8;
#pragma unroll
                    for (int bj = 0; bj < 2; ++bj) xw[m][bj] = *(const u32x4*)(xn + bj * 128); }
#pragma unroll
                for (int m = 0; m < 4; ++m) { const int row = u.pm * 256 + ai * 128 + wr * 64 + m * 16 + fr; bf16_t* xn = XB + (size_t)row * DM + col8;
#pragma unroll
                    for (int bj = 0; bj < 2; ++bj) { const u32x4 w = xw[m][bj];
                        const f32x4 x0 = {__builtin_bit_cast(float, w.x << 16), __builtin_bit_cast(float, w.x & 0xffff0000u), __builtin_bit_cast(float, w.y << 16), __builtin_bit_cast(float, w.y & 0xffff0000u)};
                        const f32x4 x1 = {__builtin_bit_cast(float, w.z << 16), __builtin_bit_cast(float, w.z & 0xffff0000u), __builtin_bit_cast(float, w.w << 16), __builtin_bit_cast(float, w.w & 0xffff0000u)};
                        const f32x4 y0 = x0 + g[bj][0] * acc[ai][bj][m][0], y1 = x1 + g[bj][1] * acc[ai][bj][m][1];
                        u32x4 o; o.x = cvt_pk_bf16(y0.x, y0.y); o.y = cvt_pk_bf16(y0.z, y0.w); o.z = cvt_pk_bf16(y1.x, y1.y); o.w = cvt_pk_bf16(y1.z, y1.w);
                        st16_wt(xn + bj * 128, o); } } }
        }
    }
};
struct EpiMoe1 {
    static constexpr bool PERM = true, AFTER_DRAIN = false;
    bf16_t* HS;
    __device__ __forceinline__ void operator()(const f32x4 (&acc)[2][2][4][2], const pg8::Unit& u, int wr, int wc, int fr, int fq) const {
        const int col8 = (u.pn & 3) * 128 + wc * 32 + 8 * fq;
#pragma unroll
        for (int ai = 0; ai < 2; ++ai)
#pragma unroll
            for (int m = 0; m < 4; ++m) { const int row = u.pm * 256 + ai * 128 + wr * 64 + m * 16 + fr;
                const f32x4 a0 = acc[ai][0][m][0], a1 = acc[ai][0][m][1], b0 = acc[ai][1][m][0], b1 = acc[ai][1][m][1];
                u32x4 w; w.x = cvt_pk_bf16(silu_f(a0[0]) * b0[0], silu_f(a0[1]) * b0[1]); w.y = cvt_pk_bf16(silu_f(a0[2]) * b0[2], silu_f(a0[3]) * b0[3]);
                w.z = cvt_pk_bf16(silu_f(a1[0]) * b1[0], silu_f(a1[1]) * b1[1]); w.w = cvt_pk_bf16(silu_f(a1[2]) * b1[2], silu_f(a1[3]) * b1[3]);
                st16_wt(HS + (size_t)row * FFE + col8, w); }
    }
};
constexpr float YS_SCALE = 16.f, YS_INV = 1.f / 16.f;
struct EpiMoe2 {
    static constexpr bool PERM = true, AFTER_DRAIN = false;
    unsigned char* YS;
    __device__ __forceinline__ void operator()(const f32x4 (&acc)[2][2][4][2], const pg8::Unit& u, int wr, int wc, int fr, int fq) const {
        const int col8 = (u.pn & 3) * 256 + wc * 32 + 8 * fq;
#pragma unroll
        for (int ai = 0; ai < 2; ++ai)
#pragma unroll
            for (int m = 0; m < 4; ++m) { const int row = u.pm * 256 + ai * 128 + wr * 64 + m * 16 + fr;
#pragma unroll
                for (int bj = 0; bj < 2; ++bj) { f32x4 v0 = acc[ai][bj][m][0] * YS_SCALE, v1 = acc[ai][bj][m][1] * YS_SCALE;
#pragma unroll
                    for (int j = 0; j < 4; ++j) { v0[j] = __builtin_amdgcn_fmed3f(v0[j], -448.f, 448.f); v1[j] = __builtin_amdgcn_fmed3f(v1[j], -448.f, 448.f); }
                    int w0 = __builtin_amdgcn_cvt_pk_fp8_f32(v0[0], v0[1], 0, false); w0 = __builtin_amdgcn_cvt_pk_fp8_f32(v0[2], v0[3], w0, true);
                    int w1 = __builtin_amdgcn_cvt_pk_fp8_f32(v1[0], v1[1], 0, false); w1 = __builtin_amdgcn_cvt_pk_fp8_f32(v1[2], v1[3], w1, true);
                    *(u32x2*)(YS + (size_t)row * DM + col8 + bj * 128) = (u32x2){(unsigned)w0, (unsigned)w1}; } }
    }
};
struct MoeOrder {
    int G, vcu, nunits; int ts[16]; const int* rowtok;
    __device__ __forceinline__ unsigned row_off(const pg8::Unit& u, int r) const { return (unsigned)min((unsigned)rowtok[u.aux + r], (unsigned)(NROW - 1)) * (unsigned)(DM * 2); }
    __device__ __forceinline__ bool next(int i, pg8::Unit& u) const {
        const int L = i * G + vcu; if (L >= nunits) return false;
        const int rt = L >> 2, ct = L & 3; int e = 0, tb = ts[0];
#pragma unroll
        for (int k = 1; k < 16; ++k) { const bool ge = rt >= ts[k]; e += ge ? 1 : 0; tb = ge ? ts[k] : tb; }
        u.pm = rt; u.pn = e * 4 + ct; u.aux = e * ROWCAP + (rt - tb) * 256; return true;
    }
    __device__ __forceinline__ int nloc() const { return vcu < nunits ? (nunits - vcu + G - 1) / G : 0; }
    __device__ __forceinline__ void a_ready(const pg8::Unit&) const {}
    __device__ __forceinline__ void done(const pg8::Unit&) const {}
};

struct MoeOrder2 {
    int vcu, nunits, part; int ts[16];
    __device__ __forceinline__ bool next(int i, pg8::Unit& u) const {
        const int U = nunits, q = U >> 8, r = U & 255; int L;
        if (part == 0) { if (vcu < r || i >= q) return false; L = i * 256 + vcu; }
        else { int b = vcu + i * 256; if (b >= (q + 1) * r) return false; int k = 0; while (b >= r) { b -= r; ++k; } L = k * 256 + b; }
        const int rt = L >> 2, ct = L & 3; int e = 0;
#pragma unroll
        for (int k = 1; k < 16; ++k) e += (rt >= ts[k]) ? 1 : 0;
        u.pm = rt; u.pn = e * 4 + ct; u.aux = 0; return true; }
    __device__ __forceinline__ void a_ready(const pg8::Unit&) const {}
    __device__ __forceinline__ void done(const pg8::Unit&) const {}
};
__device__ __forceinline__ void moe_wait(gu32* flag, int base, int n) {
    const int tid = otid();
    if (tid < 64) { for (unsigned s = 0; s < (1u << 20); ++s) { bool ok = true;
            for (int j = tid; j < n; j += 64) ok = ok && (__hip_atomic_load(flag + base + j, __ATOMIC_RELAXED, __HIP_MEMORY_SCOPE_AGENT) == 1u);
            if (__all(ok)) break; __builtin_amdgcn_s_sleep(2); }
        __builtin_amdgcn_fence(__ATOMIC_ACQUIRE, "agent"); asm volatile("s_waitcnt vmcnt(0)" ::: "memory"); }
    __syncthreads();
}

__device__ __forceinline__ void tr_item(const float* W, int ldw, int k0, int n0, bf16_t* WT, int K, int nd0, LAS float* scr, int lane) {
    f32x4 v[8];
#pragma unroll
    for (int i = 0; i < 8; ++i) v[i] = *(const f32x4*)(W + (size_t)(k0 + 8 * i + (lane >> 3)) * ldw + n0 + (lane & 7) * 4);
#pragma unroll
    for (int i = 0; i < 8; ++i) { LAS float* d = scr + (8 * i + (lane >> 3)) * 33 + (lane & 7) * 4; d[0] = v[i].x; d[1] = v[i].y; d[2] = v[i].z; d[3] = v[i].w; }
    LDS_WAIT(); asm volatile("" ::: "memory");
    const int c = lane & 7;
#pragma unroll
    for (int j = 0; j < 4; ++j) { const int n = (lane >> 3) + 8 * j; const LAS float* s = scr + (8 * c) * 33 + n;
        u32x4 o; o.x = pk2(s[0 * 33], s[1 * 33]); o.y = pk2(s[2 * 33], s[3 * 33]); o.z = pk2(s[4 * 33], s[5 * 33]); o.w = pk2(s[6 * 33], s[7 * 33]);
        *(u32x4*)(WT + (size_t)(nd0 + n) * K + k0 + 8 * c) = o; }
    LDS_WAIT(); asm volatile("" ::: "memory");
}
__device__ __forceinline__ void moe_convert(const Args& a, int L, LAS float* scr, int gw, int NGW, int lane, int it0 = 0, int it1 = 12288) {
    bf16_t* W13T = (bf16_t*)(a.ws + WS_W13) + (size_t)L * 16 * 1024 * 1024; bf16_t* W2T = (bf16_t*)(a.ws + WS_W2) + (size_t)L * 16 * 1024 * 512;
    for (int it = it0 + gw; it < it1; it += NGW) {
        if (it < 8192) { const int e = it >> 9, r2 = it & 511, kb = r2 >> 5, nb = r2 & 31, nd0 = 32 * nb, t = nd0 >> 8, bj = (nd0 >> 7) & 1, i0 = nd0 & 127;
            const float* src = (bj ? a.in[I_W3] : a.in[I_W1]) + (size_t)(L * 16 + e) * 1024 * 512;
            tr_item(src, 512, 64 * kb, t * 128 + i0, W13T + (size_t)e * 1024 * 1024, 1024, nd0, scr, lane); }
        else { const int r = it - 8192, e = r >> 8, r2 = r & 255, kb = r2 >> 5, nb = r2 & 31;
            tr_item(a.in[I_W2] + (size_t)(L * 16 + e) * 512 * 1024, 1024, 64 * kb, 32 * nb, W2T + (size_t)e * 1024 * 512, 512, 32 * nb, scr, lane); }
    }
}
__device__ __forceinline__ void prologue_phase(const Args& a, unsigned char* lds) {
    const int tid = otid(), lane = tid & 63, wave = tid >> 6, gw = blockIdx.x * NWAVES + wave, NGW = gridDim.x * NWAVES;
    LAS float* scr = (LAS float*)((LAS unsigned char*)lds + wave * 8704);
    bf16_t* WinT = (bf16_t*)(a.ws + WS_WIN); bf16_t* WoutT = (bf16_t*)(a.ws + WS_WOUT);
    for (int it = gw; it < 3584; it += NGW) {
        if (it < 2560) { const int L = it / 1280, r = it % 1280, kb = r / 80, nb = r % 80, nd0 = 32 * nb; int n0 = nd0;
            if (nd0 >= 2048) { const int q = nd0 - 2048, t = q >> 8, bj = (q >> 7) & 1, i0 = q & 127; n0 = 2048 + bj * 256 + t * 128 + i0; }
            tr_item(a.in[I_WIN] + (size_t)L * 1024 * INW, INW, 64 * kb, n0, WinT + (size_t)L * INW * 1024, 1024, nd0, scr, lane); }
        else { const int r0 = it - 2560, L = r0 >> 9, r = r0 & 511, kb = r >> 5, nb = r & 31;
            tr_item(a.in[I_WOUT] + (size_t)L * 1024 * 1024, 1024, 64 * kb, 32 * nb, WoutT + (size_t)L * 1024 * 1024, 1024, 32 * nb, scr, lane); }
    }
    moe_convert(a, 0, scr, gw, NGW, lane, 0, 8192);
    __syncthreads();
    float* sc = (float*)(lds + 71680); float* scc = sc + 1024; float* red = scc + 1024;
    float* MOD = (float*)(a.ws + WS_MOD);
    for (int u = blockIdx.x; u < 192; u += gridDim.x) {
        const int L = u / 96, col0 = (u % 96) * 64;
        for (int k = tid; k < 1024; k += NTHREADS) { const float c = a.in[I_C][k], cc = a.in[I_CCTX][k]; sc[k] = c / (1.f + expf(-c)); scc[k] = cc / (1.f + expf(-cc)); }
        __syncthreads();
        const int cg = tid & 15, ks = tid >> 4;
        const float* w = a.in[I_WADA] + ((size_t)L * 1024 + ks * 32) * 6144 + col0 + cg * 4;
        f32x4 s1 = {0.f, 0.f, 0.f, 0.f}, s2 = {0.f, 0.f, 0.f, 0.f};
#pragma unroll 8
        for (int k = 0; k < 32; ++k) { const f32x4 wv = *(const f32x4*)(w + (size_t)k * 6144); s1 = s1 + wv * sc[ks * 32 + k]; s2 = s2 + wv * scc[ks * 32 + k]; }
        *(f32x4*)(red + (ks * 16 + cg) * 8) = s1; *(f32x4*)(red + (ks * 16 + cg) * 8 + 4) = s2;
        __syncthreads();
        if (tid < 128) { const int which = tid >> 6, c = tid & 63; float s = 0.f;
            for (int k = 0; k < 32; ++k) s += red[(k * 16 + (c >> 2)) * 8 + which * 4 + (c & 3)];
            MOD[(L * 2 + which) * 6144 + col0 + c] = s + a.in[I_BADA][L * 6144 + col0 + c]; }
        __syncthreads();
    }
    if (blockIdx.x >= 192 && tid < 64) {
        float* rc = (float*)(a.ws + WS_ROPEC); float* rs = (float*)(a.ws + WS_ROPES);
        const int i = ((int)blockIdx.x - 192) * 64 + tid; const int pos = i >> 4, f = i & 15; const float inv = powf(10000.f, -(float)f / 16.f), ang = (float)pos * inv; rc[i] = cosf(ang); rs[i] = sinf(ang);
    }
    if (blockIdx.x == gridDim.x - 2 && wave < 2) {
        const float* dl = a.in[I_DLAM] + wave * 256;
        const float s01 = wave_sum(dl[lane] * dl[64 + lane]), s23 = wave_sum(dl[128 + lane] * dl[192 + lane]);
        if (lane == 0) ((float*)(a.ws + WS_LAM))[wave] = expf(s01) - expf(s23) + LAMBDA_INIT[wave];
    }
}

__device__ __forceinline__ void norm1_phase(const Args& a, int l) {
    constexpr int NR = 4;
    const int tid = otid(), lane = tid & 63, wave = tid >> 6;
    const int nrows = (l == 2) ? SEQ : NROW, rpw = (nrows + gridDim.x - 1) / gridDim.x, r0 = blockIdx.x * rpw, r1 = min(nrows, r0 + rpw);
    const int rw = (rpw + NWAVES - 1) / NWAVES, wr0 = r0 + wave * rw, wr1 = min(r1, wr0 + rw);
    bf16_t* XB = (bf16_t*)(a.ws + WS_XB); bf16_t* HB = (bf16_t*)(a.ws + WS_HB); const unsigned char* YS = a.ws + WS_RA;
    const float* MOD = (const float*)(a.ws + WS_MOD);
    const int2* TOKP = (const int2*)(a.ws + WS_TOKP); const float2* TOKW = (const float2*)(a.ws + WS_TOKW);
    f32x4 ga[4], gb[4], gq[4]; int cur_ctx = -1;
#define N1_PARAMS(isctx_) do { if ((int)(isctx_) != cur_ctx) { cur_ctx = (int)(isctx_); \
        if (l < 2) { const f32x4* g_ = (const f32x4*)(a.in[I_GMIX] + l * DM) + lane; const float* md_ = MOD + (l * 2 + cur_ctx) * 6144; \
            _Pragma("unroll") for (int j = 0; j < 4; ++j) { ga[j] = g_[64 * j] * (((const f32x4*)(md_ + 1024) + lane)[64 * j] + 1.f); gb[j] = ((const f32x4*)(md_) + lane)[64 * j]; } } \
        else { const f32x4* g_ = (const f32x4*)(a.in[I_GFIN]) + lane; _Pragma("unroll") for (int j = 0; j < 4; ++j) { ga[j] = g_[64 * j]; gb[j] = ga[j]; } } \
        if (l != 0) { const f32x4* q_ = (const f32x4*)(MOD + ((l - 1) * 2 + cur_ctx) * 6144 + 5 * 1024) + lane; _Pragma("unroll") for (int j = 0; j < 4; ++j) gq[j] = q_[64 * j]; } \
        else { _Pragma("unroll") for (int j = 0; j < 4; ++j) gq[j] = ga[j]; } } } while (0)
    for (int rb = wr0; rb < wr1; rb += NR) {
        f32x4 v[NR][4]; int rowk[NR];
#pragma unroll
        for (int k = 0; k < NR; ++k) rowk[k] = min(rb + k, wr1 - 1);
        if (l == 0) {
#pragma unroll
            for (int k = 0; k < NR; ++k) { const int row = rowk[k]; const bool isctx = row >= SEQ;
                const f32x4* src = (const f32x4*)(isctx ? a.in[I_CTX] + (size_t)(row - SEQ) * DM : a.in[I_X] + (size_t)row * DM) + lane;
#pragma unroll
                for (int j = 0; j < 4; ++j) v[k][j] = src[64 * j]; }
        } else {
            int2 pp[NR]; float2 ww[NR];
#pragma unroll
            for (int k = 0; k < NR; ++k) { pp[k] = TOKP[rowk[k]]; ww[k] = TOKW[rowk[k]]; }
            { const int* tsg = (const int*)(a.ws + WS_TSG) + (l - 1) * 32;
#pragma unroll
              for (int k = 0; k < NR; ++k) { pp[k].x = tsg[pp[k].x >> 15] * 256 + (pp[k].x & 32767); pp[k].y = tsg[pp[k].y >> 15] * 256 + (pp[k].y & 32767); } }
            unsigned y0[NR][4], y1[NR][4];
#pragma unroll
            for (int k = 0; k < NR; ++k) { const int row = rowk[k]; const bool isctx = row >= SEQ;
                const bf16_t* xb = XB + (size_t)row * DM + 4 * lane; (void)isctx;
                const unsigned* q0 = (const unsigned*)(YS + (size_t)pp[k].x * DM) + lane; const unsigned* q1 = (const unsigned*)(YS + (size_t)pp[k].y * DM) + lane;
#pragma unroll
                for (int j = 0; j < 4; ++j) { v[k][j] = ld4bf(xb + 256 * j); y0[k][j] = q0[64 * j]; y1[k][j] = q1[64 * j]; } }
#pragma unroll
            for (int k = 0; k < NR; ++k) { const bool st = (rb + k < wr1) && (l < 2); bf16_t* xb = XB + (size_t)rowk[k] * DM + 4 * lane; N1_PARAMS(rowk[k] >= SEQ);
#pragma unroll
                for (int j = 0; j < 4; ++j) { const int p0 = (int)y0[k][j], p1 = (int)y1[k][j];
                    const auto a01 = __builtin_amdgcn_cvt_pk_f32_fp8(p0, false), a23 = __builtin_amdgcn_cvt_pk_f32_fp8(p0, true), b01 = __builtin_amdgcn_cvt_pk_f32_fp8(p1, false), b23 = __builtin_amdgcn_cvt_pk_f32_fp8(p1, true);
                    const f32x4 ya = {a01[0], a01[1], a23[0], a23[1]}, yb = {b01[0], b01[1], b23[0], b23[1]};
                    v[k][j] = v[k][j] + gq[j] * (ya * (ww[k].x * YS_INV) + yb * (ww[k].y * YS_INV));
                    if (st) st4bf(xb + 256 * j, v[k][j]); } }
        }
#pragma unroll
        for (int k = 0; k < NR; ++k) { const int row = rowk[k]; const bool isctx = row >= SEQ, st = rb + k < wr1;
            float ss = 0.f;
#pragma unroll
            for (int j = 0; j < 4; ++j) ss += (v[k][j].x * v[k][j].x + v[k][j].y * v[k][j].y) + (v[k][j].z * v[k][j].z + v[k][j].w * v[k][j].w);
            const float rstd = 1.f / sqrtf(wave_sum(ss) * (1.f / DM) + EPS);
            N1_PARAMS(isctx);
            if (l < 2) {
                u32x2* o8 = (u32x2*)(HB + (size_t)row * DM) + lane;
#pragma unroll
                for (int j = 0; j < 4; ++j) { const f32x4 h = v[k][j] * rstd * ga[j] + gb[j];
                    u32x2 w; w.x = cvt_pk_bf16(h.x, h.y); w.y = cvt_pk_bf16(h.z, h.w); if (st) o8[64 * j] = w; }
            } else {
                f32x4* o = (f32x4*)(a.out + (size_t)row * DM) + lane;
#pragma unroll
                for (int j = 0; j < 4; ++j) { const f32x4 r = v[k][j] * rstd * ga[j]; if (st) o[64 * j] = r; }
            }
        }
    }
}
#undef N1_PARAMS
__device__ __forceinline__ void norm2_phase(const Args& a, int l, unsigned char* lds) {
    const int tid = otid(), lane = tid & 63, wave = tid >> 6;
    const int b_ = blockIdx.x;
    const int nlat = (l == 1) ? 64 : (b_ < 16 ? 1 : 65), lat0 = (l == 1) ? b_ * 64 : (b_ < 16 ? 240 * 65 + b_ : (b_ - 16) * 65);
    const int nlate = (l == 1) ? 0 : 4, late0 = 61 * 256 + 4 * b_, tl = 61 + (b_ >> 6), nloc = nlat + nlate;
#define N2_ROW(i) ((i) < nlat ? lat0 + (i) : late0 + ((i) - nlat))
    float* hrow = (float*)lds;
    float* logit = (float*)(lds + 65536);
    int* e01 = (int*)(lds + 65536 + 8192);
    for (int i = tid; i < 128; i += NTHREADS) e01[i] = -1;
    gu32* cnt = (gu32*)(a.ws + WS_CTL) + CW_OPC + l * 128;
#define N2_WAIT(ta_, tb_) do { if (tid < 64) { for (unsigned s = 0; s < (1u << 20); ++s) { const unsigned c = __hip_atomic_load(cnt + ((lane & 1) ? (tb_) : (ta_)), __ATOMIC_RELAXED, __HIP_MEMORY_SCOPE_AGENT); \
              if (__all(c == 32u)) break; __builtin_amdgcn_s_sleep(2); } \
          __builtin_amdgcn_fence(__ATOMIC_ACQUIRE, "agent"); asm volatile("s_waitcnt vmcnt(0)" ::: "memory"); } \
      __syncthreads(); } while (0)
    N2_WAIT(lat0 >> 8, (lat0 + nlat - 1) >> 8);
    const bf16_t* XB = (const bf16_t*)(a.ws + WS_XB); bf16_t* HB = (bf16_t*)(a.ws + WS_HB); const float* MOD = (const float*)(a.ws + WS_MOD);
    int2* TOKE = (int2*)(a.ws + WS_TOKE); float2* TOKW = (float2*)(a.ws + WS_TOKW);
    const int eg = wave & 3, rh = wave >> 2;
    f32x4 wk[4][4];
#pragma unroll
    for (int j = 0; j < 4; ++j)
#pragma unroll
        for (int c = 0; c < 4; ++c) wk[j][c] = *(const f32x4*)(a.in[I_RW] + (size_t)(256 * j + 4 * lane + c) * 16 + 4 * eg);
    f32x4 ga[4], gb[4]; int cur_ctx = -1;
#define N2_PARAMS(isctx_) do { if ((int)(isctx_) != cur_ctx) { cur_ctx = (int)(isctx_); const f32x4* g_ = (const f32x4*)(a.in[I_GFFN] + l * DM) + lane; const float* md_ = MOD + (l * 2 + cur_ctx) * 6144; \
        _Pragma("unroll") for (int j = 0; j < 4; ++j) { ga[j] = g_[64 * j] * (((const f32x4*)(md_ + 4 * 1024) + lane)[64 * j] + 1.f); gb[j] = ((const f32x4*)(md_ + 3 * 1024) + lane)[64 * j]; } } } while (0)
    u32x2 xr[2][4];
#define N2_LOADX(rb_) do { _Pragma("unroll") for (int k = 0; k < 2; ++k) { const bf16_t* xb = XB + (size_t)N2_ROW(min((rb_) + 2 * wave + k, nloc - 1)) * DM + 4 * lane; \
        _Pragma("unroll") for (int j = 0; j < 4; ++j) xr[k][j] = *(const u32x2*)(xb + 256 * j); } } while (0)
    const bool cfirst = (l != 1) && nlat < 16;
    if (cfirst) N2_WAIT(tl, tl);
    N2_LOADX(0);
    for (int rb = 0; rb < nloc; rb += 16) {
        if ((l != 1) && !cfirst && rb <= nlat && nlat < rb + 16) { N2_WAIT(tl, tl); N2_LOADX(rb); }
        f32x4 vv[2][4];
#pragma unroll
        for (int k = 0; k < 2; ++k)
#pragma unroll
            for (int j = 0; j < 4; ++j) { const u32x2 w = xr[k][j]; vv[k][j] = (f32x4){__builtin_bit_cast(float, w.x << 16), __builtin_bit_cast(float, w.x & 0xffff0000u), __builtin_bit_cast(float, w.y << 16), __builtin_bit_cast(float, w.y & 0xffff0000u)}; }
#pragma unroll
        for (int k = 0; k < 2; ++k) { const int row = N2_ROW(min(rb + 2 * wave + k, nloc - 1)); const bool isctx = row >= SEQ, st = rb + 2 * wave + k < nloc;
            float ss = 0.f;
#pragma unroll
            for (int j = 0; j < 4; ++j) ss += (vv[k][j].x * vv[k][j].x + vv[k][j].y * vv[k][j].y) + (vv[k][j].z * vv[k][j].z + vv[k][j].w * vv[k][j].w);
            const float rstd = 1.f / sqrtf(wave_sum(ss) * (1.f / DM) + EPS);
            N2_PARAMS(isctx);
            u32x2* o8 = (u32x2*)(HB + (size_t)row * DM) + lane; f32x4* hr = (f32x4*)(hrow + (2 * wave + k) * 1024) + lane;
#pragma unroll
            for (int j = 0; j < 4; ++j) { const f32x4 h = vv[k][j] * rstd * ga[j] + gb[j];
                hr[64 * j] = h; u32x2 w; w.x = cvt_pk_bf16(h.x, h.y); w.y = cvt_pk_bf16(h.z, h.w); if (st) o8[64 * j] = w; } }
        __syncthreads();
        if (rb + 16 < nloc && !((l != 1) && rb + 16 <= nlat && nlat < rb + 32)) N2_LOADX(rb + 16);
        float v32[32];
#pragma unroll
        for (int q = 0; q < 8; ++q) { const f32x4* hr = (const f32x4*)(hrow + (rh * 8 + q) * 1024) + lane; f32x4 acc = {0.f, 0.f, 0.f, 0.f};
#pragma unroll
            for (int j = 0; j < 4; ++j) { const f32x4 h = hr[64 * j];
#pragma unroll
                for (int e = 0; e < 4; ++e) { acc[e] = __builtin_fmaf(h.x, wk[j][0][e], acc[e]); acc[e] = __builtin_fmaf(h.y, wk[j][1][e], acc[e]); acc[e] = __builtin_fmaf(h.z, wk[j][2][e], acc[e]); acc[e] = __builtin_fmaf(h.w, wk[j][3][e], acc[e]); } }
            v32[q * 4] = acc[0]; v32[q * 4 + 1] = acc[1]; v32[q * 4 + 2] = acc[2]; v32[q * 4 + 3] = acc[3]; }
        float v16[16], v8[8], v4[4], v2[2], v1;
#pragma unroll
        for (int i = 0; i < 16; ++i) { const bool up = (lane & 32) != 0; v16[i] = (up ? v32[16 + i] : v32[i]) + __shfl_xor(up ? v32[i] : v32[16 + i], 32); }
#pragma unroll
        for (int i = 0; i < 8; ++i) { const bool up = (lane & 16) != 0; v8[i] = (up ? v16[8 + i] : v16[i]) + __shfl_xor(up ? v16[i] : v16[8 + i], 16); }
#pragma unroll
        for (int i = 0; i < 4; ++i) { const bool up = (lane & 8) != 0; v4[i] = (up ? v8[4 + i] : v8[i]) + __shfl_xor(up ? v8[i] : v8[4 + i], 8); }
#pragma unroll
        for (int i = 0; i < 2; ++i) { const bool up = (lane & 4) != 0; v2[i] = (up ? v4[2 + i] : v4[i]) + __shfl_xor(up ? v4[i] : v4[2 + i], 4); }
        { const bool up = (lane & 2) != 0; v1 = (up ? v2[1] : v2[0]) + __shfl_xor(up ? v2[0] : v2[1], 2); }
        v1 += __shfl_xor(v1, 1);
        { const int I = (lane >> 1) & 31, q = I >> 2, e = I & 3; const int rl = rh * 8 + q;
          if ((lane & 1) == 0 && rb + rl < nloc) logit[(rb + rl) * 16 + 4 * eg + e] = v1; }
        __syncthreads();
    }
#undef N2_LOADX
#undef N2_WAIT
#undef N2_PARAMS
    if (wave < 2) { const int rowl = wave * 64 + lane, row = N2_ROW(rowl);
      if (rowl < nloc) {
        float lg[16];
#pragma unroll
        for (int q = 0; q < 4; ++q) { const f32x4 t = *(const f32x4*)(logit + rowl * 16 + 4 * q); lg[4 * q] = t.x; lg[4 * q + 1] = t.y; lg[4 * q + 2] = t.z; lg[4 * q + 3] = t.w; }
        float sg[16], bs[16];
#pragma unroll
        for (int e = 0; e < 16; ++e) { sg[e] = sigmoid_f(lg[e]); bs[e] = sg[e] + a.in[I_RB][e]; }
        int gsel = 0; float best = 0.f;
#pragma unroll
        for (int gi = 0; gi < 4; ++gi) { const float p_ = bs[4 * gi], q_ = bs[4 * gi + 1], r_ = bs[4 * gi + 2], s_ = bs[4 * gi + 3];
            const float h1 = fmaxf(p_, q_), l1 = fminf(p_, q_), h2 = fmaxf(r_, s_), l2 = fminf(r_, s_);
            const float gsc = fmaxf(h1, h2) + fmaxf(fminf(h1, h2), fmaxf(l1, l2));
            if (gi == 0 || gsc > best) { best = gsc; gsel = gi; } }
        float gb[4], gs4[4];
#pragma unroll
        for (int i = 0; i < 4; ++i) { gb[i] = gsel == 0 ? bs[i] : gsel == 1 ? bs[4 + i] : gsel == 2 ? bs[8 + i] : bs[12 + i];
            gs4[i] = gsel == 0 ? sg[i] : gsel == 1 ? sg[4 + i] : gsel == 2 ? sg[8 + i] : sg[12 + i]; }
        int i0 = 0; float b0 = gb[0];
#pragma unroll
        for (int i = 1; i < 4; ++i) if (gb[i] > b0) { b0 = gb[i]; i0 = i; }
        int i1 = -1; float b1 = 0.f;
#pragma unroll
        for (int i = 0; i < 4; ++i) if (i != i0 && (i1 < 0 || gb[i] > b1)) { b1 = gb[i]; i1 = i; }
        const float s0 = i0 == 0 ? gs4[0] : i0 == 1 ? gs4[1] : i0 == 2 ? gs4[2] : gs4[3];
        const float s1 = i1 == 0 ? gs4[0] : i1 == 1 ? gs4[1] : i1 == 2 ? gs4[2] : gs4[3];
        const int e0 = gsel * 4 + i0, e1 = gsel * 4 + i1; const float inv = 1.f / (s0 + s1);
        TOKE[row] = make_int2(e0, e1); TOKW[row] = make_float2(s0 * inv, s1 * inv); e01[rowl] = e0 | (e1 << 8);
      } }
    __syncthreads();
    if (wave == 0) {
        int cnt = 0;
        for (int p = 0; p < 2; ++p) { const int pk = e01[p * 64 + lane]; const int e0 = pk < 0 ? -1 : (pk & 255), e1 = pk < 0 ? -1 : (pk >> 8);
#pragma unroll
            for (int e = 0; e < 16; ++e) { const int c = __popcll(__ballot(e0 == e)) + __popcll(__ballot(e1 == e)); if (lane == e) cnt += c; } }
        int base = 0;
        if (lane < 16) base = (int)__hip_atomic_fetch_add((unsigned*)(a.ws + WS_CTL) + CW_TOT + l * 64 + lane, (unsigned)cnt, __ATOMIC_RELAXED, __HIP_MEMORY_SCOPE_AGENT);
        int run[16];
#pragma unroll
        for (int e = 0; e < 16; ++e) run[e] = __builtin_amdgcn_readlane(base, e);
        int2* TOKP = (int2*)(a.ws + WS_TOKP); int* ROWTOK2 = (int*)(a.ws + WS_ROWTOK2) + (size_t)l * 16 * ROWCAP;
        for (int p = 0; p < 2; ++p) { const int i = p * 64 + lane, row = N2_ROW(i); const int pk = e01[i]; const bool ok = pk >= 0;
            const int ex = ok ? (pk & 255) : -1, ey = ok ? (pk >> 8) : -1;
            int pos0 = 0, pos1 = 0; const unsigned long long lt = (1ull << lane) - 1ull;
#pragma unroll
            for (int e = 0; e < 16; ++e) { const unsigned long long m0 = __ballot(ex == e), m1 = __ballot(ey == e);
                if (ex == e) pos0 = run[e] + __popcll(m0 & lt);
                if (ey == e) pos1 = run[e] + __popcll(m0) + __popcll(m1 & lt);
                run[e] += __popcll(m0) + __popcll(m1); }
            if (ok) { TOKP[row] = make_int2(ex * 32768 + pos0, ey * 32768 + pos1); ROWTOK2[ex * ROWCAP + pos0] = row; ROWTOK2[ey * ROWCAP + pos1] = row; } }
    }
    __syncthreads();
#undef N2_ROW
}
#ifndef ATT
#define ATT att2
#endif
#ifndef REP_INPROJ
#define REP_INPROJ 1
#endif
#ifndef REP_ATTN
#define REP_ATTN 1
#endif
#ifndef REP_OUTPROJ
#define REP_OUTPROJ 1
#endif
#ifndef REP_N2SC
#define REP_N2SC 1
#endif
#ifndef REP_MOE
#define REP_MOE 1
#endif
template <class Inner> struct RepOrder { Inner in; int ntot;
    __device__ __forceinline__ bool next(int i, pg8::Unit& u) const { if (i >= ntot) return false; const int nl = in.nloc(); return in.next(i % nl, u); }
    __device__ __forceinline__ unsigned row_off(int r) const { return in.row_off(r); }
    __device__ __forceinline__ void a_ready(const pg8::Unit&) const {}
    __device__ __forceinline__ void done(const pg8::Unit&) const {} };

__device__ __forceinline__ bool wg_any(bool pred, int* ws, int wid, int lane) {
    const int w = __any(pred) ? 1 : 0;
    __syncthreads();
    if (lane == 0) ws[wid] = w;
    __syncthreads();
    int r = 0;
#pragma unroll
    for (int i = 0; i < NWAVES; ++i) r |= ws[i];
    __syncthreads();
    return r != 0;
}
__device__ __forceinline__ void diff_unit(const Args& a, int l, int qt, int head, char* lds) {
    int tid_ = otid();
    const int tid = tid_, wid = tid >> 6, lane = tid & 63;
    const bool isctx = qt >= 64; const int q0 = qt * 256, nA = isctx ? 4 : 260, a0 = isctx ? SEQ : 0;
    const bf16_t* QA = (const bf16_t*)(a.ws + RA_QA); const bf16_t* KA = (const bf16_t*)(a.ws + RA_KA); const bf16_t* VA = (const bf16_t*)(a.ws + RA_VA);
    bf16_t* MIX = (bf16_t*)(a.ws + WS_HB);
    float* stash0 = (float*)(a.ws + WS_RB) + (size_t)blockIdx.x * 256 * 128;
    float* wsf = (float*)(lds + ATT::LDS_WS) + wid * 64;
    const float lam = ((const float*)(a.ws + WS_LAM))[l], post = 1.f - LAMBDA_INIT[l];
    for (int map = 0; map < 2; ++map) {
        f32x16 o[4]; float m_, l_;
        const bf16_t* Qw_ = QA + (size_t)(q0 + wid * 32 + (lane & 31)) * 512 + head * 128 + map * 64;
        ATT::attn_body<0, 512, 512, false>(Qw_, KA + head * 128 + map * 64, VA + head * 128, nA, a0, 0, nA, 0, lds, tid, o, m_, l_);
        if (wg_any(!(l_ < 1.0e18f), (int*)(lds + ATT::LDS_WS) + 8 * 64, wid, lane)) {
            ATT::attn_body<0, 512, 512, true>(Qw_, KA + head * 128 + map * 64, VA + head * 128, nA, a0, 0, nA, 0, lds, tid, o, m_, l_); }
        int lo_ = lane; asm volatile("" : "+v"(lo_));
        const int r32 = lo_ & 31, hi = lo_ >> 5;
        float* stashv = stash0 + (size_t)((wid << 6) | lo_) * 4;
        if (hi == 0) wsf[r32] = l_;
        LDS_WAIT();
        float rli[16];
#pragma unroll
        for (int r = 0; r < 16; ++r) rli[r] = __builtin_amdgcn_rcpf(wsf[ATT::crow(r, hi)]);
        if (map == 0) {
#pragma unroll
            for (int d0 = 0; d0 < 4; ++d0)
#pragma unroll
                for (int rq = 0; rq < 4; ++rq) *(f32x4*)(stashv + (size_t)((d0 * 4 + rq) * NTHREADS) * 4) =
                    (f32x4){o[d0][4 * rq] * rli[4 * rq], o[d0][4 * rq + 1] * rli[4 * rq + 1], o[d0][4 * rq + 2] * rli[4 * rq + 2], o[d0][4 * rq + 3] * rli[4 * rq + 3]};
        } else {
            const float* gn = a.in[I_DNG] + l * 128;
            float g4[4];
#pragma unroll
            for (int d0 = 0; d0 < 4; ++d0) g4[d0] = gn[d0 * 32 + r32] * post;
            float ss[16];
#pragma unroll
            for (int r = 0; r < 16; ++r) { ss[r] = 0.f; const float f_ = lam * rli[r];
#pragma unroll
                for (int d0 = 0; d0 < 4; ++d0) o[d0][r] *= f_; }
#pragma unroll
            for (int d0 = 0; d0 < 4; ++d0) {
                f32x4 sv[4];
#pragma unroll
                for (int rq = 0; rq < 4; ++rq) sv[rq] = *(const f32x4*)(stashv + (size_t)((d0 * 4 + rq) * NTHREADS) * 4);
                asm volatile("" : "+v"(sv[0]), "+v"(sv[1]), "+v"(sv[2]), "+v"(sv[3]));
#pragma unroll
                for (int rq = 0; rq < 4; ++rq)
#pragma unroll
                    for (int j = 0; j < 4; ++j) { const int r = 4 * rq + j; const float oc = sv[rq][j] - o[d0][r]; o[d0][r] = oc; ss[r] += oc * oc; } }
            float s8[8], s4[4], s2[2], s1;
#pragma unroll
            for (int i = 0; i < 8; ++i) { const bool up = (lo_ & 16) != 0; s8[i] = (up ? ss[8 + i] : ss[i]) + __shfl_xor(up ? ss[i] : ss[8 + i], 16); }
#pragma unroll
            for (int i = 0; i < 4; ++i) { const bool up = (lo_ & 8) != 0; s4[i] = (up ? s8[4 + i] : s8[i]) + __shfl_xor(up ? s8[i] : s8[4 + i], 8); }
#pragma unroll
            for (int i = 0; i < 2; ++i) { const bool up = (lo_ & 4) != 0; s2[i] = (up ? s4[2 + i] : s4[i]) + __shfl_xor(up ? s4[i] : s4[2 + i], 4); }
            { const bool up = (lo_ & 2) != 0; s1 = (up ? s2[1] : s2[0]) + __shfl_xor(up ? s2[0] : s2[1], 2); }
            s1 += __shfl_xor(s1, 1);
            LDS_WAIT();
            if ((lo_ & 1) == 0) wsf[hi * 16 + ((lo_ >> 1) & 15)] = s1;
            LDS_WAIT();
#pragma unroll
            for (int r = 0; r < 16; ++r) { const float sc = __builtin_amdgcn_rsqf(wsf[hi * 16 + r] * (1.f / 128.f) + EPS);
                bf16_t* orow = MIX + (size_t)(q0 + wid * 32 + ATT::crow(r, hi)) * DM + head * 128 + r32;
#pragma unroll
                for (int d0 = 0; d0 < 4; ++d0) orow[d0 * 32] = (bf16_t)f2bf(o[d0][r] * sc * g4[d0]); }
        }
    }
}
__device__ __forceinline__ void win_unit(const Args& a, int l, int n, int g, char* lds) {
    int tid_ = otid();
    const int tid = tid_, wid = tid >> 6, lane = tid & 63;
    const bool isctx = n >= 128; const int h = 2 * g + (wid >> 2);
    const int rowq = (isctx ? SEQ + (n - 128) * 128 : n * 128) + (wid & 3) * 32;
    const int nB = isctx ? 0 : (6 - (n == 0 ? 2 : 0) - (n == 127 ? 2 : 0)), b0 = (n == 0) ? 0 : (n - 1) * 128;
    const bf16_t* QB = (const bf16_t*)(a.ws + RA_QB); const bf16_t* KB = (const bf16_t*)(a.ws + RA_KB); const bf16_t* VB = (const bf16_t*)(a.ws + RA_VB);
    bf16_t* MIX = (bf16_t*)(a.ws + WS_HB);
    float* wsf = (float*)(lds + ATT::LDS_WS) + wid * 64;
    f32x16 o[4]; float m_, l_;
    const bf16_t* Qw_ = QB + (size_t)(rowq + (lane & 31)) * 256 + h * 64;
    ATT::attn_body<1, 128, 256, false>(Qw_, KB + g * 64, VB + g * 128, 4, SEQ, b0, 4 + nB, rowq + (lane & 31), lds, tid, o, m_, l_);
    if (wg_any(!(l_ < 1.0e18f), (int*)(lds + ATT::LDS_WS) + 8 * 64, wid, lane)) {
        ATT::attn_body<1, 128, 256, true>(Qw_, KB + g * 64, VB + g * 128, 4, SEQ, b0, 4 + nB, rowq + (lane & 31), lds, tid, o, m_, l_); }
    const float ltot = l_ + __builtin_amdgcn_exp2f(a.in[I_SINK][l * 4 + h] * LOG2E - m_);
    int lo_ = lane; asm volatile("" : "+v"(lo_));
    const int r32 = lo_ & 31, hi = lo_ >> 5;
    if (hi == 0) wsf[r32] = ltot;
    LDS_WAIT();
#pragma unroll
    for (int r = 0; r < 16; ++r) { const float rl = __builtin_amdgcn_rcpf(wsf[ATT::crow(r, hi)]);
        bf16_t* orow = MIX + (size_t)(rowq + ATT::crow(r, hi)) * DM + 512 + h * 64 + r32;
        orow[0] = (bf16_t)f2bf(o[0][r] * rl); orow[32] = (bf16_t)f2bf(o[1][r] * rl); }
}
__device__ __forceinline__ void conv_unit(const Args& a, int l, int u, char* lds) {
    int tid_ = otid();
    const int tid = tid_, wid = tid >> 6, lane = tid & 63;
    const bool isctx = u >= 256; const int r0 = isctx ? (u - 256) * 64 : u * 64, rbase = isctx ? SEQ : 0, slen = isctx ? CTX : SEQ;
    const bf16_t* Z = (const bf16_t*)(a.ws + RA_Z); bf16_t* MIX = (bf16_t*)(a.ws + WS_HB);
    bf16_t* zt = (bf16_t*)lds; float* co = (float*)(lds + 49152);
    __syncthreads();
    for (int c = tid; c < 94 * 32; c += NTHREADS) { const int i = c >> 5, ch = c & 31, p = r0 - 15 + i;
        u32x4 v = {0u, 0u, 0u, 0u}; if (p >= 0 && p < slen) v = *(const u32x4*)(Z + (size_t)(rbase + p) * 256 + ch * 8);
        *(u32x4*)(zt + i * 256 + ch * 8) = v; }
    __syncthreads();
    { const int c = tid & 255, t0 = (tid >> 8) * 32; float w[31];
#pragma unroll
      for (int j = 0; j < 31; ++j) w[j] = a.in[I_CONVW][(size_t)(l * 31 + j) * 256 + c];
      const float bias = a.in[I_CONVB][l * 256 + c];
#pragma unroll
      for (int tb = 0; tb < 32; tb += 8) {
          float zr[38]; unsigned zu[38];
#pragma unroll
          for (int i = 0; i < 38; ++i) zu[i] = zt[(t0 + tb + i) * 256 + c];
          asm volatile("" : "+v"(zu[0]), "+v"(zu[1]), "+v"(zu[2]), "+v"(zu[3]), "+v"(zu[4]), "+v"(zu[5]), "+v"(zu[6]), "+v"(zu[7]), "+v"(zu[8]), "+v"(zu[9]), "+v"(zu[10]), "+v"(zu[11]), "+v"(zu[12]));
          asm volatile("" : "+v"(zu[13]), "+v"(zu[14]), "+v"(zu[15]), "+v"(zu[16]), "+v"(zu[17]), "+v"(zu[18]), "+v"(zu[19]), "+v"(zu[20]), "+v"(zu[21]), "+v"(zu[22]), "+v"(zu[23]), "+v"(zu[24]), "+v"(zu[25]));
          asm volatile("" : "+v"(zu[26]), "+v"(zu[27]), "+v"(zu[28]), "+v"(zu[29]), "+v"(zu[30]), "+v"(zu[31]), "+v"(zu[32]), "+v"(zu[33]), "+v"(zu[34]), "+v"(zu[35]), "+v"(zu[36]), "+v"(zu[37]));
#pragma unroll
          for (int i = 0; i < 38; ++i) zr[i] = __builtin_bit_cast(float, zu[i] << 16);
#pragma unroll
          for (int t = 0; t < 8; ++t) { float acc = bias;
#pragma unroll
              for (int j = 0; j < 31; ++j) acc += zr[t + j] * w[j];
              co[(t0 + tb + t) * 256 + c] = acc; } } }
    __syncthreads();
    const f32x4 lg = *(const f32x4*)(a.in[I_LNG] + l * 256 + 4 * lane), lb = *(const f32x4*)(a.in[I_LNB] + l * 256 + 4 * lane);
    { f32x4 v[8]; float s[8]; float* sc8 = (float*)(lds + 114688) + wid * 16;
#pragma unroll
      for (int ti = 0; ti < 8; ++ti) { v[ti] = *(const f32x4*)(co + (wid + ti * NWAVES) * 256 + 4 * lane); s[ti] = (v[ti].x + v[ti].y) + (v[ti].z + v[ti].w); }
#define CONV_SUM8() do { float t4[4], t2[2], t1; \
        _Pragma("unroll") for (int i = 0; i < 4; ++i) { const bool up = (lane & 32) != 0; t4[i] = (up ? s[4 + i] : s[i]) + __shfl_xor(up ? s[i] : s[4 + i], 32); } \
        _Pragma("unroll") for (int i = 0; i < 2; ++i) { const bool up = (lane & 16) != 0; t2[i] = (up ? t4[2 + i] : t4[i]) + __shfl_xor(up ? t4[i] : t4[2 + i], 16); } \
        { const bool up = (lane & 8) != 0; t1 = (up ? t2[1] : t2[0]) + __shfl_xor(up ? t2[0] : t2[1], 8); } \
        t1 += __shfl_xor(t1, 4); t1 += __shfl_xor(t1, 2); t1 += __shfl_xor(t1, 1); \
        LDS_WAIT(); if ((lane & 7) == 0) sc8[lane >> 3] = t1; LDS_WAIT(); \
        _Pragma("unroll") for (int i = 0; i < 8; ++i) s[i] = sc8[i]; } while (0)
      CONV_SUM8();
#pragma unroll
      for (int ti = 0; ti < 8; ++ti) { v[ti] = v[ti] - s[ti] * (1.f / 256.f); s[ti] = (v[ti].x * v[ti].x + v[ti].y * v[ti].y) + (v[ti].z * v[ti].z + v[ti].w * v[ti].w); }
      CONV_SUM8();
#undef CONV_SUM8
#pragma unroll
      for (int ti = 0; ti < 8; ++ti) { const int t = wid + ti * NWAVES; const float rs = __builtin_amdgcn_rsqf(s[ti] * (1.f / 256.f) + EPS);
        const f32x4 zn = v[ti] * rs * lg + lb;
        u32x2 w; w.x = cvt_pk_bf16(silu_f(zn.x), silu_f(zn.y)); w.y = cvt_pk_bf16(silu_f(zn.z), silu_f(zn.w));
        *(u32x2*)(MIX + (size_t)(rbase + r0 + t) * DM + 768 + 4 * lane) = w; } }
    __syncthreads();
}
__device__ __forceinline__ void attn_phase(const Args& a, int l, char* lds, int pass) {
    const int b = blockIdx.x, G = gridDim.x, BIG = 1 << 20;
#ifndef AT_MASK
#define AT_MASK 7
#endif
    const int dst = pass == 0 ? b : (b < 4) ? 256 + b : BIG, wst = pass == 0 ? b : (b >= 4 && b < 8) ? 256 + (b - 4) : BIG, cst = pass == 0 ? b : (b >= 8 && b < 12) ? 256 + (b - 8) : BIG;
    const int uend = pass == 0 ? 256 : 260;
    if (AT_MASK & 1) for (int u = dst; u < uend; u += G) { const int qt = u < 256 ? (u >> 2) : 64, hd = u < 256 ? (u & 3) : (u - 256); diff_unit(a, l, qt, hd, lds); }
    if (AT_MASK & 2) for (int v = wst; v < uend; v += G) { const int n = v < 256 ? (v & 127) : 128 + ((v - 256) & 1), g = v < 256 ? (v >> 7) : ((v - 256) >> 1); win_unit(a, l, n, g, lds); }
    if (AT_MASK & 4) for (int v = cst; v < uend; v += G) conv_unit(a, l, v, lds);
    if (pass == 1 && b < 12) {
        asm volatile("s_waitcnt vmcnt(0)" ::: "memory"); __syncthreads();
        const int tid = otid(); if (tid < 64) { __builtin_amdgcn_fence(__ATOMIC_RELEASE, "agent"); asm volatile("s_waitcnt vmcnt(0)" ::: "memory");
            if (tid == 0) __hip_atomic_fetch_add((gu32*)(a.ws + WS_CTL) + CW_CTXC, 1u, __ATOMIC_RELAXED, __HIP_MEMORY_SCOPE_AGENT); } }
}

#ifndef MK_PER_PHASE
#define MK_PER_PHASE 0
#endif
#if defined(__HIP_DEVICE_COMPILE__)
#define KARGS(A) Args A; { const __attribute__((address_space(4))) Args* kp_ = (const __attribute__((address_space(4))) Args*)__builtin_amdgcn_kernarg_segment_ptr(); asm volatile("" : "+s"(kp_)); A = *kp_; }
#else
#define KARGS(A) Args A = a_unused;
#endif
__global__ void __launch_bounds__(NTHREADS, 2) hybrid_fwd(Args a_unused) {
    unsigned char* lds = g_lds;
    volatile LAS unsigned* MISC = (volatile LAS unsigned*)((LAS unsigned char*)lds + MISC_OFF);
    { const int tid0 = threadIdx.x; if (tid0 < 64) MISC[tid0] = 0u;
      if ((tid0 & 63) == 0) MISC[64 + ((unsigned)__builtin_amdgcn_s_getreg((5 << 11) | 4) & 63u)] = (unsigned)(tid0 >> 6); }
    __syncthreads();
    XcdBarrier bar; int lo, hi;
    { KARGS(a); lo = a.ph_lo; hi = a.ph_hi; gu32* ctl = (gu32*)(a.ws + WS_CTL);
      bar.bar = (unsigned*)(ctl + CW_BAR); bar.x = 0; bar.st = nullptr;
      if (!MK_PER_PHASE) bar = xcd_barrier_post((unsigned*)(ctl + CW_BAR), MISC); }
#ifndef PHMASK
#define PHMASK 0x3ffff
#endif
#define PHK(k) ((k) == 0 ? 0 : (k) == 17 ? 9 : (((k) - 1) & 7) + 1)
#define IN(k) (((PHMASK >> PHK(k)) & 1) && lo <= (k) && (k) < hi)
#define SEAM(k) do { if (!MK_PER_PHASE && IN(k) && IN((k) + 1)) xcd_barrier(bar); } while (0)
    LAS unsigned char* ldsl = (LAS unsigned char*)lds;
    const int G = gridDim.x, vcu = (G % 8 == 0) ? ((int)blockIdx.x % 8) * (G / 8) + (int)blockIdx.x / 8 : (int)blockIdx.x;

#ifndef REP_N1
#define REP_N1 1
#endif
#ifndef REP_SC
#define REP_SC 1
#endif
#ifndef REP_PRO
#define REP_PRO 1
#endif
    if (IN(0)) { KARGS(a); int nrep_ = REP_PRO; asm volatile("" : "+s"(nrep_)); for (int rp_ = 0; rp_ < nrep_; ++rp_) prologue_phase(a, lds); SEAM(0); }
    for (int l = 0; l < DEPTH; ++l) {
        const int pb = 1 + 8 * l;
        if (IN(pb + 0)) {
            KARGS(a);
            { int nrep_ = (l == 0) ? REP_N1 : 1; asm volatile("" : "+s"(nrep_)); for (int rp_ = 0; rp_ < nrep_; ++rp_) norm1_phase(a, l); }
            SEAM(pb + 0);
        }
        if (IN(pb + 1)) {
            KARGS(a);
            pg8::Gemm g{(const bf16_t*)(a.ws + WS_HB), (const bf16_t*)(a.ws + WS_WIN) + (size_t)l * INW * 1024, NROW, INW, DM};
            pg8::StaticOrder S; S.init(NROW, INW, G, (int)blockIdx.x);
            EpiInProj E{a.ws, (const float*)(a.ws + WS_ROPEC), (const float*)(a.ws + WS_ROPES)};
            RepOrder<pg8::StaticOrder> SR{S, REP_INPROJ * S.nloc()}; pg8::gemm_phase<EpiInProj, RepOrder<pg8::StaticOrder>, true, true>(ldsl, g, SR, E);
            if ((int)blockIdx.x >= 650 - 2 * G) {
                const int tid = otid(), c0 = 650 - 2 * G; moe_convert(a, l, (LAS float*)(ldsl + (tid >> 6) * 8704), ((int)blockIdx.x - c0) * NWAVES + (tid >> 6), (G - c0) * NWAVES, tid & 63, 8192, 12288); }
            SEAM(pb + 1);
        }
        if (IN(pb + 2)) { KARGS(a); int npass_ = (l == 0) ? 2 : 1; asm volatile("" : "+s"(npass_)); for (int ps_ = 0; ps_ < npass_; ++ps_) { attn_phase(a, l, (char*)lds, ps_); if (ps_ == 0) SEAM(pb + 2); } }
        if (IN(pb + 3)) {
            KARGS(a);
            const float* MOD = (const float*)(a.ws + WS_MOD);
            const int M = (l == DEPTH - 1) ? SEQ : NROW;
            pg8::Gemm g{(const bf16_t*)(a.ws + WS_HB), (const bf16_t*)(a.ws + WS_WOUT) + (size_t)l * 1024 * 1024, M, DM, DM};
            pg8::StaticOrder S; if (l == 0) S.init(61 * 256, DM, G - 12, (int)blockIdx.x - 12); else S.init(SEQ, DM, G, (int)blockIdx.x);
            EpiOutProj E{a.in[I_X], a.in[I_CTX], (bf16_t*)(a.ws + WS_XB), MOD + (l * 2) * 6144 + 2 * 1024, MOD + (l * 2 + 1) * 6144 + 2 * 1024, l};
            OutOrder SO{S, (gu32*)(a.ws + WS_CTL) + CW_OPC + l * 128, (l == 0) ? (gu32*)(a.ws + WS_CTL) + CW_CTXC : nullptr}; pg8::gemm_phase<EpiOutProj, OutOrder, true, true>(ldsl, g, SO, E);
            if (l == 0 && (int)blockIdx.x >= 16) {
                const int tid = otid(), nidle = G - 16; moe_convert(a, 1, (LAS float*)(ldsl + (tid >> 6) * 8704), ((int)blockIdx.x - 16) * NWAVES + (tid >> 6), nidle * NWAVES, tid & 63, 0, 8192); }
            __syncthreads();
        }
        if (IN(pb + 4)) { KARGS(a); int nrep_ = REP_N2SC; asm volatile("" : "+s"(nrep_)); for (int rp_ = 0; rp_ < nrep_; ++rp_) norm2_phase(a, l, lds); SEAM(pb + 4); }
        if (IN(pb + 6)) {
            KARGS(a);
            MoeOrder S; S.G = G; S.vcu = vcu;
            { const int tid = otid(); const unsigned* tot = (const unsigned*)(a.ws + WS_CTL) + CW_TOT + l * 64;
              if (tid == 0) { int t = 0; int* tsg = (int*)(a.ws + WS_TSG) + l * 32;
                  for (int e = 0; e < 16; ++e) { MISC[16 + e] = (unsigned)t; if (blockIdx.x == 0) tsg[e] = t; t += ((int)tot[e] + 255) >> 8; }
                  MISC[32] = (unsigned)t; if (blockIdx.x == 0) tsg[16] = t; }
              __syncthreads();
#pragma unroll
              for (int k = 0; k < 16; ++k) S.ts[k] = __builtin_amdgcn_readfirstlane((int)MISC[16 + k]);
              S.nunits = 4 * __builtin_amdgcn_readfirstlane((int)MISC[16 + 16]); }
            S.rowtok = (const int*)(a.ws + WS_ROWTOK2) + (size_t)l * 16 * ROWCAP;
            pg8::Gemm g{(const bf16_t*)(a.ws + WS_HB), (const bf16_t*)(a.ws + WS_W13) + (size_t)l * 16 * 1024 * 1024, XS_ROWS, 1024, DM};
            EpiMoe1 E{(bf16_t*)(a.ws + WS_RB)};
            pg8::gemm_phase<EpiMoe1, MoeOrder, true, true, true>(ldsl, g, S, E);
            gu32* flag = (gu32*)(a.ws + WS_CTL) + CW_MOEF + l * 256;
            { const int tid = otid(); if (tid == 0) __hip_atomic_store(flag + vcu, 1u, __ATOMIC_RELAXED, __HIP_MEMORY_SCOPE_AGENT); }
            MoeOrder2 S2; S2.vcu = vcu; S2.nunits = S.nunits;
#pragma unroll
            for (int k2 = 0; k2 < 16; ++k2) S2.ts[k2] = S.ts[k2];
            pg8::Gemm g2{(const bf16_t*)(a.ws + WS_RB), (const bf16_t*)(a.ws + WS_W2) + (size_t)l * 16 * 1024 * 512, XS_ROWS, 1024, FFE};
            EpiMoe2 E2{a.ws + WS_RA};
            const int r_ = S.nunits & 255;
            if (vcu >= r_ && S.nunits >= 256) { moe_wait(flag, vcu & ~3, 4); S2.part = 0; pg8::gemm_phase<EpiMoe2, MoeOrder2, true, true>(ldsl, g2, S2, E2); }
            if (r_ != 0) { moe_wait(flag, 0, r_); S2.part = 1; pg8::gemm_phase<EpiMoe2, MoeOrder2, true, true>(ldsl, g2, S2, E2); }
            SEAM(pb + 6);
        }
    }
    if (IN(17)) { KARGS(a); int nrep_ = REP_N1; asm volatile("" : "+s"(nrep_)); for (int rp_ = 0; rp_ < nrep_; ++rp_) norm1_phase(a, 2); }
#undef IN
#undef SEAM
}

extern "C" void kernel_launch(void* const* d_in, const int* in_sizes, int n_in, void* d_out, int out_size, void* d_ws, size_t ws_size, hipStream_t stream) {
    static int grid = 0;
    if (grid == 0) {
        if (n_in != 23 || in_sizes[0] != SEQ * DM || out_size != SEQ * DM || ws_size < WS_END) {
            fprintf(stderr, "kernel_launch: shape mismatch (n_in %d, in0 %d, out %d, ws %zu, need ws >= %zu); nothing launched\n", n_in, n_in > 0 ? in_sizes[0] : -1, out_size, ws_size, (size_t)WS_END); grid = -1; return; }
        int dev = 0, cus = 0, per_cu = 0;
        if (hipGetDevice(&dev) != hipSuccess || hipDeviceGetAttribute(&cus, hipDeviceAttributeMultiprocessorCount, dev) != hipSuccess) { fprintf(stderr, "kernel_launch: device query failed\n"); grid = -1; return; }
        if (hipFuncSetAttribute((const void*)hybrid_fwd, hipFuncAttributeMaxDynamicSharedMemorySize, LDS_BYTES) != hipSuccess) { fprintf(stderr, "kernel_launch: hipFuncSetAttribute failed\n"); grid = -1; return; }
        if (hipOccupancyMaxActiveBlocksPerMultiprocessor(&per_cu, (const void*)hybrid_fwd, NTHREADS, LDS_BYTES) != hipSuccess || per_cu < 1) { fprintf(stderr, "kernel_launch: occupancy query reports %d blocks per CU\n", per_cu); grid = -1; (void)hipGetLastError(); return; }
        if (cus != 256) { fprintf(stderr, "kernel_launch: built for 256 CUs, device has %d\n", cus); grid = -1; return; }
        grid = cus;
    }
    if (grid < 0) return;
    if (hipMemsetAsync((char*)d_ws + WS_CTL, 0, CTL_ZERO_BYTES, stream) != hipSuccess) { fprintf(stderr, "kernel_launch: memset failed\n"); return; }
    Args a{};
    for (int i = 0; i < 23; ++i) a.in[i] = (const float*)d_in[i];
    a.out = (float*)d_out; a.ws = (unsigned char*)d_ws;
#if MK_PER_PHASE
    for (int p = 0; p < N_PHASES; ++p) { a.ph_lo = p; a.ph_hi = p + 1; hipLaunchKernelGGL(hybrid_fwd, dim3(grid), dim3(NTHREADS), LDS_BYTES, stream, a); }
#else
    a.ph_lo = 0; a.ph_hi = N_PHASES;
    hipLaunchKernelGGL(hybrid_fwd, dim3(grid), dim3(NTHREADS), LDS_BYTES, stream, a);
#endif
    const hipError_t le = hipPeekAtLastError();
    if (le != hipSuccess) fprintf(stderr, "kernel_launch: launch failed: %s\n", hipGetErrorName(le));
}
```

```cpp
#define MK_PER_PHASE 0
#include <hip/hip_runtime.h>
#include <cstdio>
#include <cstdint>

#define GAS __attribute__((address_space(1)))
#define LAS __attribute__((address_space(3)))
typedef unsigned short bf16_t;
typedef short bf16x8 __attribute__((ext_vector_type(8)));
typedef short s16x4 __attribute__((ext_vector_type(4)));
typedef float f32x2 __attribute__((ext_vector_type(2)));
typedef float f32x4 __attribute__((ext_vector_type(4)));
typedef float f32x16 __attribute__((ext_vector_type(16)));
typedef unsigned u32x2 __attribute__((ext_vector_type(2)));
typedef unsigned u32x4 __attribute__((ext_vector_type(4)));
typedef GAS unsigned gu32;

constexpr int SEQ = 16384, CTX = 256, NROW = SEQ + CTX, DM = 1024, INW = 2560, NEXP = 16, FFE = 512, DEPTH = 2;
constexpr int XS_ROWS = 37376;
constexpr float EPS = 1e-6f, LOG2E = 1.4426950408889634f, QSCALE = 0.125f * 1.4426950408889634f;
constexpr int NWAVES = 8, NTHREADS = 512;

constexpr size_t MiB = 1u << 20;
constexpr size_t WS_CTL = 0, CTL_ZERO_BYTES = 128 * 1024;
constexpr size_t WS_MOD = 1 * MiB;
constexpr size_t WS_ROPEC = WS_MOD + 128 * 1024, WS_ROPES = WS_MOD + 192 * 1024;
constexpr size_t WS_LAM = WS_MOD + 256 * 1024;
constexpr size_t WS_CNT = WS_MOD + 320 * 1024;
constexpr size_t WS_TSG = WS_MOD + 384 * 1024;
constexpr size_t WS_TOKE = 2 * MiB, WS_TOKW = 2 * MiB + 256 * 1024, WS_TOKP = 2 * MiB + 512 * 1024;
constexpr size_t WS_ROWTOK = 3 * MiB;
constexpr size_t WS_WIN = 4 * MiB;
constexpr size_t WS_WOUT = 14 * MiB;
constexpr size_t WS_W13 = 18 * MiB;
constexpr size_t WS_W2 = 82 * MiB;
constexpr size_t WS_XB = 114 * MiB;
constexpr size_t WS_HB = 179 * MiB;
constexpr size_t WS_RA = 212 * MiB;
constexpr size_t RA_QA = WS_RA, RA_KA = RA_QA + (size_t)NROW * 512 * 2, RA_VA = RA_KA + (size_t)NROW * 512 * 2;
constexpr size_t RA_QB = RA_VA + (size_t)NROW * 512 * 2, RA_KB = RA_QB + (size_t)NROW * 256 * 2, RA_VB = RA_KB + (size_t)NROW * 128 * 2;
constexpr size_t RA_Z = RA_VB + (size_t)NROW * 256 * 2, RA_END = RA_Z + (size_t)NROW * 256 * 2;
constexpr size_t WS_RB = 290 * MiB;
constexpr size_t WS_ROWTOK2 = 327 * MiB;
constexpr size_t WS_END = 330 * MiB;
static_assert(RA_END <= WS_RB && WS_RA + (size_t)XS_ROWS * 2048 <= WS_RB && WS_RB + (size_t)XS_ROWS * 1024 <= WS_END && WS_RB + (size_t)256 * 256 * 128 * 4 <= WS_END, "ws map");
static_assert(WS_XB + (size_t)NROW * DM * 4 <= WS_HB && WS_HB + (size_t)NROW * DM * 2 <= WS_RA && WS_W13 + (size_t)2 * 16 * 1024 * 1024 * 2 <= WS_W2 && WS_W2 + (size_t)2 * 16 * 1024 * 512 * 2 <= WS_XB, "ws map 2");
constexpr int ROWCAP = 16640;
constexpr int CW_TOT = 24576;
constexpr int CW_MOEF = 28672;
constexpr int CW_OPC = 30720;
constexpr int CW_CTXC = 31232;
constexpr int CW_BAR = 4096;

constexpr int RING_BYTES = 131072;
constexpr int MISC_OFF = RING_BYTES;
constexpr int LDS_BYTES = 147456;

#define LDS_WAIT() asm volatile("s_waitcnt lgkmcnt(0)" ::: "memory")
#define VM_WAIT() asm volatile("s_waitcnt vmcnt(0)" ::: "memory")
__device__ __forceinline__ unsigned f2bf(float f) { unsigned u = __builtin_bit_cast(unsigned, f); return (u + 0x7fffu + ((u >> 16) & 1u)) >> 16; }
__device__ __forceinline__ unsigned pk2(float lo, float hi) { return f2bf(lo) | (f2bf(hi) << 16); }
__device__ __forceinline__ float bf2f(unsigned short b) { return __builtin_bit_cast(float, (unsigned)b << 16); }
__device__ __forceinline__ unsigned cvt_pk_bf16(float lo, float hi) { unsigned r; asm volatile("v_cvt_pk_bf16_f32 %0, %1, %2" : "=v"(r) : "v"(lo), "v"(hi)); return r; }
__device__ __forceinline__ float wave_sum(float v) {
#pragma unroll
    for (int o = 1; o < 64; o <<= 1) v += __shfl_xor(v, o);
    return v;
}
__device__ __forceinline__ f32x4 ld4bf(const bf16_t* p) { const u32x2 w = *(const u32x2*)p; return (f32x4){__builtin_bit_cast(float, w.x << 16), __builtin_bit_cast(float, w.x & 0xffff0000u), __builtin_bit_cast(float, w.y << 16), __builtin_bit_cast(float, w.y & 0xffff0000u)}; }
__device__ __forceinline__ void st4bf(bf16_t* p, const f32x4 v) { u32x2 w; w.x = cvt_pk_bf16(v.x, v.y); w.y = cvt_pk_bf16(v.z, v.w); *(u32x2*)p = w; }
__device__ __forceinline__ float silu_f(float a) { return a * __builtin_amdgcn_rcpf(1.f + __builtin_amdgcn_exp2f(-a * LOG2E)); }
__device__ __forceinline__ float sigmoid_f(float a) { return __builtin_amdgcn_rcpf(1.f + __builtin_amdgcn_exp2f(-a * LOG2E)); }
extern __shared__ __attribute__((aligned(16))) unsigned char g_lds[];
__device__ __forceinline__ int otid() {
    const unsigned slot = (unsigned)__builtin_amdgcn_s_getreg((5 << 11) | 4) & 63u;
    const int wave = ((const volatile LAS int*)((LAS unsigned char*)g_lds + MISC_OFF + 256))[slot];
    int ln; asm volatile("v_mbcnt_lo_u32_b32 %0, -1, 0\n\tv_mbcnt_hi_u32_b32 %0, -1, %0" : "=v"(ln));
    int t = (wave << 6) | ln;
    asm volatile("" : "+v"(t)); return t; }
namespace pg8 {
#define PG8_LAS __attribute__((address_space(3)))
constexpr int BM = 256, BK = 64, HALF = 128, HTB = HALF * BK * 2  , STAGE_BYTES = 8 * HTB, NXCD = 8, WGM = 8;

__host__ __device__ __forceinline__ int lds_byte(int r, int c) { const int st = (r >> 4) * 2 + (c >> 5), rr = r & 15, cc = c & 31, ob = rr * 64 + cc * 2; return st * 1024 + (ob ^ (((ob >> 9) & 1) << 5)); }
__host__ __device__ __forceinline__ void stage_rc(int b, int& R, int& C) { const int st = b / 1024, sb = b % 1024, swz = sb ^ (((sb >> 9) & 1) << 5); R = (st >> 1) * 16 + swz / 64; C = (st & 1) * 32 + (swz % 64) / 2; }
__host__ __device__ __forceinline__ int perm32(int rho) { const int n = rho >> 4, i = rho & 15; return 8 * (i >> 2) + 4 * n + (i & 3); }

struct Unit { int pm, pn, aux; };
struct Gemm { const bf16_t* A; const bf16_t* Bt; int M, N, K; };

struct StaticOrder {
    int nM, nN, nwg, G, c;
    __host__ __device__ void init(int M, int N, int G_, int c_) { nM = M / BM; nN = N / BM; nwg = nM * nN; G = G_; c = c_; }
    __host__ __device__ bool next(int i, Unit& u) const {
        const long L = (long)i * G + c; if (L >= nwg) return false;
        int wgid = (int)L; { const int q = nwg / NXCD, r = nwg % NXCD, xcd = wgid % NXCD, off = wgid / NXCD; wgid = (xcd < r ? xcd * (q + 1) : r * (q + 1) + (xcd - r) * q) + off; }
        const int nig = WGM * nN, gid = wgid / nig, fm = gid * WGM, gsz = (nM - fm) < WGM ? (nM - fm) : WGM;
        u.pm = fm + ((wgid % nig) % gsz); u.pn = (wgid % nig) / gsz; return true;
    }
    __host__ __device__ __forceinline__ int nloc() const { return c < nwg ? (nwg - c + G - 1) / G : 0; }
    __device__ __forceinline__ void a_ready(const Unit&) const {}
    __device__ __forceinline__ void done(const Unit&) const {}
};
template <class Epi, class Sched, bool ALIGN_EPI = false, bool SP2 = false, bool GATHER = false>
__device__ __forceinline__ void gemm_phase(PG8_LAS unsigned char* lds, const Gemm g, const Sched& S, const Epi& E) {
    const int tid = otid(), wid = __builtin_amdgcn_readfirstlane(tid >> 6), lane = tid & 63, wr = wid >> 2, wc = wid & 3, fr = lane & 15, fq = lane >> 4;
    const int K = g.K, nt = K / BK;
    unsigned voffA[2], voffB[2]; int rowA[2]; unsigned colA[2];
#pragma unroll
    for (int i = 0; i < 2; ++i) { int R, C; stage_rc(tid * 16 + i * 8192, R, C); const int Rb = Epi::PERM ? ((R & ~31) + perm32(R & 31)) : R;
        voffA[i] = (unsigned)(R * K + C) * 2u; voffB[i] = (unsigned)(Rb * K + C) * 2u; rowA[i] = R; colA[i] = (unsigned)C * 2u; }
    unsigned gc[2][2], gn[2][2];
#define PG8_GOFFS(dst, u) do { _Pragma("unroll") for (int h_ = 0; h_ < 2; ++h_) _Pragma("unroll") for (int i_ = 0; i_ < 2; ++i_) dst[h_][i_] = S.row_off((u), h_ * HALF + rowA[i_]) + colA[i_]; } while (0)
    const size_t kstep = (size_t)(BK * 2);
    const size_t hstep = (size_t)HALF * K * 2;
    const size_t tstep = 2 * hstep;
    const unsigned ldsw = (unsigned)wid * 1024u;
    const int aoff = lds_byte(wr * 64 + fr, fq * 8), boff = lds_byte(wc * 32 + fr, fq * 8);
#define PG8_SA(b, h) (((b) * 2 + (h)) * HTB)
#define PG8_SB(b, h) ((4 + (b) * 2 + (h)) * HTB)
#define PG8_STAGE(bufoff, gbase, voff) do { _Pragma("unroll") for (int _i = 0; _i < 2; ++_i) \
        __builtin_amdgcn_global_load_lds((const unsigned*)((const char*)(gbase) + (voff)[_i]), (PG8_LAS unsigned*)(lds + (bufoff) + ldsw + _i * 8192), 16, 0, 0); } while (0)
#define PG8_STAGE_A(bufoff, gbase, h, NX) do { _Pragma("unroll") for (int _i = 0; _i < 2; ++_i) { \
        const char* p_; if constexpr (GATHER) p_ = (const char*)(gbase) + ((NX) ? gn[h][_i] : gc[h][_i]); else p_ = (const char*)(gbase) + (h) * hstep + voffA[_i]; \
        __builtin_amdgcn_global_load_lds((const unsigned*)p_, (PG8_LAS unsigned*)(lds + (bufoff) + ldsw + _i * 8192), 16, 0, 0); } } while (0)
#define PG8_LDA(dst, b, h) do { _Pragma("unroll") for (int m = 0; m < 4; ++m) _Pragma("unroll") for (int k = 0; k < 2; ++k) dst[m][k] = *(const PG8_LAS bf16x8*)(lds + PG8_SA(b, h) + aoff + m * 2048 + k * 1024); } while (0)
#define PG8_LDB(dst, b, h) do { _Pragma("unroll") for (int n = 0; n < 2; ++n) _Pragma("unroll") for (int k = 0; k < 2; ++k) dst[n][k] = *(const PG8_LAS bf16x8*)(lds + PG8_SB(b, h) + boff + n * 2048 + k * 1024); } while (0)
#define PG8_MMA(ai, bj, At, Bt) do { __builtin_amdgcn_s_setprio(1); _Pragma("unroll") for (int m = 0; m < 4; ++m) _Pragma("unroll") for (int n = 0; n < 2; ++n) _Pragma("unroll") for (int k = 0; k < 2; ++k) \
        acc[ai][bj][m][n] = __builtin_amdgcn_mfma_f32_16x16x32_bf16(Bt[n][k], At[m][k], acc[ai][bj][m][n], 0, 0, 0); __builtin_amdgcn_s_setprio(0); } while (0)
#define PG8_WAIT_V(n) asm volatile("s_waitcnt vmcnt(" #n ")" ::: "memory")
#define PG8_WAIT_L(n) asm volatile("s_waitcnt lgkmcnt(" #n ")" ::: "memory")
#define PG8_BAR __builtin_amdgcn_s_barrier()
#define PG8_SCHED __builtin_amdgcn_sched_barrier(0)
    Unit cur, nxt; int ui = 0;
    if (!S.next(0, cur)) return;
    f32x4 acc[2][2][4][2];
#pragma unroll
    for (int a = 0; a < 2; ++a)
#pragma unroll
        for (int b = 0; b < 2; ++b)
#pragma unroll
            for (int m = 0; m < 4; ++m)
#pragma unroll
                for (int n = 0; n < 2; ++n) acc[a][b][m][n] = (f32x4){0.f, 0.f, 0.f, 0.f};
    bf16x8 At[4][2], B0[2][2], B1[2][2];
    const char* cA = GATHER ? (const char*)g.A : (const char*)g.A + (size_t)cur.pm * tstep; const char* cB = (const char*)g.Bt + (size_t)cur.pn * tstep;
    if constexpr (GATHER) { PG8_GOFFS(gc, cur); }
    S.a_ready(cur);
    if constexpr (SP2) {
        PG8_STAGE(PG8_SB(0, 0), cB, voffB); PG8_STAGE(PG8_SB(0, 1), cB + hstep, voffB); PG8_STAGE_A(PG8_SA(0, 0), cA, 0, false); PG8_STAGE_A(PG8_SA(0, 1), cA, 1, false);
        if (wr == 1) PG8_BAR;
        PG8_WAIT_V(2); PG8_BAR;
        PG8_STAGE(PG8_SB(1, 0), cB + kstep, voffB); PG8_STAGE_A(PG8_SA(1, 0), cA + kstep, 0, false); PG8_STAGE(PG8_SB(1, 1), cB + hstep + kstep, voffB);
        PG8_WAIT_V(6); PG8_BAR;
    } else {
        PG8_STAGE(PG8_SB(0, 0), cB, voffB); PG8_STAGE_A(PG8_SA(0, 0), cA, 0, false); PG8_STAGE(PG8_SB(0, 1), cB + hstep, voffB); PG8_STAGE_A(PG8_SA(0, 1), cA, 1, false);
        if (wr == 1) PG8_BAR;
        PG8_WAIT_V(4); PG8_BAR;
        PG8_STAGE(PG8_SB(1, 0), cB + kstep, voffB); PG8_STAGE_A(PG8_SA(1, 0), cA + kstep, 0, false); PG8_STAGE(PG8_SB(1, 1), cB + hstep + kstep, voffB);
        PG8_WAIT_V(6); PG8_BAR;
    }
    for (;;) {
        const bool has_next = S.next(ui + 1, nxt);
        if constexpr (GATHER) { if (has_next) { PG8_GOFFS(gn, nxt); } else {
#pragma unroll
            for (int h_ = 0; h_ < 2; ++h_) { gn[h_][0] = gc[h_][0]; gn[h_][1] = gc[h_][1]; } } }
        const char* nA = GATHER ? (const char*)g.A : has_next ? (const char*)g.A + (size_t)nxt.pm * tstep : cA; const char* nB = has_next ? (const char*)g.Bt + (size_t)nxt.pn * tstep : cB;
        for (int t = 0; t < nt; t += 2) {
            const bool last = (t == nt - 2);
            const char* a1 = cA + (size_t)(t + 1) * kstep;
            const char* a2 = last ? nA : cA + (size_t)(t + 2) * kstep; const char* b2 = last ? nB : cB + (size_t)(t + 2) * kstep;
            const char* a3 = a2 + kstep; const char* b3 = b2 + kstep;
            if (last && has_next) S.a_ready(nxt);
            if constexpr (SP2) {
            PG8_LDB(B0, 0, 0); PG8_LDB(B1, 0, 1); PG8_SCHED; PG8_LDA(At, 0, 0); PG8_STAGE_A(PG8_SA(1, 1), a1, 1, false);
            PG8_WAIT_V(8); PG8_WAIT_L(0); PG8_BAR; PG8_MMA(0, 0, At, B0); PG8_MMA(0, 1, At, B1); PG8_BAR; PG8_SCHED;
            PG8_LDA(At, 0, 1); PG8_STAGE(PG8_SB(0, 0), b2, voffB); PG8_STAGE(PG8_SB(0, 1), b2 + hstep, voffB); PG8_STAGE_A(PG8_SA(0, 0), a2, 0, last);
            PG8_WAIT_V(8); PG8_WAIT_L(0); PG8_BAR; PG8_MMA(1, 0, At, B0); PG8_MMA(1, 1, At, B1); PG8_BAR; PG8_SCHED;
            PG8_LDB(B0, 1, 0); PG8_LDB(B1, 1, 1); PG8_SCHED; PG8_LDA(At, 1, 0); PG8_STAGE_A(PG8_SA(0, 1), a2, 1, last);
            PG8_WAIT_V(8); PG8_WAIT_L(0); PG8_BAR; PG8_MMA(0, 0, At, B0); PG8_MMA(0, 1, At, B1); PG8_BAR; PG8_SCHED;
            PG8_LDA(At, 1, 1); PG8_STAGE(PG8_SB(1, 0), b3, voffB); PG8_STAGE(PG8_SB(1, 1), b3 + hstep, voffB); PG8_STAGE_A(PG8_SA(1, 0), a3, 0, last);
            PG8_WAIT_V(8); PG8_WAIT_L(0); PG8_BAR; PG8_MMA(1, 0, At, B0); PG8_MMA(1, 1, At, B1); PG8_BAR; PG8_SCHED;
            } else {
            PG8_LDB(B0, 0, 0); PG8_SCHED; PG8_LDA(At, 0, 0); PG8_STAGE_A(PG8_SA(1, 1), a1, 1, false);
            PG8_WAIT_L(8); PG8_BAR; PG8_WAIT_L(0); PG8_MMA(0, 0, At, B0); PG8_BAR; PG8_SCHED;
            PG8_LDB(B1, 0, 1); PG8_STAGE(PG8_SB(0, 0), b2, voffB);
            PG8_BAR; PG8_WAIT_L(0); PG8_MMA(0, 1, At, B1); PG8_BAR;
            PG8_LDA(At, 0, 1); PG8_STAGE_A(PG8_SA(0, 0), a2, 0, last);
            PG8_BAR; PG8_WAIT_L(0); PG8_MMA(1, 0, At, B0); PG8_BAR; PG8_SCHED;
            PG8_STAGE(PG8_SB(0, 1), b2 + hstep, voffB);
            PG8_WAIT_V(6); PG8_BAR; PG8_MMA(1, 1, At, B1); PG8_BAR;
            PG8_LDB(B0, 1, 0); PG8_SCHED; PG8_LDA(At, 1, 0); PG8_STAGE_A(PG8_SA(0, 1), a2, 1, last);
            PG8_WAIT_L(8); PG8_BAR; PG8_WAIT_L(0); PG8_MMA(0, 0, At, B0); PG8_BAR; PG8_SCHED;
            PG8_LDB(B1, 1, 1); PG8_STAGE(PG8_SB(1, 0), b3, voffB);
            PG8_BAR; PG8_WAIT_L(0); PG8_MMA(0, 1, At, B1); PG8_BAR;
            PG8_LDA(At, 1, 1); PG8_STAGE_A(PG8_SA(1, 0), a3, 0, last);
            PG8_BAR; PG8_WAIT_L(0); PG8_MMA(1, 0, At, B0); PG8_BAR; PG8_SCHED;
            PG8_STAGE(PG8_SB(1, 1), b3 + hstep, voffB);
            PG8_WAIT_V(6); PG8_BAR; PG8_MMA(1, 1, At, B1); PG8_BAR;
            }
        }
        if constexpr (ALIGN_EPI) { if (wr == 0) PG8_BAR; }
        if constexpr (!Epi::AFTER_DRAIN) { E(acc, cur, wr, wc, fr, fq); S.done(cur); }
        if (!has_next) break;
#pragma unroll
        for (int a = 0; a < 2; ++a)
#pragma unroll
            for (int b = 0; b < 2; ++b)
#pragma unroll
                for (int m = 0; m < 4; ++m)
#pragma unroll
                    for (int n = 0; n < 2; ++n) acc[a][b][m][n] = (f32x4){0.f, 0.f, 0.f, 0.f};
        cur = nxt; cA = nA; cB = nB; ++ui;
        if constexpr (GATHER) {
#pragma unroll
            for (int h_ = 0; h_ < 2; ++h_) { gc[h_][0] = gn[h_][0]; gc[h_][1] = gn[h_][1]; } }
        if constexpr (ALIGN_EPI) { if (wr == 1) PG8_BAR; }
    }
    PG8_WAIT_V(0);
    if constexpr (!ALIGN_EPI) { if (wr == 0) PG8_BAR; }
    PG8_BAR;
    if constexpr (Epi::AFTER_DRAIN) { E.fused(acc, cur, wr, wc, fr, fq, lds, wid, lane); S.done(cur); }
#undef PG8_SA
#undef PG8_SB
#undef PG8_STAGE
#undef PG8_STAGE_A
#undef PG8_GOFFS
#undef PG8_LDA
#undef PG8_LDB
#undef PG8_MMA
#undef PG8_WAIT_V
#undef PG8_WAIT_L
#undef PG8_BAR
#undef PG8_SCHED
}
}

namespace att2 {
constexpr int KSLOT = 8192, VSLOT = 16384, LDS_K = 0, LDS_V = 3 * KSLOT, LDS_WS = LDS_V + 3 * VSLOT, LDS_BYTES = LDS_WS + NWAVES * 256;
constexpr float THR = 8.f;
typedef LAS const char* lds_cptr;
typedef short v4i16_t __attribute__((ext_vector_type(4)));
typedef __bf16 bf2_t __attribute__((ext_vector_type(2)));
#define SBAR() __builtin_amdgcn_sched_barrier(0)
#define PIN(x) asm volatile("" : "+v"(x))
__device__ __forceinline__ int crow(int r, int hi) { return (r & 3) + 8 * (r >> 2) + 4 * hi; }
__device__ __forceinline__ f32x16 zero16() { float z = 0.f; asm volatile("" : "+v"(z)); f32x16 v;
#pragma unroll
    for (int r = 0; r < 16; ++r) v[r] = z;
    return v; }
__device__ __forceinline__ void glds16(const void* gsrc, unsigned lds_dst) { unsigned keep;
    asm volatile("s_mov_b32 %0, m0\n\ts_mov_b32 m0, %2\n\ts_nop 0\n\tglobal_load_lds_dwordx4 %1, off\n\ts_mov_b32 m0, %0" : "=&s"(keep) : "v"(gsrc), "s"(lds_dst) : "memory"); }
__device__ __forceinline__ bf16x8 kfrag(lds_cptr p) { return *(const LAS bf16x8*)p; }
__device__ __forceinline__ s16x4 vtr(lds_cptr p) { return __builtin_bit_cast(s16x4, __builtin_amdgcn_ds_read_tr16_b64_v4i16((LAS v4i16_t*)p)); }
__device__ __forceinline__ unsigned cvtpk_s(float lo, float hi) { typedef float f2 __attribute__((ext_vector_type(2))); typedef __bf16 b2 __attribute__((ext_vector_type(2)));
    f2 v = {lo, hi}; b2 b = __builtin_convertvector(v, b2); return __builtin_bit_cast(unsigned, b); }
#define MX3(a, b, c) __builtin_fmaxf(__builtin_fmaxf((a), (b)), (c))
__device__ __forceinline__ float rowmax(const f32x16& p0, const f32x16& p1) {
    float a = MX3(p0[0], p0[1], p1[0]), b = MX3(p0[2], p0[3], p1[1]); a = MX3(a, p1[2], p1[3]);
#pragma unroll
    for (int r = 4; r < 16; r += 4) { a = MX3(a, p0[r], p0[r + 1]); b = MX3(b, p0[r + 2], p0[r + 3]); a = MX3(a, p1[r], p1[r + 1]); b = MX3(b, p1[r + 2], p1[r + 3]); }
    float m = __builtin_fmaxf(a, b); auto rr = __builtin_amdgcn_permlane32_swap(__float_as_uint(m), __float_as_uint(m), false, false);
    return __builtin_fmaxf(__uint_as_float(rr[0]), __uint_as_float(rr[1])); }
__device__ __forceinline__ void wmask(f32x16& p0, f32x16& p1, int dk, int hi) {
#pragma unroll
    for (int r = 0; r < 16; ++r) { const int d = dk + crow(r, hi);
        if (d > 128 || d < -128) p0[r] = -1e30f;
        if (d + 32 > 128 || d + 32 < -128) p1[r] = -1e30f; } }
#define MFMA32(a, b, c) __builtin_amdgcn_mfma_f32_32x32x16_bf16(a, b, c, 0, 0, 0)
#define WAIT_BAR(N) asm volatile("s_waitcnt vmcnt(" #N ") lgkmcnt(0)\n\ts_barrier" ::: "memory")

template <int MODE, int LDK, int LDV, bool SAFE>
__device__ __forceinline__ void attn_body(const bf16_t* Qw, const bf16_t* Kh, const bf16_t* Vh, const int nA, const int a0, const int b0, const int NT, const int qpos,
                                          char* lds, const int tid, f32x16 (&o)[4], float& m_out, float& l_out) {
    constexpr int ND = (MODE == 1) ? 2 : 4, NVP = ND / 2;
    const int lane = tid & 63, r32 = lane & 31, hi = lane >> 5; const int wid = __builtin_amdgcn_readfirstlane(tid >> 6);
    const unsigned lds0 = (unsigned)(uintptr_t)lds; float* wsf = (float*)(lds + LDS_WS) + wid * 64;
#define KROW(t) ((t) < nA ? a0 + 64 * (t) : b0 + 64 * ((t) - nA))
    const bf16_t* ksrc = Kh + (size_t)lane * LDK + wid * 8;
    const bf16_t* vsrc = Vh + (size_t)(16 * (wid & 3) + (lane >> 2)) * LDV + (wid >> 2) * 32 + (lane & 3) * 8;
    const unsigned kdst = lds0 + LDS_K + wid * 1024, vdst = lds0 + LDS_V + (wid >> 2) * 4096 + (wid & 3) * 1024;
#define DMA_K(t, slot) glds16(ksrc + (size_t)KROW(t) * LDK, (unsigned)__builtin_amdgcn_readfirstlane(kdst + (slot) * KSLOT))
#define DMA_V(t, slot) do { const bf16_t* vs_ = vsrc + (size_t)KROW(t) * LDV; glds16(vs_, (unsigned)__builtin_amdgcn_readfirstlane(vdst + (slot) * VSLOT)); \
        if constexpr (NVP == 2) glds16(vs_ + 64, (unsigned)__builtin_amdgcn_readfirstlane(vdst + (slot) * VSLOT + 8192)); } while (0)
    const lds_cptr shm3 = (lds_cptr)(LAS char*)lds;
    const lds_cptr kp0 = shm3 + LDS_K + hi * 1024 + r32 * 16;
    const lds_cptr vp0 = shm3 + LDS_V + ((lane >> 4) & 1) * 32 + (lane & 3) * 8 + (4 * hi + ((lane & 15) >> 2)) * 64;
    bf16x8 qr[4];
#pragma unroll
    for (int d0 = 0; d0 < 4; ++d0) qr[d0] = *reinterpret_cast<const bf16x8*>(Qw + d0 * 16 + hi * 8);
    __syncthreads();
    if (wid >= 4) __builtin_amdgcn_s_setprio(1);
    DMA_K(0, 0); DMA_K(1, 1); DMA_V(0, 0);
    float mhat = 0.f, l_reg = 0.f;
#pragma unroll
    for (int d = 0; d < 4; ++d) o[d] = zero16();
    f32x16 negm = zero16(); PIN(negm);
    bool resc = false;
    if constexpr (NVP == 2) { WAIT_BAR(3); } else { WAIT_BAR(2); }
    f32x16 pA0, pA1, pB0, pB1;
    DMA_K(2, 2); DMA_V(1, 1);
    { bf16x8 kf[8];
#pragma unroll
      for (int i = 0; i < 8; ++i) kf[i] = kfrag(kp0 + (i >> 1) * 2048 + (i & 1) * 512);
      pA0 = MFMA32(kf[0], qr[0], negm); pA1 = MFMA32(kf[1], qr[0], negm); pA0 = MFMA32(kf[2], qr[1], pA0); pA1 = MFMA32(kf[3], qr[1], pA1);
      pA0 = MFMA32(kf[4], qr[2], pA0); pA1 = MFMA32(kf[5], qr[2], pA1); pA0 = MFMA32(kf[6], qr[3], pA0); pA1 = MFMA32(kf[7], qr[3], pA1); }
    if constexpr (MODE == 1) { if (0 >= nA) wmask(pA0, pA1, KROW(0) - qpos, hi); }
    { const float rm = rowmax(pA0, pA1); mhat = rm;
#pragma unroll
      for (int r = 0; r < 16; ++r) { pA0[r] = __builtin_amdgcn_exp2f(pA0[r] - rm); pA1[r] = __builtin_amdgcn_exp2f(pA1[r] - rm); }
#pragma unroll
      for (int r = 0; r < 16; ++r) negm[r] = -mhat;
      PIN(negm);
      if constexpr (!SAFE) { float s0 = 0.f, s1 = 0.f;
#pragma unroll
        for (int r = 0; r < 16; ++r) { s0 += pA0[r]; s1 += pA1[r]; }
        l_reg = s0 + s1; } }
    if constexpr (NVP == 2) { WAIT_BAR(3); } else { WAIT_BAR(2); }
    int sl_prev = 0, sl_cur = 1, sl_next = 2;
#define ROT() do { const int s_ = sl_prev; sl_prev = sl_cur; sl_cur = sl_next; sl_next = s_; } while (0)
#define RESC() do { if (resc) { asm volatile("s_waitcnt lgkmcnt(0)" ::: "memory"); \
        _Pragma("unroll") for (int d_ = 0; d_ < ND; ++d_) _Pragma("unroll") for (int r = 0; r < 16; ++r) o[d_][r] *= wsf[crow(r, hi)]; } } while (0)
    u32x4 pw0, pw1, pw2, pw3; s16x4 vl[16], vh[16]; bf16x8 kf[8]; float dummy_ = 0.f;
#define PAF(k) __builtin_bit_cast(bf16x8, pw##k)
#define VFR(i) (bf16x8){vl[i][0], vl[i][1], vl[i][2], vl[i][3], vh[i][0], vh[i][1], vh[i][2], vh[i][3]}
#define VRD(q, ks) do { if constexpr ((q) < ND) { vl[(q) * 4 + (ks)] = vtr(vp_ + ((q) * 4096 + (ks) * 1024)); vh[(q) * 4 + (ks)] = vtr(vp_ + ((q) * 4096 + (ks) * 1024 + 512)); } } while (0)
#define KRD(i) do { kf[i] = kfrag(kp_ + ((i) >> 1) * 2048 + ((i) & 1) * 512); } while (0)
#define PKW(P, i) cvtpk_s(P[i], P[i + 1])
#ifndef PROBE_VALU
#define PROBE_VALU 0
#endif
#ifndef ROWSUM_DOT2
#define ROWSUM_DOT2 0
#endif
#define DOT2(w, acc) __builtin_amdgcn_fdot2_f32_bf16(__builtin_bit_cast(bf2_t, (unsigned)(w)), __builtin_bit_cast(bf2_t, 0x3f803f80u), acc, false)
#define GAPA(MF, a0_, a1_, a2_, a3_, W0, W1, PW, i0_) do { MF; if (SAFE && !ROWSUM_DOT2) { sacc += a0_; sacb += a1_; sacc += a2_; sacb += a3_; PIN(sacc); PIN(sacb); } W0; W1; PIN(PW); \
        if (ROWSUM_DOT2) { sacc = DOT2(PW[i0_], sacc); sacb = DOT2(PW[(i0_) + 1], sacb); PIN(sacc); PIN(sacb); } SBAR(); } while (0)
#define EX(v) __builtin_amdgcn_exp2f(v)
#define GAPB(q, ks, X, i) do { if constexpr ((q) < ND) { o[q] = MFMA32(PAF(ks), VFR((q) * 4 + (ks)), o[q]); } X[i] = EX(X[i]); X[(i) + 1] = EX(X[(i) + 1]); X[(i) + 2] = EX(X[(i) + 2]); X[(i) + 3] = EX(X[(i) + 3]); PIN(X); SBAR(); } while (0)
#define GAPG(q, ks, ...) do { if constexpr ((q) < ND) { o[q] = MFMA32(PAF(ks), VFR((q) * 4 + (ks)), o[q]); } __VA_ARGS__; SBAR(); } while (0)
#define STEP(C0, C1, P0, P1, t, GK, GV) do { SBAR(); \
    const lds_cptr vp_ = vp0 + sl_prev * VSLOT; const lds_cptr kp_ = kp0 + sl_cur * KSLOT; \
    KRD(0); KRD(1); KRD(2); SBAR(); float sacc = (ROWSUM_DOT2 || !SAFE) ? 0.f : P0[0], sacb = (ROWSUM_DOT2 || !SAFE) ? 0.f : P0[1]; \
    KRD(3); SBAR();            GAPA(C0 = MFMA32(kf[0], qr[0], negm), P0[2], P0[3], P0[4], P0[5],     pw0[0] = PKW(P0, 0),  pw0[1] = PKW(P0, 2),  pw0, 0); \
    KRD(4); SBAR();            GAPA(C1 = MFMA32(kf[1], qr[0], negm), P0[6], P0[7], P0[8], P0[9],     pw0[2] = PKW(P0, 4),  pw0[3] = PKW(P0, 6),  pw0, 2); \
    KRD(5); SBAR();            GAPA(C0 = MFMA32(kf[2], qr[1], C0),   P0[10], P0[11], P0[12], P0[13], pw1[0] = PKW(P0, 8),  pw1[1] = PKW(P0, 10), pw1, 0); \
    KRD(6); SBAR();            GAPA(C1 = MFMA32(kf[3], qr[1], C1),   P0[14], P0[15], P1[0], P1[1],   pw1[2] = PKW(P0, 12), pw1[3] = PKW(P0, 14), pw1, 2); \
    KRD(7); VRD(0, 0); SBAR(); GAPA(C0 = MFMA32(kf[4], qr[2], C0),   P1[2], P1[3], P1[4], P1[5],     pw2[0] = PKW(P1, 0),  pw2[1] = PKW(P1, 2),  pw2, 0); \
            VRD(1, 0); SBAR(); GAPA(C1 = MFMA32(kf[5], qr[2], C1),   P1[6], P1[7], P1[8], P1[9],     pw2[2] = PKW(P1, 4),  pw2[3] = PKW(P1, 6),  pw2, 2); \
            VRD(2, 0); SBAR(); GAPA(C0 = MFMA32(kf[6], qr[3], C0),   P1[10], P1[11], P1[12], P1[13], pw3[0] = PKW(P1, 8),  pw3[1] = PKW(P1, 10), pw3, 0); \
            VRD(3, 0); SBAR(); GAPA(C1 = MFMA32(kf[7], qr[3], C1),   P1[14], P1[15], 0.f, 0.f,       pw3[2] = PKW(P1, 12), pw3[3] = PKW(P1, 14), pw3, 2); \
    if constexpr (SAFE) l_reg += sacc + sacb; \
    if constexpr (MODE == 1) { if ((t) >= nA) wmask(C0, C1, KROW(t) - qpos, hi); } \
    SBAR(); \
      \
      \
    if constexpr (!SAFE) { \
      \
    VRD(0, 1); SBAR(); GAPG(0, 0, C0[0] = EX(C0[0]); C0[1] = EX(C0[1]); PIN(C0)); \
    VRD(1, 1); SBAR(); GAPG(1, 0, C0[2] = EX(C0[2]); C0[3] = EX(C0[3]); sacc += C0[0]; sacb += C0[1]; PIN(C0); PIN(sacc); PIN(sacb)); \
    VRD(2, 1); SBAR(); GAPG(2, 0, C0[4] = EX(C0[4]); C0[5] = EX(C0[5]); sacc += C0[2]; sacb += C0[3]; PIN(C0); PIN(sacc); PIN(sacb)); \
    VRD(3, 1); SBAR(); GAPG(3, 0, C0[6] = EX(C0[6]); C0[7] = EX(C0[7]); sacc += C0[4]; sacb += C0[5]; PIN(C0); PIN(sacc); PIN(sacb)); \
    VRD(0, 2); SBAR(); GAPG(0, 1, C0[8] = EX(C0[8]); C0[9] = EX(C0[9]); sacc += C0[6]; sacb += C0[7]; PIN(C0); PIN(sacc); PIN(sacb)); \
    VRD(1, 2); SBAR(); GAPG(1, 1, C0[10] = EX(C0[10]); C0[11] = EX(C0[11]); sacc += C0[8]; sacb += C0[9]; PIN(C0); PIN(sacc); PIN(sacb)); \
    VRD(2, 2); SBAR(); GAPG(2, 1, C0[12] = EX(C0[12]); C0[13] = EX(C0[13]); sacc += C0[10]; sacb += C0[11]; PIN(C0); PIN(sacc); PIN(sacb)); \
    VRD(3, 2); SBAR(); GAPG(3, 1, C0[14] = EX(C0[14]); C0[15] = EX(C0[15]); sacc += C0[12]; sacb += C0[13]; PIN(C0); PIN(sacc); PIN(sacb)); \
    VRD(0, 3); SBAR(); GAPG(0, 2, C1[0] = EX(C1[0]); C1[1] = EX(C1[1]); sacc += C0[14]; sacb += C0[15]; PIN(C1); PIN(sacc); PIN(sacb)); \
    VRD(1, 3); SBAR(); GAPG(1, 2, C1[2] = EX(C1[2]); C1[3] = EX(C1[3]); sacc += C1[0]; sacb += C1[1]; PIN(C1); PIN(sacc); PIN(sacb)); \
    VRD(2, 3); SBAR(); GAPG(2, 2, C1[4] = EX(C1[4]); C1[5] = EX(C1[5]); sacc += C1[2]; sacb += C1[3]; PIN(C1); PIN(sacc); PIN(sacb)); \
    VRD(3, 3); SBAR(); GAPG(3, 2, C1[6] = EX(C1[6]); C1[7] = EX(C1[7]); sacc += C1[4]; sacb += C1[5]; PIN(C1); PIN(sacc); PIN(sacb)); \
    if (GK) { DMA_K((t) + 2, sl_prev); } SBAR(); GAPG(0, 3, C1[8] = EX(C1[8]); C1[9] = EX(C1[9]); sacc += C1[6]; sacb += C1[7]; PIN(C1); PIN(sacc); PIN(sacb)); \
    if (GV) { DMA_V((t) + 1, sl_next); } SBAR(); GAPG(1, 3, C1[10] = EX(C1[10]); C1[11] = EX(C1[11]); sacc += C1[8]; sacb += C1[9]; PIN(C1); PIN(sacc); PIN(sacb)); \
    GAPG(2, 3, C1[12] = EX(C1[12]); C1[13] = EX(C1[13]); sacc += C1[10]; sacb += C1[11]; PIN(C1); PIN(sacc); PIN(sacb)); \
    GAPG(3, 3, C1[14] = EX(C1[14]); C1[15] = EX(C1[15]); sacc += C1[12]; sacb += C1[13]; PIN(C1); PIN(sacc); PIN(sacb)); \
    sacc += C1[14]; sacb += C1[15]; l_reg += sacc + sacb; \
    } else { \
    float mxa, mxb; \
    VRD(0, 1); SBAR(); GAPG(0, 0, mxa = MX3(C0[0], C0[1], C0[2]); mxb = MX3(C0[3], C0[4], C0[5]); mxa = MX3(mxa, C0[6], C0[7]); mxb = MX3(mxb, C0[8], C0[9]); PIN(mxa); PIN(mxb)); \
    VRD(1, 1); SBAR(); GAPG(1, 0, mxa = MX3(mxa, C0[10], C0[11]); mxb = MX3(mxb, C0[12], C0[13]); mxa = MX3(mxa, C0[14], C0[15]); mxb = MX3(mxb, C1[0], C1[1]); PIN(mxa); PIN(mxb)); \
    VRD(2, 1); SBAR(); GAPG(2, 0, mxa = MX3(mxa, C1[2], C1[3]); mxb = MX3(mxb, C1[4], C1[5]); mxa = MX3(mxa, C1[6], C1[7]); mxb = MX3(mxb, C1[8], C1[9]); PIN(mxa); PIN(mxb)); \
    VRD(3, 1); SBAR(); GAPG(3, 0, mxa = MX3(mxa, C1[10], C1[11]); mxb = MX3(mxb, C1[12], C1[13]); mxa = MX3(mxa, C1[14], C1[15]); PIN(mxa); PIN(mxb)); \
    { float rm = __builtin_fmaxf(mxa, mxb); { auto rr = __builtin_amdgcn_permlane32_swap(__float_as_uint(rm), __float_as_uint(rm), false, false); rm = __builtin_fmaxf(__uint_as_float(rr[0]), __uint_as_float(rr[1])); } \
      resc = false; \
      if (__builtin_expect(__any(rm > THR), 0)) { const float dl = __builtin_fmaxf(rm, 0.f); mhat += dl; \
          _Pragma("unroll") for (int r = 0; r < 16; ++r) { C0[r] -= dl; C1[r] -= dl; } \
          _Pragma("unroll") for (int r = 0; r < 16; ++r) negm[r] = -mhat; PIN(negm); \
          const float f = __builtin_amdgcn_exp2f(-dl); l_reg *= f; if (hi == 0) wsf[r32] = f; resc = true; } } \
    SBAR(); \
    VRD(0, 2); SBAR(); GAPG(0, 1, C0[0] = EX(C0[0]); C0[1] = EX(C0[1]); C0[2] = EX(C0[2]); PIN(C0)); \
    VRD(1, 2); SBAR(); GAPG(1, 1, C0[3] = EX(C0[3]); C0[4] = EX(C0[4]); C0[5] = EX(C0[5]); PIN(C0)); \
    VRD(2, 2); SBAR(); GAPG(2, 1, C0[6] = EX(C0[6]); C0[7] = EX(C0[7]); C0[8] = EX(C0[8]); PIN(C0)); \
    VRD(3, 2); SBAR(); GAPG(3, 1, C0[9] = EX(C0[9]); C0[10] = EX(C0[10]); C0[11] = EX(C0[11]); PIN(C0)); \
    VRD(0, 3); SBAR(); GAPG(0, 2, C0[12] = EX(C0[12]); C0[13] = EX(C0[13]); C0[14] = EX(C0[14]); PIN(C0)); \
    VRD(1, 3); SBAR(); GAPG(1, 2, C0[15] = EX(C0[15]); C1[0] = EX(C1[0]); C1[1] = EX(C1[1]); PIN(C0); PIN(C1)); \
    VRD(2, 3); SBAR(); GAPG(2, 2, C1[2] = EX(C1[2]); C1[3] = EX(C1[3]); C1[4] = EX(C1[4]); PIN(C1)); \
    VRD(3, 3); SBAR(); GAPG(3, 2, C1[5] = EX(C1[5]); C1[6] = EX(C1[6]); C1[7] = EX(C1[7]); PIN(C1)); \
    if (GK) { DMA_K((t) + 2, sl_prev); if (PROBE_DUPK) DMA_K((t) + 2, sl_prev); } SBAR(); GAPG(0, 3, C1[8] = EX(C1[8]); C1[9] = EX(C1[9]); PIN(C1)); \
    if (GV) { DMA_V((t) + 1, sl_next); if (PROBE_DUPV) DMA_V((t) + 1, sl_next); } SBAR(); GAPG(1, 3, C1[10] = EX(C1[10]); C1[11] = EX(C1[11]); PIN(C1)); \
    GAPG(2, 3, C1[12] = EX(C1[12]); C1[13] = EX(C1[13]); PIN(C1)); \
    GAPG(3, 3, C1[14] = EX(C1[14]); C1[15] = EX(C1[15]); PIN(C1)); \
    } \
    } while (0)
#ifndef PROBE_DUPK
#define PROBE_DUPK 0
#endif
#ifndef PROBE_DUPV
#define PROBE_DUPV 0
#endif
#define WAIT_N(n_) do { if ((n_) == 6) { WAIT_BAR(6); } else if ((n_) == 5) { WAIT_BAR(5); } else if ((n_) == 4) { WAIT_BAR(4); } else if ((n_) == 3) { WAIT_BAR(3); } else if ((n_) == 2) { WAIT_BAR(2); } else if ((n_) == 1) { WAIT_BAR(1); } else { WAIT_BAR(0); } } while (0)
#define ENDW(tt) do { const int nk_ = ((tt) + 2 < NT) ? 1 + PROBE_DUPK : 0, nv_ = ((tt) + 1 < NT) ? NVP * (1 + PROBE_DUPV) : 0; WAIT_N(nk_ + nv_); } while (0)
    int t = 1;
    for (; t + 3 < NT; t += 2) {
        STEP(pB0, pB1, pA0, pA1, t, true, true);     WAIT_N(1 + PROBE_DUPK + NVP * (1 + PROBE_DUPV)); RESC(); ROT();
        STEP(pA0, pA1, pB0, pB1, t + 1, true, true); WAIT_N(1 + PROBE_DUPK + NVP * (1 + PROBE_DUPV)); RESC(); ROT();
    }
    for (; t + 1 < NT; t += 2) {
        STEP(pB0, pB1, pA0, pA1, t, (t + 2 < NT), (t + 1 < NT));         ENDW(t);     RESC(); ROT();
        STEP(pA0, pA1, pB0, pB1, t + 1, (t + 3 < NT), (t + 2 < NT));     ENDW(t + 1); RESC(); ROT();
    }
    STEP(pB0, pB1, pA0, pA1, NT - 1, false, false); WAIT_BAR(0); RESC(); ROT();
    { if constexpr (SAFE) { float sacc = pB0[0] + pB0[1];
#pragma unroll
      for (int r = 2; r < 16; ++r) sacc += pB0[r];
#pragma unroll
      for (int r = 0; r < 16; ++r) sacc += pB1[r];
      l_reg += sacc; }
      pw0 = (u32x4){PKW(pB0, 0), PKW(pB0, 2), PKW(pB0, 4), PKW(pB0, 6)}; pw1 = (u32x4){PKW(pB0, 8), PKW(pB0, 10), PKW(pB0, 12), PKW(pB0, 14)};
      pw2 = (u32x4){PKW(pB1, 0), PKW(pB1, 2), PKW(pB1, 4), PKW(pB1, 6)}; pw3 = (u32x4){PKW(pB1, 8), PKW(pB1, 10), PKW(pB1, 12), PKW(pB1, 14)};
      const lds_cptr vp_ = vp0 + sl_prev * VSLOT;
#pragma unroll
      for (int q = 0; q < ND; ++q) {
          s16x4 l0 = vtr(vp_ + q * 4096), h0 = vtr(vp_ + q * 4096 + 512), l1 = vtr(vp_ + q * 4096 + 1024), h1 = vtr(vp_ + q * 4096 + 1024 + 512);
          s16x4 l2 = vtr(vp_ + q * 4096 + 2048), h2 = vtr(vp_ + q * 4096 + 2048 + 512), l3 = vtr(vp_ + q * 4096 + 3072), h3 = vtr(vp_ + q * 4096 + 3072 + 512);
#define PKV(L, H) (bf16x8){L[0], L[1], L[2], L[3], H[0], H[1], H[2], H[3]}
          o[q] = MFMA32(PAF(0), PKV(l0, h0), o[q]); o[q] = MFMA32(PAF(1), PKV(l1, h1), o[q]); o[q] = MFMA32(PAF(2), PKV(l2, h2), o[q]); o[q] = MFMA32(PAF(3), PKV(l3, h3), o[q]);
#undef PKV
      } }
    { auto rr = __builtin_amdgcn_permlane32_swap(__float_as_uint(l_reg), __float_as_uint(l_reg), false, false); l_reg = __uint_as_float(rr[0]) + __uint_as_float(rr[1]); }
    if (PROBE_VALU) asm volatile("" :: "v"(dummy_));
    __builtin_amdgcn_s_setprio(0);
    m_out = mhat; l_out = l_reg;
#undef KROW
#undef DMA_K
#undef DMA_V
#undef ROT
#undef RESC
#undef PAF
#undef VFR
#undef VRD
#undef KRD
#undef PKW
#undef GAPA
#undef DOT2
#undef GAPB
#undef GAPG
#undef EX
#undef STEP
#undef ENDW
#undef WAIT_N
}
#undef SBAR
#undef PIN
#undef MX3
#undef MFMA32
#undef WAIT_BAR
}

#define XB_TMO      128
#define XB_XCNT(j)  (256  + 64 * (j))
#define XB_XSUB(j)  (1280 + 64 * (j))
#define XB_XGEN(j)  (2304 + 64 * (j))
#define XB_TOP      3328
#define XB_TOPGEN   3392
#define XCD_BAR_WORDS 3456
#define XB_SPIN_CAP (1u << 18)

__device__ __forceinline__ unsigned xb_ld(unsigned* p)              { return __hip_atomic_load(p, __ATOMIC_RELAXED, __HIP_MEMORY_SCOPE_AGENT); }
__device__ __forceinline__ unsigned xb_add(unsigned* p, unsigned v) { return __hip_atomic_fetch_add(p, v, __ATOMIC_RELAXED, __HIP_MEMORY_SCOPE_AGENT); }
__device__ __forceinline__ unsigned xb_xcc_id() { return (unsigned)__builtin_amdgcn_s_getreg((3 << 11) | 20) & 0xFu; }
#define XB_SPIN(cond, bar) do { unsigned _sp = 0; while (cond) { __builtin_amdgcn_s_sleep(1); \
    if ((++_sp & 255u) == 0u) { if (xb_ld(&(bar)[XB_TMO])) break; if (_sp > XB_SPIN_CAP) { atomicAdd(&(bar)[XB_TMO], 1u); break; } } } } while (0)

struct XcdBarrier {
    unsigned* bar; unsigned x;
    volatile LAS unsigned* st;
};

__device__ __forceinline__ XcdBarrier xcd_barrier_post(unsigned* bar, volatile LAS unsigned* st) {
    XcdBarrier b; b.bar = bar; b.x = xb_xcc_id(); b.st = st;
    if (threadIdx.x == 0) (void)xb_add(&bar[XB_XCNT(b.x)], 1u);
    return b;
}
__device__ __forceinline__ void xcd_barrier_complete(unsigned* bar, unsigned x, unsigned& nloc, unsigned& nx) {
    const unsigned G = gridDim.x * gridDim.y * gridDim.z;
    unsigned sum, cnt, mine, sp = 0u;
    for (;;) {
        sum = 0u; cnt = 0u; mine = 0u;
#pragma unroll
        for (unsigned j = 0; j < 16; ++j) { const unsigned c = xb_ld(&bar[XB_XCNT(j)]); sum += c; cnt += (c > 0u) ? 1u : 0u; mine = (j == x) ? c : mine; }
        if (sum == G) break;
        __builtin_amdgcn_s_sleep(1);
        if ((++sp & 255u) == 0u) { if (xb_ld(&bar[XB_TMO])) break; if (sp > XB_SPIN_CAP) { atomicAdd(&bar[XB_TMO], 1u); break; } }
    }
    nloc = mine > 0u ? mine : 1u; nx = cnt > 0u ? cnt : 1u;
}

__device__ __forceinline__ void xcd_barrier(const XcdBarrier& b) {
    asm volatile("s_waitcnt vmcnt(0)" ::: "memory");
    __syncthreads();
    if (threadIdx.x == 0) {
        unsigned* bar = b.bar;
        __builtin_amdgcn_s_waitcnt(0);
        unsigned nloc = b.st[0], nx = b.st[1];
        if (nloc == 0u) { xcd_barrier_complete(bar, b.x, nloc, nx); b.st[0] = nloc; b.st[1] = nx; }
        const unsigned old = xb_add(&bar[XB_XSUB(b.x)], 1u);
        const unsigned gen = old / nloc;
        if (old + 1u == (gen + 1u) * nloc) {
            __builtin_amdgcn_fence(__ATOMIC_RELEASE, "agent");
            asm volatile("s_waitcnt vmcnt(0)" ::: "memory");
            const unsigned og = xb_add(&bar[XB_TOP], 1u);
            const unsigned tg = og / nx;
            if (og + 1u == (tg + 1u) * nx) xb_add(&bar[XB_TOPGEN], 1u);
            else XB_SPIN(xb_ld(&bar[XB_TOPGEN]) == tg, bar);
            __builtin_amdgcn_fence(__ATOMIC_ACQUIRE, "agent");
            xb_add(&bar[XB_XGEN(b.x)], 1u);
            asm volatile("s_waitcnt vmcnt(0)" ::: "memory");
        } else {
            XB_SPIN(xb_ld(&bar[XB_XGEN(b.x)]) == gen, bar);
            __builtin_amdgcn_fence(__ATOMIC_ACQUIRE, "agent");
            asm volatile("s_waitcnt vmcnt(0)" ::: "memory");
        }
    }
    __syncthreads();
}

struct Args { const float* in[23]; float* out; unsigned char* ws; int ph_lo, ph_hi; };
enum { I_X = 0, I_C, I_CTX, I_CCTX, I_WADA, I_BADA, I_GMIX, I_WIN, I_DLAM, I_DNG, I_SINK, I_CONVW, I_CONVB, I_LNG, I_LNB, I_WOUT, I_GFFN, I_RW, I_RB, I_W1, I_W3, I_W2, I_GFIN };
constexpr int N_PHASES = 18;
__device__ __constant__ const float LAMBDA_INIT[2] = {0.2f, 0.35550906759097f};

struct EpiInProj {
    static constexpr bool PERM = true, AFTER_DRAIN = false;
    unsigned char* ws; const float* ropeC; const float* ropeS;
    __device__ __forceinline__ void operator()(const f32x4 (&acc)[2][2][4][2], const pg8::Unit& u, int wr, int wc, int fr, int fq) const {
        const int pn = u.pn; const bool latent = u.pm < 64; const int rowb = u.pm * 256 + wr * 64 + fr;
        if (pn >= 8) {
            bf16_t* Z = (bf16_t*)(ws + RA_Z); const int ch0 = (pn - 8) * 128 + wc * 32 + 8 * fq;
#pragma unroll
            for (int ai = 0; ai < 2; ++ai)
#pragma unroll
                for (int m = 0; m < 4; ++m) { const int row = rowb + ai * 128 + m * 16;
                    const f32x4 a0 = acc[ai][0][m][0], a1 = acc[ai][0][m][1], g0 = acc[ai][1][m][0], g1 = acc[ai][1][m][1];
                    u32x4 w; w.x = cvt_pk_bf16(a0[0] * sigmoid_f(g0[0]), a0[1] * sigmoid_f(g0[1])); w.y = cvt_pk_bf16(a0[2] * sigmoid_f(g0[2]), a0[3] * sigmoid_f(g0[3]));
                    w.z = cvt_pk_bf16(a1[0] * sigmoid_f(g1[0]), a1[1] * sigmoid_f(g1[1])); w.w = cvt_pk_bf16(a1[2] * sigmoid_f(g1[2]), a1[3] * sigmoid_f(g1[3]));
                    *(u32x4*)(Z + (size_t)row * 256 + ch0) = w; }
            return;
        }
        const float sgn = (fq < 2) ? -1.f : 1.f;
        const bool anyrope = latent && (pn < 4 || pn >= 6);
#pragma unroll
        for (int ai = 0; ai < 2; ++ai)
#pragma unroll
            for (int m = 0; m < 4; ++m) { const int row = rowb + ai * 128 + m * 16;
                f32x4 c0, c1, s0, s1;
                if (anyrope) { const int pos = (wc & 1) ? (row & 63) : (row >> 6); const int fo = pos * 16 + 8 * (fq & 1);
                    c0 = *(const f32x4*)(ropeC + fo); c1 = *(const f32x4*)(ropeC + fo + 4); s0 = *(const f32x4*)(ropeS + fo) * sgn; s1 = *(const f32x4*)(ropeS + fo + 4) * sgn; }
#pragma unroll
                for (int bj = 0; bj < 2; ++bj) {
                    bf16_t* dst; int ld, dcol; bool rope; float sc = 1.f; bool isvb = false;
                    if (pn < 2)       { dst = (bf16_t*)(ws + RA_QA); ld = 512; dcol = pn * 256 + bj * 128 + wc * 32; rope = true; sc = QSCALE; }
                    else if (pn < 4)  { dst = (bf16_t*)(ws + RA_KA); ld = 512; dcol = (pn - 2) * 256 + bj * 128 + wc * 32; rope = true; }
                    else if (pn < 6)  { dst = (bf16_t*)(ws + RA_VA); ld = 512; dcol = (pn - 4) * 256 + bj * 128 + wc * 32; rope = false; }
                    else if (pn == 6) { dst = (bf16_t*)(ws + RA_QB); ld = 256; dcol = bj * 128 + wc * 32; rope = true; sc = QSCALE; }
                    else if (bj == 0) { dst = (bf16_t*)(ws + RA_KB); ld = 128; dcol = wc * 32; rope = true; }
                    else              { dst = (bf16_t*)(ws + RA_VB); ld = 256; dcol = (wc >> 1) * 128 + (wc & 1) * 32; rope = false; isvb = true; }
                    rope = rope && latent;
                    f32x4 x0 = acc[ai][bj][m][0], x1 = acc[ai][bj][m][1];
                    if (rope) { f32x4 p0, p1;
#pragma unroll
                        for (int j = 0; j < 4; ++j) {
                            auto s0_ = __builtin_amdgcn_permlane32_swap(__float_as_uint(x0[j]), __float_as_uint(x0[j]), false, false); p0[j] = __uint_as_float(fq < 2 ? s0_[1] : s0_[0]);
                            auto s1_ = __builtin_amdgcn_permlane32_swap(__float_as_uint(x1[j]), __float_as_uint(x1[j]), false, false); p1[j] = __uint_as_float(fq < 2 ? s1_[1] : s1_[0]); }
                        x0 = x0 * c0 + p0 * s0; x1 = x1 * c1 + p1 * s1; }
                    x0 = x0 * sc; x1 = x1 * sc;
                    bf16_t* p = dst + (size_t)row * ld + dcol + 8 * fq;
                    u32x4 w; w.x = cvt_pk_bf16(x0[0], x0[1]); w.y = cvt_pk_bf16(x0[2], x0[3]); w.z = cvt_pk_bf16(x1[0], x1[1]); w.w = cvt_pk_bf16(x1[2], x1[3]);
                    *(u32x4*)p = w;
                    if (isvb) { unsigned zz = 0u; asm volatile("" : "+v"(zz)); const u32x4 z = {zz, zz, zz, zz}; *(u32x4*)(p + 64) = z; } }
            }
    }
};
__device__ __forceinline__ void st16_wt(void* p, const u32x4 v) { asm volatile("global_store_dwordx4 %0, %1, off sc1\n\ts_nop 1" :: "v"(p), "v"(v) : "memory"); }
__device__ __forceinline__ void st4bf_wt(bf16_t* p, const f32x4 v) { u32x2 w; w.x = cvt_pk_bf16(v.x, v.y); w.y = cvt_pk_bf16(v.z, v.w); asm volatile("global_store_dwordx2 %0, %1, off sc1\n\ts_nop 0" :: "v"(p), "v"(w) : "memory"); }
struct OutOrder {
    pg8::StaticOrder in; gu32* cnt; gu32* ctxc;
    __device__ __forceinline__ bool next(int i, pg8::Unit& u) const {
        if (ctxc == nullptr) { if (i != 0) return false; return in.next(0, u); }
        const int c = blockIdx.x;
        if (c < 12) { if (i != 0) return false; u.pm = 61 + (c >> 2); u.pn = c & 3; u.aux = 0; return true; }
        if (i == 0) return in.next(0, u);
        if (i == 1 && c < 16) { u.pm = 64; u.pn = c - 12; u.aux = 0; return true; }
        return false; }
    __device__ __forceinline__ void a_ready(const pg8::Unit& u) const {
        if (ctxc != nullptr && u.pm >= 64) { for (unsigned s = 0; s < (1u << 20); ++s) { if ((unsigned)__builtin_amdgcn_readfirstlane((int)__hip_atomic_load(ctxc, __ATOMIC_RELAXED, __HIP_MEMORY_SCOPE_AGENT)) == 12u) break; __builtin_amdgcn_s_sleep(2); }
            __builtin_amdgcn_fence(__ATOMIC_ACQUIRE, "agent"); } }
    __device__ __forceinline__ void done(const pg8::Unit& u) const {
        asm volatile("s_waitcnt vmcnt(0)" ::: "memory");
        int ln; asm volatile("v_mbcnt_lo_u32_b32 %0, -1, 0\n\tv_mbcnt_hi_u32_b32 %0, -1, %0" : "=v"(ln));
        if (ln == 0) __hip_atomic_fetch_add(cnt + u.pm, 1u, __ATOMIC_RELAXED, __HIP_MEMORY_SCOPE_AGENT); }
};
struct EpiOutProj {
    static constexpr bool PERM = true, AFTER_DRAIN = false;
    const float* xin; const float* ctxin; bf16_t* XB; const float* gate_lat; const float* gate_ctx; int layer;
    __device__ __forceinline__ void operator()(const f32x4 (&acc)[2][2][4][2], const pg8::Unit& u, int wr, int wc, int fr, int fq) const {
        const bool isctx = u.pm >= 64; const float* gate = isctx ? gate_ctx : gate_lat; const int col8 = u.pn * 256 + wc * 32 + 8 * fq;
        f32x4 g[2][2];
#pragma unroll
        for (int bj = 0; bj < 2; ++bj) { g[bj][0] = *(const f32x4*)(gate + col8 + bj * 128); g[bj][1] = *(const f32x4*)(gate + col8 + bj * 128 + 4); }
        if (layer == 0) {
#pragma unroll
            for (int am = 0; am < 4; ++am) { const int ai = am >> 1, m0 = (am & 1) * 2; f32x4 x[2][2][2];
#pragma unroll
                for (int mm = 0; mm < 2; ++mm) { const int row = u.pm * 256 + ai * 128 + wr * 64 + (m0 + mm) * 16 + fr;
                    const float* xo = (isctx ? ctxin + (size_t)(row - SEQ) * DM : xin + (size_t)row * DM) + col8;
#pragma unroll
                    for (int bj = 0; bj < 2; ++bj) { x[mm][bj][0] = *(const f32x4*)(xo + bj * 128); x[mm][bj][1] = *(const f32x4*)(xo + bj * 128 + 4); } }
#pragma unroll
                for (int mm = 0; mm < 2; ++mm) { const int m = m0 + mm; const int row = u.pm * 256 + ai * 128 + wr * 64 + m * 16 + fr; bf16_t* xn = XB + (size_t)row * DM + col8;
#pragma unroll
                    for (int bj = 0; bj < 2; ++bj) { const f32x4 y0 = x[mm][bj][0] + g[bj][0] * acc[ai][bj][m][0], y1 = x[mm][bj][1] + g[bj][1] * acc[ai][bj][m][1];
                        u32x4 o; o.x = cvt_pk_bf16(y0.x, y0.y); o.y = cvt_pk_bf16(y0.z, y0.w); o.z = cvt_pk_bf16(y1.x, y1.y); o.w = cvt_pk_bf16(y1.z, y1.w);
                        st16_wt(xn + bj * 128, o); } } }
        } else {
#pragma unroll
            for (int ai = 0; ai < 2; ++ai) { u32x4 xw[4][2];
#pragma unroll
                for (int m = 0; m < 4; ++m) { const int row = u.pm * 256 + ai * 128 + wr * 64 + m * 16 + fr; const bf16_t* xn = XB + (size_t)row * DM + col8;
#pragma unroll
                    for (int bj = 0; bj < 2; ++bj) xw[m][bj] = *(const u32x4*)(xn + bj * 128); }
#pragma unroll
                for (int m = 0; m < 4; ++m) { const int row = u.pm * 256 + ai * 128 + wr * 64 + m * 16 + fr; bf16_t* xn = XB + (size_t)row * DM + col8;
#pragma unroll
                    for (int bj = 0; bj < 2; ++bj) { const u32x4 w = xw[m][bj];
                        const f32x4 x0 = {__builtin_bit_cast(float, w.x << 16), __builtin_bit_cast(float, w.x & 0xffff0000u), __builtin_bit_cast(float, w.y << 16), __builtin_bit_cast(float, w.y & 0xffff0000u)};
                        const f32x4 x1 = {__builtin_bit_cast(float, w.z << 16), __builtin_bit_cast(float, w.z & 0xffff0000u), __builtin_bit_cast(float, w.w << 16), __builtin_bit_cast(float, w.w & 0xffff0000u)};
                        const f32x4 y0 = x0 + g[bj][0] * acc[ai][bj][m][0], y1 = x1 + g[bj][1] * acc[ai][bj][m][1];
                        u32x4 o; o.x = cvt_pk_bf16(y0.x, y0.y); o.y = cvt_pk_bf16(y0.z, y0.w); o.z = cvt_pk_bf16(y1.x, y1.y); o.w = cvt_pk_bf16(y1.z, y1.w);
                        st16_wt(xn + bj * 128, o); } } }
        }
    }
};
struct EpiMoe1 {
    static constexpr bool PERM = true, AFTER_DRAIN = false;
    bf16_t* HS;
    __device__ __forceinline__ void operator()(const f32x4 (&acc)[2][2][4][2], const pg8::Unit& u, int wr, int wc, int fr, int fq) const {
        const int col8 = (u.pn & 3) * 128 + wc * 32 + 8 * fq;
#pragma unroll
        for (int ai = 0; ai < 2; ++ai)
#pragma unroll
            for (int m = 0; m < 4; ++m) { const int row = u.pm * 256 + ai * 128 + wr * 64 + m * 16 + fr;
                const f32x4 a0 = acc[ai][0][m][0], a1 = acc[ai][0][m][1], b0 = acc[ai][1][m][0], b1 = acc[ai][1][m][1];
                u32x4 w; w.x = cvt_pk_bf16(silu_f(a0[0]) * b0[0], silu_f(a0[1]) * b0[1]); w.y = cvt_pk_bf16(silu_f(a0[2]) * b0[2], silu_f(a0[3]) * b0[3]);
                w.z = cvt_pk_bf16(silu_f(a1[0]) * b1[0], silu_f(a1[1]) * b1[1]); w.w = cvt_pk_bf16(silu_f(a1[2]) * b1[2], silu_f(a1[3]) * b1[3]);
                st16_wt(HS + (size_t)row * FFE + col8, w); }
    }
};
constexpr float YS_SCALE = 16.f, YS_INV = 1.f / 16.f;
struct EpiMoe2 {
    static constexpr bool PERM = true, AFTER_DRAIN = false;
    unsigned char* YS;
    __device__ __forceinline__ void operator()(const f32x4 (&acc)[2][2][4][2], const pg8::Unit& u, int wr, int wc, int fr, int fq) const {
        const int col8 = (u.pn & 3) * 256 + wc * 32 + 8 * fq;
#pragma unroll
        for (int ai = 0; ai < 2; ++ai)
#pragma unroll
            for (int m = 0; m < 4; ++m) { const int row = u.pm * 256 + ai * 128 + wr * 64 + m * 16 + fr;
#pragma unroll
                for (int bj = 0; bj < 2; ++bj) { f32x4 v0 = acc[ai][bj][m][0] * YS_SCALE, v1 = acc[ai][bj][m][1] * YS_SCALE;
#pragma unroll
                    for (int j = 0; j < 4; ++j) { v0[j] = __builtin_amdgcn_fmed3f(v0[j], -448.f, 448.f); v1[j] = __builtin_amdgcn_fmed3f(v1[j], -448.f, 448.f); }
                    int w0 = __builtin_amdgcn_cvt_pk_fp8_f32(v0[0], v0[1], 0, false); w0 = __builtin_amdgcn_cvt_pk_fp8_f32(v0[2], v0[3], w0, true);
                    int w1 = __builtin_amdgcn_cvt_pk_fp8_f32(v1[0], v1[1], 0, false); w1 = __builtin_amdgcn_cvt_pk_fp8_f32(v1[2], v1[3], w1, true);
                    *(u32x2*)(YS + (size_t)row * DM + col8 + bj * 128) = (u32x2){(unsigned)w0, (unsigned)w1}; } }
    }
};
struct MoeOrder {
    int G, vcu, nunits; int ts[16]; const int* rowtok;
    __device__ __forceinline__ unsigned row_off(const pg8::Unit& u, int r) const { return (unsigned)min((unsigned)rowtok[u.aux + r], (unsigned)(NROW - 1)) * (unsigned)(DM * 2); }
    __device__ __forceinline__ bool next(int i, pg8::Unit& u) const {
        const int L = i * G + vcu; if (L >= nunits) return false;
        const int rt = L >> 2, ct = L & 3; int e = 0, tb = ts[0];
#pragma unroll
        for (int k = 1; k < 16; ++k) { const bool ge = rt >= ts[k]; e += ge ? 1 : 0; tb = ge ? ts[k] : tb; }
        u.pm = rt; u.pn = e * 4 + ct; u.aux = e * ROWCAP + (rt - tb) * 256; return true;
    }
    __device__ __forceinline__ int nloc() const { return vcu < nunits ? (nunits - vcu + G - 1) / G : 0; }
    __device__ __forceinline__ void a_ready(const pg8::Unit&) const {}
    __device__ __forceinline__ void done(const pg8::Unit&) const {}
};

struct MoeOrder2 {
    int vcu, nunits, part; int ts[16];
    __device__ __forceinline__ bool next(int i, pg8::Unit& u) const {
        const int U = nunits, q = U >> 8, r = U & 255; int L;
        if (part == 0) { if (vcu < r || i >= q) return false; L = i * 256 + vcu; }
        else { int b = vcu + i * 256; if (b >= (q + 1) * r) return false; int k = 0; while (b >= r) { b -= r; ++k; } L = k * 256 + b; }
        const int rt = L >> 2, ct = L & 3; int e = 0;
#pragma unroll
        for (int k = 1; k < 16; ++k) e += (rt >= ts[k]) ? 1 : 0;
        u.pm = rt; u.pn = e * 4 + ct; u.aux = 0; return true; }
    __device__ __forceinline__ void a_ready(const pg8::Unit&) const {}
    __device__ __forceinline__ void done(const pg8::Unit&) const {}
};
__device__ __forceinline__ void moe_wait(gu32* flag, int base, int n) {
    const int tid = otid();
    if (tid < 64) { for (unsigned s = 0; s < (1u << 20); ++s) { bool ok = true;
            for (int j = tid; j < n; j += 64) ok = ok && (__hip_atomic_load(flag + base + j, __ATOMIC_RELAXED, __HIP_MEMORY_SCOPE_AGENT) == 1u);
            if (__all(ok)) break; __builtin_amdgcn_s_sleep(2); }
        __builtin_amdgcn_fence(__ATOMIC_ACQUIRE, "agent"); asm volatile("s_waitcnt vmcnt(0)" ::: "memory"); }
    __syncthreads();
}

__device__ __forceinline__ void tr_item(const float* W, int ldw, int k0, int n0, bf16_t* WT, int K, int nd0, LAS float* scr, int lane) {
    f32x4 v[8];
#pragma unroll
    for (int i = 0; i < 8; ++i) v[i] = *(const f32x4*)(W + (size_t)(k0 + 8 * i + (lane >> 3)) * ldw + n0 + (lane & 7) * 4);
#pragma unroll
    for (int i = 0; i < 8; ++i) { LAS float* d = scr + (8 * i + (lane >> 3)) * 33 + (lane & 7) * 4; d[0] = v[i].x; d[1] = v[i].y; d[2] = v[i].z; d[3] = v[i].w; }
    LDS_WAIT(); asm volatile("" ::: "memory");
    const int c = lane & 7;
#pragma unroll
    for (int j = 0; j < 4; ++j) { const int n = (lane >> 3) + 8 * j; const LAS float* s = scr + (8 * c) * 33 + n;
        u32x4 o; o.x = pk2(s[0 * 33], s[1 * 33]); o.y = pk2(s[2 * 33], s[3 * 33]); o.z = pk2(s[4 * 33], s[5 * 33]); o.w = pk2(s[6 * 33], s[7 * 33]);
        *(u32x4*)(WT + (size_t)(nd0 + n) * K + k0 + 8 * c) = o; }
    LDS_WAIT(); asm volatile("" ::: "memory");
}
__device__ __forceinline__ void moe_convert(const Args& a, int L, LAS float* scr, int gw, int NGW, int lane, int it0 = 0, int it1 = 12288) {
    bf16_t* W13T = (bf16_t*)(a.ws + WS_W13) + (size_t)L * 16 * 1024 * 1024; bf16_t* W2T = (bf16_t*)(a.ws + WS_W2) + (size_t)L * 16 * 1024 * 512;
    for (int it = it0 + gw; it < it1; it += NGW) {
        if (it < 8192) { const int e = it >> 9, r2 = it & 511, kb = r2 >> 5, nb = r2 & 31, nd0 = 32 * nb, t = nd0 >> 8, bj = (nd0 >> 7) & 1, i0 = nd0 & 127;
            const float* src = (bj ? a.in[I_W3] : a.in[I_W1]) + (size_t)(L * 16 + e) * 1024 * 512;
            tr_item(src, 512, 64 * kb, t * 128 + i0, W13T + (size_t)e * 1024 * 1024, 1024, nd0, scr, lane); }
        else { const int r = it - 8192, e = r >> 8, r2 = r & 255, kb = r2 >> 5, nb = r2 & 31;
            tr_item(a.in[I_W2] + (size_t)(L * 16 + e) * 512 * 1024, 1024, 64 * kb, 32 * nb, W2T + (size_t)e * 1024 * 512, 512, 32 * nb, scr, lane); }
    }
}
__device__ __forceinline__ void prologue_phase(const Args& a, unsigned char* lds) {
    const int tid = otid(), lane = tid & 63, wave = tid >> 6, gw = blockIdx.x * NWAVES + wave, NGW = gridDim.x * NWAVES;
    LAS float* scr = (LAS float*)((LAS unsigned char*)lds + wave * 8704);
    bf16_t* WinT = (bf16_t*)(a.ws + WS_WIN); bf16_t* WoutT = (bf16_t*)(a.ws + WS_WOUT);
    for (int it = gw; it < 3584; it += NGW) {
        if (it < 2560) { const int L = it / 1280, r = it % 1280, kb = r / 80, nb = r % 80, nd0 = 32 * nb; int n0 = nd0;
            if (nd0 >= 2048) { const int q = nd0 - 2048, t = q >> 8, bj = (q >> 7) & 1, i0 = q & 127; n0 = 2048 + bj * 256 + t * 128 + i0; }
            tr_item(a.in[I_WIN] + (size_t)L * 1024 * INW, INW, 64 * kb, n0, WinT + (size_t)L * INW * 1024, 1024, nd0, scr, lane); }
        else { const int r0 = it - 2560, L = r0 >> 9, r = r0 & 511, kb = r >> 5, nb = r & 31;
            tr_item(a.in[I_WOUT] + (size_t)L * 1024 * 1024, 1024, 64 * kb, 32 * nb, WoutT + (size_t)L * 1024 * 1024, 1024, 32 * nb, scr, lane); }
    }
    moe_convert(a, 0, scr, gw, NGW, lane, 0, 8192);
    __syncthreads();
    float* sc = (float*)(lds + 71680); float* scc = sc + 1024; float* red = scc + 1024;
    float* MOD = (float*)(a.ws + WS_MOD);
    for (int u = blockIdx.x; u < 192; u += gridDim.x) {
        const int L = u / 96, col0 = (u % 96) * 64;
        for (int k = tid; k < 1024; k += NTHREADS) { const float c = a.in[I_C][k], cc = a.in[I_CCTX][k]; sc[k] = c / (1.f + expf(-c)); scc[k] = cc / (1.f + expf(-cc)); }
        __syncthreads();
        const int cg = tid & 15, ks = tid >> 4;
        const float* w = a.in[I_WADA] + ((size_t)L * 1024 + ks * 32) * 6144 + col0 + cg * 4;
        f32x4 s1 = {0.f, 0.f, 0.f, 0.f}, s2 = {0.f, 0.f, 0.f, 0.f};
#pragma unroll 8
        for (int k = 0; k < 32; ++k) { const f32x4 wv = *(const f32x4*)(w + (size_t)k * 6144); s1 = s1 + wv * sc[ks * 32 + k]; s2 = s2 + wv * scc[ks * 32 + k]; }
        *(f32x4*)(red + (ks * 16 + cg) * 8) = s1; *(f32x4*)(red + (ks * 16 + cg) * 8 + 4) = s2;
        __syncthreads();
        if (tid < 128) { const int which = tid >> 6, c = tid & 63; float s = 0.f;
            for (int k = 0; k < 32; ++k) s += red[(k * 16 + (c >> 2)) * 8 + which * 4 + (c & 3)];
            MOD[(L * 2 + which) * 6144 + col0 + c] = s + a.in[I_BADA][L * 6144 + col0 + c]; }
        __syncthreads();
    }
    if (blockIdx.x >= 192 && tid < 64) {
        float* rc = (float*)(a.ws + WS_ROPEC); float* rs = (float*)(a.ws + WS_ROPES);
        const int i = ((int)blockIdx.x - 192) * 64 + tid; const int pos = i >> 4, f = i & 15; const float inv = powf(10000.f, -(float)f / 16.f), ang = (float)pos * inv; rc[i] = cosf(ang); rs[i] = sinf(ang);
    }
    if (blockIdx.x == gridDim.x - 2 && wave < 2) {
        const float* dl = a.in[I_DLAM] + wave * 256;
        const float s01 = wave_sum(dl[lane] * dl[64 + lane]), s23 = wave_sum(dl[128 + lane] * dl[192 + lane]);
        if (lane == 0) ((float*)(a.ws + WS_LAM))[wave] = expf(s01) - expf(s23) + LAMBDA_INIT[wave];
    }
}

__device__ __forceinline__ void norm1_phase(const Args& a, int l) {
    constexpr int NR = 4;
    const int tid = otid(), lane = tid & 63, wave = tid >> 6;
    const int nrows = (l == 2) ? SEQ : NROW, rpw = (nrows + gridDim.x - 1) / gridDim.x, r0 = blockIdx.x * rpw, r1 = min(nrows, r0 + rpw);
    const int rw = (rpw + NWAVES - 1) / NWAVES, wr0 = r0 + wave * rw, wr1 = min(r1, wr0 + rw);
    bf16_t* XB = (bf16_t*)(a.ws + WS_XB); bf16_t* HB = (bf16_t*)(a.ws + WS_HB); const unsigned char* YS = a.ws + WS_RA;
    const float* MOD = (const float*)(a.ws + WS_MOD);
    const int2* TOKP = (const int2*)(a.ws + WS_TOKP); const float2* TOKW = (const float2*)(a.ws + WS_TOKW);
    f32x4 ga[4], gb[4], gq[4]; int cur_ctx = -1;
#define N1_PARAMS(isctx_) do { if ((int)(isctx_) != cur_ctx) { cur_ctx = (int)(isctx_); \
        if (l < 2) { const f32x4* g_ = (const f32x4*)(a.in[I_GMIX] + l * DM) + lane; const float* md_ = MOD + (l * 2 + cur_ctx) * 6144; \
            _Pragma("unroll") for (int j = 0; j < 4; ++j) { ga[j] = g_[64 * j] * (((const f32x4*)(md_ + 1024) + lane)[64 * j] + 1.f); gb[j] = ((const f32x4*)(md_) + lane)[64 * j]; } } \
        else { const f32x4* g_ = (const f32x4*)(a.in[I_GFIN]) + lane; _Pragma("unroll") for (int j = 0; j < 4; ++j) { ga[j] = g_[64 * j]; gb[j] = ga[j]; } } \
        if (l != 0) { const f32x4* q_ = (const f32x4*)(MOD + ((l - 1) * 2 + cur_ctx) * 6144 + 5 * 1024) + lane; _Pragma("unroll") for (int j = 0; j < 4; ++j) gq[j] = q_[64 * j]; } \
        else { _Pragma("unroll") for (int j = 0; j < 4; ++j) gq[j] = ga[j]; } } } while (0)
    for (int rb = wr0; rb < wr1; rb += NR) {
        f32x4 v[NR][4]; int rowk[NR];
#pragma unroll
        for (int k = 0; k < NR; ++k) rowk[k] = min(rb + k, wr1 - 1);
        if (l == 0) {
#pragma unroll
            for (int k = 0; k < NR; ++k) { const int row = rowk[k]; const bool isctx = row >= SEQ;
                const f32x4* src = (const f32x4*)(isctx ? a.in[I_CTX] + (size_t)(row - SEQ) * DM : a.in[I_X] + (size_t)row * DM) + lane;
#pragma unroll
                for (int j = 0; j < 4; ++j) v[k][j] = src[64 * j]; }
        } else {
            int2 pp[NR]; float2 ww[NR];
#pragma unroll
            for (int k = 0; k < NR; ++k) { pp[k] = TOKP[rowk[k]]; ww[k] = TOKW[rowk[k]]; }
            { const int* tsg = (const int*)(a.ws + WS_TSG) + (l - 1) * 32;
#pragma unroll
              for (int k = 0; k < NR; ++k) { pp[k].x = tsg[pp[k].x >> 15] * 256 + (pp[k].x & 32767); pp[k].y = tsg[pp[k].y >> 15] * 256 + (pp[k].y & 32767); } }
            unsigned y0[NR][4], y1[NR][4];
#pragma unroll
            for (int k = 0; k < NR; ++k) { const int row = rowk[k]; const bool isctx = row >= SEQ;
                const bf16_t* xb = XB + (size_t)row * DM + 4 * lane; (void)isctx;
                const unsigned* q0 = (const unsigned*)(YS + (size_t)pp[k].x * DM) + lane; const unsigned* q1 = (const unsigned*)(YS + (size_t)pp[k].y * DM) + lane;
#pragma unroll
                for (int j = 0; j < 4; ++j) { v[k][j] = ld4bf(xb + 256 * j); y0[k][j] = q0[64 * j]; y1[k][j] = q1[64 * j]; } }
#pragma unroll
            for (int k = 0; k < NR; ++k) { const bool st = (rb + k < wr1) && (l < 2); bf16_t* xb = XB + (size_t)rowk[k] * DM + 4 * lane; N1_PARAMS(rowk[k] >= SEQ);
#pragma unroll
                for (int j = 0; j < 4; ++j) { const int p0 = (int)y0[k][j], p1 = (int)y1[k][j];
                    const auto a01 = __builtin_amdgcn_cvt_pk_f32_fp8(p0, false), a23 = __builtin_amdgcn_cvt_pk_f32_fp8(p0, true), b01 = __builtin_amdgcn_cvt_pk_f32_fp8(p1, false), b23 = __builtin_amdgcn_cvt_pk_f32_fp8(p1, true);
                    const f32x4 ya = {a01[0], a01[1], a23[0], a23[1]}, yb = {b01[0], b01[1], b23[0], b23[1]};
                    v[k][j] = v[k][j] + gq[j] * (ya * (ww[k].x * YS_INV) + yb * (ww[k].y * YS_INV));
                    if (st) st4bf(xb + 256 * j, v[k][j]); } }
        }
#pragma unroll
        for (int k = 0; k < NR; ++k) { const int row = rowk[k]; const bool isctx = row >= SEQ, st = rb + k < wr1;
            float ss = 0.f;
#pragma unroll
            for (int j = 0; j < 4; ++j) ss += (v[k][j].x * v[k][j].x + v[k][j].y * v[k][j].y) + (v[k][j].z * v[k][j].z + v[k][j].w * v[k][j].w);
            const float rstd = 1.f / sqrtf(wave_sum(ss) * (1.f / DM) + EPS);
            N1_PARAMS(isctx);
            if (l < 2) {
                u32x2* o8 = (u32x2*)(HB + (size_t)row * DM) + lane;
#pragma unroll
                for (int j = 0; j < 4; ++j) { const f32x4 h = v[k][j] * rstd * ga[j] + gb[j];
                    u32x2 w; w.x = cvt_pk_bf16(h.x, h.y); w.y = cvt_pk_bf16(h.z, h.w); if (st) o8[64 * j] = w; }
            } else {
                f32x4* o = (f32x4*)(a.out + (size_t)row * DM) + lane;
#pragma unroll
                for (int j = 0; j < 4; ++j) { const f32x4 r = v[k][j] * rstd * ga[j]; if (st) o[64 * j] = r; }
            }
        }
    }
}
#undef N1_PARAMS
__device__ __forceinline__ void norm2_phase(const Args& a, int l, unsigned char* lds) {
    const int tid = otid(), lane = tid & 63, wave = tid >> 6;
    const int b_ = blockIdx.x;
    const int nlat = (l == 1) ? 64 : (b_ < 16 ? 1 : 65), lat0 = (l == 1) ? b_ * 64 : (b_ < 16 ? 240 * 65 + b_ : (b_ - 16) * 65);
    const int nlate = (l == 1) ? 0 : 4, late0 = 61 * 256 + 4 * b_, tl = 61 + (b_ >> 6), nloc = nlat + nlate;
#define N2_ROW(i) ((i) < nlat ? lat0 + (i) : late0 + ((i) - nlat))
    float* hrow = (float*)lds;
    float* logit = (float*)(lds + 65536);
    int* e01 = (int*)(lds + 65536 + 8192);
    for (int i = tid; i < 128; i += NTHREADS) e01[i] = -1;
    gu32* cnt = (gu32*)(a.ws + WS_CTL) + CW_OPC + l * 128;
#define N2_WAIT(ta_, tb_) do { if (tid < 64) { for (unsigned s = 0; s < (1u << 20); ++s) { const unsigned c = __hip_atomic_load(cnt + ((lane & 1) ? (tb_) : (ta_)), __ATOMIC_RELAXED, __HIP_MEMORY_SCOPE_AGENT); \
              if (__all(c == 32u)) break; __builtin_amdgcn_s_sleep(2); } \
          __builtin_amdgcn_fence(__ATOMIC_ACQUIRE, "agent"); asm volatile("s_waitcnt vmcnt(0)" ::: "memory"); } \
      __syncthreads(); } while (0)
    N2_WAIT(lat0 >> 8, (lat0 + nlat - 1) >> 8);
    const bf16_t* XB = (const bf16_t*)(a.ws + WS_XB); bf16_t* HB = (bf16_t*)(a.ws + WS_HB); const float* MOD = (const float*)(a.ws + WS_MOD);
    int2* TOKE = (int2*)(a.ws + WS_TOKE); float2* TOKW = (float2*)(a.ws + WS_TOKW);
    const int eg = wave & 3, rh = wave >> 2;
    f32x4 wk[4][4];
#pragma unroll
    for (int j = 0; j < 4; ++j)
#pragma unroll
        for (int c = 0; c < 4; ++c) wk[j][c] = *(const f32x4*)(a.in[I_RW] + (size_t)(256 * j + 4 * lane + c) * 16 + 4 * eg);
    f32x4 ga[4], gb[4]; int cur_ctx = -1;
#define N2_PARAMS(isctx_) do { if ((int)(isctx_) != cur_ctx) { cur_ctx = (int)(isctx_); const f32x4* g_ = (const f32x4*)(a.in[I_GFFN] + l * DM) + lane; const float* md_ = MOD + (l * 2 + cur_ctx) * 6144; \
        _Pragma("unroll") for (int j = 0; j < 4; ++j) { ga[j] = g_[64 * j] * (((const f32x4*)(md_ + 4 * 1024) + lane)[64 * j] + 1.f); gb[j] = ((const f32x4*)(md_ + 3 * 1024) + lane)[64 * j]; } } } while (0)
    u32x2 xr[2][4];
#define N2_LOADX(rb_) do { _Pragma("unroll") for (int k = 0; k < 2; ++k) { const bf16_t* xb = XB + (size_t)N2_ROW(min((rb_) + 2 * wave + k, nloc - 1)) * DM + 4 * lane; \
        _Pragma("unroll") for (int j = 0; j < 4; ++j) xr[k][j] = *(const u32x2*)(xb + 256 * j); } } while (0)
    const bool cfirst = (l != 1) && nlat < 16;
    if (cfirst) N2_WAIT(tl, tl);
    N2_LOADX(0);
    for (int rb = 0; rb < nloc; rb += 16) {
        if ((l != 1) && !cfirst && rb <= nlat && nlat < rb + 16) { N2_WAIT(tl, tl); N2_LOADX(rb); }
        f32x4 vv[2][4];
#pragma unroll
        for (int k = 0; k < 2; ++k)
#pragma unroll
            for (int j = 0; j < 4; ++j) { const u32x2 w = xr[k][j]; vv[k][j] = (f32x4){__builtin_bit_cast(float, w.x << 16), __builtin_bit_cast(float, w.x & 0xffff0000u), __builtin_bit_cast(float, w.y << 16), __builtin_bit_cast(float, w.y & 0xffff0000u)}; }
#pragma unroll
        for (int k = 0; k < 2; ++k) { const int row = N2_ROW(min(rb + 2 * wave + k, nloc - 1)); const bool isctx = row >= SEQ, st = rb + 2 * wave + k < nloc;
            float ss = 0.f;
#pragma unroll
            for (int j = 0; j < 4; ++j) ss += (vv[k][j].x * vv[k][j].x + vv[k][j].y * vv[k][j].y) + (vv[k][j].z * vv[k][j].z + vv[k][j].w * vv[k][j].w);
            const float rstd = 1.f / sqrtf(wave_sum(ss) * (1.f / DM) + EPS);
            N2_PARAMS(isctx);
            u32x2* o8 = (u32x2*)(HB + (size_t)row * DM) + lane; f32x4* hr = (f32x4*)(hrow + (2 * wave + k) * 1024) + lane;
#pragma unroll
            for (int j = 0; j < 4; ++j) { const f32x4 h = vv[k][j] * rstd * ga[j] + gb[j];
                hr[64 * j] = h; u32x2 w; w.x = cvt_pk_bf16(h.x, h.y); w.y = cvt_pk_bf16(h.z, h.w); if (st) o8[64 * j] = w; } }
        __syncthreads();
        if (rb + 16 < nloc && !((l != 1) && rb + 16 <= nlat && nlat < rb + 32)) N2_LOADX(rb + 16);
        float v32[32];
#pragma unroll
        for (int q2 = 0; q2 < 4; ++q2) {
            f32x4 h[2][4];
#pragma unroll
            for (int qq = 0; qq < 2; ++qq) { const f32x4* hr = (const f32x4*)(hrow + (rh * 8 + q2 * 2 + qq) * 1024) + lane;
#pragma unroll
                for (int j = 0; j < 4; ++j) h[qq][j] = hr[64 * j]; }
            asm volatile("" : "+v"(h[0][0]), "+v"(h[0][1]), "+v"(h[0][2]), "+v"(h[0][3]), "+v"(h[1][0]), "+v"(h[1][1]), "+v"(h[1][2]), "+v"(h[1][3]));
#pragma unroll
            for (int qq = 0; qq < 2; ++qq) { const int q = q2 * 2 + qq; f32x4 acc = {0.f, 0.f, 0.f, 0.f};
#pragma unroll
                for (int j = 0; j < 4; ++j)
#pragma unroll
                    for (int e = 0; e < 4; ++e) { acc[e] = __builtin_fmaf(h[qq][j].x, wk[j][0][e], acc[e]); acc[e] = __builtin_fmaf(h[qq][j].y, wk[j][1][e], acc[e]); acc[e] = __builtin_fmaf(h[qq][j].z, wk[j][2][e], acc[e]); acc[e] = __builtin_fmaf(h[qq][j].w, wk[j][3][e], acc[e]); }
                v32[q * 4] = acc[0]; v32[q * 4 + 1] = acc[1]; v32[q * 4 + 2] = acc[2]; v32[q * 4 + 3] = acc[3]; } }
        float v16[16], v8[8], v4[4], v2[2], v1;
        { float sh[16], kp[16]; const bool up = (lane & 32) != 0;
#pragma unroll
          for (int i = 0; i < 16; ++i) { const float lo_ = v32[i], hi_ = v32[16 + i]; kp[i] = up ? hi_ : lo_; sh[i] = __shfl_xor(up ? lo_ : hi_, 32); }
          asm volatile("" : "+v"(sh[0]), "+v"(sh[1]), "+v"(sh[2]), "+v"(sh[3]), "+v"(sh[4]), "+v"(sh[5]), "+v"(sh[6]), "+v"(sh[7]));
          asm volatile("" : "+v"(sh[8]), "+v"(sh[9]), "+v"(sh[10]), "+v"(sh[11]), "+v"(sh[12]), "+v"(sh[13]), "+v"(sh[14]), "+v"(sh[15]));
#pragma unroll
          for (int i = 0; i < 16; ++i) v16[i] = kp[i] + sh[i]; }
        { float sh[8], kp[8]; const bool up = (lane & 16) != 0;
#pragma unroll
          for (int i = 0; i < 8; ++i) { const float lo_ = v16[i], hi_ = v16[8 + i]; kp[i] = up ? hi_ : lo_; sh[i] = __shfl_xor(up ? lo_ : hi_, 16); }
          asm volatile("" : "+v"(sh[0]), "+v"(sh[1]), "+v"(sh[2]), "+v"(sh[3]), "+v"(sh[4]), "+v"(sh[5]), "+v"(sh[6]), "+v"(sh[7]));
#pragma unroll
          for (int i = 0; i < 8; ++i) v8[i] = kp[i] + sh[i]; }
        { float sh[4], kp[4]; const bool up = (lane & 8) != 0;
#pragma unroll
          for (int i = 0; i < 4; ++i) { const float lo_ = v8[i], hi_ = v8[4 + i]; kp[i] = up ? hi_ : lo_; sh[i] = __shfl_xor(up ? lo_ : hi_, 8); }
          asm volatile("" : "+v"(sh[0]), "+v"(sh[1]), "+v"(sh[2]), "+v"(sh[3]));
#pragma unroll
          for (int i = 0; i < 4; ++i) v4[i] = kp[i] + sh[i]; }
        { float sh[2], kp[2]; const bool up = (lane & 4) != 0;
#pragma unroll
          for (int i = 0; i < 2; ++i) { const float lo_ = v4[i], hi_ = v4[2 + i]; kp[i] = up ? hi_ : lo_; sh[i] = __shfl_xor(up ? lo_ : hi_, 4); }
          asm volatile("" : "+v"(sh[0]), "+v"(sh[1]));
#pragma unroll
          for (int i = 0; i < 2; ++i) v2[i] = kp[i] + sh[i]; }
        { const bool up = (lane & 2) != 0; v1 = (up ? v2[1] : v2[0]) + __shfl_xor(up ? v2[0] : v2[1], 2); }
        v1 += __shfl_xor(v1, 1);
        { const int I = (lane >> 1) & 31, q = I >> 2, e = I & 3; const int rl = rh * 8 + q;
          if ((lane & 1) == 0 && rb + rl < nloc) logit[(rb + rl) * 16 + 4 * eg + e] = v1; }
        __syncthreads();
    }
#undef N2_LOADX
#undef N2_WAIT
#undef N2_PARAMS
    if (wave < 2) { const int rowl = wave * 64 + lane, row = N2_ROW(rowl);
      if (rowl < nloc) {
        float lg[16];
#pragma unroll
        for (int q = 0; q < 4; ++q) { const f32x4 t = *(const f32x4*)(logit + rowl * 16 + 4 * q); lg[4 * q] = t.x; lg[4 * q + 1] = t.y; lg[4 * q + 2] = t.z; lg[4 * q + 3] = t.w; }
        float sg[16], bs[16];
#pragma unroll
        for (int e = 0; e < 16; ++e) { sg[e] = sigmoid_f(lg[e]); bs[e] = sg[e] + a.in[I_RB][e]; }
        int gsel = 0; float best = 0.f;
#pragma unroll
        for (int gi = 0; gi < 4; ++gi) { const float p_ = bs[4 * gi], q_ = bs[4 * gi + 1], r_ = bs[4 * gi + 2], s_ = bs[4 * gi + 3];
            const float h1 = fmaxf(p_, q_), l1 = fminf(p_, q_), h2 = fmaxf(r_, s_), l2 = fminf(r_, s_);
            const float gsc = fmaxf(h1, h2) + fmaxf(fminf(h1, h2), fmaxf(l1, l2));
            if (gi == 0 || gsc > best) { best = gsc; gsel = gi; } }
        float gb[4], gs4[4];
#pragma unroll
        for (int i = 0; i < 4; ++i) { gb[i] = gsel == 0 ? bs[i] : gsel == 1 ? bs[4 + i] : gsel == 2 ? bs[8 + i] : bs[12 + i];
            gs4[i] = gsel == 0 ? sg[i] : gsel == 1 ? sg[4 + i] : gsel == 2 ? sg[8 + i] : sg[12 + i]; }
        int i0 = 0; float b0 = gb[0];
#pragma unroll
        for (int i = 1; i < 4; ++i) if (gb[i] > b0) { b0 = gb[i]; i0 = i; }
        int i1 = -1; float b1 = 0.f;
#pragma unroll
        for (int i = 0; i < 4; ++i) if (i != i0 && (i1 < 0 || gb[i] > b1)) { b1 = gb[i]; i1 = i; }
        const float s0 = i0 == 0 ? gs4[0] : i0 == 1 ? gs4[1] : i0 == 2 ? gs4[2] : gs4[3];
        const float s1 = i1 == 0 ? gs4[0] : i1 == 1 ? gs4[1] : i1 == 2 ? gs4[2] : gs4[3];
        const int e0 = gsel * 4 + i0, e1 = gsel * 4 + i1; const float inv = 1.f / (s0 + s1);
        TOKE[row] = make_int2(e0, e1); TOKW[row] = make_float2(s0 * inv, s1 * inv); e01[rowl] = e0 | (e1 << 8);
      } }
    __syncthreads();
    if (wave == 0) {
        int cnt = 0;
        for (int p = 0; p < 2; ++p) { const int pk = e01[p * 64 + lane]; const int e0 = pk < 0 ? -1 : (pk & 255), e1 = pk < 0 ? -1 : (pk >> 8);
#pragma unroll
            for (int e = 0; e < 16; ++e) { const int c = __popcll(__ballot(e0 == e)) + __popcll(__ballot(e1 == e)); if (lane == e) cnt += c; } }
        int base = 0;
        if (lane < 16) base = (int)__hip_atomic_fetch_add((unsigned*)(a.ws + WS_CTL) + CW_TOT + l * 64 + lane, (unsigned)cnt, __ATOMIC_RELAXED, __HIP_MEMORY_SCOPE_AGENT);
        int run[16];
#pragma unroll
        for (int e = 0; e < 16; ++e) run[e] = __builtin_amdgcn_readlane(base, e);
        int2* TOKP = (int2*)(a.ws + WS_TOKP); int* ROWTOK2 = (int*)(a.ws + WS_ROWTOK2) + (size_t)l * 16 * ROWCAP;
        for (int p = 0; p < 2; ++p) { const int i = p * 64 + lane, row = N2_ROW(i); const int pk = e01[i]; const bool ok = pk >= 0;
            const int ex = ok ? (pk & 255) : -1, ey = ok ? (pk >> 8) : -1;
            int pos0 = 0, pos1 = 0; const unsigned long long lt = (1ull << lane) - 1ull;
#pragma unroll
            for (int e = 0; e < 16; ++e) { const unsigned long long m0 = __ballot(ex == e), m1 = __ballot(ey == e);
                if (ex == e) pos0 = run[e] + __popcll(m0 & lt);
                if (ey == e) pos1 = run[e] + __popcll(m0) + __popcll(m1 & lt);
                run[e] += __popcll(m0) + __popcll(m1); }
            if (ok) { TOKP[row] = make_int2(ex * 32768 + pos0, ey * 32768 + pos1); ROWTOK2[ex * ROWCAP + pos0] = row; ROWTOK2[ey * ROWCAP + pos1] = row; } }
    }
    __syncthreads();
#undef N2_ROW
}
#ifndef ATT
#define ATT att2
#endif
#ifndef REP_INPROJ
#define REP_INPROJ 1
#endif
#ifndef REP_ATTN
#define REP_ATTN 1
#endif
#ifndef REP_OUTPROJ
#define REP_OUTPROJ 1
#endif
#ifndef REP_N2SC
#define REP_N2SC 1
#endif
#ifndef REP_MOE
#define REP_MOE 1
#endif
template <class Inner> struct RepOrder { Inner in; int ntot;
    __device__ __forceinline__ bool next(int i, pg8::Unit& u) const { if (i >= ntot) return false; const int nl = in.nloc(); return in.next(i % nl, u); }
    __device__ __forceinline__ unsigned row_off(int r) const { return in.row_off(r); }
    __device__ __forceinline__ void a_ready(const pg8::Unit&) const {}
    __device__ __forceinline__ void done(const pg8::Unit&) const {} };

__device__ __forceinline__ bool wg_any(bool pred, int* ws, int wid, int lane) {
    const int w = __any(pred) ? 1 : 0;
    __syncthreads();
    if (lane == 0) ws[wid] = w;
    __syncthreads();
    int r = 0;
#pragma unroll
    for (int i = 0; i < NWAVES; ++i) r |= ws[i];
    __syncthreads();
    return r != 0;
}
__device__ __forceinline__ void diff_unit(const Args& a, int l, int qt, int head, char* lds) {
    int tid_ = otid();
    const int tid = tid_, wid = tid >> 6, lane = tid & 63;
    const bool isctx = qt >= 64; const int q0 = qt * 256, nA = isctx ? 4 : 260, a0 = isctx ? SEQ : 0;
    const bf16_t* QA = (const bf16_t*)(a.ws + RA_QA); const bf16_t* KA = (const bf16_t*)(a.ws + RA_KA); const bf16_t* VA = (const bf16_t*)(a.ws + RA_VA);
    bf16_t* MIX = (bf16_t*)(a.ws + WS_HB);
    float* stash0 = (float*)(a.ws + WS_RB) + (size_t)blockIdx.x * 256 * 128;
    float* wsf = (float*)(lds + ATT::LDS_WS) + wid * 64;
    const float lam = ((const float*)(a.ws + WS_LAM))[l], post = 1.f - LAMBDA_INIT[l];
    for (int map = 0; map < 2; ++map) {
        f32x16 o[4]; float m_, l_;
        const bf16_t* Qw_ = QA + (size_t)(q0 + wid * 32 + (lane & 31)) * 512 + head * 128 + map * 64;
        ATT::attn_body<0, 512, 512, false>(Qw_, KA + head * 128 + map * 64, VA + head * 128, nA, a0, 0, nA, 0, lds, tid, o, m_, l_);
        if (wg_any(!(l_ < 1.0e18f), (int*)(lds + ATT::LDS_WS) + 8 * 64, wid, lane)) {
            ATT::attn_body<0, 512, 512, true>(Qw_, KA + head * 128 + map * 64, VA + head * 128, nA, a0, 0, nA, 0, lds, tid, o, m_, l_); }
        int lo_ = lane; asm volatile("" : "+v"(lo_));
        const int r32 = lo_ & 31, hi = lo_ >> 5;
        float* stashv = stash0 + (size_t)((wid << 6) | lo_) * 4;
        if (hi == 0) wsf[r32] = l_;
        LDS_WAIT();
        float rli[16];
#pragma unroll
        for (int r = 0; r < 16; ++r) rli[r] = __builtin_amdgcn_rcpf(wsf[ATT::crow(r, hi)]);
        if (map == 0) {
#pragma unroll
            for (int d0 = 0; d0 < 4; ++d0)
#pragma unroll
                for (int rq = 0; rq < 4; ++rq) *(f32x4*)(stashv + (size_t)((d0 * 4 + rq) * NTHREADS) * 4) =
                    (f32x4){o[d0][4 * rq] * rli[4 * rq], o[d0][4 * rq + 1] * rli[4 * rq + 1], o[d0][4 * rq + 2] * rli[4 * rq + 2], o[d0][4 * rq + 3] * rli[4 * rq + 3]};
        } else {
            const float* gn = a.in[I_DNG] + l * 128;
            float g4[4];
#pragma unroll
            for (int d0 = 0; d0 < 4; ++d0) g4[d0] = gn[d0 * 32 + r32] * post;
            float ss[16];
#pragma unroll
            for (int r = 0; r < 16; ++r) { ss[r] = 0.f; const float f_ = lam * rli[r];
#pragma unroll
                for (int d0 = 0; d0 < 4; ++d0) o[d0][r] *= f_; }
#pragma unroll
            for (int d0 = 0; d0 < 4; ++d0) {
                f32x4 sv[4];
#pragma unroll
                for (int rq = 0; rq < 4; ++rq) sv[rq] = *(const f32x4*)(stashv + (size_t)((d0 * 4 + rq) * NTHREADS) * 4);
                asm volatile("" : "+v"(sv[0]), "+v"(sv[1]), "+v"(sv[2]), "+v"(sv[3]));
#pragma unroll
                for (int rq = 0; rq < 4; ++rq)
#pragma unroll
                    for (int j = 0; j < 4; ++j) { const int r = 4 * rq + j; const float oc = sv[rq][j] - o[d0][r]; o[d0][r] = oc; ss[r] += oc * oc; } }
            float s8[8], s4[4], s2[2], s1;
#pragma unroll
            for (int i = 0; i < 8; ++i) { const bool up = (lo_ & 16) != 0; s8[i] = (up ? ss[8 + i] : ss[i]) + __shfl_xor(up ? ss[i] : ss[8 + i], 16); }
#pragma unroll
            for (int i = 0; i < 4; ++i) { const bool up = (lo_ & 8) != 0; s4[i] = (up ? s8[4 + i] : s8[i]) + __shfl_xor(up ? s8[i] : s8[4 + i], 8); }
#pragma unroll
            for (int i = 0; i < 2; ++i) { const bool up = (lo_ & 4) != 0; s2[i] = (up ? s4[2 + i] : s4[i]) + __shfl_xor(up ? s4[i] : s4[2 + i], 4); }
            { const bool up = (lo_ & 2) != 0; s1 = (up ? s2[1] : s2[0]) + __shfl_xor(up ? s2[0] : s2[1], 2); }
            s1 += __shfl_xor(s1, 1);
            LDS_WAIT();
            if ((lo_ & 1) == 0) wsf[hi * 16 + ((lo_ >> 1) & 15)] = s1;
            LDS_WAIT();
#pragma unroll
            for (int r = 0; r < 16; ++r) { const float sc = __builtin_amdgcn_rsqf(wsf[hi * 16 + r] * (1.f / 128.f) + EPS);
                bf16_t* orow = MIX + (size_t)(q0 + wid * 32 + ATT::crow(r, hi)) * DM + head * 128 + r32;
#pragma unroll
                for (int d0 = 0; d0 < 4; ++d0) orow[d0 * 32] = (bf16_t)f2bf(o[d0][r] * sc * g4[d0]); }
        }
    }
}
__device__ __forceinline__ void win_unit(const Args& a, int l, int n, int g, char* lds) {
    int tid_ = otid();
    const int tid = tid_, wid = tid >> 6, lane = tid & 63;
    const bool isctx = n >= 128; const int h = 2 * g + (wid >> 2);
    const int rowq = (isctx ? SEQ + (n - 128) * 128 : n * 128) + (wid & 3) * 32;
    const int nB = isctx ? 0 : (6 - (n == 0 ? 2 : 0) - (n == 127 ? 2 : 0)), b0 = (n == 0) ? 0 : (n - 1) * 128;
    const bf16_t* QB = (const bf16_t*)(a.ws + RA_QB); const bf16_t* KB = (const bf16_t*)(a.ws + RA_KB); const bf16_t* VB = (const bf16_t*)(a.ws + RA_VB);
    bf16_t* MIX = (bf16_t*)(a.ws + WS_HB);
    float* wsf = (float*)(lds + ATT::LDS_WS) + wid * 64;
    f32x16 o[4]; float m_, l_;
    const bf16_t* Qw_ = QB + (size_t)(rowq + (lane & 31)) * 256 + h * 64;
    ATT::attn_body<1, 128, 256, false>(Qw_, KB + g * 64, VB + g * 128, 4, SEQ, b0, 4 + nB, rowq + (lane & 31), lds, tid, o, m_, l_);
    if (wg_any(!(l_ < 1.0e18f), (int*)(lds + ATT::LDS_WS) + 8 * 64, wid, lane)) {
        ATT::attn_body<1, 128, 256, true>(Qw_, KB + g * 64, VB + g * 128, 4, SEQ, b0, 4 + nB, rowq + (lane & 31), lds, tid, o, m_, l_); }
    const float ltot = l_ + __builtin_amdgcn_exp2f(a.in[I_SINK][l * 4 + h] * LOG2E - m_);
    int lo_ = lane; asm volatile("" : "+v"(lo_));
    const int r32 = lo_ & 31, hi = lo_ >> 5;
    if (hi == 0) wsf[r32] = ltot;
    LDS_WAIT();
#pragma unroll
    for (int r = 0; r < 16; ++r) { const float rl = __builtin_amdgcn_rcpf(wsf[ATT::crow(r, hi)]);
        bf16_t* orow = MIX + (size_t)(rowq + ATT::crow(r, hi)) * DM + 512 + h * 64 + r32;
        orow[0] = (bf16_t)f2bf(o[0][r] * rl); orow[32] = (bf16_t)f2bf(o[1][r] * rl); }
}
__device__ __forceinline__ void conv_unit(const Args& a, int l, int u, char* lds) {
    int tid_ = otid();
    const int tid = tid_, wid = tid >> 6, lane = tid & 63;
    const bool isctx = u >= 256; const int r0 = isctx ? (u - 256) * 64 : u * 64, rbase = isctx ? SEQ : 0, slen = isctx ? CTX : SEQ;
    const bf16_t* Z = (const bf16_t*)(a.ws + RA_Z); bf16_t* MIX = (bf16_t*)(a.ws + WS_HB);
    bf16_t* zt = (bf16_t*)lds; float* co = (float*)(lds + 49152);
    __syncthreads();
    for (int c = tid; c < 94 * 32; c += NTHREADS) { const int i = c >> 5, ch = c & 31, p = r0 - 15 + i;
        u32x4 v = {0u, 0u, 0u, 0u}; if (p >= 0 && p < slen) v = *(const u32x4*)(Z + (size_t)(rbase + p) * 256 + ch * 8);
        *(u32x4*)(zt + i * 256 + ch * 8) = v; }
    __syncthreads();
    { const int c = tid & 255, t0 = (tid >> 8) * 32; float w[31];
#pragma unroll
      for (int j = 0; j < 31; ++j) w[j] = a.in[I_CONVW][(size_t)(l * 31 + j) * 256 + c];
      const float bias = a.in[I_CONVB][l * 256 + c];
#pragma unroll
      for (int tb = 0; tb < 32; tb += 8) {
          float zr[38]; unsigned zu[38];
#pragma unroll
          for (int i = 0; i < 38; ++i) zu[i] = zt[(t0 + tb + i) * 256 + c];
          asm volatile("" : "+v"(zu[0]), "+v"(zu[1]), "+v"(zu[2]), "+v"(zu[3]), "+v"(zu[4]), "+v"(zu[5]), "+v"(zu[6]), "+v"(zu[7]), "+v"(zu[8]), "+v"(zu[9]), "+v"(zu[10]), "+v"(zu[11]), "+v"(zu[12]));
          asm volatile("" : "+v"(zu[13]), "+v"(zu[14]), "+v"(zu[15]), "+v"(zu[16]), "+v"(zu[17]), "+v"(zu[18]), "+v"(zu[19]), "+v"(zu[20]), "+v"(zu[21]), "+v"(zu[22]), "+v"(zu[23]), "+v"(zu[24]), "+v"(zu[25]));
          asm volatile("" : "+v"(zu[26]), "+v"(zu[27]), "+v"(zu[28]), "+v"(zu[29]), "+v"(zu[30]), "+v"(zu[31]), "+v"(zu[32]), "+v"(zu[33]), "+v"(zu[34]), "+v"(zu[35]), "+v"(zu[36]), "+v"(zu[37]));
#pragma unroll
          for (int i = 0; i < 38; ++i) zr[i] = __builtin_bit_cast(float, zu[i] << 16);
#pragma unroll
          for (int t = 0; t < 8; ++t) { float acc = bias;
#pragma unroll
              for (int j = 0; j < 31; ++j) acc += zr[t + j] * w[j];
              co[(t0 + tb + t) * 256 + c] = acc; } } }
    __syncthreads();
    const f32x4 lg = *(const f32x4*)(a.in[I_LNG] + l * 256 + 4 * lane), lb = *(const f32x4*)(a.in[I_LNB] + l * 256 + 4 * lane);
    { f32x4 v[8]; float s[8]; float* sc8 = (float*)(lds + 114688) + wid * 16;
#pragma unroll
      for (int ti = 0; ti < 8; ++ti) { v[ti] = *(const f32x4*)(co + (wid + ti * NWAVES) * 256 + 4 * lane); s[ti] = (v[ti].x + v[ti].y) + (v[ti].z + v[ti].w); }
#define CONV_SUM8() do { float t4[4], t2[2], t1; \
        _Pragma("unroll") for (int i = 0; i < 4; ++i) { const bool up = (lane & 32) != 0; t4[i] = (up ? s[4 + i] : s[i]) + __shfl_xor(up ? s[i] : s[4 + i], 32); } \
        _Pragma("unroll") for (int i = 0; i < 2; ++i) { const bool up = (lane & 16) != 0; t2[i] = (up ? t4[2 + i] : t4[i]) + __shfl_xor(up ? t4[i] : t4[2 + i], 16); } \
        { const bool up = (lane & 8) != 0; t1 = (up ? t2[1] : t2[0]) + __shfl_xor(up ? t2[0] : t2[1], 8); } \
        t1 += __shfl_xor(t1, 4); t1 += __shfl_xor(t1, 2); t1 += __shfl_xor(t1, 1); \
        LDS_WAIT(); if ((lane & 7) == 0) sc8[lane >> 3] = t1; LDS_WAIT(); \
        _Pragma("unroll") for (int i = 0; i < 8; ++i) s[i] = sc8[i]; } while (0)
      CONV_SUM8();
#pragma unroll
      for (int ti = 0; ti < 8; ++ti) { v[ti] = v[ti] - s[ti] * (1.f / 256.f); s[ti] = (v[ti].x * v[ti].x + v[ti].y * v[ti].y) + (v[ti].z * v[ti].z + v[ti].w * v[ti].w); }
      CONV_SUM8();
#undef CONV_SUM8
#pragma unroll
      for (int ti = 0; ti < 8; ++ti) { const int t = wid + ti * NWAVES; const float rs = __builtin_amdgcn_rsqf(s[ti] * (1.f / 256.f) + EPS);
        const f32x4 zn = v[ti] * rs * lg + lb;
        u32x2 w; w.x = cvt_pk_bf16(silu_f(zn.x), silu_f(zn.y)); w.y = cvt_pk_bf16(silu_f(zn.z), silu_f(zn.w));
        *(u32x2*)(MIX + (size_t)(rbase + r0 + t) * DM + 768 + 4 * lane) = w; } }
    __syncthreads();
}
__device__ __forceinline__ void attn_phase(const Args& a, int l, char* lds, int pass) {
    const int b = blockIdx.x, G = gridDim.x, BIG = 1 << 20;
#ifndef AT_MASK
#define AT_MASK 7
#endif
    const int dst = pass == 0 ? b : (b < 4) ? 256 + b : BIG, wst = pass == 0 ? b : (b >= 4 && b < 8) ? 256 + (b - 4) : BIG, cst = pass == 0 ? b : (b >= 8 && b < 12) ? 256 + (b - 8) : BIG;
    const int uend = pass == 0 ? 256 : 260;
    if (AT_MASK & 1) for (int u = dst; u < uend; u += G) { const int qt = u < 256 ? (u >> 2) : 64, hd = u < 256 ? (u & 3) : (u - 256); diff_unit(a, l, qt, hd, lds); }
    if (AT_MASK & 2) for (int v = wst; v < uend; v += G) { const int n = v < 256 ? (v & 127) : 128 + ((v - 256) & 1), g = v < 256 ? (v >> 7) : ((v - 256) >> 1); win_unit(a, l, n, g, lds); }
    if (AT_MASK & 4) for (int v = cst; v < uend; v += G) conv_unit(a, l, v, lds);
    if (pass == 1 && b < 12) {
        asm volatile("s_waitcnt vmcnt(0)" ::: "memory"); __syncthreads();
        const int tid = otid(); if (tid < 64) { __builtin_amdgcn_fence(__ATOMIC_RELEASE, "agent"); asm volatile("s_waitcnt vmcnt(0)" ::: "memory");
            if (tid == 0) __hip_atomic_fetch_add((gu32*)(a.ws + WS_CTL) + CW_CTXC, 1u, __ATOMIC_RELAXED, __HIP_MEMORY_SCOPE_AGENT); } }
}

#ifndef MK_PER_PHASE
#define MK_PER_PHASE 0
#endif
#if defined(__HIP_DEVICE_COMPILE__)
#define KARGS(A) Args A; { const __attribute__((address_space(4))) Args* kp_ = (const __attribute__((address_space(4))) Args*)__builtin_amdgcn_kernarg_segment_ptr(); asm volatile("" : "+s"(kp_)); A = *kp_; }
#else
#define KARGS(A) Args A = a_unused;
#endif
__global__ void __launch_bounds__(NTHREADS, 2) hybrid_fwd(Args a_unused) {
    unsigned char* lds = g_lds;
    volatile LAS unsigned* MISC = (volatile LAS unsigned*)((LAS unsigned char*)lds + MISC_OFF);
    { const int tid0 = threadIdx.x; if (tid0 < 64) MISC[tid0] = 0u;
      if ((tid0 & 63) == 0) MISC[64 + ((unsigned)__builtin_amdgcn_s_getreg((5 << 11) | 4) & 63u)] = (unsigned)(tid0 >> 6); }
    __syncthreads();
    XcdBarrier bar; int lo, hi;
    { KARGS(a); lo = a.ph_lo; hi = a.ph_hi; gu32* ctl = (gu32*)(a.ws + WS_CTL);
      bar.bar = (unsigned*)(ctl + CW_BAR); bar.x = 0; bar.st = nullptr;
      if (!MK_PER_PHASE) bar = xcd_barrier_post((unsigned*)(ctl + CW_BAR), MISC); }
#ifndef PHMASK
#define PHMASK 0x3ffff
#endif
#define PHK(k) ((k) == 0 ? 0 : (k) == 17 ? 9 : (((k) - 1) & 7) + 1)
#define IN(k) (((PHMASK >> PHK(k)) & 1) && lo <= (k) && (k) < hi)
#define SEAM(k) do { if (!MK_PER_PHASE && IN(k) && IN((k) + 1)) xcd_barrier(bar); } while (0)
    LAS unsigned char* ldsl = (LAS unsigned char*)lds;
    const int G = gridDim.x, vcu = (G % 8 == 0) ? ((int)blockIdx.x % 8) * (G / 8) + (int)blockIdx.x / 8 : (int)blockIdx.x;

#ifndef REP_N1
#define REP_N1 1
#endif
#ifndef REP_SC
#define REP_SC 1
#endif
#ifndef REP_PRO
#define REP_PRO 1
#endif
    if (IN(0)) { KARGS(a); int nrep_ = REP_PRO; asm volatile("" : "+s"(nrep_)); for (int rp_ = 0; rp_ < nrep_; ++rp_) prologue_phase(a, lds); SEAM(0); }
    for (int l = 0; l < DEPTH; ++l) {
        const int pb = 1 + 8 * l;
        if (IN(pb + 0)) {
            KARGS(a);
            { int nrep_ = (l == 0) ? REP_N1 : 1; asm volatile("" : "+s"(nrep_)); for (int rp_ = 0; rp_ < nrep_; ++rp_) norm1_phase(a, l); }
            SEAM(pb + 0);
        }
        if (IN(pb + 1)) {
            KARGS(a);
            pg8::Gemm g{(const bf16_t*)(a.ws + WS_HB), (const bf16_t*)(a.ws + WS_WIN) + (size_t)l * INW * 1024, NROW, INW, DM};
            pg8::StaticOrder S; S.init(NROW, INW, G, (int)blockIdx.x);
            EpiInProj E{a.ws, (const float*)(a.ws + WS_ROPEC), (const float*)(a.ws + WS_ROPES)};
            RepOrder<pg8::StaticOrder> SR{S, REP_INPROJ * S.nloc()}; pg8::gemm_phase<EpiInProj, RepOrder<pg8::StaticOrder>, true, true>(ldsl, g, SR, E);
            if ((int)blockIdx.x >= 650 - 2 * G) {
                const int tid = otid(), c0 = 650 - 2 * G; moe_convert(a, l, (LAS float*)(ldsl + (tid >> 6) * 8704), ((int)blockIdx.x - c0) * NWAVES + (tid >> 6), (G - c0) * NWAVES, tid & 63, 8192, 12288); }
            SEAM(pb + 1);
        }
        if (IN(pb + 2)) { KARGS(a); int npass_ = (l == 0) ? 2 : 1; asm volatile("" : "+s"(npass_)); for (int ps_ = 0; ps_ < npass_; ++ps_) { attn_phase(a, l, (char*)lds, ps_); if (ps_ == 0) SEAM(pb + 2); } }
        if (IN(pb + 3)) {
            KARGS(a);
            const float* MOD = (const float*)(a.ws + WS_MOD);
            const int M = (l == DEPTH - 1) ? SEQ : NROW;
            pg8::Gemm g{(const bf16_t*)(a.ws + WS_HB), (const bf16_t*)(a.ws + WS_WOUT) + (size_t)l * 1024 * 1024, M, DM, DM};
            pg8::StaticOrder S; if (l == 0) S.init(61 * 256, DM, G - 12, (int)blockIdx.x - 12); else S.init(SEQ, DM, G, (int)blockIdx.x);
            EpiOutProj E{a.in[I_X], a.in[I_CTX], (bf16_t*)(a.ws + WS_XB), MOD + (l * 2) * 6144 + 2 * 1024, MOD + (l * 2 + 1) * 6144 + 2 * 1024, l};
            OutOrder SO{S, (gu32*)(a.ws + WS_CTL) + CW_OPC + l * 128, (l == 0) ? (gu32*)(a.ws + WS_CTL) + CW_CTXC : nullptr}; pg8::gemm_phase<EpiOutProj, OutOrder, true, true>(ldsl, g, SO, E);
            if (l == 0 && (int)blockIdx.x >= 16) {
                const int tid = otid(), nidle = G - 16; moe_convert(a, 1, (LAS float*)(ldsl + (tid >> 6) * 8704), ((int)blockIdx.x - 16) * NWAVES + (tid >> 6), nidle * NWAVES, tid & 63, 0, 8192); }
            __syncthreads();
        }
        if (IN(pb + 4)) { KARGS(a); int nrep_ = REP_N2SC; asm volatile("" : "+s"(nrep_)); for (int rp_ = 0; rp_ < nrep_; ++rp_) norm2_phase(a, l, lds); SEAM(pb + 4); }
        if (IN(pb + 6)) {
            KARGS(a);
            MoeOrder S; S.G = G; S.vcu = vcu;
            { const int tid = otid(); const unsigned* tot = (const unsigned*)(a.ws + WS_CTL) + CW_TOT + l * 64;
              if (tid == 0) { int t = 0; int* tsg = (int*)(a.ws + WS_TSG) + l * 32;
                  for (int e = 0; e < 16; ++e) { MISC[16 + e] = (unsigned)t; if (blockIdx.x == 0) tsg[e] = t; t += ((int)tot[e] + 255) >> 8; }
                  MISC[32] = (unsigned)t; if (blockIdx.x == 0) tsg[16] = t; }
              __syncthreads();
#pragma unroll
              for (int k = 0; k < 16; ++k) S.ts[k] = __builtin_amdgcn_readfirstlane((int)MISC[16 + k]);
              S.nunits = 4 * __builtin_amdgcn_readfirstlane((int)MISC[16 + 16]); }
            S.rowtok = (const int*)(a.ws + WS_ROWTOK2) + (size_t)l * 16 * ROWCAP;
            pg8::Gemm g{(const bf16_t*)(a.ws + WS_HB), (const bf16_t*)(a.ws + WS_W13) + (size_t)l * 16 * 1024 * 1024, XS_ROWS, 1024, DM};
            EpiMoe1 E{(bf16_t*)(a.ws + WS_RB)};
            pg8::gemm_phase<EpiMoe1, MoeOrder, true, true, true>(ldsl, g, S, E);
            gu32* flag = (gu32*)(a.ws + WS_CTL) + CW_MOEF + l * 256;
            { const int tid = otid(); if (tid == 0) __hip_atomic_store(flag + vcu, 1u, __ATOMIC_RELAXED, __HIP_MEMORY_SCOPE_AGENT); }
            MoeOrder2 S2; S2.vcu = vcu; S2.nunits = S.nunits;
#pragma unroll
            for (int k2 = 0; k2 < 16; ++k2) S2.ts[k2] = S.ts[k2];
            pg8::Gemm g2{(const bf16_t*)(a.ws + WS_RB), (const bf16_t*)(a.ws + WS_W2) + (size_t)l * 16 * 1024 * 512, XS_ROWS, 1024, FFE};
            EpiMoe2 E2{a.ws + WS_RA};
            const int r_ = S.nunits & 255;
            if (vcu >= r_ && S.nunits >= 256) { moe_wait(flag, vcu & ~3, 4); S2.part = 0; pg8::gemm_phase<EpiMoe2, MoeOrder2, true, true>(ldsl, g2, S2, E2); }
            if (r_ != 0) { moe_wait(flag, 0, r_); S2.part = 1; pg8::gemm_phase<EpiMoe2, MoeOrder2, true, true>(ldsl, g2, S2, E2); }
            SEAM(pb + 6);
        }
    }
    if (IN(17)) { KARGS(a); int nrep_ = REP_N1; asm volatile("" : "+s"(nrep_)); for (int rp_ = 0; rp_ < nrep_; ++rp_) norm1_phase(a, 2); }
#undef IN
#undef SEAM
}

extern "C" void kernel_launch(void* const* d_in, const int* in_sizes, int n_in, void* d_out, int out_size, void* d_ws, size_t ws_size, hipStream_t stream) {
    static int grid = 0;
    if (grid == 0) {
        if (n_in != 23 || in_sizes[0] != SEQ * DM || out_size != SEQ * DM || ws_size < WS_END) {
            fprintf(stderr, "kernel_launch: shape mismatch (n_in %d, in0 %d, out %d, ws %zu, need ws >= %zu); nothing launched\n", n_in, n_in > 0 ? in_sizes[0] : -1, out_size, ws_size, (size_t)WS_END); grid = -1; return; }
        int dev = 0, cus = 0, per_cu = 0;
        if (hipGetDevice(&dev) != hipSuccess || hipDeviceGetAttribute(&cus, hipDeviceAttributeMultiprocessorCount, dev) != hipSuccess) { fprintf(stderr, "kernel_launch: device query failed\n"); grid = -1; return; }
        if (hipFuncSetAttribute((const void*)hybrid_fwd, hipFuncAttributeMaxDynamicSharedMemorySize, LDS_BYTES) != hipSuccess) { fprintf(stderr, "kernel_launch: hipFuncSetAttribute failed\n"); grid = -1; return; }
        if (hipOccupancyMaxActiveBlocksPerMultiprocessor(&per_cu, (const void*)hybrid_fwd, NTHREADS, LDS_BYTES) != hipSuccess || per_cu < 1) { fprintf(stderr, "kernel_launch: occupancy query reports %d blocks per CU\n", per_cu); grid = -1; (void)hipGetLastError(); return; }
        if (cus != 256) { fprintf(stderr, "kernel_launch: built for 256 CUs, device has %d\n", cus); grid = -1; return; }
        grid = cus;
    }
    if (grid < 0) return;
    if (hipMemsetAsync((char*)d_ws + WS_CTL, 0, CTL_ZERO_BYTES, stream) != hipSuccess) { fprintf(stderr, "kernel_launch: memset failed\n"); return; }
    Args a{};
    for (int i = 0; i < 23; ++i) a.in[i] = (const float*)d_in[i];
    a.out = (float*)d_out; a.ws = (unsigned char*)d_ws;
#if MK_PER_PHASE
    for (int p = 0; p < N_PHASES; ++p) { a.ph_lo = p; a.ph_hi = p + 1; hipLaunchKernelGGL(hybrid_fwd, dim3(grid), dim3(NTHREADS), LDS_BYTES, stream, a); }
#else
    a.ph_lo = 0; a.ph_hi = N_PHASES;
    hipLaunchKernelGGL(hybrid_fwd, dim3(grid), dim3(NTHREADS), LDS_BYTES, stream, a);
#endif
    const hipError_t le = hipPeekAtLastError();
    if (le != hipSuccess) fprintf(stderr, "kernel_launch: launch failed: %s\n", hipGetErrorName(le));
}
```

```cpp
#define MK_PER_PHASE 0
#include <hip/hip_runtime.h>
#include <cstdio>
#include <cstdint>

#define GAS __attribute__((address_space(1)))
#define LAS __attribute__((address_space(3)))
typedef unsigned short bf16_t;
typedef short bf16x8 __attribute__((ext_vector_type(8)));
typedef short s16x4 __attribute__((ext_vector_type(4)));
typedef float f32x2 __attribute__((ext_vector_type(2)));
typedef float f32x4 __attribute__((ext_vector_type(4)));
typedef float f32x16 __attribute__((ext_vector_type(16)));
typedef unsigned u32x2 __attribute__((ext_vector_type(2)));
typedef unsigned u32x4 __attribute__((ext_vector_type(4)));
typedef GAS unsigned gu32;

constexpr int SEQ = 16384, CTX = 256, NROW = SEQ + CTX, DM = 1024, INW = 2560, NEXP = 16, FFE = 512, DEPTH = 2;
constexpr int XS_ROWS = 37376;
constexpr float EPS = 1e-6f, LOG2E = 1.4426950408889634f, QSCALE = 0.125f * 1.4426950408889634f;
constexpr int NWAVES = 8, NTHREADS = 512;

constexpr size_t MiB = 1u << 20;
constexpr size_t WS_CTL = 0, CTL_ZERO_BYTES = 128 * 1024;
constexpr size_t WS_MOD = 1 * MiB;
constexpr size_t WS_ROPEC = WS_MOD + 128 * 1024, WS_ROPES = WS_MOD + 192 * 1024;
constexpr size_t WS_LAM = WS_MOD + 256 * 1024;
constexpr size_t WS_CNT = WS_MOD + 320 * 1024;
constexpr size_t WS_TSG = WS_MOD + 384 * 1024;
constexpr size_t WS_TOKE = 2 * MiB, WS_TOKW = 2 * MiB + 256 * 1024, WS_TOKP = 2 * MiB + 512 * 1024;
constexpr size_t WS_ROWTOK = 3 * MiB;
constexpr size_t WS_WIN = 4 * MiB;
constexpr size_t WS_WOUT = 14 * MiB;
constexpr size_t WS_W13 = 18 * MiB;
constexpr size_t WS_W2 = 82 * MiB;
constexpr size_t WS_XB = 114 * MiB;
constexpr size_t WS_HB = 179 * MiB;
constexpr size_t WS_RA = 212 * MiB;
constexpr size_t RA_QA = WS_RA, RA_KA = RA_QA + (size_t)NROW * 512 * 2, RA_VA = RA_KA + (size_t)NROW * 512 * 2;
constexpr size_t RA_QB = RA_VA + (size_t)NROW * 512 * 2, RA_KB = RA_QB + (size_t)NROW * 256 * 2, RA_VB = RA_KB + (size_t)NROW * 128 * 2;
constexpr size_t RA_Z = RA_VB + (size_t)NROW * 256 * 2, RA_END = RA_Z + (size_t)NROW * 256 * 2;
constexpr size_t WS_RB = 290 * MiB;
constexpr size_t WS_ROWTOK2 = 327 * MiB;
constexpr size_t WS_END = 330 * MiB;
static_assert(RA_END <= WS_RB && WS_RA + (size_t)XS_ROWS * 2048 <= WS_RB && WS_RB + (size_t)XS_ROWS * 1024 <= WS_END && WS_RB + (size_t)256 * 256 * 128 * 4 <= WS_END, "ws map");
static_assert(WS_XB + (size_t)NROW * DM * 4 <= WS_HB && WS_HB + (size_t)NROW * DM * 2 <= WS_RA && WS_W13 + (size_t)2 * 16 * 1024 * 1024 * 2 <= WS_W2 && WS_W2 + (size_t)2 * 16 * 1024 * 512 * 2 <= WS_XB, "ws map 2");
constexpr int ROWCAP = 16640;
constexpr int CW_TOT = 24576;
constexpr int CW_MOEF = 28672;
constexpr int CW_OPC = 30720;
constexpr int CW_CTXC = 31232;
constexpr int CW_BAR = 4096;

constexpr int RING_BYTES = 131072;
constexpr int MISC_OFF = RING_BYTES;
constexpr int LDS_BYTES = 147456;

#define LDS_WAIT() asm volatile("s_waitcnt lgkmcnt(0)" ::: "memory")
#define VM_WAIT() asm volatile("s_waitcnt vmcnt(0)" ::: "memory")
__device__ __forceinline__ unsigned f2bf(float f) { unsigned u = __builtin_bit_cast(unsigned, f); return (u + 0x7fffu + ((u >> 16) & 1u)) >> 16; }
__device__ __forceinline__ unsigned pk2(float lo, float hi) { return f2bf(lo) | (f2bf(hi) << 16); }
__device__ __forceinline__ float bf2f(unsigned short b) { return __builtin_bit_cast(float, (unsigned)b << 16); }
__device__ __forceinline__ unsigned cvt_pk_bf16(float lo, float hi) { unsigned r; asm volatile("v_cvt_pk_bf16_f32 %0, %1, %2" : "=v"(r) : "v"(lo), "v"(hi)); return r; }
__device__ __forceinline__ float wave_sum(float v) {
#pragma unroll
    for (int o = 1; o < 64; o <<= 1) v += __shfl_xor(v, o);
    return v;
}
__device__ __forceinline__ f32x4 ld4bf(const bf16_t* p) { const u32x2 w = *(const u32x2*)p; return (f32x4){__builtin_bit_cast(float, w.x << 16), __builtin_bit_cast(float, w.x & 0xffff0000u), __builtin_bit_cast(float, w.y << 16), __builtin_bit_cast(float, w.y & 0xffff0000u)}; }
__device__ __forceinline__ void st4bf(bf16_t* p, const f32x4 v) { u32x2 w; w.x = cvt_pk_bf16(v.x, v.y); w.y = cvt_pk_bf16(v.z, v.w); *(u32x2*)p = w; }
__device__ __forceinline__ float silu_f(float a) { return a * __builtin_amdgcn_rcpf(1.f + __builtin_amdgcn_exp2f(-a * LOG2E)); }
__device__ __forceinline__ float sigmoid_f(float a) { return __builtin_amdgcn_rcpf(1.f + __builtin_amdgcn_exp2f(-a * LOG2E)); }
extern __shared__ __attribute__((aligned(16))) unsigned char g_lds[];
__device__ __forceinline__ int otid() {
    const unsigned slot = (unsigned)__builtin_amdgcn_s_getreg((5 << 11) | 4) & 63u;
    const int wave = ((const volatile LAS int*)((LAS unsigned char*)g_lds + MISC_OFF + 256))[slot];
    int ln; asm volatile("v_mbcnt_lo_u32_b32 %0, -1, 0\n\tv_mbcnt_hi_u32_b32 %0, -1, %0" : "=v"(ln));
    int t = (wave << 6) | ln;
    asm volatile("" : "+v"(t)); return t; }
namespace pg8 {
#define PG8_LAS __attribute__((address_space(3)))
constexpr int BM = 256, BK = 64, HALF = 128, HTB = HALF * BK * 2  , STAGE_BYTES = 8 * HTB, NXCD = 8, WGM = 8;

__host__ __device__ __forceinline__ int lds_byte(int r, int c) { const int st = (r >> 4) * 2 + (c >> 5), rr = r & 15, cc = c & 31, ob = rr * 64 + cc * 2; return st * 1024 + (ob ^ (((ob >> 9) & 1) << 5)); }
__host__ __device__ __forceinline__ void stage_rc(int b, int& R, int& C) { const int st = b / 1024, sb = b % 1024, swz = sb ^ (((sb >> 9) & 1) << 5); R = (st >> 1) * 16 + swz / 64; C = (st & 1) * 32 + (swz % 64) / 2; }
__host__ __device__ __forceinline__ int perm32(int rho) { const int n = rho >> 4, i = rho & 15; return 8 * (i >> 2) + 4 * n + (i & 3); }

struct Unit { int pm, pn, aux; };
struct Gemm { const bf16_t* A; const bf16_t* Bt; int M, N, K; };

struct StaticOrder {
    int nM, nN, nwg, G, c;
    __host__ __device__ void init(int M, int N, int G_, int c_) { nM = M / BM; nN = N / BM; nwg = nM * nN; G = G_; c = c_; }
    __host__ __device__ bool next(int i, Unit& u) const {
        const long L = (long)i * G + c; if (L >= nwg) return false;
        int wgid = (int)L; { const int q = nwg / NXCD, r = nwg % NXCD, xcd = wgid % NXCD, off = wgid / NXCD; wgid = (xcd < r ? xcd * (q + 1) : r * (q + 1) + (xcd - r) * q) + off; }
        const int nig = WGM * nN, gid = wgid / nig, fm = gid * WGM, gsz = (nM - fm) < WGM ? (nM - fm) : WGM;
        u.pm = fm + ((wgid % nig) % gsz); u.pn = (wgid % nig) / gsz; return true;
    }
    __host__ __device__ __forceinline__ int nloc() const { return c < nwg ? (nwg - c + G - 1) / G : 0; }
    __device__ __forceinline__ void a_ready(const Unit&) const {}
    __device__ __forceinline__ void done(const Unit&) const {}
};
template <class Epi, class Sched, bool ALIGN_EPI = false, bool SP2 = false, bool GATHER = false, bool HALFN = false>
__device__ __forceinline__ void gemm_phase(PG8_LAS unsigned char* lds, const Gemm g, const Sched& S, const Epi& E) {
    const int tid = otid(), wid = __builtin_amdgcn_readfirstlane(tid >> 6), lane = tid & 63, wr = wid >> 2, wc = wid & 3, fr = lane & 15, fq = lane >> 4;
    const int K = g.K, nt = K / BK;
    unsigned voffA[2], voffB[2]; int rowA[2]; unsigned colA[2];
#pragma unroll
    for (int i = 0; i < 2; ++i) { int R, C; stage_rc(tid * 16 + i * 8192, R, C); const int Rb = Epi::PERM ? ((R & ~31) + perm32(R & 31)) : R;
        voffA[i] = (unsigned)(R * K + C) * 2u; voffB[i] = (unsigned)(Rb * K + C) * 2u; rowA[i] = R; colA[i] = (unsigned)C * 2u; }
    unsigned gc[2][2], gn[2][2];
#define PG8_GOFFS(dst, u) do { _Pragma("unroll") for (int h_ = 0; h_ < 2; ++h_) _Pragma("unroll") for (int i_ = 0; i_ < 2; ++i_) dst[h_][i_] = S.row_off((u), h_ * HALF + rowA[i_]) + colA[i_]; } while (0)
    const size_t kstep = (size_t)(BK * 2);
    const size_t hstep = (size_t)HALF * K * 2;
    const size_t tstep = 2 * hstep;
    const unsigned ldsw = (unsigned)wid * 1024u;
    const int aoff = lds_byte(wr * 64 + fr, fq * 8), boff = lds_byte(wc * 32 + fr, fq * 8);
#define PG8_SA(b, h) (((b) * 2 + (h)) * HTB)
#define PG8_SB(b, h) ((4 + (b) * 2 + (h)) * HTB)
#define PG8_STAGE(bufoff, gbase, voff) do { _Pragma("unroll") for (int _i = 0; _i < 2; ++_i) \
        __builtin_amdgcn_global_load_lds((const unsigned*)((const char*)(gbase) + (voff)[_i]), (PG8_LAS unsigned*)(lds + (bufoff) + ldsw + _i * 8192), 16, 0, 0); } while (0)
#define PG8_STAGE_A(bufoff, gbase, h, NX) do { _Pragma("unroll") for (int _i = 0; _i < 2; ++_i) { \
        const char* p_; if constexpr (GATHER) p_ = (const char*)(gbase) + ((NX) ? gn[h][_i] : gc[h][_i]); else p_ = (const char*)(gbase) + (h) * hstep + voffA[_i]; \
        __builtin_amdgcn_global_load_lds((const unsigned*)p_, (PG8_LAS unsigned*)(lds + (bufoff) + ldsw + _i * 8192), 16, 0, 0); } } while (0)
#define PG8_LDA(dst, b, h) do { _Pragma("unroll") for (int m = 0; m < 4; ++m) _Pragma("unroll") for (int k = 0; k < 2; ++k) dst[m][k] = *(const PG8_LAS bf16x8*)(lds + PG8_SA(b, h) + aoff + m * 2048 + k * 1024); } while (0)
#define PG8_LDB(dst, b, h) do { _Pragma("unroll") for (int n = 0; n < 2; ++n) _Pragma("unroll") for (int k = 0; k < 2; ++k) dst[n][k] = *(const PG8_LAS bf16x8*)(lds + PG8_SB(b, h) + boff + n * 2048 + k * 1024); } while (0)
#define PG8_LDBH(dst, b) do { _Pragma("unroll") for (int n = 0; n < 2; ++n) _Pragma("unroll") for (int k = 0; k < 2; ++k) dst[n][k] = *(const PG8_LAS bf16x8*)(lds + PG8_SB(b, 0) + hbo + boff + n * 2048 + k * 1024); } while (0)
#define PG8_MMA(ai, bj, At, Bt) do { __builtin_amdgcn_s_setprio(1); _Pragma("unroll") for (int m = 0; m < 4; ++m) _Pragma("unroll") for (int n = 0; n < 2; ++n) _Pragma("unroll") for (int k = 0; k < 2; ++k) \
        acc[ai][bj][m][n] = __builtin_amdgcn_mfma_f32_16x16x32_bf16(Bt[n][k], At[m][k], acc[ai][bj][m][n], 0, 0, 0); __builtin_amdgcn_s_setprio(0); } while (0)
#define PG8_WAIT_V(n) asm volatile("s_waitcnt vmcnt(" #n ")" ::: "memory")
#define PG8_WAIT_L(n) asm volatile("s_waitcnt lgkmcnt(" #n ")" ::: "memory")
#define PG8_BAR __builtin_amdgcn_s_barrier()
#define PG8_SCHED __builtin_amdgcn_sched_barrier(0)
    Unit cur, nxt; int ui = 0;
    if (!S.next(0, cur)) return;
    f32x4 acc[2][2][4][2];
#pragma unroll
    for (int a = 0; a < 2; ++a)
#pragma unroll
        for (int b = 0; b < 2; ++b)
#pragma unroll
            for (int m = 0; m < 4; ++m)
#pragma unroll
                for (int n = 0; n < 2; ++n) acc[a][b][m][n] = (f32x4){0.f, 0.f, 0.f, 0.f};
    bf16x8 At[4][2], B0[2][2], B1[2][2];
    const char* cA = GATHER ? (const char*)g.A : (const char*)g.A + (size_t)cur.pm * tstep; const char* cB = (const char*)g.Bt + (size_t)cur.pn * tstep;
    if constexpr (GATHER) { PG8_GOFFS(gc, cur); }
    S.a_ready(cur);
    if constexpr (SP2) {
        PG8_STAGE(PG8_SB(0, 0), cB, voffB); PG8_STAGE(PG8_SB(0, 1), cB + hstep, voffB); PG8_STAGE_A(PG8_SA(0, 0), cA, 0, false); PG8_STAGE_A(PG8_SA(0, 1), cA, 1, false);
        if (wr == 1) PG8_BAR;
        PG8_WAIT_V(2); PG8_BAR;
        PG8_STAGE(PG8_SB(1, 0), cB + kstep, voffB); PG8_STAGE_A(PG8_SA(1, 0), cA + kstep, 0, false); PG8_STAGE(PG8_SB(1, 1), cB + hstep + kstep, voffB);
        PG8_WAIT_V(6); PG8_BAR;
    } else {
        PG8_STAGE(PG8_SB(0, 0), cB, voffB); PG8_STAGE_A(PG8_SA(0, 0), cA, 0, false); PG8_STAGE(PG8_SB(0, 1), cB + hstep, voffB); PG8_STAGE_A(PG8_SA(0, 1), cA, 1, false);
        if (wr == 1) PG8_BAR;
        PG8_WAIT_V(4); PG8_BAR;
        PG8_STAGE(PG8_SB(1, 0), cB + kstep, voffB); PG8_STAGE_A(PG8_SA(1, 0), cA + kstep, 0, false); PG8_STAGE(PG8_SB(1, 1), cB + hstep + kstep, voffB);
        PG8_WAIT_V(6); PG8_BAR;
    }
    for (;;) {
        const bool has_next = S.next(ui + 1, nxt);
        if constexpr (GATHER) { if (has_next) { PG8_GOFFS(gn, nxt); } else {
#pragma unroll
            for (int h_ = 0; h_ < 2; ++h_) { gn[h_][0] = gc[h_][0]; gn[h_][1] = gc[h_][1]; } } }
        const unsigned hbo = HALFN ? (unsigned)(cur.aux & 1) * (unsigned)HTB : 0u;
        const char* nA = GATHER ? (const char*)g.A : has_next ? (const char*)g.A + (size_t)nxt.pm * tstep : cA; const char* nB = has_next ? (const char*)g.Bt + (size_t)nxt.pn * tstep : cB;
        for (int t = 0; t < nt; t += 2) {
            const bool last = (t == nt - 2);
            const char* a1 = cA + (size_t)(t + 1) * kstep;
            const char* a2 = last ? nA : cA + (size_t)(t + 2) * kstep; const char* b2 = last ? nB : cB + (size_t)(t + 2) * kstep;
            const char* a3 = a2 + kstep; const char* b3 = b2 + kstep;
            if (last && has_next) S.a_ready(nxt);
            if constexpr (SP2) {
            if constexpr (HALFN) { PG8_LDBH(B0, 0); } else { PG8_LDB(B0, 0, 0); PG8_LDB(B1, 0, 1); } PG8_SCHED; PG8_LDA(At, 0, 0); PG8_STAGE_A(PG8_SA(1, 1), a1, 1, false);
            PG8_WAIT_V(8); PG8_WAIT_L(0); PG8_BAR; PG8_MMA(0, 0, At, B0); if constexpr (!HALFN) PG8_MMA(0, 1, At, B1); PG8_BAR; PG8_SCHED;
            PG8_LDA(At, 0, 1); PG8_STAGE(PG8_SB(0, 0), b2, voffB); PG8_STAGE(PG8_SB(0, 1), b2 + hstep, voffB); PG8_STAGE_A(PG8_SA(0, 0), a2, 0, last);
            PG8_WAIT_V(8); PG8_WAIT_L(0); PG8_BAR; PG8_MMA(1, 0, At, B0); if constexpr (!HALFN) PG8_MMA(1, 1, At, B1); PG8_BAR; PG8_SCHED;
            if constexpr (HALFN) { PG8_LDBH(B0, 1); } else { PG8_LDB(B0, 1, 0); PG8_LDB(B1, 1, 1); } PG8_SCHED; PG8_LDA(At, 1, 0); PG8_STAGE_A(PG8_SA(0, 1), a2, 1, last);
            PG8_WAIT_V(8); PG8_WAIT_L(0); PG8_BAR; PG8_MMA(0, 0, At, B0); if constexpr (!HALFN) PG8_MMA(0, 1, At, B1); PG8_BAR; PG8_SCHED;
            PG8_LDA(At, 1, 1); PG8_STAGE(PG8_SB(1, 0), b3, voffB); PG8_STAGE(PG8_SB(1, 1), b3 + hstep, voffB); PG8_STAGE_A(PG8_SA(1, 0), a3, 0, last);
            PG8_WAIT_V(8); PG8_WAIT_L(0); PG8_BAR; PG8_MMA(1, 0, At, B0); if constexpr (!HALFN) PG8_MMA(1, 1, At, B1); PG8_BAR; PG8_SCHED;
            } else {
            PG8_LDB(B0, 0, 0); PG8_SCHED; PG8_LDA(At, 0, 0); PG8_STAGE_A(PG8_SA(1, 1), a1, 1, false);
            PG8_WAIT_L(8); PG8_BAR; PG8_WAIT_L(0); PG8_MMA(0, 0, At, B0); PG8_BAR; PG8_SCHED;
            PG8_LDB(B1, 0, 1); PG8_STAGE(PG8_SB(0, 0), b2, voffB);
            PG8_BAR; PG8_WAIT_L(0); PG8_MMA(0, 1, At, B1); PG8_BAR;
            PG8_LDA(At, 0, 1); PG8_STAGE_A(PG8_SA(0, 0), a2, 0, last);
            PG8_BAR; PG8_WAIT_L(0); PG8_MMA(1, 0, At, B0); PG8_BAR; PG8_SCHED;
            PG8_STAGE(PG8_SB(0, 1), b2 + hstep, voffB);
            PG8_WAIT_V(6); PG8_BAR; PG8_MMA(1, 1, At, B1); PG8_BAR;
            PG8_LDB(B0, 1, 0); PG8_SCHED; PG8_LDA(At, 1, 0); PG8_STAGE_A(PG8_SA(0, 1), a2, 1, last);
            PG8_WAIT_L(8); PG8_BAR; PG8_WAIT_L(0); PG8_MMA(0, 0, At, B0); PG8_BAR; PG8_SCHED;
            PG8_LDB(B1, 1, 1); PG8_STAGE(PG8_SB(1, 0), b3, voffB);
            PG8_BAR; PG8_WAIT_L(0); PG8_MMA(0, 1, At, B1); PG8_BAR;
            PG8_LDA(At, 1, 1); PG8_STAGE_A(PG8_SA(1, 0), a3, 0, last);
            PG8_BAR; PG8_WAIT_L(0); PG8_MMA(1, 0, At, B0); PG8_BAR; PG8_SCHED;
            PG8_STAGE(PG8_SB(1, 1), b3 + hstep, voffB);
            PG8_WAIT_V(6); PG8_BAR; PG8_MMA(1, 1, At, B1); PG8_BAR;
            }
        }
        if constexpr (ALIGN_EPI) { if (wr == 0) PG8_BAR; }
        if constexpr (!Epi::AFTER_DRAIN) { E(acc, cur, wr, wc, fr, fq); S.done(cur); }
        if (!has_next) break;
#pragma unroll
        for (int a = 0; a < 2; ++a)
#pragma unroll
            for (int b = 0; b < 2; ++b)
#pragma unroll
                for (int m = 0; m < 4; ++m)
#pragma unroll
                    for (int n = 0; n < 2; ++n) acc[a][b][m][n] = (f32x4){0.f, 0.f, 0.f, 0.f};
        cur = nxt; cA = nA; cB = nB; ++ui;
        if constexpr (GATHER) {
#pragma unroll
            for (int h_ = 0; h_ < 2; ++h_) { gc[h_][0] = gn[h_][0]; gc[h_][1] = gn[h_][1]; } }
        if constexpr (ALIGN_EPI) { if (wr == 1) PG8_BAR; }
    }
    PG8_WAIT_V(0);
    if constexpr (!ALIGN_EPI) { if (wr == 0) PG8_BAR; }
    PG8_BAR;
    if constexpr (Epi::AFTER_DRAIN) { E.fused(acc, cur, wr, wc, fr, fq, lds, wid, lane); S.done(cur); }
#undef PG8_SA
#undef PG8_SB
#undef PG8_STAGE
#undef PG8_STAGE_A
#undef PG8_GOFFS
#undef PG8_LDA
#undef PG8_LDB
#undef PG8_LDBH
#undef PG8_MMA
#undef PG8_WAIT_V
#undef PG8_WAIT_L
#undef PG8_BAR
#undef PG8_SCHED
}
}

namespace att2 {
constexpr int KSLOT = 8192, VSLOT = 16384, LDS_K = 0, LDS_V = 3 * KSLOT, LDS_WS = LDS_V + 3 * VSLOT, LDS_BYTES = LDS_WS + NWAVES * 256;
constexpr float THR = 8.f;
typedef LAS const char* lds_cptr;
typedef short v4i16_t __attribute__((ext_vector_type(4)));
typedef __bf16 bf2_t __attribute__((ext_vector_type(2)));
#define SBAR() __builtin_amdgcn_sched_barrier(0)
#define PIN(x) asm volatile("" : "+v"(x))
__device__ __forceinline__ int crow(int r, int hi) { return (r & 3) + 8 * (r >> 2) + 4 * hi; }
__device__ __forceinline__ f32x16 zero16() { float z = 0.f; asm volatile("" : "+v"(z)); f32x16 v;
#pragma unroll
    for (int r = 0; r < 16; ++r) v[r] = z;
    return v; }
__device__ __forceinline__ void glds16(const void* gsrc, unsigned lds_dst) { unsigned keep;
    asm volatile("s_mov_b32 %0, m0\n\ts_mov_b32 m0, %2\n\ts_nop 0\n\tglobal_load_lds_dwordx4 %1, off\n\ts_mov_b32 m0, %0" : "=&s"(keep) : "v"(gsrc), "s"(lds_dst) : "memory"); }
__device__ __forceinline__ bf16x8 kfrag(lds_cptr p) { return *(const LAS bf16x8*)p; }
__device__ __forceinline__ s16x4 vtr(lds_cptr p) { return __builtin_bit_cast(s16x4, __builtin_amdgcn_ds_read_tr16_b64_v4i16((LAS v4i16_t*)p)); }
__device__ __forceinline__ unsigned cvtpk_s(float lo, float hi) { typedef float f2 __attribute__((ext_vector_type(2))); typedef __bf16 b2 __attribute__((ext_vector_type(2)));
    f2 v = {lo, hi}; b2 b = __builtin_convertvector(v, b2); return __builtin_bit_cast(unsigned, b); }
#define MX3(a, b, c) __builtin_fmaxf(__builtin_fmaxf((a), (b)), (c))
__device__ __forceinline__ float rowmax(const f32x16& p0, const f32x16& p1) {
    float a = MX3(p0[0], p0[1], p1[0]), b = MX3(p0[2], p0[3], p1[1]); a = MX3(a, p1[2], p1[3]);
#pragma unroll
    for (int r = 4; r < 16; r += 4) { a = MX3(a, p0[r], p0[r + 1]); b = MX3(b, p0[r + 2], p0[r + 3]); a = MX3(a, p1[r], p1[r + 1]); b = MX3(b, p1[r + 2], p1[r + 3]); }
    float m = __builtin_fmaxf(a, b); auto rr = __builtin_amdgcn_permlane32_swap(__float_as_uint(m), __float_as_uint(m), false, false);
    return __builtin_fmaxf(__uint_as_float(rr[0]), __uint_as_float(rr[1])); }
__device__ __forceinline__ void wmask(f32x16& p0, f32x16& p1, int dk, int hi) {
#pragma unroll
    for (int r = 0; r < 16; ++r) { const int d = dk + crow(r, hi);
        if (d > 128 || d < -128) p0[r] = -1e30f;
        if (d + 32 > 128 || d + 32 < -128) p1[r] = -1e30f; } }
#define MFMA32(a, b, c) __builtin_amdgcn_mfma_f32_32x32x16_bf16(a, b, c, 0, 0, 0)
#define WAIT_BAR(N) asm volatile("s_waitcnt vmcnt(" #N ") lgkmcnt(0)\n\ts_barrier" ::: "memory")

template <int MODE, int LDK, int LDV, bool SAFE>
__device__ __forceinline__ void attn_body(const bf16_t* Qw, const bf16_t* Kh, const bf16_t* Vh, const int nA, const int a0, const int b0, const int NT, const int qpos,
                                          char* lds, const int tid, f32x16 (&o)[4], float& m_out, float& l_out) {
    constexpr int ND = (MODE == 1) ? 2 : 4, NVP = ND / 2;
    const int lane = tid & 63, r32 = lane & 31, hi = lane >> 5; const int wid = __builtin_amdgcn_readfirstlane(tid >> 6);
    const unsigned lds0 = (unsigned)(uintptr_t)lds; float* wsf = (float*)(lds + LDS_WS) + wid * 64;
#define KROW(t) ((t) < nA ? a0 + 64 * (t) : b0 + 64 * ((t) - nA))
    const bf16_t* ksrc = Kh + (size_t)lane * LDK + wid * 8;
    const bf16_t* vsrc = Vh + (size_t)(16 * (wid & 3) + (lane >> 2)) * LDV + (wid >> 2) * 32 + (lane & 3) * 8;
    const unsigned kdst = lds0 + LDS_K + wid * 1024, vdst = lds0 + LDS_V + (wid >> 2) * 4096 + (wid & 3) * 1024;
#define DMA_K(t, slot) glds16(ksrc + (size_t)KROW(t) * LDK, (unsigned)__builtin_amdgcn_readfirstlane(kdst + (slot) * KSLOT))
#define DMA_V(t, slot) do { const bf16_t* vs_ = vsrc + (size_t)KROW(t) * LDV; glds16(vs_, (unsigned)__builtin_amdgcn_readfirstlane(vdst + (slot) * VSLOT)); \
        if constexpr (NVP == 2) glds16(vs_ + 64, (unsigned)__builtin_amdgcn_readfirstlane(vdst + (slot) * VSLOT + 8192)); } while (0)
    const lds_cptr shm3 = (lds_cptr)(LAS char*)lds;
    const lds_cptr kp0 = shm3 + LDS_K + hi * 1024 + r32 * 16;
    const lds_cptr vp0 = shm3 + LDS_V + ((lane >> 4) & 1) * 32 + (lane & 3) * 8 + (4 * hi + ((lane & 15) >> 2)) * 64;
    bf16x8 qr[4];
#pragma unroll
    for (int d0 = 0; d0 < 4; ++d0) qr[d0] = *reinterpret_cast<const bf16x8*>(Qw + d0 * 16 + hi * 8);
    __syncthreads();
    if (wid >= 4) __builtin_amdgcn_s_setprio(1);
    DMA_K(0, 0); DMA_K(1, 1); DMA_V(0, 0);
    float mhat = 0.f, l_reg = 0.f;
#pragma unroll
    for (int d = 0; d < 4; ++d) o[d] = zero16();
    f32x16 negm = zero16(); PIN(negm);
    bool resc = false;
    if constexpr (NVP == 2) { WAIT_BAR(3); } else { WAIT_BAR(2); }
    f32x16 pA0, pA1, pB0, pB1;
    DMA_K(2, 2); DMA_V(1, 1);
    { bf16x8 kf[8];
#pragma unroll
      for (int i = 0; i < 8; ++i) kf[i] = kfrag(kp0 + (i >> 1) * 2048 + (i & 1) * 512);
      pA0 = MFMA32(kf[0], qr[0], negm); pA1 = MFMA32(kf[1], qr[0], negm); pA0 = MFMA32(kf[2], qr[1], pA0); pA1 = MFMA32(kf[3], qr[1], pA1);
      pA0 = MFMA32(kf[4], qr[2], pA0); pA1 = MFMA32(kf[5], qr[2], pA1); pA0 = MFMA32(kf[6], qr[3], pA0); pA1 = MFMA32(kf[7], qr[3], pA1); }
    if constexpr (MODE == 1) { if (0 >= nA) wmask(pA0, pA1, KROW(0) - qpos, hi); }
    { const float rm = rowmax(pA0, pA1); mhat = rm;
#pragma unroll
      for (int r = 0; r < 16; ++r) { pA0[r] = __builtin_amdgcn_exp2f(pA0[r] - rm); pA1[r] = __builtin_amdgcn_exp2f(pA1[r] - rm); }
#pragma unroll
      for (int r = 0; r < 16; ++r) negm[r] = -mhat;
      PIN(negm);
      if constexpr (!SAFE) { float s0 = 0.f, s1 = 0.f;
#pragma unroll
        for (int r = 0; r < 16; ++r) { s0 += pA0[r]; s1 += pA1[r]; }
        l_reg = s0 + s1; } }
    if constexpr (NVP == 2) { WAIT_BAR(3); } else { WAIT_BAR(2); }
    int sl_prev = 0, sl_cur = 1, sl_next = 2;
#define ROT() do { const int s_ = sl_prev; sl_prev = sl_cur; sl_cur = sl_next; sl_next = s_; } while (0)
#define RESC() do { if (resc) { asm volatile("s_waitcnt lgkmcnt(0)" ::: "memory"); \
        _Pragma("unroll") for (int d_ = 0; d_ < ND; ++d_) _Pragma("unroll") for (int r = 0; r < 16; ++r) o[d_][r] *= wsf[crow(r, hi)]; } } while (0)
    u32x4 pw0, pw1, pw2, pw3; s16x4 vl[16], vh[16]; bf16x8 kf[8]; float dummy_ = 0.f;
#define PAF(k) __builtin_bit_cast(bf16x8, pw##k)
#define VFR(i) (bf16x8){vl[i][0], vl[i][1], vl[i][2], vl[i][3], vh[i][0], vh[i][1], vh[i][2], vh[i][3]}
#define VRD(q, ks) do { if constexpr ((q) < ND) { vl[(q) * 4 + (ks)] = vtr(vp_ + ((q) * 4096 + (ks) * 1024)); vh[(q) * 4 + (ks)] = vtr(vp_ + ((q) * 4096 + (ks) * 1024 + 512)); } } while (0)
#define KRD(i) do { kf[i] = kfrag(kp_ + ((i) >> 1) * 2048 + ((i) & 1) * 512); } while (0)
#define PKW(P, i) cvtpk_s(P[i], P[i + 1])
#ifndef PROBE_VALU
#define PROBE_VALU 0
#endif
#ifndef ROWSUM_DOT2
#define ROWSUM_DOT2 0
#endif
#define DOT2(w, acc) __builtin_amdgcn_fdot2_f32_bf16(__builtin_bit_cast(bf2_t, (unsigned)(w)), __builtin_bit_cast(bf2_t, 0x3f803f80u), acc, false)
#define GAPA(MF, a0_, a1_, a2_, a3_, W0, W1, PW, i0_) do { MF; if (SAFE && !ROWSUM_DOT2) { sacc += a0_; sacb += a1_; sacc += a2_; sacb += a3_; PIN(sacc); PIN(sacb); } W0; W1; PIN(PW); \
        if (ROWSUM_DOT2) { sacc = DOT2(PW[i0_], sacc); sacb = DOT2(PW[(i0_) + 1], sacb); PIN(sacc); PIN(sacb); } SBAR(); } while (0)
#define EX(v) __builtin_amdgcn_exp2f(v)
#define GAPB(q, ks, X, i) do { if constexpr ((q) < ND) { o[q] = MFMA32(PAF(ks), VFR((q) * 4 + (ks)), o[q]); } X[i] = EX(X[i]); X[(i) + 1] = EX(X[(i) + 1]); X[(i) + 2] = EX(X[(i) + 2]); X[(i) + 3] = EX(X[(i) + 3]); PIN(X); SBAR(); } while (0)
#define GAPG(q, ks, ...) do { if constexpr ((q) < ND) { o[q] = MFMA32(PAF(ks), VFR((q) * 4 + (ks)), o[q]); } __VA_ARGS__; SBAR(); } while (0)
#define STEP(C0, C1, P0, P1, t, GK, GV) do { SBAR(); \
    const lds_cptr vp_ = vp0 + sl_prev * VSLOT; const lds_cptr kp_ = kp0 + sl_cur * KSLOT; \
    KRD(0); KRD(1); KRD(2); SBAR(); float sacc = (ROWSUM_DOT2 || !SAFE) ? 0.f : P0[0], sacb = (ROWSUM_DOT2 || !SAFE) ? 0.f : P0[1]; \
    KRD(3); SBAR();            GAPA(C0 = MFMA32(kf[0], qr[0], negm), P0[2], P0[3], P0[4], P0[5],     pw0[0] = PKW(P0, 0),  pw0[1] = PKW(P0, 2),  pw0, 0); \
    KRD(4); SBAR();            GAPA(C1 = MFMA32(kf[1], qr[0], negm), P0[6], P0[7], P0[8], P0[9],     pw0[2] = PKW(P0, 4),  pw0[3] = PKW(P0, 6),  pw0, 2); \
    KRD(5); SBAR();            GAPA(C0 = MFMA32(kf[2], qr[1], C0),   P0[10], P0[11], P0[12], P0[13], pw1[0] = PKW(P0, 8),  pw1[1] = PKW(P0, 10), pw1, 0); \
    KRD(6); SBAR();            GAPA(C1 = MFMA32(kf[3], qr[1], C1),   P0[14], P0[15], P1[0], P1[1],   pw1[2] = PKW(P0, 12), pw1[3] = PKW(P0, 14), pw1, 2); \
    KRD(7); VRD(0, 0); SBAR(); GAPA(C0 = MFMA32(kf[4], qr[2], C0),   P1[2], P1[3], P1[4], P1[5],     pw2[0] = PKW(P1, 0),  pw2[1] = PKW(P1, 2),  pw2, 0); \
            VRD(1, 0); SBAR(); GAPA(C1 = MFMA32(kf[5], qr[2], C1),   P1[6], P1[7], P1[8], P1[9],     pw2[2] = PKW(P1, 4),  pw2[3] = PKW(P1, 6),  pw2, 2); \
            VRD(2, 0); SBAR(); GAPA(C0 = MFMA32(kf[6], qr[3], C0),   P1[10], P1[11], P1[12], P1[13], pw3[0] = PKW(P1, 8),  pw3[1] = PKW(P1, 10), pw3, 0); \
            VRD(3, 0); SBAR(); GAPA(C1 = MFMA32(kf[7], qr[3], C1),   P1[14], P1[15], 0.f, 0.f,       pw3[2] = PKW(P1, 12), pw3[3] = PKW(P1, 14), pw3, 2); \
    if constexpr (SAFE) l_reg += sacc + sacb; \
    if constexpr (MODE == 1) { if ((t) >= nA) wmask(C0, C1, KROW(t) - qpos, hi); } \
    SBAR(); \
      \
      \
    if constexpr (!SAFE) { \
      \
    VRD(0, 1); SBAR(); GAPG(0, 0, C0[0] = EX(C0[0]); C0[1] = EX(C0[1]); PIN(C0)); \
    VRD(1, 1); SBAR(); GAPG(1, 0, C0[2] = EX(C0[2]); C0[3] = EX(C0[3]); sacc += C0[0]; sacb += C0[1]; PIN(C0); PIN(sacc); PIN(sacb)); \
    VRD(2, 1); SBAR(); GAPG(2, 0, C0[4] = EX(C0[4]); C0[5] = EX(C0[5]); sacc += C0[2]; sacb += C0[3]; PIN(C0); PIN(sacc); PIN(sacb)); \
    VRD(3, 1); SBAR(); GAPG(3, 0, C0[6] = EX(C0[6]); C0[7] = EX(C0[7]); sacc += C0[4]; sacb += C0[5]; PIN(C0); PIN(sacc); PIN(sacb)); \
    VRD(0, 2); SBAR(); GAPG(0, 1, C0[8] = EX(C0[8]); C0[9] = EX(C0[9]); sacc += C0[6]; sacb += C0[7]; PIN(C0); PIN(sacc); PIN(sacb)); \
    VRD(1, 2); SBAR(); GAPG(1, 1, C0[10] = EX(C0[10]); C0[11] = EX(C0[11]); sacc += C0[8]; sacb += C0[9]; PIN(C0); PIN(sacc); PIN(sacb)); \
    VRD(2, 2); SBAR(); GAPG(2, 1, C0[12] = EX(C0[12]); C0[13] = EX(C0[13]); sacc += C0[10]; sacb += C0[11]; PIN(C0); PIN(sacc); PIN(sacb)); \
    VRD(3, 2); SBAR(); GAPG(3, 1, C0[14] = EX(C0[14]); C0[15] = EX(C0[15]); sacc += C0[12]; sacb += C0[13]; PIN(C0); PIN(sacc); PIN(sacb)); \
    VRD(0, 3); SBAR(); GAPG(0, 2, C1[0] = EX(C1[0]); C1[1] = EX(C1[1]); sacc += C0[14]; sacb += C0[15]; PIN(C1); PIN(sacc); PIN(sacb)); \
    VRD(1, 3); SBAR(); GAPG(1, 2, C1[2] = EX(C1[2]); C1[3] = EX(C1[3]); sacc += C1[0]; sacb += C1[1]; PIN(C1); PIN(sacc); PIN(sacb)); \
    VRD(2, 3); SBAR(); GAPG(2, 2, C1[4] = EX(C1[4]); C1[5] = EX(C1[5]); sacc += C1[2]; sacb += C1[3]; PIN(C1); PIN(sacc); PIN(sacb)); \
    VRD(3, 3); SBAR(); GAPG(3, 2, C1[6] = EX(C1[6]); C1[7] = EX(C1[7]); sacc += C1[4]; sacb += C1[5]; PIN(C1); PIN(sacc); PIN(sacb)); \
    if (GK) { DMA_K((t) + 2, sl_prev); } SBAR(); GAPG(0, 3, C1[8] = EX(C1[8]); C1[9] = EX(C1[9]); sacc += C1[6]; sacb += C1[7]; PIN(C1); PIN(sacc); PIN(sacb)); \
    if (GV) { DMA_V((t) + 1, sl_next); } SBAR(); GAPG(1, 3, C1[10] = EX(C1[10]); C1[11] = EX(C1[11]); sacc += C1[8]; sacb += C1[9]; PIN(C1); PIN(sacc); PIN(sacb)); \
    GAPG(2, 3, C1[12] = EX(C1[12]); C1[13] = EX(C1[13]); sacc += C1[10]; sacb += C1[11]; PIN(C1); PIN(sacc); PIN(sacb)); \
    GAPG(3, 3, C1[14] = EX(C1[14]); C1[15] = EX(C1[15]); sacc += C1[12]; sacb += C1[13]; PIN(C1); PIN(sacc); PIN(sacb)); \
    sacc += C1[14]; sacb += C1[15]; l_reg += sacc + sacb; \
    } else { \
    float mxa, mxb; \
    VRD(0, 1); SBAR(); GAPG(0, 0, mxa = MX3(C0[0], C0[1], C0[2]); mxb = MX3(C0[3], C0[4], C0[5]); mxa = MX3(mxa, C0[6], C0[7]); mxb = MX3(mxb, C0[8], C0[9]); PIN(mxa); PIN(mxb)); \
    VRD(1, 1); SBAR(); GAPG(1, 0, mxa = MX3(mxa, C0[10], C0[11]); mxb = MX3(mxb, C0[12], C0[13]); mxa = MX3(mxa, C0[14], C0[15]); mxb = MX3(mxb, C1[0], C1[1]); PIN(mxa); PIN(mxb)); \
    VRD(2, 1); SBAR(); GAPG(2, 0, mxa = MX3(mxa, C1[2], C1[3]); mxb = MX3(mxb, C1[4], C1[5]); mxa = MX3(mxa, C1[6], C1[7]); mxb = MX3(mxb, C1[8], C1[9]); PIN(mxa); PIN(mxb)); \
    VRD(3, 1); SBAR(); GAPG(3, 0, mxa = MX3(mxa, C1[10], C1[11]); mxb = MX3(mxb, C1[12], C1[13]); mxa = MX3(mxa, C1[14], C1[15]); PIN(mxa); PIN(mxb)); \
    { float rm = __builtin_fmaxf(mxa, mxb); { auto rr = __builtin_amdgcn_permlane32_swap(__float_as_uint(rm), __float_as_uint(rm), false, false); rm = __builtin_fmaxf(__uint_as_float(rr[0]), __uint_as_float(rr[1])); } \
      resc = false; \
      if (__builtin_expect(__any(rm > THR), 0)) { const float dl = __builtin_fmaxf(rm, 0.f); mhat += dl; \
          _Pragma("unroll") for (int r = 0; r < 16; ++r) { C0[r] -= dl; C1[r] -= dl; } \
          _Pragma("unroll") for (int r = 0; r < 16; ++r) negm[r] = -mhat; PIN(negm); \
          const float f = __builtin_amdgcn_exp2f(-dl); l_reg *= f; if (hi == 0) wsf[r32] = f; resc = true; } } \
    SBAR(); \
    VRD(0, 2); SBAR(); GAPG(0, 1, C0[0] = EX(C0[0]); C0[1] = EX(C0[1]); C0[2] = EX(C0[2]); PIN(C0)); \
    VRD(1, 2); SBAR(); GAPG(1, 1, C0[3] = EX(C0[3]); C0[4] = EX(C0[4]); C0[5] = EX(C0[5]); PIN(C0)); \
    VRD(2, 2); SBAR(); GAPG(2, 1, C0[6] = EX(C0[6]); C0[7] = EX(C0[7]); C0[8] = EX(C0[8]); PIN(C0)); \
    VRD(3, 2); SBAR(); GAPG(3, 1, C0[9] = EX(C0[9]); C0[10] = EX(C0[10]); C0[11] = EX(C0[11]); PIN(C0)); \
    VRD(0, 3); SBAR(); GAPG(0, 2, C0[12] = EX(C0[12]); C0[13] = EX(C0[13]); C0[14] = EX(C0[14]); PIN(C0)); \
    VRD(1, 3); SBAR(); GAPG(1, 2, C0[15] = EX(C0[15]); C1[0] = EX(C1[0]); C1[1] = EX(C1[1]); PIN(C0); PIN(C1)); \
    VRD(2, 3); SBAR(); GAPG(2, 2, C1[2] = EX(C1[2]); C1[3] = EX(C1[3]); C1[4] = EX(C1[4]); PIN(C1)); \
    VRD(3, 3); SBAR(); GAPG(3, 2, C1[5] = EX(C1[5]); C1[6] = EX(C1[6]); C1[7] = EX(C1[7]); PIN(C1)); \
    if (GK) { DMA_K((t) + 2, sl_prev); if (PROBE_DUPK) DMA_K((t) + 2, sl_prev); } SBAR(); GAPG(0, 3, C1[8] = EX(C1[8]); C1[9] = EX(C1[9]); PIN(C1)); \
    if (GV) { DMA_V((t) + 1, sl_next); if (PROBE_DUPV) DMA_V((t) + 1, sl_next); } SBAR(); GAPG(1, 3, C1[10] = EX(C1[10]); C1[11] = EX(C1[11]); PIN(C1)); \
    GAPG(2, 3, C1[12] = EX(C1[12]); C1[13] = EX(C1[13]); PIN(C1)); \
    GAPG(3, 3, C1[14] = EX(C1[14]); C1[15] = EX(C1[15]); PIN(C1)); \
    } \
    } while (0)
#ifndef PROBE_DUPK
#define PROBE_DUPK 0
#endif
#ifndef PROBE_DUPV
#define PROBE_DUPV 0
#endif
#define WAIT_N(n_) do { if ((n_) == 6) { WAIT_BAR(6); } else if ((n_) == 5) { WAIT_BAR(5); } else if ((n_) == 4) { WAIT_BAR(4); } else if ((n_) == 3) { WAIT_BAR(3); } else if ((n_) == 2) { WAIT_BAR(2); } else if ((n_) == 1) { WAIT_BAR(1); } else { WAIT_BAR(0); } } while (0)
#define ENDW(tt) do { const int nk_ = ((tt) + 2 < NT) ? 1 + PROBE_DUPK : 0, nv_ = ((tt) + 1 < NT) ? NVP * (1 + PROBE_DUPV) : 0; WAIT_N(nk_ + nv_); } while (0)
    int t = 1;
    for (; t + 3 < NT; t += 2) {
        STEP(pB0, pB1, pA0, pA1, t, true, true);     WAIT_N(1 + PROBE_DUPK + NVP * (1 + PROBE_DUPV)); RESC(); ROT();
        STEP(pA0, pA1, pB0, pB1, t + 1, true, true); WAIT_N(1 + PROBE_DUPK + NVP * (1 + PROBE_DUPV)); RESC(); ROT();
    }
    for (; t + 1 < NT; t += 2) {
        STEP(pB0, pB1, pA0, pA1, t, (t + 2 < NT), (t + 1 < NT));         ENDW(t);     RESC(); ROT();
        STEP(pA0, pA1, pB0, pB1, t + 1, (t + 3 < NT), (t + 2 < NT));     ENDW(t + 1); RESC(); ROT();
    }
    STEP(pB0, pB1, pA0, pA1, NT - 1, false, false); WAIT_BAR(0); RESC(); ROT();
    { if constexpr (SAFE) { float sacc = pB0[0] + pB0[1];
#pragma unroll
      for (int r = 2; r < 16; ++r) sacc += pB0[r];
#pragma unroll
      for (int r = 0; r < 16; ++r) sacc += pB1[r];
      l_reg += sacc; }
      pw0 = (u32x4){PKW(pB0, 0), PKW(pB0, 2), PKW(pB0, 4), PKW(pB0, 6)}; pw1 = (u32x4){PKW(pB0, 8), PKW(pB0, 10), PKW(pB0, 12), PKW(pB0, 14)};
      pw2 = (u32x4){PKW(pB1, 0), PKW(pB1, 2), PKW(pB1, 4), PKW(pB1, 6)}; pw3 = (u32x4){PKW(pB1, 8), PKW(pB1, 10), PKW(pB1, 12), PKW(pB1, 14)};
      const lds_cptr vp_ = vp0 + sl_prev * VSLOT;
#pragma unroll
      for (int q = 0; q < ND; ++q) {
          s16x4 l0 = vtr(vp_ + q * 4096), h0 = vtr(vp_ + q * 4096 + 512), l1 = vtr(vp_ + q * 4096 + 1024), h1 = vtr(vp_ + q * 4096 + 1024 + 512);
          s16x4 l2 = vtr(vp_ + q * 4096 + 2048), h2 = vtr(vp_ + q * 4096 + 2048 + 512), l3 = vtr(vp_ + q * 4096 + 3072), h3 = vtr(vp_ + q * 4096 + 3072 + 512);
#define PKV(L, H) (bf16x8){L[0], L[1], L[2], L[3], H[0], H[1], H[2], H[3]}
          o[q] = MFMA32(PAF(0), PKV(l0, h0), o[q]); o[q] = MFMA32(PAF(1), PKV(l1, h1), o[q]); o[q] = MFMA32(PAF(2), PKV(l2, h2), o[q]); o[q] = MFMA32(PAF(3), PKV(l3, h3), o[q]);
#undef PKV
      } }
    { auto rr = __builtin_amdgcn_permlane32_swap(__float_as_uint(l_reg), __float_as_uint(l_reg), false, false); l_reg = __uint_as_float(rr[0]) + __uint_as_float(rr[1]); }
    if (PROBE_VALU) asm volatile("" :: "v"(dummy_));
    __builtin_amdgcn_s_setprio(0);
    m_out = mhat; l_out = l_reg;
#undef KROW
#undef DMA_K
#undef DMA_V
#undef ROT
#undef RESC
#undef PAF
#undef VFR
#undef VRD
#undef KRD
#undef PKW
#undef GAPA
#undef DOT2
#undef GAPB
#undef GAPG
#undef EX
#undef STEP
#undef ENDW
#undef WAIT_N
}
#undef SBAR
#undef PIN
#undef MX3
#undef MFMA32
#undef WAIT_BAR
}

#define XB_TMO      128
#define XB_XCNT(j)  (256  + 64 * (j))
#define XB_XSUB(j)  (1280 + 64 * (j))
#define XB_XGEN(j)  (2304 + 64 * (j))
#define XB_TOP      3328
#define XB_TOPGEN   3392
#define XCD_BAR_WORDS 3456
#define XB_SPIN_CAP (1u << 18)

__device__ __forceinline__ unsigned xb_ld(unsigned* p)              { return __hip_atomic_load(p, __ATOMIC_RELAXED, __HIP_MEMORY_SCOPE_AGENT); }
__device__ __forceinline__ unsigned xb_add(unsigned* p, unsigned v) { return __hip_atomic_fetch_add(p, v, __ATOMIC_RELAXED, __HIP_MEMORY_SCOPE_AGENT); }
__device__ __forceinline__ unsigned xb_xcc_id() { return (unsigned)__builtin_amdgcn_s_getreg((3 << 11) | 20) & 0xFu; }
#define XB_SPIN(cond, bar) do { unsigned _sp = 0; while (cond) { __builtin_amdgcn_s_sleep(1); \
    if ((++_sp & 255u) == 0u) { if (xb_ld(&(bar)[XB_TMO])) break; if (_sp > XB_SPIN_CAP) { atomicAdd(&(bar)[XB_TMO], 1u); break; } } } } while (0)

struct XcdBarrier {
    unsigned* bar; unsigned x;
    volatile LAS unsigned* st;
};

__device__ __forceinline__ XcdBarrier xcd_barrier_post(unsigned* bar, volatile LAS unsigned* st) {
    XcdBarrier b; b.bar = bar; b.x = xb_xcc_id(); b.st = st;
    if (threadIdx.x == 0) (void)xb_add(&bar[XB_XCNT(b.x)], 1u);
    return b;
}
__device__ __forceinline__ void xcd_barrier_complete(unsigned* bar, unsigned x, unsigned& nloc, unsigned& nx) {
    const unsigned G = gridDim.x * gridDim.y * gridDim.z;
    unsigned sum, cnt, mine, sp = 0u;
    for (;;) {
        sum = 0u; cnt = 0u; mine = 0u;
#pragma unroll
        for (unsigned j = 0; j < 16; ++j) { const unsigned c = xb_ld(&bar[XB_XCNT(j)]); sum += c; cnt += (c > 0u) ? 1u : 0u; mine = (j == x) ? c : mine; }
        if (sum == G) break;
        __builtin_amdgcn_s_sleep(1);
        if ((++sp & 255u) == 0u) { if (xb_ld(&bar[XB_TMO])) break; if (sp > XB_SPIN_CAP) { atomicAdd(&bar[XB_TMO], 1u); break; } }
    }
    nloc = mine > 0u ? mine : 1u; nx = cnt > 0u ? cnt : 1u;
}

__device__ __forceinline__ void xcd_barrier(const XcdBarrier& b) {
    asm volatile("s_waitcnt vmcnt(0)" ::: "memory");
    __syncthreads();
    if (threadIdx.x == 0) {
        unsigned* bar = b.bar;
        __builtin_amdgcn_s_waitcnt(0);
        unsigned nloc = b.st[0], nx = b.st[1];
        if (nloc == 0u) { xcd_barrier_complete(bar, b.x, nloc, nx); b.st[0] = nloc; b.st[1] = nx; }
        const unsigned old = xb_add(&bar[XB_XSUB(b.x)], 1u);
        const unsigned gen = old / nloc;
        if (old + 1u == (gen + 1u) * nloc) {
            __builtin_amdgcn_fence(__ATOMIC_RELEASE, "agent");
            asm volatile("s_waitcnt vmcnt(0)" ::: "memory");
            const unsigned og = xb_add(&bar[XB_TOP], 1u);
            const unsigned tg = og / nx;
            if (og + 1u == (tg + 1u) * nx) xb_add(&bar[XB_TOPGEN], 1u);
            else XB_SPIN(xb_ld(&bar[XB_TOPGEN]) == tg, bar);
            __builtin_amdgcn_fence(__ATOMIC_ACQUIRE, "agent");
            xb_add(&bar[XB_XGEN(b.x)], 1u);
            asm volatile("s_waitcnt vmcnt(0)" ::: "memory");
        } else {
            XB_SPIN(xb_ld(&bar[XB_XGEN(b.x)]) == gen, bar);
            __builtin_amdgcn_fence(__ATOMIC_ACQUIRE, "agent");
            asm volatile("s_waitcnt vmcnt(0)" ::: "memory");
        }
    }
    __syncthreads();
}

struct Args { const float* in[23]; float* out; unsigned char* ws; int ph_lo, ph_hi; };
enum { I_X = 0, I_C, I_CTX, I_CCTX, I_WADA, I_BADA, I_GMIX, I_WIN, I_DLAM, I_DNG, I_SINK, I_CONVW, I_CONVB, I_LNG, I_LNB, I_WOUT, I_GFFN, I_RW, I_RB, I_W1, I_W3, I_W2, I_GFIN };
constexpr int N_PHASES = 18;
__device__ __constant__ const float LAMBDA_INIT[2] = {0.2f, 0.35550906759097f};

struct EpiInProj {
    static constexpr bool PERM = true, AFTER_DRAIN = false;
    unsigned char* ws; const float* ropeC; const float* ropeS;
    __device__ __forceinline__ void operator()(const f32x4 (&acc)[2][2][4][2], const pg8::Unit& u, int wr, int wc, int fr, int fq) const {
        const int pn = u.pn; const bool latent = u.pm < 64; const int rowb = u.pm * 256 + wr * 64 + fr;
        if (pn >= 8) {
            bf16_t* Z = (bf16_t*)(ws + RA_Z); const int ch0 = (pn - 8) * 128 + wc * 32 + 8 * fq;
#pragma unroll
            for (int ai = 0; ai < 2; ++ai)
#pragma unroll
                for (int m = 0; m < 4; ++m) { const int row = rowb + ai * 128 + m * 16;
                    const f32x4 a0 = acc[ai][0][m][0], a1 = acc[ai][0][m][1], g0 = acc[ai][1][m][0], g1 = acc[ai][1][m][1];
                    u32x4 w; w.x = cvt_pk_bf16(a0[0] * sigmoid_f(g0[0]), a0[1] * sigmoid_f(g0[1])); w.y = cvt_pk_bf16(a0[2] * sigmoid_f(g0[2]), a0[3] * sigmoid_f(g0[3]));
                    w.z = cvt_pk_bf16(a1[0] * sigmoid_f(g1[0]), a1[1] * sigmoid_f(g1[1])); w.w = cvt_pk_bf16(a1[2] * sigmoid_f(g1[2]), a1[3] * sigmoid_f(g1[3]));
                    *(u32x4*)(Z + (size_t)row * 256 + ch0) = w; }
            return;
        }
        const float sgn = (fq < 2) ? -1.f : 1.f;
        const bool anyrope = latent && (pn < 4 || pn >= 6);
#pragma unroll
        for (int ai = 0; ai < 2; ++ai)
#pragma unroll
            for (int m = 0; m < 4; ++m) { const int row = rowb + ai * 128 + m * 16;
                f32x4 c0, c1, s0, s1;
                if (anyrope) { const int pos = (wc & 1) ? (row & 63) : (row >> 6); const int fo = pos * 16 + 8 * (fq & 1);
                    c0 = *(const f32x4*)(ropeC + fo); c1 = *(const f32x4*)(ropeC + fo + 4); s0 = *(const f32x4*)(ropeS + fo) * sgn; s1 = *(const f32x4*)(ropeS + fo + 4) * sgn; }
#pragma unroll
                for (int bj = 0; bj < 2; ++bj) {
                    bf16_t* dst; int ld, dcol; bool rope; float sc = 1.f; bool isvb = false;
                    if (pn < 2)       { dst = (bf16_t*)(ws + RA_QA); ld = 512; dcol = pn * 256 + bj * 128 + wc * 32; rope = true; sc = QSCALE; }
                    else if (pn < 4)  { dst = (bf16_t*)(ws + RA_KA); ld = 512; dcol = (pn - 2) * 256 + bj * 128 + wc * 32; rope = true; }
                    else if (pn < 6)  { dst = (bf16_t*)(ws + RA_VA); ld = 512; dcol = (pn - 4) * 256 + bj * 128 + wc * 32; rope = false; }
                    else if (pn == 6) { dst = (bf16_t*)(ws + RA_QB); ld = 256; dcol = bj * 128 + wc * 32; rope = true; sc = QSCALE; }
                    else if (bj == 0) { dst = (bf16_t*)(ws + RA_KB); ld = 128; dcol = wc * 32; rope = true; }
                    else              { dst = (bf16_t*)(ws + RA_VB); ld = 256; dcol = (wc >> 1) * 128 + (wc & 1) * 32; rope = false; isvb = true; }
                    rope = rope && latent;
                    f32x4 x0 = acc[ai][bj][m][0], x1 = acc[ai][bj][m][1];
                    if (rope) { f32x4 p0, p1;
#pragma unroll
                        for (int j = 0; j < 4; ++j) {
                            auto s0_ = __builtin_amdgcn_permlane32_swap(__float_as_uint(x0[j]), __float_as_uint(x0[j]), false, false); p0[j] = __uint_as_float(fq < 2 ? s0_[1] : s0_[0]);
                            auto s1_ = __builtin_amdgcn_permlane32_swap(__float_as_uint(x1[j]), __float_as_uint(x1[j]), false, false); p1[j] = __uint_as_float(fq < 2 ? s1_[1] : s1_[0]); }
                        x0 = x0 * c0 + p0 * s0; x1 = x1 * c1 + p1 * s1; }
                    x0 = x0 * sc; x1 = x1 * sc;
                    bf16_t* p = dst + (size_t)row * ld + dcol + 8 * fq;
                    u32x4 w; w.x = cvt_pk_bf16(x0[0], x0[1]); w.y = cvt_pk_bf16(x0[2], x0[3]); w.z = cvt_pk_bf16(x1[0], x1[1]); w.w = cvt_pk_bf16(x1[2], x1[3]);
                    *(u32x4*)p = w;
                    if (isvb) { unsigned zz = 0u; asm volatile("" : "+v"(zz)); const u32x4 z = {zz, zz, zz, zz}; *(u32x4*)(p + 64) = z; } }
            }
    }
};
__device__ __forceinline__ void st16_wt(void* p, const u32x4 v) { asm volatile("global_store_dwordx4 %0, %1, off sc1\n\ts_nop 1" :: "v"(p), "v"(v) : "memory"); }
__device__ __forceinline__ void st4bf_wt(bf16_t* p, const f32x4 v) { u32x2 w; w.x = cvt_pk_bf16(v.x, v.y); w.y = cvt_pk_bf16(v.z, v.w); asm volatile("global_store_dwordx2 %0, %1, off sc1\n\ts_nop 0" :: "v"(p), "v"(w) : "memory"); }
struct OutOrder {
    pg8::StaticOrder in; gu32* cnt; gu32* ctxc;
    __device__ __forceinline__ bool next(int i, pg8::Unit& u) const {
        if (ctxc == nullptr) { if (i != 0) return false; return in.next(0, u); }
        const int c = blockIdx.x;
        if (c < 12) { if (i != 0) return false; u.pm = 61 + (c >> 2); u.pn = c & 3; u.aux = 0; return true; }
        if (i == 0) return in.next(0, u);
        if (i == 1 && c < 16) { u.pm = 64; u.pn = c - 12; u.aux = 0; return true; }
        return false; }
    __device__ __forceinline__ void a_ready(const pg8::Unit& u) const {
        if (ctxc != nullptr && u.pm >= 64) { for (unsigned s = 0; s < (1u << 20); ++s) { if ((unsigned)__builtin_amdgcn_readfirstlane((int)__hip_atomic_load(ctxc, __ATOMIC_RELAXED, __HIP_MEMORY_SCOPE_AGENT)) == 12u) break; __builtin_amdgcn_s_sleep(2); }
            __builtin_amdgcn_fence(__ATOMIC_ACQUIRE, "agent"); } }
    __device__ __forceinline__ void done(const pg8::Unit& u) const {
        asm volatile("s_waitcnt vmcnt(0)" ::: "memory");
        int ln; asm volatile("v_mbcnt_lo_u32_b32 %0, -1, 0\n\tv_mbcnt_hi_u32_b32 %0, -1, %0" : "=v"(ln));
        if (ln == 0) __hip_atomic_fetch_add(cnt + u.pm, 1u, __ATOMIC_RELAXED, __HIP_MEMORY_SCOPE_AGENT); }
};
struct EpiOutProj {
    static constexpr bool PERM = true, AFTER_DRAIN = false;
    const float* xin; const float* ctxin; bf16_t* XB; const float* gate_lat; const float* gate_ctx; int layer;
    __device__ __forceinline__ void operator()(const f32x4 (&acc)[2][2][4][2], const pg8::Unit& u, int wr, int wc, int fr, int fq) const {
        const bool isctx = u.pm >= 64; const float* gate = isctx ? gate_ctx : gate_lat; const int col8 = u.pn * 256 + wc * 32 + 8 * fq;
        f32x4 g[2][2];
#pragma unroll
        for (int bj = 0; bj < 2; ++bj) { g[bj][0] = *(const f32x4*)(gate + col8 + bj * 128); g[bj][1] = *(const f32x4*)(gate + col8 + bj * 128 + 4); }
        if (layer == 0) {
#pragma unroll
            for (int am = 0; am < 4; ++am) { const int ai = am >> 1, m0 = (am & 1) * 2; f32x4 x[2][2][2];
#pragma unroll
                for (int mm = 0; mm < 2; ++mm) { const int row = u.pm * 256 + ai * 128 + wr * 64 + (m0 + mm) * 16 + fr;
                    const float* xo = (isctx ? ctxin + (size_t)(row - SEQ) * DM : xin + (size_t)row * DM) + col8;
#pragma unroll
                    for (int bj = 0; bj < 2; ++bj) { x[mm][bj][0] = *(const f32x4*)(xo + bj * 128); x[mm][bj][1] = *(const f32x4*)(xo + bj * 128 + 4); } }
#pragma unroll
                for (int mm = 0; mm < 2; ++mm) { const int m = m0 + mm; const int row = u.pm * 256 + ai * 128 + wr * 64 + m * 16 + fr; bf16_t* xn = XB + (size_t)row * DM + col8;
#pragma unroll
                    for (int bj = 0; bj < 2; ++bj) { const f32x4 y0 = x[mm][bj][0] + g[bj][0] * acc[ai][bj][m][0], y1 = x[mm][bj][1] + g[bj][1] * acc[ai][bj][m][1];
                        u32x4 o; o.x = cvt_pk_bf16(y0.x, y0.y); o.y = cvt_pk_bf16(y0.z, y0.w); o.z = cvt_pk_bf16(y1.x, y1.y); o.w = cvt_pk_bf16(y1.z, y1.w);
                        st16_wt(xn + bj * 128, o); } } }
        } else {
#pragma unroll
            for (int ai = 0; ai < 2; ++ai) { u32x4 xw[4][2];
#pragma unroll
                for (int m = 0; m < 4; ++m) { const int row = u.pm * 256 + ai * 128 + wr * 64 + m * 16 + fr; const bf16_t* xn = XB + (size_t)row * DM + col8;
#pragma unroll
                    for (int bj = 0; bj < 2; ++bj) xw[m][bj] = *(const u32x4*)(xn + bj * 128); }
#pragma unroll
                for (int m = 0; m < 4; ++m) { const int row = u.pm * 256 + ai * 128 + wr * 64 + m * 16 + fr; bf16_t* xn = XB + (size_t)row * DM + col8;
#pragma unroll
                    for (int bj = 0; bj < 2; ++bj) { const u32x4 w = xw[m][bj];
                        const f32x4 x0 = {__builtin_bit_cast(float, w.x << 16), __builtin_bit_cast(float, w.x & 0xffff0000u), __builtin_bit_cast(float, w.y << 16), __builtin_bit_cast(float, w.y & 0xffff0000u)};
                        const f32x4 x1 = {__builtin_bit_cast(float, w.z << 16), __builtin_bit_cast(float, w.z & 0xffff0000u), __builtin_bit_cast(float, w.w << 16), __builtin_bit_cast(float, w.w & 0xffff0000u)};
                        const f32x4 y0 = x0 + g[bj][0] * acc[ai][bj][m][0], y1 = x1 + g[bj][1] * acc[ai][bj][m][1];
                        u32x4 o; o.x = cvt_pk_bf16(y0.x, y0.y); o.y = cvt_pk_bf16(y0.z, y0.w); o.z = cvt_pk_bf16(y1.x, y1.y); o.w = cvt_pk_bf16(y1.z, y1.w);
                        st16_wt(xn + bj * 128, o); } } }
        }
    }
};
struct EpiMoe1 {
    static constexpr bool PERM = true, AFTER_DRAIN = false;
    bf16_t* HS;
    __device__ __forceinline__ void operator()(const f32x4 (&acc)[2][2][4][2], const pg8::Unit& u, int wr, int wc, int fr, int fq) const {
        const int col8 = (u.pn & 3) * 128 + wc * 32 + 8 * fq;
#pragma unroll
        for (int ai = 0; ai < 2; ++ai)
#pragma unroll
            for (int m = 0; m < 4; ++m) { const int row = u.pm * 256 + ai * 128 + wr * 64 + m * 16 + fr;
                const f32x4 a0 = acc[ai][0][m][0], a1 = acc[ai][0][m][1], b0 = acc[ai][1][m][0], b1 = acc[ai][1][m][1];
                u32x4 w; w.x = cvt_pk_bf16(silu_f(a0[0]) * b0[0], silu_f(a0[1]) * b0[1]); w.y = cvt_pk_bf16(silu_f(a0[2]) * b0[2], silu_f(a0[3]) * b0[3]);
                w.z = cvt_pk_bf16(silu_f(a1[0]) * b1[0], silu_f(a1[1]) * b1[1]); w.w = cvt_pk_bf16(silu_f(a1[2]) * b1[2], silu_f(a1[3]) * b1[3]);
                st16_wt(HS + (size_t)row * FFE + col8, w); }
    }
};
constexpr float YS_SCALE = 16.f, YS_INV = 1.f / 16.f;
struct EpiMoe2 {
    static constexpr bool PERM = true, AFTER_DRAIN = false;
    unsigned char* YS; bool halfn = false;
    __device__ __forceinline__ void operator()(const f32x4 (&acc)[2][2][4][2], const pg8::Unit& u, int wr, int wc, int fr, int fq) const {
        const int col8 = (u.pn & 3) * 256 + wc * 32 + 8 * fq + (halfn ? (u.aux & 1) * 128 : 0);
#pragma unroll
        for (int ai = 0; ai < 2; ++ai)
#pragma unroll
            for (int m = 0; m < 4; ++m) { const int row = u.pm * 256 + ai * 128 + wr * 64 + m * 16 + fr;
#pragma unroll
                for (int bj = 0; bj < 2; ++bj) { if (bj == 1 && halfn) break;
                    f32x4 v0 = acc[ai][bj][m][0] * YS_SCALE, v1 = acc[ai][bj][m][1] * YS_SCALE;
#pragma unroll
                    for (int j = 0; j < 4; ++j) { v0[j] = __builtin_amdgcn_fmed3f(v0[j], -448.f, 448.f); v1[j] = __builtin_amdgcn_fmed3f(v1[j], -448.f, 448.f); }
                    int w0 = __builtin_amdgcn_cvt_pk_fp8_f32(v0[0], v0[1], 0, false); w0 = __builtin_amdgcn_cvt_pk_fp8_f32(v0[2], v0[3], w0, true);
                    int w1 = __builtin_amdgcn_cvt_pk_fp8_f32(v1[0], v1[1], 0, false); w1 = __builtin_amdgcn_cvt_pk_fp8_f32(v1[2], v1[3], w1, true);
                    *(u32x2*)(YS + (size_t)row * DM + col8 + bj * 128) = (u32x2){(unsigned)w0, (unsigned)w1}; } }
    }
};
struct MoeOrder {
    int G, vcu, nunits; int ts[16]; const int* rowtok;
    __device__ __forceinline__ unsigned row_off(const pg8::Unit& u, int r) const { return (unsigned)min((unsigned)rowtok[u.aux + r], (unsigned)(NROW - 1)) * (unsigned)(DM * 2); }
    __device__ __forceinline__ bool next(int i, pg8::Unit& u) const {
        const int L = i * G + vcu; if (L >= nunits) return false;
        const int rt = L >> 2, ct = L & 3; int e = 0, tb = ts[0];
#pragma unroll
        for (int k = 1; k < 16; ++k) { const bool ge = rt >= ts[k]; e += ge ? 1 : 0; tb = ge ? ts[k] : tb; }
        u.pm = rt; u.pn = e * 4 + ct; u.aux = e * ROWCAP + (rt - tb) * 256; return true;
    }
    __device__ __forceinline__ int nloc() const { return vcu < nunits ? (nunits - vcu + G - 1) / G : 0; }
    __device__ __forceinline__ void a_ready(const pg8::Unit&) const {}
    __device__ __forceinline__ void done(const pg8::Unit&) const {}
};

struct MoeOrder2 {
    int vcu, nunits, part; int ts[16]; bool halfn = false;
    __device__ __forceinline__ bool next(int i, pg8::Unit& u) const {
        const int U = nunits, q = U >> 8, r = U & 255; int L; int hb = 0;
        if (part == 0) { if (vcu < r || i >= q) return false; L = i * 256 + vcu; }
        else { int b = vcu + i * 256; if (halfn) { hb = b & 1; b >>= 1; } if (b >= (q + 1) * r) return false; int k = 0; while (b >= r) { b -= r; ++k; } L = k * 256 + b; }
        const int rt = L >> 2, ct = L & 3; int e = 0;
#pragma unroll
        for (int k = 1; k < 16; ++k) e += (rt >= ts[k]) ? 1 : 0;
        u.pm = rt; u.pn = e * 4 + ct; u.aux = hb; return true; }
    __device__ __forceinline__ void a_ready(const pg8::Unit&) const {}
    __device__ __forceinline__ void done(const pg8::Unit&) const {}
};
__device__ __forceinline__ void moe_wait(gu32* flag, int base, int n) {
    const int tid = otid();
    if (tid < 64) { for (unsigned s = 0; s < (1u << 20); ++s) { bool ok = true;
            for (int j = tid; j < n; j += 64) ok = ok && (__hip_atomic_load(flag + base + j, __ATOMIC_RELAXED, __HIP_MEMORY_SCOPE_AGENT) == 1u);
            if (__all(ok)) break; __builtin_amdgcn_s_sleep(2); }
        __builtin_amdgcn_fence(__ATOMIC_ACQUIRE, "agent"); asm volatile("s_waitcnt vmcnt(0)" ::: "memory"); }
    __syncthreads();
}

__device__ __forceinline__ void tr_item(const float* W, int ldw, int k0, int n0, bf16_t* WT, int K, int nd0, LAS float* scr, int lane) {
    f32x4 v[8];
#pragma unroll
    for (int i = 0; i < 8; ++i) v[i] = *(const f32x4*)(W + (size_t)(k0 + 8 * i + (lane >> 3)) * ldw + n0 + (lane & 7) * 4);
#pragma unroll
    for (int i = 0; i < 8; ++i) { LAS float* d = scr + (8 * i + (lane >> 3)) * 33 + (lane & 7) * 4; d[0] = v[i].x; d[1] = v[i].y; d[2] = v[i].z; d[3] = v[i].w; }
    LDS_WAIT(); asm volatile("" ::: "memory");
    const int c = lane & 7;
#pragma unroll
    for (int j = 0; j < 4; ++j) { const int n = (lane >> 3) + 8 * j; const LAS float* s = scr + (8 * c) * 33 + n;
        u32x4 o; o.x = pk2(s[0 * 33], s[1 * 33]); o.y = pk2(s[2 * 33], s[3 * 33]); o.z = pk2(s[4 * 33], s[5 * 33]); o.w = pk2(s[6 * 33], s[7 * 33]);
        *(u32x4*)(WT + (size_t)(nd0 + n) * K + k0 + 8 * c) = o; }
    LDS_WAIT(); asm volatile("" ::: "memory");
}
__device__ __forceinline__ void moe_convert(const Args& a, int L, LAS float* scr, int gw, int NGW, int lane, int it0 = 0, int it1 = 12288) {
    bf16_t* W13T = (bf16_t*)(a.ws + WS_W13) + (size_t)L * 16 * 1024 * 1024; bf16_t* W2T = (bf16_t*)(a.ws + WS_W2) + (size_t)L * 16 * 1024 * 512;
    for (int it = it0 + gw; it < it1; it += NGW) {
        if (it < 8192) { const int e = it >> 9, r2 = it & 511, kb = r2 >> 5, nb = r2 & 31, nd0 = 32 * nb, t = nd0 >> 8, bj = (nd0 >> 7) & 1, i0 = nd0 & 127;
            const float* src = (bj ? a.in[I_W3] : a.in[I_W1]) + (size_t)(L * 16 + e) * 1024 * 512;
            tr_item(src, 512, 64 * kb, t * 128 + i0, W13T + (size_t)e * 1024 * 1024, 1024, nd0, scr, lane); }
        else { const int r = it - 8192, e = r >> 8, r2 = r & 255, kb = r2 >> 5, nb = r2 & 31;
            tr_item(a.in[I_W2] + (size_t)(L * 16 + e) * 512 * 1024, 1024, 64 * kb, 32 * nb, W2T + (size_t)e * 1024 * 512, 512, 32 * nb, scr, lane); }
    }
}
__device__ __forceinline__ void prologue_phase(const Args& a, unsigned char* lds) {
    const int tid = otid(), lane = tid & 63, wave = tid >> 6, gw = blockIdx.x * NWAVES + wave, NGW = gridDim.x * NWAVES;
    LAS float* scr = (LAS float*)((LAS unsigned char*)lds + wave * 8704);
    bf16_t* WinT = (bf16_t*)(a.ws + WS_WIN); bf16_t* WoutT = (bf16_t*)(a.ws + WS_WOUT);
    for (int it = gw; it < 3584; it += NGW) {
        if (it < 2560) { const int L = it / 1280, r = it % 1280, kb = r / 80, nb = r % 80, nd0 = 32 * nb; int n0 = nd0;
            if (nd0 >= 2048) { const int q = nd0 - 2048, t = q >> 8, bj = (q >> 7) & 1, i0 = q & 127; n0 = 2048 + bj * 256 + t * 128 + i0; }
            tr_item(a.in[I_WIN] + (size_t)L * 1024 * INW, INW, 64 * kb, n0, WinT + (size_t)L * INW * 1024, 1024, nd0, scr, lane); }
        else { const int r0 = it - 2560, L = r0 >> 9, r = r0 & 511, kb = r >> 5, nb = r & 31;
            tr_item(a.in[I_WOUT] + (size_t)L * 1024 * 1024, 1024, 64 * kb, 32 * nb, WoutT + (size_t)L * 1024 * 1024, 1024, 32 * nb, scr, lane); }
    }
    moe_convert(a, 0, scr, gw, NGW, lane, 0, 8192);
    __syncthreads();
    float* sc = (float*)(lds + 71680); float* scc = sc + 1024; float* red = scc + 1024;
    float* MOD = (float*)(a.ws + WS_MOD);
    for (int u = blockIdx.x; u < 192; u += gridDim.x) {
        const int L = u / 96, col0 = (u % 96) * 64;
        for (int k = tid; k < 1024; k += NTHREADS) { const float c = a.in[I_C][k], cc = a.in[I_CCTX][k]; sc[k] = c / (1.f + expf(-c)); scc[k] = cc / (1.f + expf(-cc)); }
        __syncthreads();
        const int cg = tid & 15, ks = tid >> 4;
        const float* w = a.in[I_WADA] + ((size_t)L * 1024 + ks * 32) * 6144 + col0 + cg * 4;
        f32x4 s1 = {0.f, 0.f, 0.f, 0.f}, s2 = {0.f, 0.f, 0.f, 0.f};
#pragma unroll 8
        for (int k = 0; k < 32; ++k) { const f32x4 wv = *(const f32x4*)(w + (size_t)k * 6144); s1 = s1 + wv * sc[ks * 32 + k]; s2 = s2 + wv * scc[ks * 32 + k]; }
        *(f32x4*)(red + (ks * 16 + cg) * 8) = s1; *(f32x4*)(red + (ks * 16 + cg) * 8 + 4) = s2;
        __syncthreads();
        if (tid < 128) { const int which = tid >> 6, c = tid & 63; float s = 0.f;
            for (int k = 0; k < 32; ++k) s += red[(k * 16 + (c >> 2)) * 8 + which * 4 + (c & 3)];
            MOD[(L * 2 + which) * 6144 + col0 + c] = s + a.in[I_BADA][L * 6144 + col0 + c]; }
        __syncthreads();
    }
    if (blockIdx.x >= 192 && tid < 64) {
        float* rc = (float*)(a.ws + WS_ROPEC); float* rs = (float*)(a.ws + WS_ROPES);
        const int i = ((int)blockIdx.x - 192) * 64 + tid; const int pos = i >> 4, f = i & 15; const float inv = powf(10000.f, -(float)f / 16.f), ang = (float)pos * inv; rc[i] = cosf(ang); rs[i] = sinf(ang);
    }
    if (blockIdx.x == gridDim.x - 2 && wave < 2) {
        const float* dl = a.in[I_DLAM] + wave * 256;
        const float s01 = wave_sum(dl[lane] * dl[64 + lane]), s23 = wave_sum(dl[128 + lane] * dl[192 + lane]);
        if (lane == 0) ((float*)(a.ws + WS_LAM))[wave] = expf(s01) - expf(s23) + LAMBDA_INIT[wave];
    }
}

__device__ __forceinline__ void norm1_phase(const Args& a, int l) {
    constexpr int NR = 4;
    const int tid = otid(), lane = tid & 63, wave = tid >> 6;
    const int nrows = (l == 2) ? SEQ : NROW, rpw = (nrows + gridDim.x - 1) / gridDim.x, r0 = blockIdx.x * rpw, r1 = min(nrows, r0 + rpw);
    const int rw = (rpw + NWAVES - 1) / NWAVES, wr0 = r0 + wave * rw, wr1 = min(r1, wr0 + rw);
    bf16_t* XB = (bf16_t*)(a.ws + WS_XB); bf16_t* HB = (bf16_t*)(a.ws + WS_HB); const unsigned char* YS = a.ws + WS_RA;
    const float* MOD = (const float*)(a.ws + WS_MOD);
    const int2* TOKP = (const int2*)(a.ws + WS_TOKP); const float2* TOKW = (const float2*)(a.ws + WS_TOKW);
    f32x4 ga[4], gb[4], gq[4]; int cur_ctx = -1;
#define N1_PARAMS(isctx_) do { if ((int)(isctx_) != cur_ctx) { cur_ctx = (int)(isctx_); \
        if (l < 2) { const f32x4* g_ = (const f32x4*)(a.in[I_GMIX] + l * DM) + lane; const float* md_ = MOD + (l * 2 + cur_ctx) * 6144; \
            _Pragma("unroll") for (int j = 0; j < 4; ++j) { ga[j] = g_[64 * j] * (((const f32x4*)(md_ + 1024) + lane)[64 * j] + 1.f); gb[j] = ((const f32x4*)(md_) + lane)[64 * j]; } } \
        else { const f32x4* g_ = (const f32x4*)(a.in[I_GFIN]) + lane; _Pragma("unroll") for (int j = 0; j < 4; ++j) { ga[j] = g_[64 * j]; gb[j] = ga[j]; } } \
        if (l != 0) { const f32x4* q_ = (const f32x4*)(MOD + ((l - 1) * 2 + cur_ctx) * 6144 + 5 * 1024) + lane; _Pragma("unroll") for (int j = 0; j < 4; ++j) gq[j] = q_[64 * j]; } \
        else { _Pragma("unroll") for (int j = 0; j < 4; ++j) gq[j] = ga[j]; } } } while (0)
    for (int rb = wr0; rb < wr1; rb += NR) {
        f32x4 v[NR][4]; int rowk[NR];
#pragma unroll
        for (int k = 0; k < NR; ++k) rowk[k] = min(rb + k, wr1 - 1);
        if (l == 0) {
#pragma unroll
            for (int k = 0; k < NR; ++k) { const int row = rowk[k]; const bool isctx = row >= SEQ;
                const f32x4* src = (const f32x4*)(isctx ? a.in[I_CTX] + (size_t)(row - SEQ) * DM : a.in[I_X] + (size_t)row * DM) + lane;
#pragma unroll
                for (int j = 0; j < 4; ++j) v[k][j] = src[64 * j]; }
        } else {
            int2 pp[NR]; float2 ww[NR];
#pragma unroll
            for (int k = 0; k < NR; ++k) { pp[k] = TOKP[rowk[k]]; ww[k] = TOKW[rowk[k]]; }
            { const int* tsg = (const int*)(a.ws + WS_TSG) + (l - 1) * 32;
#pragma unroll
              for (int k = 0; k < NR; ++k) { pp[k].x = tsg[pp[k].x >> 15] * 256 + (pp[k].x & 32767); pp[k].y = tsg[pp[k].y >> 15] * 256 + (pp[k].y & 32767); } }
            unsigned y0[NR][4], y1[NR][4];
#pragma unroll
            for (int k = 0; k < NR; ++k) { const int row = rowk[k]; const bool isctx = row >= SEQ;
                const bf16_t* xb = XB + (size_t)row * DM + 4 * lane; (void)isctx;
                const unsigned* q0 = (const unsigned*)(YS + (size_t)pp[k].x * DM) + lane; const unsigned* q1 = (const unsigned*)(YS + (size_t)pp[k].y * DM) + lane;
#pragma unroll
                for (int j = 0; j < 4; ++j) { v[k][j] = ld4bf(xb + 256 * j); y0[k][j] = q0[64 * j]; y1[k][j] = q1[64 * j]; } }
#pragma unroll
            for (int k = 0; k < NR; ++k) { const bool st = (rb + k < wr1) && (l < 2); bf16_t* xb = XB + (size_t)rowk[k] * DM + 4 * lane; N1_PARAMS(rowk[k] >= SEQ);
#pragma unroll
                for (int j = 0; j < 4; ++j) { const int p0 = (int)y0[k][j], p1 = (int)y1[k][j];
                    const auto a01 = __builtin_amdgcn_cvt_pk_f32_fp8(p0, false), a23 = __builtin_amdgcn_cvt_pk_f32_fp8(p0, true), b01 = __builtin_amdgcn_cvt_pk_f32_fp8(p1, false), b23 = __builtin_amdgcn_cvt_pk_f32_fp8(p1, true);
                    const f32x4 ya = {a01[0], a01[1], a23[0], a23[1]}, yb = {b01[0], b01[1], b23[0], b23[1]};
                    v[k][j] = v[k][j] + gq[j] * (ya * (ww[k].x * YS_INV) + yb * (ww[k].y * YS_INV));
                    if (st) st4bf(xb + 256 * j, v[k][j]); } }
        }
#pragma unroll
        for (int k = 0; k < NR; ++k) { const int row = rowk[k]; const bool isctx = row >= SEQ, st = rb + k < wr1;
            float ss = 0.f;
#pragma unroll
            for (int j = 0; j < 4; ++j) ss += (v[k][j].x * v[k][j].x + v[k][j].y * v[k][j].y) + (v[k][j].z * v[k][j].z + v[k][j].w * v[k][j].w);
            const float rstd = 1.f / sqrtf(wave_sum(ss) * (1.f / DM) + EPS);
            N1_PARAMS(isctx);
            if (l < 2) {
                u32x2* o8 = (u32x2*)(HB + (size_t)row * DM) + lane;
#pragma unroll
                for (int j = 0; j < 4; ++j) { const f32x4 h = v[k][j] * rstd * ga[j] + gb[j];
                    u32x2 w; w.x = cvt_pk_bf16(h.x, h.y); w.y = cvt_pk_bf16(h.z, h.w); if (st) o8[64 * j] = w; }
            } else {
                f32x4* o = (f32x4*)(a.out + (size_t)row * DM) + lane;
#pragma unroll
                for (int j = 0; j < 4; ++j) { const f32x4 r = v[k][j] * rstd * ga[j]; if (st) o[64 * j] = r; }
            }
        }
    }
}
#undef N1_PARAMS
__device__ __forceinline__ void norm2_phase(const Args& a, int l, unsigned char* lds) {
    const int tid = otid(), lane = tid & 63, wave = tid >> 6;
    const int b_ = blockIdx.x;
    const int nlat = (l == 1) ? 64 : (b_ < 16 ? 1 : 65), lat0 = (l == 1) ? b_ * 64 : (b_ < 16 ? 240 * 65 + b_ : (b_ - 16) * 65);
    const int nlate = (l == 1) ? 0 : 4, late0 = 61 * 256 + 4 * b_, tl = 61 + (b_ >> 6), nloc = nlat + nlate;
#define N2_ROW(i) ((i) < nlat ? lat0 + (i) : late0 + ((i) - nlat))
    float* hrow = (float*)lds;
    float* logit = (float*)(lds + 65536);
    int* e01 = (int*)(lds + 65536 + 8192);
    for (int i = tid; i < 128; i += NTHREADS) e01[i] = -1;
    gu32* cnt = (gu32*)(a.ws + WS_CTL) + CW_OPC + l * 128;
#define N2_WAIT(ta_, tb_) do { if (tid < 64) { for (unsigned s = 0; s < (1u << 20); ++s) { const unsigned c = __hip_atomic_load(cnt + ((lane & 1) ? (tb_) : (ta_)), __ATOMIC_RELAXED, __HIP_MEMORY_SCOPE_AGENT); \
              if (__all(c == 32u)) break; __builtin_amdgcn_s_sleep(2); } \
          __builtin_amdgcn_fence(__ATOMIC_ACQUIRE, "agent"); asm volatile("s_waitcnt vmcnt(0)" ::: "memory"); } \
      __syncthreads(); } while (0)
    N2_WAIT(lat0 >> 8, (lat0 + nlat - 1) >> 8);
    const bf16_t* XB = (const bf16_t*)(a.ws + WS_XB); bf16_t* HB = (bf16_t*)(a.ws + WS_HB); const float* MOD = (const float*)(a.ws + WS_MOD);
    int2* TOKE = (int2*)(a.ws + WS_TOKE); float2* TOKW = (float2*)(a.ws + WS_TOKW);
    const int eg = wave & 3, rh = wave >> 2;
    f32x4 wk[4][4];
#pragma unroll
    for (int j = 0; j < 4; ++j)
#pragma unroll
        for (int c = 0; c < 4; ++c) wk[j][c] = *(const f32x4*)(a.in[I_RW] + (size_t)(256 * j + 4 * lane + c) * 16 + 4 * eg);
    f32x4 ga[4], gb[4]; int cur_ctx = -1;
#define N2_PARAMS(isctx_) do { if ((int)(isctx_) != cur_ctx) { cur_ctx = (int)(isctx_); const f32x4* g_ = (const f32x4*)(a.in[I_GFFN] + l * DM) + lane; const float* md_ = MOD + (l * 2 + cur_ctx) * 6144; \
        _Pragma("unroll") for (int j = 0; j < 4; ++j) { ga[j] = g_[64 * j] * (((const f32x4*)(md_ + 4 * 1024) + lane)[64 * j] + 1.f); gb[j] = ((const f32x4*)(md_ + 3 * 1024) + lane)[64 * j]; } } } while (0)
    u32x2 xr[2][4];
#define N2_LOADX(rb_) do { _Pragma("unroll") for (int k = 0; k < 2; ++k) { const bf16_t* xb = XB + (size_t)N2_ROW(min((rb_) + 2 * wave + k, nloc - 1)) * DM + 4 * lane; \
        _Pragma("unroll") for (int j = 0; j < 4; ++j) xr[k][j] = *(const u32x2*)(xb + 256 * j); } } while (0)
    const bool cfirst = (l != 1) && nlat < 16;
    if (cfirst) N2_WAIT(tl, tl);
    N2_LOADX(0);
    for (int rb = 0; rb < nloc; rb += 16) {
        if ((l != 1) && !cfirst && rb <= nlat && nlat < rb + 16) { N2_WAIT(tl, tl); N2_LOADX(rb); }
        f32x4 vv[2][4];
#pragma unroll
        for (int k = 0; k < 2; ++k)
#pragma unroll
            for (int j = 0; j < 4; ++j) { const u32x2 w = xr[k][j]; vv[k][j] = (f32x4){__builtin_bit_cast(float, w.x << 16), __builtin_bit_cast(float, w.x & 0xffff0000u), __builtin_bit_cast(float, w.y << 16), __builtin_bit_cast(float, w.y & 0xffff0000u)}; }
#pragma unroll
        for (int k = 0; k < 2; ++k) { const int row = N2_ROW(min(rb + 2 * wave + k, nloc - 1)); const bool isctx = row >= SEQ, st = rb + 2 * wave + k < nloc;
            float ss = 0.f;
#pragma unroll
            for (int j = 0; j < 4; ++j) ss += (vv[k][j].x * vv[k][j].x + vv[k][j].y * vv[k][j].y) + (vv[k][j].z * vv[k][j].z + vv[k][j].w * vv[k][j].w);
            const float rstd = 1.f / sqrtf(wave_sum(ss) * (1.f / DM) + EPS);
            N2_PARAMS(isctx);
            u32x2* o8 = (u32x2*)(HB + (size_t)row * DM) + lane; f32x4* hr = (f32x4*)(hrow + (2 * wave + k) * 1024) + lane;
#pragma unroll
            for (int j = 0; j < 4; ++j) { const f32x4 h = vv[k][j] * rstd * ga[j] + gb[j];
                hr[64 * j] = h; u32x2 w; w.x = cvt_pk_bf16(h.x, h.y); w.y = cvt_pk_bf16(h.z, h.w); if (st) o8[64 * j] = w; } }
        __syncthreads();
        if (rb + 16 < nloc && !((l != 1) && rb + 16 <= nlat && nlat < rb + 32)) N2_LOADX(rb + 16);
        float v32[32];
#pragma unroll
        for (int q2 = 0; q2 < 4; ++q2) {
            f32x4 h[2][4];
#pragma unroll
            for (int qq = 0; qq < 2; ++qq) { const f32x4* hr = (const f32x4*)(hrow + (rh * 8 + q2 * 2 + qq) * 1024) + lane;
#pragma unroll
                for (int j = 0; j < 4; ++j) h[qq][j] = hr[64 * j]; }
            asm volatile("" : "+v"(h[0][0]), "+v"(h[0][1]), "+v"(h[0][2]), "+v"(h[0][3]), "+v"(h[1][0]), "+v"(h[1][1]), "+v"(h[1][2]), "+v"(h[1][3]));
#pragma unroll
            for (int qq = 0; qq < 2; ++qq) { const int q = q2 * 2 + qq; f32x4 acc = {0.f, 0.f, 0.f, 0.f};
#pragma unroll
                for (int j = 0; j < 4; ++j)
#pragma unroll
                    for (int e = 0; e < 4; ++e) { acc[e] = __builtin_fmaf(h[qq][j].x, wk[j][0][e], acc[e]); acc[e] = __builtin_fmaf(h[qq][j].y, wk[j][1][e], acc[e]); acc[e] = __builtin_fmaf(h[qq][j].z, wk[j][2][e], acc[e]); acc[e] = __builtin_fmaf(h[qq][j].w, wk[j][3][e], acc[e]); }
                v32[q * 4] = acc[0]; v32[q * 4 + 1] = acc[1]; v32[q * 4 + 2] = acc[2]; v32[q * 4 + 3] = acc[3]; } }
        float v16[16], v8[8], v4[4], v2[2], v1;
        { float sh[16], kp[16]; const bool up = (lane & 32) != 0;
#pragma unroll
          for (int i = 0; i < 16; ++i) { const float lo_ = v32[i], hi_ = v32[16 + i]; kp[i] = up ? hi_ : lo_; sh[i] = __shfl_xor(up ? lo_ : hi_, 32); }
          asm volatile("" : "+v"(sh[0]), "+v"(sh[1]), "+v"(sh[2]), "+v"(sh[3]), "+v"(sh[4]), "+v"(sh[5]), "+v"(sh[6]), "+v"(sh[7]));
          asm volatile("" : "+v"(sh[8]), "+v"(sh[9]), "+v"(sh[10]), "+v"(sh[11]), "+v"(sh[12]), "+v"(sh[13]), "+v"(sh[14]), "+v"(sh[15]));
#pragma unroll
          for (int i = 0; i < 16; ++i) v16[i] = kp[i] + sh[i]; }
        { float sh[8], kp[8]; const bool up = (lane & 16) != 0;
#pragma unroll
          for (int i = 0; i < 8; ++i) { const float lo_ = v16[i], hi_ = v16[8 + i]; kp[i] = up ? hi_ : lo_; sh[i] = __shfl_xor(up ? lo_ : hi_, 16); }
          asm volatile("" : "+v"(sh[0]), "+v"(sh[1]), "+v"(sh[2]), "+v"(sh[3]), "+v"(sh[4]), "+v"(sh[5]), "+v"(sh[6]), "+v"(sh[7]));
#pragma unroll
          for (int i = 0; i < 8; ++i) v8[i] = kp[i] + sh[i]; }
        { float sh[4], kp[4]; const bool up = (lane & 8) != 0;
#pragma unroll
          for (int i = 0; i < 4; ++i) { const float lo_ = v8[i], hi_ = v8[4 + i]; kp[i] = up ? hi_ : lo_; sh[i] = __shfl_xor(up ? lo_ : hi_, 8); }
          asm volatile("" : "+v"(sh[0]), "+v"(sh[1]), "+v"(sh[2]), "+v"(sh[3]));
#pragma unroll
          for (int i = 0; i < 4; ++i) v4[i] = kp[i] + sh[i]; }
        { float sh[2], kp[2]; const bool up = (lane & 4) != 0;
#pragma unroll
          for (int i = 0; i < 2; ++i) { const float lo_ = v4[i], hi_ = v4[2 + i]; kp[i] = up ? hi_ : lo_; sh[i] = __shfl_xor(up ? lo_ : hi_, 4); }
          asm volatile("" : "+v"(sh[0]), "+v"(sh[1]));
#pragma unroll
          for (int i = 0; i < 2; ++i) v2[i] = kp[i] + sh[i]; }
        { const bool up = (lane & 2) != 0; v1 = (up ? v2[1] : v2[0]) + __shfl_xor(up ? v2[0] : v2[1], 2); }
        v1 += __shfl_xor(v1, 1);
        { const int I = (lane >> 1) & 31, q = I >> 2, e = I & 3; const int rl = rh * 8 + q;
          if ((lane & 1) == 0 && rb + rl < nloc) logit[(rb + rl) * 16 + 4 * eg + e] = v1; }
        __syncthreads();
    }
#undef N2_LOADX
#undef N2_WAIT
#undef N2_PARAMS
    if (wave < 2) { const int rowl = wave * 64 + lane, row = N2_ROW(rowl);
      if (rowl < nloc) {
        float lg[16];
#pragma unroll
        for (int q = 0; q < 4; ++q) { const f32x4 t = *(const f32x4*)(logit + rowl * 16 + 4 * q); lg[4 * q] = t.x; lg[4 * q + 1] = t.y; lg[4 * q + 2] = t.z; lg[4 * q + 3] = t.w; }
        float sg[16], bs[16];
#pragma unroll
        for (int e = 0; e < 16; ++e) { sg[e] = sigmoid_f(lg[e]); bs[e] = sg[e] + a.in[I_RB][e]; }
        int gsel = 0; float best = 0.f;
#pragma unroll
        for (int gi = 0; gi < 4; ++gi) { const float p_ = bs[4 * gi], q_ = bs[4 * gi + 1], r_ = bs[4 * gi + 2], s_ = bs[4 * gi + 3];
            const float h1 = fmaxf(p_, q_), l1 = fminf(p_, q_), h2 = fmaxf(r_, s_), l2 = fminf(r_, s_);
            const float gsc = fmaxf(h1, h2) + fmaxf(fminf(h1, h2), fmaxf(l1, l2));
            if (gi == 0 || gsc > best) { best = gsc; gsel = gi; } }
        float gb[4], gs4[4];
#pragma unroll
        for (int i = 0; i < 4; ++i) { gb[i] = gsel == 0 ? bs[i] : gsel == 1 ? bs[4 + i] : gsel == 2 ? bs[8 + i] : bs[12 + i];
            gs4[i] = gsel == 0 ? sg[i] : gsel == 1 ? sg[4 + i] : gsel == 2 ? sg[8 + i] : sg[12 + i]; }
        int i0 = 0; float b0 = gb[0];
#pragma unroll
        for (int i = 1; i < 4; ++i) if (gb[i] > b0) { b0 = gb[i]; i0 = i; }
        int i1 = -1; float b1 = 0.f;
#pragma unroll
        for (int i = 0; i < 4; ++i) if (i != i0 && (i1 < 0 || gb[i] > b1)) { b1 = gb[i]; i1 = i; }
        const float s0 = i0 == 0 ? gs4[0] : i0 == 1 ? gs4[1] : i0 == 2 ? gs4[2] : gs4[3];
        const float s1 = i1 == 0 ? gs4[0] : i1 == 1 ? gs4[1] : i1 == 2 ? gs4[2] : gs4[3];
        const int e0 = gsel * 4 + i0, e1 = gsel * 4 + i1; const float inv = 1.f / (s0 + s1);
        TOKE[row] = make_int2(e0, e1); TOKW[row] = make_float2(s0 * inv, s1 * inv); e01[rowl] = e0 | (e1 << 8);
      } }
    __syncthreads();
    if (wave == 0) {
        int cnt = 0;
        for (int p = 0; p < 2; ++p) { const int pk = e01[p * 64 + lane]; const int e0 = pk < 0 ? -1 : (pk & 255), e1 = pk < 0 ? -1 : (pk >> 8);
#pragma unroll
            for (int e = 0; e < 16; ++e) { const int c = __popcll(__ballot(e0 == e)) + __popcll(__ballot(e1 == e)); if (lane == e) cnt += c; } }
        int base = 0;
        if (lane < 16) base = (int)__hip_atomic_fetch_add((unsigned*)(a.ws + WS_CTL) + CW_TOT + l * 64 + lane, (unsigned)cnt, __ATOMIC_RELAXED, __HIP_MEMORY_SCOPE_AGENT);
        int run[16];
#pragma unroll
        for (int e = 0; e < 16; ++e) run[e] = __builtin_amdgcn_readlane(base, e);
        int2* TOKP = (int2*)(a.ws + WS_TOKP); int* ROWTOK2 = (int*)(a.ws + WS_ROWTOK2) + (size_t)l * 16 * ROWCAP;
        for (int p = 0; p < 2; ++p) { const int i = p * 64 + lane, row = N2_ROW(i); const int pk = e01[i]; const bool ok = pk >= 0;
            const int ex = ok ? (pk & 255) : -1, ey = ok ? (pk >> 8) : -1;
            int pos0 = 0, pos1 = 0; const unsigned long long lt = (1ull << lane) - 1ull;
#pragma unroll
            for (int e = 0; e < 16; ++e) { const unsigned long long m0 = __ballot(ex == e), m1 = __ballot(ey == e);
                if (ex == e) pos0 = run[e] + __popcll(m0 & lt);
                if (ey == e) pos1 = run[e] + __popcll(m0) + __popcll(m1 & lt);
                run[e] += __popcll(m0) + __popcll(m1); }
            if (ok) { TOKP[row] = make_int2(ex * 32768 + pos0, ey * 32768 + pos1); ROWTOK2[ex * ROWCAP + pos0] = row; ROWTOK2[ey * ROWCAP + pos1] = row; } }
    }
    __syncthreads();
#undef N2_ROW
}
#ifndef ATT
#define ATT att2
#endif
#ifndef REP_INPROJ
#define REP_INPROJ 1
#endif
#ifndef REP_ATTN
#define REP_ATTN 1
#endif
#ifndef REP_OUTPROJ
#define REP_OUTPROJ 1
#endif
#ifndef REP_N2SC
#define REP_N2SC 1
#endif
#ifndef REP_MOE
#define REP_MOE 1
#endif
template <class Inner> struct RepOrder { Inner in; int ntot;
    __device__ __forceinline__ bool next(int i, pg8::Unit& u) const { if (i >= ntot) return false; const int nl = in.nloc(); return in.next(i % nl, u); }
    __device__ __forceinline__ unsigned row_off(int r) const { return in.row_off(r); }
    __device__ __forceinline__ void a_ready(const pg8::Unit&) const {}
    __device__ __forceinline__ void done(const pg8::Unit&) const {} };

__device__ __forceinline__ bool wg_any(bool pred, int* ws, int wid, int lane) {
    const int w = __any(pred) ? 1 : 0;
    __syncthreads();
    if (lane == 0) ws[wid] = w;
    __syncthreads();
    int r = 0;
#pragma unroll
    for (int i = 0; i < NWAVES; ++i) r |= ws[i];
    __syncthreads();
    return r != 0;
}
__device__ __forceinline__ void diff_unit(const Args& a, int l, int qt, int head, char* lds) {
    int tid_ = otid();
    const int tid = tid_, wid = tid >> 6, lane = tid & 63;
    const bool isctx = qt >= 64; const int q0 = qt * 256, nA = isctx ? 4 : 260, a0 = isctx ? SEQ : 0;
    const bf16_t* QA = (const bf16_t*)(a.ws + RA_QA); const bf16_t* KA = (const bf16_t*)(a.ws + RA_KA); const bf16_t* VA = (const bf16_t*)(a.ws + RA_VA);
    bf16_t* MIX = (bf16_t*)(a.ws + WS_HB);
    float* stash0 = (float*)(a.ws + WS_RB) + (size_t)blockIdx.x * 256 * 128;
    float* wsf = (float*)(lds + ATT::LDS_WS) + wid * 64;
    const float lam = ((const float*)(a.ws + WS_LAM))[l], post = 1.f - LAMBDA_INIT[l];
    for (int map = 0; map < 2; ++map) {
        f32x16 o[4]; float m_, l_;
        const bf16_t* Qw_ = QA + (size_t)(q0 + wid * 32 + (lane & 31)) * 512 + head * 128 + map * 64;
        ATT::attn_body<0, 512, 512, false>(Qw_, KA + head * 128 + map * 64, VA + head * 128, nA, a0, 0, nA, 0, lds, tid, o, m_, l_);
        if (wg_any(!(l_ < 1.0e18f), (int*)(lds + ATT::LDS_WS) + 8 * 64, wid, lane)) {
            ATT::attn_body<0, 512, 512, true>(Qw_, KA + head * 128 + map * 64, VA + head * 128, nA, a0, 0, nA, 0, lds, tid, o, m_, l_); }
        int lo_ = lane; asm volatile("" : "+v"(lo_));
        const int r32 = lo_ & 31, hi = lo_ >> 5;
        float* stashv = stash0 + (size_t)((wid << 6) | lo_) * 4;
        if (hi == 0) wsf[r32] = l_;
        LDS_WAIT();
        float rli[16];
#pragma unroll
        for (int r = 0; r < 16; ++r) rli[r] = __builtin_amdgcn_rcpf(wsf[ATT::crow(r, hi)]);
        if (map == 0) {
#pragma unroll
            for (int d0 = 0; d0 < 4; ++d0)
#pragma unroll
                for (int rq = 0; rq < 4; ++rq) *(f32x4*)(stashv + (size_t)((d0 * 4 + rq) * NTHREADS) * 4) =
                    (f32x4){o[d0][4 * rq] * rli[4 * rq], o[d0][4 * rq + 1] * rli[4 * rq + 1], o[d0][4 * rq + 2] * rli[4 * rq + 2], o[d0][4 * rq + 3] * rli[4 * rq + 3]};
        } else {
            const float* gn = a.in[I_DNG] + l * 128;
            float g4[4];
#pragma unroll
            for (int d0 = 0; d0 < 4; ++d0) g4[d0] = gn[d0 * 32 + r32] * post;
            float ss[16];
#pragma unroll
            for (int r = 0; r < 16; ++r) { ss[r] = 0.f; const float f_ = lam * rli[r];
#pragma unroll
                for (int d0 = 0; d0 < 4; ++d0) o[d0][r] *= f_; }
#pragma unroll
            for (int d0 = 0; d0 < 4; ++d0) {
                f32x4 sv[4];
#pragma unroll
                for (int rq = 0; rq < 4; ++rq) sv[rq] = *(const f32x4*)(stashv + (size_t)((d0 * 4 + rq) * NTHREADS) * 4);
                asm volatile("" : "+v"(sv[0]), "+v"(sv[1]), "+v"(sv[2]), "+v"(sv[3]));
#pragma unroll
                for (int rq = 0; rq < 4; ++rq)
#pragma unroll
                    for (int j = 0; j < 4; ++j) { const int r = 4 * rq + j; const float oc = sv[rq][j] - o[d0][r]; o[d0][r] = oc; ss[r] += oc * oc; } }
            float s8[8], s4[4], s2[2], s1;
#pragma unroll
            for (int i = 0; i < 8; ++i) { const bool up = (lo_ & 16) != 0; s8[i] = (up ? ss[8 + i] : ss[i]) + __shfl_xor(up ? ss[i] : ss[8 + i], 16); }
#pragma unroll
            for (int i = 0; i < 4; ++i) { const bool up = (lo_ & 8) != 0; s4[i] = (up ? s8[4 + i] : s8[i]) + __shfl_xor(up ? s8[i] : s8[4 + i], 8); }
#pragma unroll
            for (int i = 0; i < 2; ++i) { const bool up = (lo_ & 4) != 0; s2[i] = (up ? s4[2 + i] : s4[i]) + __shfl_xor(up ? s4[i] : s4[2 + i], 4); }
            { const bool up = (lo_ & 2) != 0; s1 = (up ? s2[1] : s2[0]) + __shfl_xor(up ? s2[0] : s2[1], 2); }
            s1 += __shfl_xor(s1, 1);
            LDS_WAIT();
            if ((lo_ & 1) == 0) wsf[hi * 16 + ((lo_ >> 1) & 15)] = s1;
            LDS_WAIT();
#pragma unroll
            for (int r = 0; r < 16; ++r) { const float sc = __builtin_amdgcn_rsqf(wsf[hi * 16 + r] * (1.f / 128.f) + EPS);
                bf16_t* orow = MIX + (size_t)(q0 + wid * 32 + ATT::crow(r, hi)) * DM + head * 128 + r32;
#pragma unroll
                for (int d0 = 0; d0 < 4; ++d0) orow[d0 * 32] = (bf16_t)f2bf(o[d0][r] * sc * g4[d0]); }
        }
    }
}
__device__ __forceinline__ void win_unit(const Args& a, int l, int n, int g, char* lds) {
    int tid_ = otid();
    const int tid = tid_, wid = tid >> 6, lane = tid & 63;
    const bool isctx = n >= 128; const int h = 2 * g + (wid >> 2);
    const int rowq = (isctx ? SEQ + (n - 128) * 128 : n * 128) + (wid & 3) * 32;
    const int nB = isctx ? 0 : (6 - (n == 0 ? 2 : 0) - (n == 127 ? 2 : 0)), b0 = (n == 0) ? 0 : (n - 1) * 128;
    const bf16_t* QB = (const bf16_t*)(a.ws + RA_QB); const bf16_t* KB = (const bf16_t*)(a.ws + RA_KB); const bf16_t* VB = (const bf16_t*)(a.ws + RA_VB);
    bf16_t* MIX = (bf16_t*)(a.ws + WS_HB);
    float* wsf = (float*)(lds + ATT::LDS_WS) + wid * 64;
    f32x16 o[4]; float m_, l_;
    const bf16_t* Qw_ = QB + (size_t)(rowq + (lane & 31)) * 256 + h * 64;
    ATT::attn_body<1, 128, 256, false>(Qw_, KB + g * 64, VB + g * 128, 4, SEQ, b0, 4 + nB, rowq + (lane & 31), lds, tid, o, m_, l_);
    if (wg_any(!(l_ < 1.0e18f), (int*)(lds + ATT::LDS_WS) + 8 * 64, wid, lane)) {
        ATT::attn_body<1, 128, 256, true>(Qw_, KB + g * 64, VB + g * 128, 4, SEQ, b0, 4 + nB, rowq + (lane & 31), lds, tid, o, m_, l_); }
    const float ltot = l_ + __builtin_amdgcn_exp2f(a.in[I_SINK][l * 4 + h] * LOG2E - m_);
    int lo_ = lane; asm volatile("" : "+v"(lo_));
    const int r32 = lo_ & 31, hi = lo_ >> 5;
    if (hi == 0) wsf[r32] = ltot;
    LDS_WAIT();
#pragma unroll
    for (int r = 0; r < 16; ++r) { const float rl = __builtin_amdgcn_rcpf(wsf[ATT::crow(r, hi)]);
        bf16_t* orow = MIX + (size_t)(rowq + ATT::crow(r, hi)) * DM + 512 + h * 64 + r32;
        orow[0] = (bf16_t)f2bf(o[0][r] * rl); orow[32] = (bf16_t)f2bf(o[1][r] * rl); }
}
__device__ __forceinline__ void conv_unit(const Args& a, int l, int u, char* lds) {
    int tid_ = otid();
    const int tid = tid_, wid = tid >> 6, lane = tid & 63;
    const bool isctx = u >= 256; const int r0 = isctx ? (u - 256) * 64 : u * 64, rbase = isctx ? SEQ : 0, slen = isctx ? CTX : SEQ;
    const bf16_t* Z = (const bf16_t*)(a.ws + RA_Z); bf16_t* MIX = (bf16_t*)(a.ws + WS_HB);
    bf16_t* zt = (bf16_t*)lds; float* co = (float*)(lds + 49152);
    __syncthreads();
    for (int c = tid; c < 94 * 32; c += NTHREADS) { const int i = c >> 5, ch = c & 31, p = r0 - 15 + i;
        u32x4 v = {0u, 0u, 0u, 0u}; if (p >= 0 && p < slen) v = *(const u32x4*)(Z + (size_t)(rbase + p) * 256 + ch * 8);
        *(u32x4*)(zt + i * 256 + ch * 8) = v; }
    __syncthreads();
    { const int c = tid & 255, t0 = (tid >> 8) * 32; float w[31];
#pragma unroll
      for (int j = 0; j < 31; ++j) w[j] = a.in[I_CONVW][(size_t)(l * 31 + j) * 256 + c];
      const float bias = a.in[I_CONVB][l * 256 + c];
#pragma unroll
      for (int tb = 0; tb < 32; tb += 8) {
          float zr[38]; unsigned zu[38];
#pragma unroll
          for (int i = 0; i < 38; ++i) zu[i] = zt[(t0 + tb + i) * 256 + c];
          asm volatile("" : "+v"(zu[0]), "+v"(zu[1]), "+v"(zu[2]), "+v"(zu[3]), "+v"(zu[4]), "+v"(zu[5]), "+v"(zu[6]), "+v"(zu[7]), "+v"(zu[8]), "+v"(zu[9]), "+v"(zu[10]), "+v"(zu[11]), "+v"(zu[12]));
          asm volatile("" : "+v"(zu[13]), "+v"(zu[14]), "+v"(zu[15]), "+v"(zu[16]), "+v"(zu[17]), "+v"(zu[18]), "+v"(zu[19]), "+v"(zu[20]), "+v"(zu[21]), "+v"(zu[22]), "+v"(zu[23]), "+v"(zu[24]), "+v"(zu[25]));
          asm volatile("" : "+v"(zu[26]), "+v"(zu[27]), "+v"(zu[28]), "+v"(zu[29]), "+v"(zu[30]), "+v"(zu[31]), "+v"(zu[32]), "+v"(zu[33]), "+v"(zu[34]), "+v"(zu[35]), "+v"(zu[36]), "+v"(zu[37]));
#pragma unroll
          for (int i = 0; i < 38; ++i) zr[i] = __builtin_bit_cast(float, zu[i] << 16);
#pragma unroll
          for (int t = 0; t < 8; ++t) { float acc = bias;
#pragma unroll
              for (int j = 0; j < 31; ++j) acc += zr[t + j] * w[j];
              co[(t0 + tb + t) * 256 + c] = acc; } } }
    __syncthreads();
    const f32x4 lg = *(const f32x4*)(a.in[I_LNG] + l * 256 + 4 * lane), lb = *(const f32x4*)(a.in[I_LNB] + l * 256 + 4 * lane);
    { f32x4 v[8]; float s[8]; float* sc8 = (float*)(lds + 114688) + wid * 16;
#pragma unroll
      for (int ti = 0; ti < 8; ++ti) { v[ti] = *(const f32x4*)(co + (wid + ti * NWAVES) * 256 + 4 * lane); s[ti] = (v[ti].x + v[ti].y) + (v[ti].z + v[ti].w); }
#define CONV_SUM8() do { float t4[4], t2[2], t1; \
        _Pragma("unroll") for (int i = 0; i < 4; ++i) { const bool up = (lane & 32) != 0; t4[i] = (up ? s[4 + i] : s[i]) + __shfl_xor(up ? s[i] : s[4 + i], 32); } \
        _Pragma("unroll") for (int i = 0; i < 2; ++i) { const bool up = (lane & 16) != 0; t2[i] = (up ? t4[2 + i] : t4[i]) + __shfl_xor(up ? t4[i] : t4[2 + i], 16); } \
        { const bool up = (lane & 8) != 0; t1 = (up ? t2[1] : t2[0]) + __shfl_xor(up ? t2[0] : t2[1], 8); } \
        t1 += __shfl_xor(t1, 4); t1 += __shfl_xor(t1, 2); t1 += __shfl_xor(t1, 1); \
        LDS_WAIT(); if ((lane & 7) == 0) sc8[lane >> 3] = t1; LDS_WAIT(); \
        _Pragma("unroll") for (int i = 0; i < 8; ++i) s[i] = sc8[i]; } while (0)
      CONV_SUM8();
#pragma unroll
      for (int ti = 0; ti < 8; ++ti) { v[ti] = v[ti] - s[ti] * (1.f / 256.f); s[ti] = (v[ti].x * v[ti].x + v[ti].y * v[ti].y) + (v[ti].z * v[ti].z + v[ti].w * v[ti].w); }
      CONV_SUM8();
#undef CONV_SUM8
#pragma unroll
      for (int ti = 0; ti < 8; ++ti) { const int t = wid + ti * NWAVES; const float rs = __builtin_amdgcn_rsqf(s[ti] * (1.f / 256.f) + EPS);
        const f32x4 zn = v[ti] * rs * lg + lb;
        u32x2 w; w.x = cvt_pk_bf16(silu_f(zn.x), silu_f(zn.y)); w.y = cvt_pk_bf16(silu_f(zn.z), silu_f(zn.w));
        *(u32x2*)(MIX + (size_t)(rbase + r0 + t) * DM + 768 + 4 * lane) = w; } }
    __syncthreads();
}
__device__ __forceinline__ void attn_phase(const Args& a, int l, char* lds, int pass) {
    const int b = blockIdx.x, G = gridDim.x, BIG = 1 << 20;
#ifndef AT_MASK
#define AT_MASK 7
#endif
    const int dst = pass == 0 ? b : (b < 4) ? 256 + b : BIG, wst = pass == 0 ? b : (b >= 4 && b < 8) ? 256 + (b - 4) : BIG, cst = pass == 0 ? b : (b >= 8 && b < 12) ? 256 + (b - 8) : BIG;
    const int uend = pass == 0 ? 256 : 260;
    if (AT_MASK & 1) for (int u = dst; u < uend; u += G) { const int qt = u < 256 ? (u >> 2) : 64, hd = u < 256 ? (u & 3) : (u - 256); diff_unit(a, l, qt, hd, lds); }
    if (AT_MASK & 2) for (int v = wst; v < uend; v += G) { const int n = v < 256 ? (v & 127) : 128 + ((v - 256) & 1), g = v < 256 ? (v >> 7) : ((v - 256) >> 1); win_unit(a, l, n, g, lds); }
    if (AT_MASK & 4) for (int v = cst; v < uend; v += G) conv_unit(a, l, v, lds);
    if (pass == 1 && b < 12) {
        asm volatile("s_waitcnt vmcnt(0)" ::: "memory"); __syncthreads();
        const int tid = otid(); if (tid < 64) { __builtin_amdgcn_fence(__ATOMIC_RELEASE, "agent"); asm volatile("s_waitcnt vmcnt(0)" ::: "memory");
            if (tid == 0) __hip_atomic_fetch_add((gu32*)(a.ws + WS_CTL) + CW_CTXC, 1u, __ATOMIC_RELAXED, __HIP_MEMORY_SCOPE_AGENT); } }
}

#ifndef MK_PER_PHASE
#define MK_PER_PHASE 0
#endif
#if defined(__HIP_DEVICE_COMPILE__)
#define KARGS(A) Args A; { const __attribute__((address_space(4))) Args* kp_ = (const __attribute__((address_space(4))) Args*)__builtin_amdgcn_kernarg_segment_ptr(); asm volatile("" : "+s"(kp_)); A = *kp_; }
#else
#define KARGS(A) Args A = a_unused;
#endif
__global__ void __launch_bounds__(NTHREADS, 2) hybrid_fwd(Args a_unused) {
    unsigned char* lds = g_lds;
    volatile LAS unsigned* MISC = (volatile LAS unsigned*)((LAS unsigned char*)lds + MISC_OFF);
    { const int tid0 = threadIdx.x; if (tid0 < 64) MISC[tid0] = 0u;
      if ((tid0 & 63) == 0) MISC[64 + ((unsigned)__builtin_amdgcn_s_getreg((5 << 11) | 4) & 63u)] = (unsigned)(tid0 >> 6); }
    __syncthreads();
    XcdBarrier bar; int lo, hi;
    { KARGS(a); lo = a.ph_lo; hi = a.ph_hi; gu32* ctl = (gu32*)(a.ws + WS_CTL);
      bar.bar = (unsigned*)(ctl + CW_BAR); bar.x = 0; bar.st = nullptr;
      if (!MK_PER_PHASE) bar = xcd_barrier_post((unsigned*)(ctl + CW_BAR), MISC); }
#ifndef PHMASK
#define PHMASK 0x3ffff
#endif
#define PHK(k) ((k) == 0 ? 0 : (k) == 17 ? 9 : (((k) - 1) & 7) + 1)
#define IN(k) (((PHMASK >> PHK(k)) & 1) && lo <= (k) && (k) < hi)
#define SEAM(k) do { if (!MK_PER_PHASE && IN(k) && IN((k) + 1)) xcd_barrier(bar); } while (0)
    LAS unsigned char* ldsl = (LAS unsigned char*)lds;
    const int G = gridDim.x, vcu = (G % 8 == 0) ? ((int)blockIdx.x % 8) * (G / 8) + (int)blockIdx.x / 8 : (int)blockIdx.x;

#ifndef REP_N1
#define REP_N1 1
#endif
#ifndef REP_SC
#define REP_SC 1
#endif
#ifndef REP_PRO
#define REP_PRO 1
#endif
    if (IN(0)) { KARGS(a); int nrep_ = REP_PRO; asm volatile("" : "+s"(nrep_)); for (int rp_ = 0; rp_ < nrep_; ++rp_) prologue_phase(a, lds); SEAM(0); }
    for (int l = 0; l < DEPTH; ++l) {
        const int pb = 1 + 8 * l;
        if (IN(pb + 0)) {
            KARGS(a);
            { int nrep_ = (l == 0) ? REP_N1 : 1; asm volatile("" : "+s"(nrep_)); for (int rp_ = 0; rp_ < nrep_; ++rp_) norm1_phase(a, l); }
            SEAM(pb + 0);
        }
        if (IN(pb + 1)) {
            KARGS(a);
            pg8::Gemm g{(const bf16_t*)(a.ws + WS_HB), (const bf16_t*)(a.ws + WS_WIN) + (size_t)l * INW * 1024, NROW, INW, DM};
            pg8::StaticOrder S; S.init(NROW, INW, G, (int)blockIdx.x);
            EpiInProj E{a.ws, (const float*)(a.ws + WS_ROPEC), (const float*)(a.ws + WS_ROPES)};
            RepOrder<pg8::StaticOrder> SR{S, REP_INPROJ * S.nloc()}; pg8::gemm_phase<EpiInProj, RepOrder<pg8::StaticOrder>, true, true>(ldsl, g, SR, E);
            if ((int)blockIdx.x >= 650 - 2 * G) {
                const int tid = otid(), c0 = 650 - 2 * G; moe_convert(a, l, (LAS float*)(ldsl + (tid >> 6) * 8704), ((int)blockIdx.x - c0) * NWAVES + (tid >> 6), (G - c0) * NWAVES, tid & 63, 8192, 12288); }
            SEAM(pb + 1);
        }
        if (IN(pb + 2)) { KARGS(a); int npass_ = (l == 0) ? 2 : 1; asm volatile("" : "+s"(npass_)); for (int ps_ = 0; ps_ < npass_; ++ps_) { attn_phase(a, l, (char*)lds, ps_); if (ps_ == 0) SEAM(pb + 2); } }
        if (IN(pb + 3)) {
            KARGS(a);
            const float* MOD = (const float*)(a.ws + WS_MOD);
            const int M = (l == DEPTH - 1) ? SEQ : NROW;
            pg8::Gemm g{(const bf16_t*)(a.ws + WS_HB), (const bf16_t*)(a.ws + WS_WOUT) + (size_t)l * 1024 * 1024, M, DM, DM};
            pg8::StaticOrder S; if (l == 0) S.init(61 * 256, DM, G - 12, (int)blockIdx.x - 12); else S.init(SEQ, DM, G, (int)blockIdx.x);
            EpiOutProj E{a.in[I_X], a.in[I_CTX], (bf16_t*)(a.ws + WS_XB), MOD + (l * 2) * 6144 + 2 * 1024, MOD + (l * 2 + 1) * 6144 + 2 * 1024, l};
            OutOrder SO{S, (gu32*)(a.ws + WS_CTL) + CW_OPC + l * 128, (l == 0) ? (gu32*)(a.ws + WS_CTL) + CW_CTXC : nullptr}; pg8::gemm_phase<EpiOutProj, OutOrder, true, true>(ldsl, g, SO, E);
            if (l == 0 && (int)blockIdx.x >= 16) {
                const int tid = otid(), nidle = G - 16; moe_convert(a, 1, (LAS float*)(ldsl + (tid >> 6) * 8704), ((int)blockIdx.x - 16) * NWAVES + (tid >> 6), nidle * NWAVES, tid & 63, 0, 8192); }
            __syncthreads();
        }
        if (IN(pb + 4)) { KARGS(a); int nrep_ = REP_N2SC; asm volatile("" : "+s"(nrep_)); for (int rp_ = 0; rp_ < nrep_; ++rp_) norm2_phase(a, l, lds); SEAM(pb + 4); }
        if (IN(pb + 6)) {
            KARGS(a);
            MoeOrder S; S.G = G; S.vcu = vcu;
            { const int tid = otid(); const unsigned* tot = (const unsigned*)(a.ws + WS_CTL) + CW_TOT + l * 64;
              if (tid == 0) { int t = 0; int* tsg = (int*)(a.ws + WS_TSG) + l * 32;
                  for (int e = 0; e < 16; ++e) { MISC[16 + e] = (unsigned)t; if (blockIdx.x == 0) tsg[e] = t; t += ((int)tot[e] + 255) >> 8; }
                  MISC[32] = (unsigned)t; if (blockIdx.x == 0) tsg[16] = t; }
              __syncthreads();
#pragma unroll
              for (int k = 0; k < 16; ++k) S.ts[k] = __builtin_amdgcn_readfirstlane((int)MISC[16 + k]);
              S.nunits = 4 * __builtin_amdgcn_readfirstlane((int)MISC[16 + 16]); }
            S.rowtok = (const int*)(a.ws + WS_ROWTOK2) + (size_t)l * 16 * ROWCAP;
            pg8::Gemm g{(const bf16_t*)(a.ws + WS_HB), (const bf16_t*)(a.ws + WS_W13) + (size_t)l * 16 * 1024 * 1024, XS_ROWS, 1024, DM};
            EpiMoe1 E{(bf16_t*)(a.ws + WS_RB)};
            pg8::gemm_phase<EpiMoe1, MoeOrder, true, true, true>(ldsl, g, S, E);
            gu32* flag = (gu32*)(a.ws + WS_CTL) + CW_MOEF + l * 256;
            { const int tid = otid(); if (tid == 0) __hip_atomic_store(flag + vcu, 1u, __ATOMIC_RELAXED, __HIP_MEMORY_SCOPE_AGENT); }
            MoeOrder2 S2; S2.vcu = vcu; S2.nunits = S.nunits;
#pragma unroll
            for (int k2 = 0; k2 < 16; ++k2) S2.ts[k2] = S.ts[k2];
            pg8::Gemm g2{(const bf16_t*)(a.ws + WS_RB), (const bf16_t*)(a.ws + WS_W2) + (size_t)l * 16 * 1024 * 512, XS_ROWS, 1024, FFE};
            EpiMoe2 E2{a.ws + WS_RA};
            const int r_ = S.nunits & 255;
            if (vcu >= r_ && S.nunits >= 256) { moe_wait(flag, vcu & ~3, 4); S2.part = 0; pg8::gemm_phase<EpiMoe2, MoeOrder2, true, true>(ldsl, g2, S2, E2); }
            if (r_ != 0) { moe_wait(flag, 0, r_); S2.part = 1; S2.halfn = true; E2.halfn = true; pg8::gemm_phase<EpiMoe2, MoeOrder2, true, true, false, true>(ldsl, g2, S2, E2); }
            SEAM(pb + 6);
        }
    }
    if (IN(17)) { KARGS(a); int nrep_ = REP_N1; asm volatile("" : "+s"(nrep_)); for (int rp_ = 0; rp_ < nrep_; ++rp_) norm1_phase(a, 2); }
#undef IN
#undef SEAM
}

extern "C" void kernel_launch(void* const* d_in, const int* in_sizes, int n_in, void* d_out, int out_size, void* d_ws, size_t ws_size, hipStream_t stream) {
    static int grid = 0;
    if (grid == 0) {
        if (n_in != 23 || in_sizes[0] != SEQ * DM || out_size != SEQ * DM || ws_size < WS_END) {
            fprintf(stderr, "kernel_launch: shape mismatch (n_in %d, in0 %d, out %d, ws %zu, need ws >= %zu); nothing launched\n", n_in, n_in > 0 ? in_sizes[0] : -1, out_size, ws_size, (size_t)WS_END); grid = -1; return; }
        int dev = 0, cus = 0, per_cu = 0;
        if (hipGetDevice(&dev) != hipSuccess || hipDeviceGetAttribute(&cus, hipDeviceAttributeMultiprocessorCount, dev) != hipSuccess) { fprintf(stderr, "kernel_launch: device query failed\n"); grid = -1; return; }
        if (hipFuncSetAttribute((const void*)hybrid_fwd, hipFuncAttributeMaxDynamicSharedMemorySize, LDS_BYTES) != hipSuccess) { fprintf(stderr, "kernel_launch: hipFuncSetAttribute failed\n"); grid = -1; return; }
        if (hipOccupancyMaxActiveBlocksPerMultiprocessor(&per_cu, (const void*)hybrid_fwd, NTHREADS, LDS_BYTES) != hipSuccess || per_cu < 1) { fprintf(stderr, "kernel_launch: occupancy query reports %d blocks per CU\n", per_cu); grid = -1; (void)hipGetLastError(); return; }
        if (cus != 256) { fprintf(stderr, "kernel_launch: built for 256 CUs, device has %d\n", cus); grid = -1; return; }
        grid = cus;
    }
    if (grid < 0) return;
    if (hipMemsetAsync((char*)d_ws + WS_CTL, 0, CTL_ZERO_BYTES, stream) != hipSuccess) { fprintf(stderr, "kernel_launch: memset failed\n"); return; }
    Args a{};
    for (int i = 0; i < 23; ++i) a.in[i] = (const float*)d_in[i];
    a.out = (float*)d_out; a.ws = (unsigned char*)d_ws;
#if MK_PER_PHASE
    for (int p = 0; p < N_PHASES; ++p) { a.ph_lo = p; a.ph_hi = p + 1; hipLaunchKernelGGL(hybrid_fwd, dim3(grid), dim3(NTHREADS), LDS_BYTES, stream, a); }
#else
    a.ph_lo = 0; a.ph_hi = N_PHASES;
    hipLaunchKernelGGL(hybrid_fwd, dim3(grid), dim3(NTHREADS), LDS_BYTES, stream, a);
#endif
    const hipError_t le = hipPeekAtLastError();
    if (le != hipSuccess) fprintf(stderr, "kernel_launch: launch failed: %s\n", hipGetErrorName(le));
}
```
